# Optimizing an MI355X kernel written in HIP

```python
import math
import jax, jax.numpy as jnp
from jax import lax
import numpy as np

D_MODEL = 1024
BATCH = 8
SEQ = 4096
DEPTH = 1

SSM_WIDTH = 512
SSM_GROUP = 16
SSM_GROUPS = SSM_WIDTH // SSM_GROUP
SSM_STATE = 64
DT_MIN = 1e-3
DT_MAX = 1e-1
N_HEADS = 8
HEAD_DIM = 64
ATTN_WIDTH = N_HEADS * HEAD_DIM
IDX_HEADS = 8
IDX_DIM = 64
TOPK_MAX = 256
Q_BLOCK = 128
N_EXPERTS = 64
TOP_K = 8
N_GROUPS = 8
TOPK_GROUPS = 4
EXPERT_DIM = 256
SHARED_DIM = 256
ROUTED_SCALE = 2.5
DISPATCH_BLOCK = 128
EPS = 1e-6

IN_SPLIT_SIZES = (SSM_WIDTH, ATTN_WIDTH, HEAD_DIM, HEAD_DIM, IDX_HEADS * IDX_DIM, IDX_DIM, IDX_HEADS, D_MODEL, D_MODEL)
IN_WIDTH = SSM_WIDTH + ATTN_WIDTH + 2 * HEAD_DIM + IDX_HEADS * IDX_DIM + IDX_DIM + IDX_HEADS + 2 * D_MODEL

kernel_name = "hybrid_s5_dsa_moe_adaln_block"


def rms_norm(x, g):
    xf = x.astype(jnp.float32)
    y = xf * lax.rsqrt(jnp.mean(xf * xf, axis=-1, keepdims=True) + EPS)
    return (y * g.astype(jnp.float32)).astype(x.dtype)


def modulate(x, g, shift, scale):
    return rms_norm(x, g) * (1.0 + scale) + shift


def alibi_slopes(n):
    return 2.0 ** (-8.0 * (jnp.arange(n, dtype=jnp.float32) + 1.0) / n)


def _complex_linear_combine(e1, e2):
    a1r, a1i, b1r, b1i = e1
    a2r, a2i, b2r, b2i = e2
    return (a1r * a2r - a1i * a2i,
            a1r * a2i + a1i * a2r,
            a2r * b1r - a2i * b1i + b2r,
            a2r * b1i + a2i * b1r + b2i)


def s5_mixer(u, lam_re, lam_im, log_dt, b_re, b_im, c_re, c_im, d_skip, w_glu, b_glu):
    bsz, seq, _ = u.shape
    f32 = jnp.float32
    uf = u.astype(f32)
    ug = uf.reshape(bsz, seq, SSM_GROUPS, SSM_GROUP)
    dt = jnp.exp(log_dt.astype(f32))[:, None]
    lr = lam_re.astype(f32)
    li = lam_im.astype(f32)
    mag = jnp.exp(lr * dt)
    a_re = mag * jnp.cos(li * dt)
    a_im = mag * jnp.sin(li * dt)
    den = lr * lr + li * li
    n_re = a_re - 1.0
    f_re = (n_re * lr + a_im * li) / den
    f_im = (a_im * lr - n_re * li) / den
    br = b_re.astype(f32)
    bi = b_im.astype(f32)
    bb_re = f_re[..., None] * br - f_im[..., None] * bi
    bb_im = f_re[..., None] * bi + f_im[..., None] * br
    bu_re = jnp.einsum('blgh,gph->lbgp', ug, bb_re)
    bu_im = jnp.einsum('blgh,gph->lbgp', ug, bb_im)
    shape_a = (seq, 1, SSM_GROUPS, SSM_STATE)
    a_re_t = jnp.broadcast_to(a_re, shape_a)
    a_im_t = jnp.broadcast_to(a_im, shape_a)
    _, _, h_re, h_im = lax.associative_scan(_complex_linear_combine, (a_re_t, a_im_t, bu_re, bu_im), axis=0)
    y = (jnp.einsum('ghp,lbgp->blgh', c_re.astype(f32), h_re)
         - jnp.einsum('ghp,lbgp->blgh', c_im.astype(f32), h_im))
    y = y.reshape(bsz, seq, SSM_WIDTH) + d_skip.astype(f32) * uf
    y = jax.nn.gelu(y)
    y = y * jax.nn.sigmoid(y @ w_glu.astype(f32) + b_glu.astype(f32))
    return y.astype(u.dtype)


def dsa_attention(q, k, v, q_idx, k_idx, w_idx):
    bsz, seq = q.shape[0], q.shape[1]
    f32 = jnp.float32
    topk = min(TOPK_MAX, seq // 4)
    n_blocks = seq // Q_BLOCK
    slopes = alibi_slopes(N_HEADS)
    key_pos = jnp.arange(seq)
    kf = k_idx.astype(f32)

    def to_blocks(a):
        return a.reshape((bsz, n_blocks, Q_BLOCK) + a.shape[2:]).swapaxes(0, 1)

    def block(args):
        qb, qib, wb, blk = args
        q_pos = blk * Q_BLOCK + jnp.arange(Q_BLOCK)
        s_idx = jnp.einsum('bqhd,bsd->bqhs', qib.astype(f32), kf) * (IDX_DIM ** -0.5)
        score = jnp.einsum('bqh,bqhs->bqs', wb.astype(f32) * (IDX_HEADS ** -0.5), jax.nn.relu(s_idx))
        causal = key_pos[None, :] <= q_pos[:, None]
        score = jnp.where(causal[None], score, -jnp.inf)
        _, sel = lax.top_k(score, topk)
        k_sel = jax.vmap(lambda kk, ii: kk[ii])(k, sel)
        v_sel = jax.vmap(lambda vv, ii: vv[ii])(v, sel)
        logits = jnp.einsum('bqhd,bqkd->bhqk', qb, k_sel).astype(f32) * (HEAD_DIM ** -0.5)
        dist = (q_pos[None, :, None] - sel).astype(f32)
        logits = logits - slopes[None, :, None, None] * dist[:, None]
        valid = sel <= q_pos[None, :, None]
        logits = jnp.where(valid[:, None], logits, -jnp.inf)
        p = jax.nn.softmax(logits, axis=-1).astype(v.dtype)
        return jnp.einsum('bhqk,bqkd->bqhd', p, v_sel)

    out = lax.map(block, (to_blocks(q), to_blocks(q_idx), to_blocks(w_idx), jnp.arange(n_blocks)))
    return out.swapaxes(0, 1).reshape(bsz, seq, ATTN_WIDTH)


def moe_ffn(u, w_router, router_bias, w_gate, w_up, w_down, ws_gate, ws_up, ws_down):
    bsz, seq, d = u.shape
    f32 = jnp.float32
    xt = u.reshape(-1, d)
    n_tok = xt.shape[0]
    scores = jax.nn.sigmoid(xt.astype(f32) @ w_router.astype(f32))
    biased = scores + router_bias.astype(f32)
    per_group = N_EXPERTS // N_GROUPS
    group_score = lax.top_k(biased.reshape(n_tok, N_GROUPS, per_group), 2)[0].sum(-1)
    _, gsel = lax.top_k(group_score, TOPK_GROUPS)
    gmask = jnp.any(gsel[:, :, None] == jnp.arange(N_GROUPS)[None, None, :], axis=1)
    emask = jnp.repeat(gmask, per_group, axis=1)
    _, eidx = lax.top_k(jnp.where(emask, biased, -jnp.inf), TOP_K)
    gate = jnp.take_along_axis(scores, eidx, axis=1)
    gate = gate / jnp.sum(gate, axis=-1, keepdims=True) * ROUTED_SCALE

    n_assign = n_tok * TOP_K
    e_flat = eidx.reshape(-1)
    t_flat = jnp.repeat(jnp.arange(n_tok, dtype=jnp.int32), TOP_K)
    g_flat = gate.reshape(-1)
    order = jnp.argsort(e_flat)
    e_s = e_flat[order]
    t_s = t_flat[order]
    g_s = g_flat[order]
    counts = jnp.bincount(e_flat, length=N_EXPERTS)
    padded = (counts + DISPATCH_BLOCK - 1) // DISPATCH_BLOCK * DISPATCH_BLOCK
    start = jnp.cumsum(counts) - counts
    pend = jnp.cumsum(padded)
    pstart = pend - padded
    dest = pstart[e_s] + jnp.arange(n_assign) - start[e_s]
    n_blocks = (n_assign + N_EXPERTS * (DISPATCH_BLOCK - 1) + DISPATCH_BLOCK - 1) // DISPATCH_BLOCK
    total = n_blocks * DISPATCH_BLOCK
    tok_pad = jnp.zeros((total,), jnp.int32).at[dest].set(t_s)
    gate_pad = jnp.zeros((total,), f32).at[dest].set(g_s)
    blk_expert = jnp.minimum(jnp.searchsorted(pend, jnp.arange(n_blocks) * DISPATCH_BLOCK, side='right'), N_EXPERTS - 1)

    def step(acc, blk):
        tok, g, e = blk
        xb = xt[tok]
        hb = jax.nn.silu(xb @ w_gate[e]) * (xb @ w_up[e])
        yb = (hb @ w_down[e]).astype(f32) * g[:, None]
        return acc.at[tok].add(yb), None

    routed, _ = lax.scan(step, jnp.zeros((n_tok, d), f32),
                         (tok_pad.reshape(n_blocks, DISPATCH_BLOCK), gate_pad.reshape(n_blocks, DISPATCH_BLOCK), blk_expert))
    shared = (jax.nn.silu(xt @ ws_gate) * (xt @ ws_up)) @ ws_down
    return (routed + shared.astype(f32)).astype(u.dtype).reshape(bsz, seq, d)


def setup_inputs(seed: int = 0) -> dict:
    key = jax.random.key(seed)
    ks = iter(jax.random.split(key, 40))
    f32 = jnp.float32

    def nrm(shape, s):
        return jax.random.normal(next(ks), shape, f32) * s

    L = DEPTH
    d = D_MODEL
    lam_im_base = math.pi * jnp.arange(SSM_STATE, dtype=f32)
    return {
        "x": nrm((BATCH, SEQ, d), 1.0),
        "c": nrm((BATCH, d), 1.0),
        "w_ada": nrm((L, d, 6 * d), 0.5 * d ** -0.5),
        "b_ada": nrm((L, 6 * d), 0.02),
        "norm1_g": 1.0 + nrm((L, d), 0.02),
        "w_in": nrm((L, d, IN_WIDTH), d ** -0.5),
        "ssm_lambda_re": -0.5 + nrm((L, SSM_GROUPS, SSM_STATE), 0.01),
        "ssm_lambda_im": lam_im_base + nrm((L, SSM_GROUPS, SSM_STATE), 0.01),
        "ssm_log_dt": jax.random.uniform(next(ks), (L, SSM_GROUPS), f32, math.log(DT_MIN), math.log(DT_MAX)),
        "ssm_b_re": nrm((L, SSM_GROUPS, SSM_STATE, SSM_GROUP), (2.0 * SSM_GROUP) ** -0.5),
        "ssm_b_im": nrm((L, SSM_GROUPS, SSM_STATE, SSM_GROUP), (2.0 * SSM_GROUP) ** -0.5),
        "ssm_c_re": nrm((L, SSM_GROUPS, SSM_GROUP, SSM_STATE), (2.0 * SSM_STATE) ** -0.5),
        "ssm_c_im": nrm((L, SSM_GROUPS, SSM_GROUP, SSM_STATE), (2.0 * SSM_STATE) ** -0.5),
        "ssm_d": nrm((L, SSM_WIDTH), 1.0),
        "ssm_w_glu": nrm((L, SSM_WIDTH, SSM_WIDTH), SSM_WIDTH ** -0.5),
        "ssm_b_glu": nrm((L, SSM_WIDTH), 0.02),
        "w_proj_ssm": nrm((L, SSM_WIDTH, d), SSM_WIDTH ** -0.5),
        "w_proj_attn": nrm((L, ATTN_WIDTH, d), ATTN_WIDTH ** -0.5),
        "w_out": nrm((L, d, d), d ** -0.5),
        "norm2_g": 1.0 + nrm((L, d), 0.02),
        "w_router": nrm((L, d, N_EXPERTS), d ** -0.5),
        "router_bias": nrm((L, N_EXPERTS), 0.01),
        "w_exp_gate": nrm((L, N_EXPERTS, d, EXPERT_DIM), d ** -0.5),
        "w_exp_up": nrm((L, N_EXPERTS, d, EXPERT_DIM), d ** -0.5),
        "w_exp_down": nrm((L, N_EXPERTS, EXPERT_DIM, d), EXPERT_DIM ** -0.5),
        "w_sh_gate": nrm((L, d, SHARED_DIM), d ** -0.5),
        "w_sh_up": nrm((L, d, SHARED_DIM), d ** -0.5),
        "w_sh_down": nrm((L, SHARED_DIM, d), SHARED_DIM ** -0.5),
        "norm_f_g": 1.0 + nrm((d,), 0.02),
    }


def reference(x, c, w_ada, b_ada, norm1_g, w_in, ssm_lambda_re, ssm_lambda_im, ssm_log_dt,
              ssm_b_re, ssm_b_im, ssm_c_re, ssm_c_im, ssm_d, ssm_w_glu, ssm_b_glu,
              w_proj_ssm, w_proj_attn, w_out, norm2_g, w_router, router_bias,
              w_exp_gate, w_exp_up, w_exp_down, w_sh_gate, w_sh_up, w_sh_down, norm_f_g):
    bsz, seq, _ = x.shape
    offsets = [int(o) for o in np.cumsum(IN_SPLIT_SIZES)[:-1]]
    h = x
    for layer in range(DEPTH):
        ada = jax.nn.silu(c) @ w_ada[layer] + b_ada[layer]
        shift1, scale1, gate1, shift2, scale2, gate2 = jnp.split(ada[:, None, :], 6, axis=-1)

        u = modulate(h, norm1_g[layer], shift1, scale1)
        proj = u @ w_in[layer]
        u_ssm, q, k, v, q_idx, k_idx, w_idx, g_ssm, g_attn = jnp.split(proj, offsets, axis=-1)
        y_ssm = s5_mixer(u_ssm, ssm_lambda_re[layer], ssm_lambda_im[layer], ssm_log_dt[layer],
                         ssm_b_re[layer], ssm_b_im[layer], ssm_c_re[layer], ssm_c_im[layer],
                         ssm_d[layer], ssm_w_glu[layer], ssm_b_glu[layer])
        y_attn = dsa_attention(q.reshape(bsz, seq, N_HEADS, HEAD_DIM), k, v,
                               q_idx.reshape(bsz, seq, IDX_HEADS, IDX_DIM), k_idx, w_idx)
        mixed = (jax.nn.sigmoid(g_ssm) * (y_ssm @ w_proj_ssm[layer])
                 + jax.nn.sigmoid(g_attn) * (y_attn @ w_proj_attn[layer]))
        h = h + gate1 * (mixed @ w_out[layer])

        u2 = modulate(h, norm2_g[layer], shift2, scale2)
        h = h + gate2 * moe_ffn(u2, w_router[layer], router_bias[layer], w_exp_gate[layer], w_exp_up[layer],
                                w_exp_down[layer], w_sh_gate[layer], w_sh_up[layer], w_sh_down[layer])
    return rms_norm(h, norm_f_g)
```

```cpp
#include <hip/hip_runtime.h>
#include <hip/hip_cooperative_groups.h>
#include <cstdio>
#include <cstdint>
#include <cmath>
namespace cg = cooperative_groups;

#define GAS __attribute__((address_space(1)))
#define LAS __attribute__((address_space(3)))
typedef unsigned short bf16_t;
typedef short bf16x8 __attribute__((ext_vector_type(8)));
typedef float f32x4 __attribute__((ext_vector_type(4)));
typedef float f32x2 __attribute__((ext_vector_type(2)));
typedef unsigned u32x4 __attribute__((ext_vector_type(4)));
typedef unsigned u32x2 __attribute__((ext_vector_type(2)));

constexpr int NB = 8, SEQ = 4096, NTOK = NB * SEQ, D = 1024;
constexpr int IN_W = 3784, NIN = 3840, PROJ_W = 1792, G_W = 2048;
constexpr int C_USSM = 0, C_Q = 512, C_K = 1024, C_V = 1088, C_QI = 1152, C_KI = 1664, C_WI = 1728, PROJ_USED = 1736;
constexpr int NE = 64, TOPK = 8, NCHUNK = 4, CHTOK = NTOK / NCHUNK, NPAIR = NCHUNK * NE, PAIRCAP = CHTOK;
constexpr int HROWS_ROUTED = NTOK * TOPK, HSH_ROW0 = HROWS_ROUTED + 256;
constexpr float EPS = 1e-6f;
constexpr int NWAVES = 8, NTHR = 512;

constexpr size_t MiB = 1u << 20;
constexpr size_t WS_CTL = 0, CTL_BYTES = 1 * MiB;
constexpr size_t WS_ADA = 1 * MiB;
constexpr size_t WS_IDENT = 1 * MiB + 512 * 1024;
constexpr size_t WS_W_IN = 2 * MiB;
constexpr size_t WS_W_GLU = 10 * MiB;
constexpr size_t WS_W_PS = 11 * MiB;
constexpr size_t WS_W_PA = 12 * MiB;
constexpr size_t WS_W_OUT = 13 * MiB;
constexpr size_t WS_W_SGU = 15 * MiB;
constexpr size_t WS_W_SD = 16 * MiB;
constexpr size_t WS_TZF = 17 * MiB, WS_WINF = 18 * MiB, WS_WOUTF = 22 * MiB;
constexpr size_t WS_W_EGU = 26 * MiB;
constexpr size_t WS_W_ED = 90 * MiB;
constexpr size_t WS_EIDX = 122 * MiB;
constexpr size_t WS_GSEL = 123 * MiB;
constexpr size_t WS_POS = 124 * MiB;
constexpr size_t WS_U = 128 * MiB;
constexpr size_t WS_PROJ = 192 * MiB;
constexpr size_t WS_G = 304 * MiB;
constexpr size_t WS_YG = 432 * MiB;
constexpr size_t WS_YATTN = 464 * MiB;
constexpr size_t WS_TOKL = 496 * MiB;
constexpr size_t WS_GATEL = 504 * MiB;
constexpr size_t WS_MERGED = 192 * MiB;
constexpr size_t WS_H = 192 * MiB;
constexpr size_t WS_Y = 340 * MiB;
constexpr size_t WS_NEED = 512 * MiB;
constexpr int CW_CNT = 0;
constexpr int CW_BAR = 4096;

constexpr int STAGE_BYTES = 131072;
constexpr int LDS_RO = STAGE_BYTES;
constexpr int LDS_MISC = LDS_RO + 2048;
constexpr int LDS_CNT = LDS_MISC + 128;
constexpr int LDS_RS = LDS_CNT + 1024;
constexpr int LDS_TB = LDS_RS + 1040;
constexpr int LDS_TD = LDS_TB + 1040;
constexpr int LDS_BYTES = 147456;
static_assert(LDS_TD + 1408 * 4 <= LDS_BYTES, "LDS map");

__device__ __forceinline__ unsigned f2bf(float f) { unsigned u = __builtin_bit_cast(unsigned, f); return (u + 0x7fffu + ((u >> 16) & 1u)) >> 16; }
__device__ __forceinline__ unsigned pk2(float lo, float hi) { return f2bf(lo) | (f2bf(hi) << 16); }
__device__ __forceinline__ float bf2f(unsigned short b) { return __builtin_bit_cast(float, (unsigned)b << 16); }
__device__ __forceinline__ float bflo(unsigned w) { return __builtin_bit_cast(float, w << 16); }
__device__ __forceinline__ float bfhi(unsigned w) { return __builtin_bit_cast(float, w & 0xffff0000u); }
__device__ __forceinline__ float sigmoidf_(float x) { return 1.0f / (1.0f + __expf(-x)); }
__device__ __forceinline__ float wave_sum(float v) {
#pragma unroll
    for (int o = 1; o < 64; o <<= 1) v += __shfl_xor(v, o);
    return v;
}
#define LDS_WAIT() asm volatile("s_waitcnt lgkmcnt(0)" ::: "memory")

namespace pg8 {
constexpr int BM = 256, BK = 64, HALF = 128, HTB = HALF * BK * 2, NXCD = 8, WGM = 8;
__host__ __device__ __forceinline__ int lds_byte(int r, int c) { const int st = (r >> 4) * 2 + (c >> 5), rr = r & 15, cc = c & 31, ob = rr * 64 + cc * 2; return st * 1024 + (ob ^ (((ob >> 9) & 1) << 5)); }
__host__ __device__ __forceinline__ void stage_rc(int b, int& R, int& C) { const int st = b / 1024, sb = b % 1024, swz = sb ^ (((sb >> 9) & 1) << 5); R = (st >> 1) * 16 + swz / 64; C = (st & 1) * 32 + (swz % 64) / 2; }
__host__ __device__ __forceinline__ int perm32(int rho) { const int n = rho >> 4, i = rho & 15; return 8 * (i >> 2) + 4 * n + (i & 3); }

struct Unit { int pm, pn; const char* A; const char* B; const int* rows; int valid; int x0; int mode; const float* gp; };

struct DenseSched {
    int nM, nN, nwg, G, c; const char* A; const char* B; size_t tstep;
    __device__ __forceinline__ void init(const void* A_, const void* B_, int M, int N, int K, int G_, int c_) { nM = M / BM; nN = N / BM; nwg = nM * nN; G = G_; c = c_; A = (const char*)A_; B = (const char*)B_; tstep = (size_t)BM * K * 2; }
    __device__ __forceinline__ bool next(int i, Unit& u) const {
        const long L = (long)i * G + c; if (L >= nwg) return false;
        int wgid = (int)L; { const int q = nwg / NXCD, r = nwg % NXCD, xcd = wgid % NXCD, off = wgid / NXCD; wgid = (xcd < r ? xcd * (q + 1) : r * (q + 1) + (xcd - r) * q) + off; }
        const int nig = WGM * nN, gid = wgid / nig, fm = gid * WGM, gsz = (nM - fm) < WGM ? (nM - fm) : WGM;
        u.pm = fm + ((wgid % nig) % gsz); u.pn = (wgid % nig) / gsz;
        u.A = A + (size_t)u.pm * tstep; u.B = B + (size_t)u.pn * tstep; u.rows = nullptr; u.valid = 256; u.x0 = 0; u.mode = 0; u.gp = nullptr; return true;
    }
};

template <class Epi, class Sched, bool GATHER>
__device__ __forceinline__ void gemm_phase(LAS unsigned char* lds, const int K, const Sched& S, const Epi& E) {
    const int tid = threadIdx.x, wid = __builtin_amdgcn_readfirstlane(tid >> 6), lane = tid & 63, wr = wid >> 2, wc = wid & 3, fr = lane & 15, fq = lane >> 4;
    const int nt = K / BK;
    unsigned voffA[2], voffB[2]; int roA[2];
#pragma unroll
    for (int i = 0; i < 2; ++i) { int R, C; stage_rc(tid * 16 + i * 8192, R, C); const int Rb = (R & ~31) + perm32(R & 31);
        voffA[i] = GATHER ? (unsigned)(C * 2) : (unsigned)(R * K + C) * 2u; voffB[i] = (unsigned)(Rb * K + C) * 2u; roA[i] = R * 4; }
    const size_t kstep = (size_t)(BK * 2);
    const size_t hstep = (size_t)HALF * K * 2;
    const unsigned ldsw = (unsigned)wid * 1024u;
    const int aoff = lds_byte(wr * 64 + fr, fq * 8), boff = lds_byte(wc * 32 + fr, fq * 8);
    LAS unsigned char* ro = lds + LDS_RO;
#define PG8_SA(b, h) (((b) * 2 + (h)) * HTB)
#define PG8_SB(b, h) ((4 + (b) * 2 + (h)) * HTB)
#define PG8_STAGE_B(bufoff, gbase) do { _Pragma("unroll") for (int _i = 0; _i < 2; ++_i) \
        __builtin_amdgcn_global_load_lds((const unsigned*)((const char*)(gbase) + voffB[_i]), (LAS unsigned*)(lds + (bufoff) + ldsw + _i * 8192), 16, 0, 0); } while (0)
#define PG8_STAGE_A(bufoff, gbase, h, slot) do { _Pragma("unroll") for (int _i = 0; _i < 2; ++_i) { \
        unsigned _vo = voffA[_i]; const char* _gb = (const char*)(gbase); \
        if (GATHER) _vo += *(const LAS unsigned*)(ro + (slot) * 1024 + (h) * 512 + roA[_i]); else _gb += (h) * hstep; \
        __builtin_amdgcn_global_load_lds((const unsigned*)(_gb + _vo), (LAS unsigned*)(lds + (bufoff) + ldsw + _i * 8192), 16, 0, 0); } } while (0)
#define PG8_LDA(dst, b, h) do { _Pragma("unroll") for (int m = 0; m < 4; ++m) _Pragma("unroll") for (int k = 0; k < 2; ++k) dst[m][k] = *(const LAS bf16x8*)(lds + PG8_SA(b, h) + aoff + m * 2048 + k * 1024); } while (0)
#define PG8_LDB(dst, b, h) do { _Pragma("unroll") for (int n = 0; n < 2; ++n) _Pragma("unroll") for (int k = 0; k < 2; ++k) dst[n][k] = *(const LAS bf16x8*)(lds + PG8_SB(b, h) + boff + n * 2048 + k * 1024); } while (0)
#define PG8_MMA(ai, bj, At, Bt) do { __builtin_amdgcn_s_setprio(1); _Pragma("unroll") for (int m = 0; m < 4; ++m) _Pragma("unroll") for (int n = 0; n < 2; ++n) _Pragma("unroll") for (int k = 0; k < 2; ++k) \
        acc[ai][bj][m][n] = __builtin_amdgcn_mfma_f32_16x16x32_bf16(Bt[n][k], At[m][k], acc[ai][bj][m][n], 0, 0, 0); __builtin_amdgcn_s_setprio(0); } while (0)
#define PG8_WAIT_V(n) asm volatile("s_waitcnt vmcnt(" #n ")" ::: "memory")
#define PG8_WAIT_L(n) asm volatile("s_waitcnt lgkmcnt(" #n ")" ::: "memory")
#define PG8_BAR __builtin_amdgcn_s_barrier()
#define PG8_SCHED __builtin_amdgcn_sched_barrier(0)
    Unit cur, nxt; int ui = 0;
    if (!S.next(0, cur)) return;
    f32x4 acc[2][2][4][2];
#pragma unroll
    for (int a = 0; a < 2; ++a)
#pragma unroll
        for (int b = 0; b < 2; ++b)
#pragma unroll
            for (int m = 0; m < 4; ++m)
#pragma unroll
                for (int n = 0; n < 2; ++n) acc[a][b][m][n] = (f32x4){0.f, 0.f, 0.f, 0.f};
    bf16x8 At[4][2], B0[2][2], B1[2][2];
    const char* cA = cur.A; const char* cB = cur.B;
    if (GATHER) {
        if (tid < 256) { const int r = tid < cur.valid ? cur.rows[tid] : 0; *(LAS unsigned*)(ro + tid * 4) = (unsigned)r * (unsigned)(K * 2); }
        __syncthreads();
    }
    PG8_STAGE_B(PG8_SB(0, 0), cB); PG8_STAGE_B(PG8_SB(0, 1), cB + hstep); PG8_STAGE_A(PG8_SA(0, 0), cA, 0, 0); PG8_STAGE_A(PG8_SA(0, 1), cA, 1, 0);
    if (wr == 1) PG8_BAR;
    PG8_WAIT_V(2); PG8_BAR;
    PG8_STAGE_B(PG8_SB(1, 0), cB + kstep); PG8_STAGE_A(PG8_SA(1, 0), cA + kstep, 0, 0); PG8_STAGE_B(PG8_SB(1, 1), cB + hstep + kstep);
    PG8_WAIT_V(6); PG8_BAR;
    for (;;) {
        const bool has_next = S.next(ui + 1, nxt);
        const int cslot = ui & 1, nslot = has_next ? (cslot ^ 1) : cslot;
        if (GATHER) { if (has_next && tid < 256) { const int r = tid < nxt.valid ? nxt.rows[tid] : 0; *(LAS unsigned*)(ro + nslot * 1024 + tid * 4) = (unsigned)r * (unsigned)(K * 2); } }
        const char* nA = has_next ? nxt.A : cA; const char* nB = has_next ? nxt.B : cB;
#pragma unroll 1
        for (int t = 0; t < nt; t += 2) {
            const bool last = (t == nt - 2);
            const char* a1 = cA + (size_t)(t + 1) * kstep;
            const char* a2 = last ? nA : cA + (size_t)(t + 2) * kstep; const char* b2 = last ? nB : cB + (size_t)(t + 2) * kstep;
            const char* a3 = a2 + kstep; const char* b3 = b2 + kstep;
            const int slot2 = last ? nslot : cslot;
            PG8_LDB(B0, 0, 0); PG8_LDB(B1, 0, 1); PG8_SCHED; PG8_LDA(At, 0, 0); PG8_STAGE_A(PG8_SA(1, 1), a1, 1, cslot);
            PG8_WAIT_V(8); PG8_WAIT_L(0); PG8_BAR; PG8_MMA(0, 0, At, B0); PG8_MMA(0, 1, At, B1); PG8_BAR; PG8_SCHED;
            PG8_LDA(At, 0, 1); PG8_STAGE_B(PG8_SB(0, 0), b2); PG8_STAGE_B(PG8_SB(0, 1), b2 + hstep); PG8_STAGE_A(PG8_SA(0, 0), a2, 0, slot2);
            PG8_WAIT_V(8); PG8_WAIT_L(0); PG8_BAR; PG8_MMA(1, 0, At, B0); PG8_MMA(1, 1, At, B1); PG8_BAR; PG8_SCHED;
            PG8_LDB(B0, 1, 0); PG8_LDB(B1, 1, 1); PG8_SCHED; PG8_LDA(At, 1, 0); PG8_STAGE_A(PG8_SA(0, 1), a2, 1, slot2);
            PG8_WAIT_V(8); PG8_WAIT_L(0); PG8_BAR; PG8_MMA(0, 0, At, B0); PG8_MMA(0, 1, At, B1); PG8_BAR; PG8_SCHED;
            PG8_LDA(At, 1, 1); PG8_STAGE_B(PG8_SB(1, 0), b3); PG8_STAGE_B(PG8_SB(1, 1), b3 + hstep); PG8_STAGE_A(PG8_SA(1, 0), a3, 0, slot2);
            PG8_WAIT_V(8); PG8_WAIT_L(0); PG8_BAR; PG8_MMA(1, 0, At, B0); PG8_MMA(1, 1, At, B1); PG8_BAR; PG8_SCHED;
        }
        if (wr == 0) PG8_BAR;
        E(acc, cur, wr, wc, fr, fq);
        if (!has_next) break;
#pragma unroll
        for (int a = 0; a < 2; ++a)
#pragma unroll
            for (int b = 0; b < 2; ++b)
#pragma unroll
                for (int m = 0; m < 4; ++m)
#pragma unroll
                    for (int n = 0; n < 2; ++n) acc[a][b][m][n] = (f32x4){0.f, 0.f, 0.f, 0.f};
        cur = nxt; cA = nA; cB = nB; ++ui;
        if (wr == 1) PG8_BAR;
    }
    PG8_WAIT_V(0);
    PG8_BAR;
#undef PG8_SA
#undef PG8_SB
#undef PG8_STAGE_A
#undef PG8_STAGE_B
#undef PG8_LDA
#undef PG8_LDB
#undef PG8_MMA
#undef PG8_WAIT_V
#undef PG8_WAIT_L
#undef PG8_BAR
#undef PG8_SCHED
}
}
using pg8::Unit;

#define EPI_LOOP_BEGIN \
    _Pragma("unroll") for (int ai = 0; ai < 2; ++ai) _Pragma("unroll") for (int m = 0; m < 4; ++m) { const int rl = ai * 128 + wr * 64 + m * 16 + fr; const int row = u.pm * 256 + rl; \
    _Pragma("unroll") for (int bj = 0; bj < 2; ++bj) { const int col = u.pn * 256 + bj * 128 + wc * 32 + 8 * fq; const f32x4 v0 = acc[ai][bj][m][0], v1 = acc[ai][bj][m][1]; (void)row; (void)col; (void)rl;
#define EPI_LOOP_END } if (m & 1) asm volatile("" ::: "memory"); }
__device__ __forceinline__ u32x4 pack8(const f32x4 a, const f32x4 b) { u32x4 w; w.x = pk2(a[0], a[1]); w.y = pk2(a[2], a[3]); w.z = pk2(b[0], b[1]); w.w = pk2(b[2], b[3]); return w; }
__device__ __forceinline__ void unpack8(const u32x4 w, float (&f)[8]) { f[0] = bflo(w.x); f[1] = bfhi(w.x); f[2] = bflo(w.y); f[3] = bfhi(w.y); f[4] = bflo(w.z); f[5] = bfhi(w.z); f[6] = bflo(w.w); f[7] = bfhi(w.w); }

struct EpiInProj {
    bf16_t* PROJ; bf16_t* G;
    __device__ __forceinline__ void operator()(const f32x4 (&acc)[2][2][4][2], const Unit& u, int wr, int wc, int fr, int fq) const {
        EPI_LOOP_BEGIN
            if (u.pn < 7) { *(u32x4*)(PROJ + (size_t)row * PROJ_W + col) = pack8(v0, v1); }
            else { f32x4 s0, s1;
#pragma unroll
                for (int j = 0; j < 4; ++j) { s0[j] = sigmoidf_(v0[j]); s1[j] = sigmoidf_(v1[j]); }
                *(u32x4*)(G + (size_t)row * G_W + (col - PROJ_W)) = pack8(s0, s1); }
        EPI_LOOP_END
    }
};
struct EpiGlu {
    const bf16_t* YG; const float* bias; bf16_t* O;
    __device__ __forceinline__ void operator()(const f32x4 (&acc)[2][2][4][2], const Unit& u, int wr, int wc, int fr, int fq) const {
        EPI_LOOP_BEGIN
            float y[8]; unpack8(*(const u32x4*)(YG + (size_t)row * 512 + col), y);
            const f32x4 b0 = *(const f32x4*)(bias + col), b1 = *(const f32x4*)(bias + col + 4); f32x4 o0, o1;
#pragma unroll
            for (int j = 0; j < 4; ++j) { o0[j] = y[j] * sigmoidf_(v0[j] + b0[j]); o1[j] = y[4 + j] * sigmoidf_(v1[j] + b1[j]); }
            *(u32x4*)(O + (size_t)row * 512 + col) = pack8(o0, o1);
        EPI_LOOP_END
    }
};
struct EpiMixA {
    const bf16_t* G; float* T;
    __device__ __forceinline__ void operator()(const f32x4 (&acc)[2][2][4][2], const Unit& u, int wr, int wc, int fr, int fq) const {
        EPI_LOOP_BEGIN
            float g[8]; unpack8(*(const u32x4*)(G + (size_t)row * G_W + col), g); f32x4 o0, o1;
#pragma unroll
            for (int j = 0; j < 4; ++j) { o0[j] = g[j] * v0[j]; o1[j] = g[4 + j] * v1[j]; }
            *(f32x4*)(T + (size_t)row * D + col) = o0; *(f32x4*)(T + (size_t)row * D + col + 4) = o1;
        EPI_LOOP_END
    }
};
struct EpiMixB {
    const bf16_t* G; const float* T; bf16_t* O;
    __device__ __forceinline__ void operator()(const f32x4 (&acc)[2][2][4][2], const Unit& u, int wr, int wc, int fr, int fq) const {
        EPI_LOOP_BEGIN
            float g[8]; unpack8(*(const u32x4*)(G + (size_t)row * G_W + 1024 + col), g);
            const f32x4 t0 = *(const f32x4*)(T + (size_t)row * D + col), t1 = *(const f32x4*)(T + (size_t)row * D + col + 4); f32x4 o0, o1;
#pragma unroll
            for (int j = 0; j < 4; ++j) { o0[j] = t0[j] + g[j] * v0[j]; o1[j] = t1[j] + g[4 + j] * v1[j]; }
            *(u32x4*)(O + (size_t)row * D + col) = pack8(o0, o1);
        EPI_LOOP_END
    }
};
struct EpiOut {
    const float* X; const float* ada; float* O;
    __device__ __forceinline__ void operator()(const f32x4 (&acc)[2][2][4][2], const Unit& u, int wr, int wc, int fr, int fq) const {
        EPI_LOOP_BEGIN
            const float* gp = ada + (size_t)(row >> 12) * 6144 + 2048 + col;
            const f32x4 g0 = *(const f32x4*)gp, g1 = *(const f32x4*)(gp + 4);
            const f32x4 x0 = *(const f32x4*)(X + (size_t)row * D + col), x1 = *(const f32x4*)(X + (size_t)row * D + col + 4);
            *(f32x4*)(O + (size_t)row * D + col) = x0 + g0 * v0; *(f32x4*)(O + (size_t)row * D + col + 4) = x1 + g1 * v1;
        EPI_LOOP_END
    }
};
struct EpiMoe1 {
    bf16_t* H;
    __device__ __forceinline__ void operator()(const f32x4 (&acc)[2][2][4][2], const Unit& u, int wr, int wc, int fr, int fq) const {
        EPI_LOOP_BEGIN
            if (rl < u.valid) { const int hc = u.pn * 128 + bj * 64 + wc * 16 + 4 * fq; float o[4];
#pragma unroll
                for (int j = 0; j < 4; ++j) o[j] = v0[j] * sigmoidf_(v0[j]) * v1[j];
                u32x2 w; w.x = pk2(o[0], o[1]); w.y = pk2(o[2], o[3]);
                *(u32x2*)(H + (size_t)(u.x0 + rl) * 256 + hc) = w; }
        EPI_LOOP_END
    }
};
struct EpiMoe2 {
    bf16_t* Y; float* O; const float* ada;
    __device__ __forceinline__ void operator()(const f32x4 (&acc)[2][2][4][2], const Unit& u, int wr, int wc, int fr, int fq) const {
        EPI_LOOP_BEGIN
            if (u.mode == 0) {
                if (rl < u.valid) { const float g = u.gp[rl]; *(u32x4*)(Y + (size_t)(u.x0 + rl) * D + col) = pack8(v0 * g, v1 * g); }
            } else {
                const int tok = u.x0 + rl; const float* gp = ada + (size_t)(tok >> 12) * 6144 + 5120 + col;
                const f32x4 g0 = *(const f32x4*)gp, g1 = *(const f32x4*)(gp + 4);
                float* op = O + (size_t)tok * D + col;
                const f32x4 a0 = *(const f32x4*)op, a1 = *(const f32x4*)(op + 4);
                *(f32x4*)op = a0 + g0 * v0; *(f32x4*)(op + 4) = a1 + g1 * v1;
            }
        EPI_LOOP_END
    }
};

__device__ __forceinline__ void build_moe_tables(LAS unsigned char* lds, const unsigned* cnt_g) {
    LAS int* CNT = (LAS int*)(lds + LDS_CNT); LAS int* RS = (LAS int*)(lds + LDS_RS); LAS int* TB = (LAS int*)(lds + LDS_TB); LAS unsigned* TD = (LAS unsigned*)(lds + LDS_TD);
    const int tid = threadIdx.x;
    __syncthreads();
    if (tid < 256) { int c = (int)cnt_g[tid]; c = c < 0 ? 0 : (c > PAIRCAP ? PAIRCAP : c); CNT[tid] = c; }
    __syncthreads();
    if (tid == 0) { int rs = 0, tb = 0; for (int j = 0; j < 256; ++j) { RS[j] = rs; TB[j] = tb; const int c = CNT[j]; rs += c; tb += (c + 255) >> 8; } RS[256] = rs; TB[256] = tb; }
    __syncthreads();
    if (tid < 256) { const int c = CNT[tid], nt = (c + 255) >> 8, tb = TB[tid]; for (int k = 0; k < nt; ++k) TD[tb + k] = (unsigned)tid | ((unsigned)k << 9); }
    __syncthreads();
}
#define RFL(x) __builtin_amdgcn_readfirstlane(x)
struct Moe1Sched {
    LAS unsigned char* lds; int G, c; const char* U2; const int* tokl; const int* ident; const char* Wegu; const char* Wsgu;
    __device__ __forceinline__ bool next(int i, Unit& u) const {
        LAS int* CNT = (LAS int*)(lds + LDS_CNT); LAS int* RS = (LAS int*)(lds + LDS_RS); LAS int* TB = (LAS int*)(lds + LDS_TB); LAS unsigned* TD = (LAS unsigned*)(lds + LDS_TD);
        const int ntr = RFL(TB[256]); const int L = i * G + c; if (L >= (ntr + 128) * 2) return false;
        const int tau = L >> 1; u.pn = L & 1; u.pm = 0; u.A = U2; u.mode = 0; u.gp = nullptr;
        if (tau < ntr) { const unsigned d = (unsigned)RFL((int)TD[tau]); const int j = d & 511, k = d >> 9; u.valid = min(256, RFL(CNT[j]) - k * 256); u.rows = tokl + (size_t)(j * PAIRCAP + k * 256); u.x0 = RFL(RS[j]) + k * 256;
            u.B = Wegu + (size_t)(j & 63) * (512 * 1024 * 2) + (size_t)u.pn * (256 * 1024 * 2); }
        else { const int k = tau - ntr; u.valid = 256; u.rows = ident + k * 256; u.x0 = HSH_ROW0 + k * 256; u.B = Wsgu + (size_t)u.pn * (256 * 1024 * 2); }
        return true;
    }
};
struct Moe2Sched {
    LAS unsigned char* lds; int G, c, ch; const char* H; const float* gatel; const char* Wed; const char* Wsd;
    __device__ __forceinline__ bool next(int i, Unit& u) const {
        LAS int* CNT = (LAS int*)(lds + LDS_CNT); LAS int* RS = (LAS int*)(lds + LDS_RS); LAS int* TB = (LAS int*)(lds + LDS_TB); LAS unsigned* TD = (LAS unsigned*)(lds + LDS_TD);
        const int t0 = RFL(TB[64 * ch]), ntr = RFL(TB[64 * ch + 64]) - t0; const int L = i * G + c; if (L >= (ntr + 32) * 4) return false;
        const int tau = L >> 2; u.pn = L & 3; u.pm = 0; u.rows = nullptr;
        if (tau < ntr) { const unsigned d = (unsigned)RFL((int)TD[t0 + tau]); const int j = d & 511, k = d >> 9; u.valid = min(256, RFL(CNT[j]) - k * 256); u.mode = 0;
            const int rsj = RFL(RS[j]);
            u.A = H + (size_t)(rsj + k * 256) * 512; u.x0 = rsj - RFL(RS[64 * ch]) + k * 256; u.gp = gatel + (size_t)(j * PAIRCAP + k * 256);
            u.B = Wed + (size_t)(j & 63) * (1024 * 256 * 2) + (size_t)u.pn * (256 * 256 * 2); }
        else { const int k = 32 * ch + (tau - ntr); u.valid = 256; u.mode = 1; u.A = H + (size_t)(HSH_ROW0 + k * 256) * 512; u.x0 = k * 256; u.gp = nullptr; u.B = Wsd + (size_t)u.pn * (256 * 256 * 2); }
        return true;
    }
};

struct Params { const float* in[29]; float* out; unsigned char* ws; int ph_lo, ph_hi; };

template <class RowMap>
__device__ __forceinline__ void transpose_item(const float* W, int K, int N, bf16_t* WT, RowMap rm, LAS float* scr, int item, int lane) {
    const int nblk = (N + 31) >> 5, kb = item / nblk, nb = item - kb * nblk, k0 = 64 * kb, n0 = 32 * nb;
    const int nn = n0 + (lane & 31);
#pragma unroll 8
    for (int i = 0; i < 32; ++i) { const int kk = 2 * i + (lane >> 5); scr[kk * 33 + (lane & 31)] = (nn < N) ? W[(size_t)(k0 + kk) * N + nn] : 0.f; }
    LDS_WAIT(); asm volatile("" ::: "memory");
    const int c = lane & 7;
#pragma unroll
    for (int j = 0; j < 4; ++j) { const int nl = (lane >> 3) + 8 * j; const LAS float* s = scr + (8 * c) * 33 + nl;
        u32x4 o; o.x = pk2(s[0 * 33], s[1 * 33]); o.y = pk2(s[2 * 33], s[3 * 33]); o.z = pk2(s[4 * 33], s[5 * 33]); o.w = pk2(s[6 * 33], s[7 * 33]);
        if (n0 + nl < N) *(u32x4*)(WT + (size_t)rm(n0 + nl) * K + k0 + 8 * c) = o; }
    LDS_WAIT(); asm volatile("" ::: "memory");
}
struct RmId { __device__ int operator()(int n) const { return n; } };
struct RmIn { __device__ int operator()(int n) const { return n < PROJ_USED ? n : n + (PROJ_W - PROJ_USED); } };
struct RmGate { __device__ int operator()(int n) const { return 8 * (n >> 2) + (n & 3); } };
struct RmUp { __device__ int operator()(int n) const { return 8 * (n >> 2) + 4 + (n & 3); } };

__device__ __forceinline__ void p0_prep(const Params& p, LAS unsigned char* lds, int vcu, int G) {
    const int tid = threadIdx.x, lane = tid & 63, wave = __builtin_amdgcn_readfirstlane(tid >> 6);
    unsigned char* ws = p.ws;
    {
        LAS float* sc = (LAS float*)lds;
        LAS float* red = (LAS float*)(lds + 32768);
        const float* c = p.in[1]; const float* w = p.in[2]; const float* bb = p.in[3]; float* ada = (float*)(ws + WS_ADA);
        bool loaded = false;
        for (int it = vcu; it < 96; it += G) {
            if (!loaded) { for (int i = tid; i < 8192; i += NTHR) { const float v = c[i]; sc[i] = v * sigmoidf_(v); } loaded = true; }
            __syncthreads();
            const int kq = tid >> 6, col = it * 64 + lane; float a[8];
#pragma unroll
            for (int b = 0; b < 8; ++b) a[b] = 0.f;
            for (int k = kq * 128; k < kq * 128 + 128; ++k) { const float wv = w[(size_t)k * 6144 + col];
#pragma unroll
                for (int b = 0; b < 8; ++b) a[b] += sc[b * 1024 + k] * wv; }
#pragma unroll
            for (int b = 0; b < 8; ++b) red[(kq * 8 + b) * 64 + lane] = a[b];
            __syncthreads();
            { const int b = tid >> 6; float s = bb[col];
#pragma unroll
              for (int q = 0; q < 8; ++q) s += red[(q * 8 + b) * 64 + lane];
              ada[b * 6144 + col] = s; }
            __syncthreads();
        }
        __syncthreads();
    }
    {
        LAS float* scr = (LAS float*)(lds + wave * 8704);
        const int gw = vcu * NWAVES + wave, NGW = G * NWAVES;
        constexpr int I_IN = 16 * 119, I_GLU = 8 * 16, I_PS = 8 * 32, I_OUT = 16 * 32, I_SG = 16 * 8, I_SD = 4 * 32, I_EG = 64 * 128;
        constexpr int NITEMS = I_IN + I_GLU + 2 * I_PS + I_OUT + 2 * I_SG + I_SD + 3 * I_EG;
        for (int it = gw; it < NITEMS; it += NGW) {
            int r = it;
            if (r < I_IN) { transpose_item(p.in[5], 1024, IN_W, (bf16_t*)(ws + WS_W_IN), RmIn(), scr, r, lane); continue; } r -= I_IN;
            if (r < I_GLU) { transpose_item(p.in[14], 512, 512, (bf16_t*)(ws + WS_W_GLU), RmId(), scr, r, lane); continue; } r -= I_GLU;
            if (r < I_PS) { transpose_item(p.in[16], 512, 1024, (bf16_t*)(ws + WS_W_PS), RmId(), scr, r, lane); continue; } r -= I_PS;
            if (r < I_PS) { transpose_item(p.in[17], 512, 1024, (bf16_t*)(ws + WS_W_PA), RmId(), scr, r, lane); continue; } r -= I_PS;
            if (r < I_OUT) { transpose_item(p.in[18], 1024, 1024, (bf16_t*)(ws + WS_W_OUT), RmId(), scr, r, lane); continue; } r -= I_OUT;
            if (r < I_SG) { transpose_item(p.in[25], 1024, 256, (bf16_t*)(ws + WS_W_SGU), RmGate(), scr, r, lane); continue; } r -= I_SG;
            if (r < I_SG) { transpose_item(p.in[26], 1024, 256, (bf16_t*)(ws + WS_W_SGU), RmUp(), scr, r, lane); continue; } r -= I_SG;
            if (r < I_SD) { transpose_item(p.in[27], 256, 1024, (bf16_t*)(ws + WS_W_SD), RmId(), scr, r, lane); continue; } r -= I_SD;
            if (r < I_EG) { const int e = r >> 7; transpose_item(p.in[22] + (size_t)e * 262144, 1024, 256, (bf16_t*)(ws + WS_W_EGU) + (size_t)e * 524288, RmGate(), scr, r & 127, lane); continue; } r -= I_EG;
            if (r < I_EG) { const int e = r >> 7; transpose_item(p.in[23] + (size_t)e * 262144, 1024, 256, (bf16_t*)(ws + WS_W_EGU) + (size_t)e * 524288, RmUp(), scr, r & 127, lane); continue; } r -= I_EG;
            { const int e = r >> 7; transpose_item(p.in[24] + (size_t)e * 262144, 256, 1024, (bf16_t*)(ws + WS_W_ED) + (size_t)e * 262144, RmId(), scr, r & 127, lane); }
        }
    }
    { const int gt = vcu * NTHR + tid, NGT = G * NTHR;
      u32x4* z = (u32x4*)(ws + WS_W_IN + (size_t)PROJ_USED * 1024 * 2);
      for (int i = gt; i < (PROJ_W - PROJ_USED) * 1024 * 2 / 16; i += NGT) z[i] = (u32x4){0u, 0u, 0u, 0u};
      int* id = (int*)(ws + WS_IDENT); for (int i = gt; i < NTOK; i += NGT) id[i] = i; }
}

__device__ __forceinline__ void p1_modulate(const Params& p, int vcu, int G) {
    const int tid = threadIdx.x, lane = tid & 63, wave = tid >> 6; const int gw = vcu * NWAVES + wave, NGW = G * NWAVES;
    const float* ada = (const float*)(p.ws + WS_ADA); const float* g1 = p.in[4]; bf16_t* U = (bf16_t*)(p.ws + WS_U);
    for (int m = gw; m < NTOK; m += NGW) {
        const f32x4* xr = (const f32x4*)(p.in[0] + (size_t)m * D) + lane; const int b = m >> 12;
        f32x4 v[4]; float s = 0.f;
#pragma unroll
        for (int j = 0; j < 4; ++j) { v[j] = xr[64 * j]; s += (v[j].x * v[j].x + v[j].y * v[j].y) + (v[j].z * v[j].z + v[j].w * v[j].w); }
        const float rstd = 1.0f / sqrtf(wave_sum(s) * (1.f / D) + EPS);
        unsigned long long* o8 = (unsigned long long*)(U + (size_t)m * D) + lane;
#pragma unroll
        for (int j = 0; j < 4; ++j) { const int c0 = 4 * lane + 256 * j;
            const f32x4 gg = *(const f32x4*)(g1 + c0), sh = *(const f32x4*)(ada + b * 6144 + c0), scl = *(const f32x4*)(ada + b * 6144 + 1024 + c0);
            const f32x4 y = v[j] * rstd * gg * (scl + 1.0f) + sh;
            o8[64 * j] = (unsigned long long)pk2(y.x, y.y) | ((unsigned long long)pk2(y.z, y.w) << 32); }
    }
}

__device__ __forceinline__ void p_combine(const Params& p, LAS unsigned char* lds, int vcu, int G, int ch) {
    LAS int* RS = (LAS int*)(lds + LDS_RS);
    const int tid = threadIdx.x, lane = tid & 63, wave = tid >> 6; const int gw = vcu * NWAVES + wave, NGW = G * NWAVES;
    const float* ada = (const float*)(p.ws + WS_ADA); const float* gf = p.in[28];
    const int* eidx = (const int*)(p.ws + WS_EIDX); const int* pos = (const int*)(p.ws + WS_POS); const bf16_t* Y = (const bf16_t*)(p.ws + WS_Y);
    const int rs0 = RS[64 * ch];
    for (int mi = gw; mi < CHTOK; mi += NGW) {
        const int m = ch * CHTOK + mi; const int b = m >> 12;
        float a[16];
#pragma unroll
        for (int j = 0; j < 16; ++j) a[j] = 0.f;
#pragma unroll
        for (int k = 0; k < TOPK; ++k) { const int e = eidx[m * 8 + k], ps = pos[m * 8 + k]; const int yr = RS[64 * ch + e] - rs0 + ps;
            const bf16_t* yp = Y + (size_t)yr * D + lane * 8; float f[8];
            unpack8(*(const u32x4*)yp, f);
#pragma unroll
            for (int j = 0; j < 8; ++j) a[j] += f[j];
            unpack8(*(const u32x4*)(yp + 512), f);
#pragma unroll
            for (int j = 0; j < 8; ++j) a[8 + j] += f[j]; }
        float* orow = p.out + (size_t)m * D; float r[16]; float s = 0.f;
#pragma unroll
        for (int hh = 0; hh < 2; ++hh) { const int c0 = hh * 512 + lane * 8;
#pragma unroll
            for (int q = 0; q < 2; ++q) { const f32x4 h = *(const f32x4*)(orow + c0 + 4 * q), g2 = *(const f32x4*)(ada + b * 6144 + 5120 + c0 + 4 * q);
#pragma unroll
                for (int j = 0; j < 4; ++j) { const float v = h[j] + g2[j] * a[hh * 8 + q * 4 + j]; r[hh * 8 + q * 4 + j] = v; s += v * v; } } }
        const float rstd = 1.0f / sqrtf(wave_sum(s) * (1.f / D) + EPS);
#pragma unroll
        for (int hh = 0; hh < 2; ++hh) { const int c0 = hh * 512 + lane * 8;
#pragma unroll
            for (int q = 0; q < 2; ++q) { const f32x4 g = *(const f32x4*)(gf + c0 + 4 * q); f32x4 o;
#pragma unroll
                for (int j = 0; j < 4; ++j) o[j] = r[hh * 8 + q * 4 + j] * rstd * g[j];
                *(f32x4*)(orow + c0 + 4 * q) = o; } }
    }
}

enum { PH_PREP = 0, PH_MOD, PH_INPROJ, PH_MIX  , PH_GLU, PH_MIXAB, PH_OUT, PH_ROUTE  , PH_MOE1, PH_MOE2_0, PH_COMB_0, PH_MOE2_1, PH_COMB_1, PH_MOE2_2, PH_COMB_2, PH_MOE2_3, PH_COMB_3, PH_END };

__global__ void __launch_bounds__(NTHR, 2) mega(Params p) {
    extern __shared__ __attribute__((aligned(16))) unsigned char lds_raw[];
    LAS unsigned char* lds = (LAS unsigned char*)lds_raw;
    const int G = gridDim.x, bx = blockIdx.x;
    const int vcu = (G % 8 == 0) ? (bx % 8) * (G / 8) + bx / 8 : bx;
    unsigned char* ws = p.ws;
    const int lo = p.ph_lo, hi = p.ph_hi;
#ifndef ONLY_PH
#define ONLY_PH -1
#endif
#define IN(k) ((ONLY_PH < 0 || ONLY_PH == (k) || (ONLY_PH == 100 && (k) >= PH_MOE2_0) || (ONLY_PH == 101 && (k) >= PH_MOE2_0 && (((k) - PH_MOE2_0) & 1) == 0) || (ONLY_PH == 102 && (k) >= PH_MOE2_0 && (((k) - PH_MOE2_0) & 1) == 1)) && lo <= (k) && (k) < hi)
    if (IN(PH_PREP)) p0_prep(p, lds, vcu, G);
    if (IN(PH_MOD)) p1_modulate(p, vcu, G);
    if (IN(PH_INPROJ)) {
        pg8::DenseSched S; S.init(ws + WS_U, ws + WS_W_IN, NTOK, NIN, 1024, G, bx);
        EpiInProj E{(bf16_t*)(ws + WS_PROJ), (bf16_t*)(ws + WS_G)};
        pg8::gemm_phase<EpiInProj, pg8::DenseSched, false>(lds, 1024, S, E);
    }
    if (IN(PH_GLU)) {
        pg8::DenseSched S; S.init(ws + WS_YG, ws + WS_W_GLU, NTOK, 512, 512, G, bx);
        EpiGlu E{(const bf16_t*)(ws + WS_YG), p.in[15], (bf16_t*)(ws + WS_U)};
        pg8::gemm_phase<EpiGlu, pg8::DenseSched, false>(lds, 512, S, E);
    }
    if (IN(PH_MIXAB)) {
        { pg8::DenseSched S; S.init(ws + WS_U, ws + WS_W_PS, NTOK, 1024, 512, G, bx);
          EpiMixA E{(const bf16_t*)(ws + WS_G), p.out};
          pg8::gemm_phase<EpiMixA, pg8::DenseSched, false>(lds, 512, S, E); }
        { pg8::DenseSched S; S.init(ws + WS_YATTN, ws + WS_W_PA, NTOK, 1024, 512, G, bx);
          EpiMixB E{(const bf16_t*)(ws + WS_G), p.out, (bf16_t*)(ws + WS_MERGED)};
          pg8::gemm_phase<EpiMixB, pg8::DenseSched, false>(lds, 512, S, E); }
    }
    if (IN(PH_OUT)) {
        pg8::DenseSched S; S.init(ws + WS_MERGED, ws + WS_W_OUT, NTOK, 1024, 1024, G, bx);
        EpiOut E{p.in[0], (const float*)(ws + WS_ADA), p.out};
        pg8::gemm_phase<EpiOut, pg8::DenseSched, false>(lds, 1024, S, E);
    }
    if (IN(PH_MOE1)) {
        build_moe_tables(lds, (const unsigned*)(ws + WS_CTL) + CW_CNT);
        Moe1Sched S{lds, G, bx, (const char*)(ws + WS_U), (const int*)(ws + WS_TOKL), (const int*)(ws + WS_IDENT), (const char*)(ws + WS_W_EGU), (const char*)(ws + WS_W_SGU)};
        EpiMoe1 E{(bf16_t*)(ws + WS_H)};
        pg8::gemm_phase<EpiMoe1, Moe1Sched, true>(lds, 1024, S, E);
    }
#pragma unroll 1
    for (int ch = 0; ch < NCHUNK; ++ch) {
        if (IN(PH_MOE2_0 + 2 * ch)) {
            build_moe_tables(lds, (const unsigned*)(ws + WS_CTL) + CW_CNT);
            Moe2Sched S{lds, G, bx, ch, (const char*)(ws + WS_H), (const float*)(ws + WS_GATEL), (const char*)(ws + WS_W_ED), (const char*)(ws + WS_W_SD)};
            EpiMoe2 E{(bf16_t*)(ws + WS_Y), p.out, (const float*)(ws + WS_ADA)};
            pg8::gemm_phase<EpiMoe2, Moe2Sched, false>(lds, 256, S, E);
        }
        if (IN(PH_COMB_0 + 2 * ch)) {
            build_moe_tables(lds, (const unsigned*)(ws + WS_CTL) + CW_CNT);
            p_combine(p, lds, vcu, G, ch);
        }
    }
#undef IN
}

__global__ void __launch_bounds__(64) gold_s5(Params p) {
    const int b = blockIdx.x >> 5, g = blockIdx.x & 31, lane = threadIdx.x;
    const bf16_t* PROJ = (const bf16_t*)(p.ws + WS_PROJ); bf16_t* YG = (bf16_t*)(p.ws + WS_YG);
    const float dt = expf(p.in[8][g]); const float lr = p.in[6][g * 64 + lane], li = p.in[7][g * 64 + lane];
    const float mag = expf(lr * dt); const float a_re = mag * cosf(li * dt), a_im = mag * sinf(li * dt);
    const float den = lr * lr + li * li, n_re = a_re - 1.0f;
    const float f_re = (n_re * lr + a_im * li) / den, f_im = (a_im * lr - n_re * li) / den;
    float bbr[16], bbi[16], cr[16], ci[16];
#pragma unroll
    for (int h = 0; h < 16; ++h) { const float br = p.in[9][(g * 64 + lane) * 16 + h], bi = p.in[10][(g * 64 + lane) * 16 + h];
        bbr[h] = f_re * br - f_im * bi; bbi[h] = f_re * bi + f_im * br;
        cr[h] = p.in[11][(g * 16 + h) * 64 + lane]; ci[h] = p.in[12][(g * 16 + h) * 64 + lane]; }
    const float dsk = p.in[13][g * 16 + (lane & 15)];
    float hr = 0.f, hi = 0.f;
    for (int t = 0; t < SEQ; ++t) {
        const size_t row = (size_t)b * SEQ + t;
        const u32x4 w0 = *(const u32x4*)(PROJ + row * PROJ_W + C_USSM + g * 16), w1 = *(const u32x4*)(PROJ + row * PROJ_W + C_USSM + g * 16 + 8);
        float u[16]; { float f[8]; unpack8(w0, f);
#pragma unroll
            for (int j = 0; j < 8; ++j) u[j] = f[j];
            unpack8(w1, f);
#pragma unroll
            for (int j = 0; j < 8; ++j) u[8 + j] = f[j]; }
        float bur = 0.f, bui = 0.f;
#pragma unroll
        for (int h = 0; h < 16; ++h) { bur += bbr[h] * u[h]; bui += bbi[h] * u[h]; }
        const float nr = a_re * hr - a_im * hi + bur, ni = a_re * hi + a_im * hr + bui; hr = nr; hi = ni;
        float y = 0.f, um = 0.f;
#pragma unroll
        for (int h = 0; h < 16; ++h) { const float v = wave_sum(cr[h] * hr - ci[h] * hi); if ((lane & 15) == h) { y = v; um = u[h]; } }
        y += dsk * um;
        const float gl = 0.5f * y * (1.0f + tanhf(0.7978845608028654f * (y + 0.044715f * y * y * y)));
        if (lane < 16) YG[row * 512 + g * 16 + lane] = (bf16_t)f2bf(gl);
    }
}

__device__ __forceinline__ unsigned fkey(float x) { const unsigned u = __builtin_bit_cast(unsigned, x); return (u & 0x80000000u) ? ~u : (u | 0x80000000u); }

__global__ void __launch_bounds__(256) gold_attn(Params p) {
    __shared__ float qi[512], wi[8], sc[4096], qv[512], lg[8][256], mx[8], sm[8];
    __shared__ int sel[256]; __shared__ int cnt, red[256]; __shared__ unsigned thr_s;
    const int tid = threadIdx.x; const int qid = blockIdx.x; const int b = qid >> 12, t = qid & 4095;
    const bf16_t* PROJ = (const bf16_t*)(p.ws + WS_PROJ); bf16_t* YA = (bf16_t*)(p.ws + WS_YATTN);
    const size_t qrow = (size_t)qid * PROJ_W;
    for (int i = tid; i < 512; i += 256) { qi[i] = bf2f(PROJ[qrow + C_QI + i]); qv[i] = bf2f(PROJ[qrow + C_Q + i]); }
    if (tid < 8) wi[tid] = bf2f(PROJ[qrow + C_WI + tid]);
    if (tid == 0) cnt = 0;
    __syncthreads();
    const int n = t + 1;
    for (int s = tid; s < n; s += 256) {
        const bf16_t* kp = PROJ + ((size_t)b * SEQ + s) * PROJ_W + C_KI; float kk[64];
#pragma unroll
        for (int c8 = 0; c8 < 8; ++c8) { float f[8]; unpack8(*(const u32x4*)(kp + c8 * 8), f);
#pragma unroll
            for (int j = 0; j < 8; ++j) kk[c8 * 8 + j] = f[j]; }
        float score = 0.f;
        for (int h = 0; h < 8; ++h) { float d = 0.f;
#pragma unroll
            for (int j = 0; j < 64; ++j) d += qi[h * 64 + j] * kk[j];
            score += wi[h] * fmaxf(d, 0.f); }
        sc[s] = score;
    }
    __syncthreads();
    if (n <= 256) { if (tid < n) sel[tid] = tid; if (tid == 0) cnt = n; __syncthreads(); }
    else {
        unsigned thr = 0u;
        for (int bit = 31; bit >= 0; --bit) {
            const unsigned cand = thr | (1u << bit); int c = 0;
            for (int s = tid; s < n; s += 256) c += (fkey(sc[s]) >= cand) ? 1 : 0;
            red[tid] = c; __syncthreads();
            for (int o = 128; o > 0; o >>= 1) { if (tid < o) red[tid] += red[tid + o]; __syncthreads(); }
            if (red[0] >= 256) thr = cand;
            __syncthreads();
        }
        for (int s = tid; s < n; s += 256) if (fkey(sc[s]) > thr) { const int ps = atomicAdd(&cnt, 1); sel[ps] = s; }
        __syncthreads();
        if (tid == 0) { int c = cnt; for (int s = 0; s < n && c < 256; ++s) if (fkey(sc[s]) == thr) sel[c++] = s; cnt = c; }
        __syncthreads();
    }
    const int ns = cnt;
    { const int j = tid; const int s = (j < ns) ? sel[j] : 0;
      const bf16_t* kp = PROJ + ((size_t)b * SEQ + s) * PROJ_W + C_K; float kk[64];
#pragma unroll
      for (int c8 = 0; c8 < 8; ++c8) { float f[8]; unpack8(*(const u32x4*)(kp + c8 * 8), f);
#pragma unroll
          for (int jj = 0; jj < 8; ++jj) kk[c8 * 8 + jj] = f[jj]; }
      for (int h = 0; h < 8; ++h) { float d = 0.f;
#pragma unroll
          for (int jj = 0; jj < 64; ++jj) d += qv[h * 64 + jj] * kk[jj];
          const float slope = exp2f(-(float)(h + 1));
          lg[h][j] = (j < ns) ? d * 0.125f - slope * (float)(t - s) : -INFINITY; } }
    __syncthreads();
    if (tid < 8) { float m = -INFINITY; for (int j = 0; j < 256; ++j) m = fmaxf(m, lg[tid][j]); float s = 0.f; for (int j = 0; j < 256; ++j) s += __expf(lg[tid][j] - m); mx[tid] = m; sm[tid] = s; }
    __syncthreads();
    for (int i = tid; i < 2048; i += 256) { const int h = i >> 8, j = i & 255; lg[h][j] = __expf(lg[h][j] - mx[h]) / sm[h]; }
    __syncthreads();
    { const int h = tid >> 5, d0 = (tid & 31) * 2; float o0 = 0.f, o1 = 0.f;
      for (int j = 0; j < ns; ++j) { const unsigned w = *(const unsigned*)(PROJ + ((size_t)b * SEQ + sel[j]) * PROJ_W + C_V + d0); const float pj = lg[h][j]; o0 += pj * bflo(w); o1 += pj * bfhi(w); }
      *(unsigned*)(YA + (size_t)qid * 512 + h * 64 + d0) = pk2(o0, o1); }
}

__global__ void __launch_bounds__(64) gold_route(Params p) {
    __shared__ float u2s[1024];
    const int m = blockIdx.x, lane = threadIdx.x, b = m >> 12;
    const float* ada = (const float*)(p.ws + WS_ADA); const float* g2 = p.in[19];
    const float* hrow = p.out + (size_t)m * D; bf16_t* U2 = (bf16_t*)(p.ws + WS_U);
    float v[16]; float s = 0.f;
#pragma unroll
    for (int j = 0; j < 4; ++j) { const f32x4 x = *(const f32x4*)(hrow + 4 * lane + 256 * j); v[4 * j] = x.x; v[4 * j + 1] = x.y; v[4 * j + 2] = x.z; v[4 * j + 3] = x.w; s += (x.x * x.x + x.y * x.y) + (x.z * x.z + x.w * x.w); }
    const float rstd = 1.0f / sqrtf(wave_sum(s) * (1.f / D) + EPS);
#pragma unroll
    for (int j = 0; j < 4; ++j) { const int c0 = 4 * lane + 256 * j; float y[4];
#pragma unroll
        for (int q = 0; q < 4; ++q) { y[q] = v[4 * j + q] * rstd * g2[c0 + q] * (1.0f + ada[b * 6144 + 4096 + c0 + q]) + ada[b * 6144 + 3072 + c0 + q]; u2s[c0 + q] = y[q]; }
        *(unsigned long long*)(U2 + (size_t)m * D + c0) = (unsigned long long)pk2(y[0], y[1]) | ((unsigned long long)pk2(y[2], y[3]) << 32); }
    __syncthreads();
    const float* wr = p.in[20]; float lgt = 0.f;
    for (int k = 0; k < 1024; ++k) lgt += u2s[k] * wr[k * 64 + lane];
    const float score = sigmoidf_(lgt); const float biased = score + p.in[21][lane];
    float m1 = biased;
#pragma unroll
    for (int o = 1; o < 8; o <<= 1) m1 = fmaxf(m1, __shfl_xor(m1, o));
    const unsigned long long bal = __ballot(biased == m1); const int grp = lane >> 3;
    const unsigned gm = (unsigned)((bal >> (grp * 8)) & 0xffull); const int first = __ffs((int)gm) - 1;
    float v2 = ((lane & 7) == first) ? -INFINITY : biased;
#pragma unroll
    for (int o = 1; o < 8; o <<= 1) v2 = fmaxf(v2, __shfl_xor(v2, o));
    const float gscore = m1 + v2;
    int grank = 0;
#pragma unroll
    for (int og = 0; og < 8; ++og) { const float o = __shfl(gscore, og * 8); grank += (o > gscore || (o == gscore && og < grp)) ? 1 : 0; }
    const bool gsel = grank < 4;
    const float mv = gsel ? biased : -INFINITY;
    int rank = 0;
    for (int o = 0; o < 64; ++o) { const float ov = __shfl(mv, o); rank += (ov > mv || (ov == mv && o < lane)) ? 1 : 0; }
    const bool chosen = rank < 8;
    const float gsum = wave_sum(chosen ? score : 0.f);
    if (chosen) {
        const float gate = score / gsum * 2.5f; const int ch = m / CHTOK, pair = ch * NE + lane;
        const int ps = (int)atomicAdd((unsigned*)(p.ws + WS_CTL) + CW_CNT + pair, 1u);
        ((int*)(p.ws + WS_EIDX))[m * 8 + rank] = lane; ((float*)(p.ws + WS_GSEL))[m * 8 + rank] = gate; ((int*)(p.ws + WS_POS))[m * 8 + rank] = ps;
        ((int*)(p.ws + WS_TOKL))[(size_t)pair * PAIRCAP + ps] = m; ((float*)(p.ws + WS_GATEL))[(size_t)pair * PAIRCAP + ps] = gate;
    }
}

extern "C" void kernel_launch(void* const* d_in, const int* in_sizes, int n_in, void* d_out, int out_size, void* d_ws, size_t ws_size, hipStream_t stream) {
    static int grid = 0;
    if (grid == 0) {
        if (n_in != 29 || out_size != NTOK * D || ws_size < WS_NEED) { fprintf(stderr, "kernel_launch: unexpected shapes n_in %d out %d ws %zu\n", n_in, out_size, ws_size); grid = -1; return; }
        int dev = 0, cus = 0, per_cu = 0;
        hipGetDevice(&dev); hipDeviceGetAttribute(&cus, hipDeviceAttributeMultiprocessorCount, dev);
        hipFuncSetAttribute((const void*)mega, hipFuncAttributeMaxDynamicSharedMemorySize, LDS_BYTES);
        hipOccupancyMaxActiveBlocksPerMultiprocessor(&per_cu, (const void*)mega, NTHR, LDS_BYTES);
        (void)hipGetLastError();
        grid = (per_cu >= 1) ? cus : -1;
        if (grid < 0) { fprintf(stderr, "kernel_launch: occupancy query says %d blocks/CU\n", per_cu); return; }
    }
    if (grid < 0) return;
    hipMemsetAsync((char*)d_ws + WS_CTL, 0, CTL_BYTES, stream);
    Params p{};
    for (int i = 0; i < 29; ++i) p.in[i] = (const float*)d_in[i];
    p.out = (float*)d_out; p.ws = (unsigned char*)d_ws;
    auto run = [&](int lo, int hi) { p.ph_lo = lo; p.ph_hi = hi; hipLaunchKernelGGL(mega, dim3(grid), dim3(NTHR), LDS_BYTES, stream, p); };
    run(PH_PREP, PH_PREP + 1);
    run(PH_MOD, PH_MOD + 1);
    run(PH_INPROJ, PH_INPROJ + 1);
    p.ph_lo = p.ph_hi = 0;
    hipLaunchKernelGGL(gold_s5, dim3(256), dim3(64), 0, stream, p);
    hipLaunchKernelGGL(gold_attn, dim3(NTOK), dim3(256), 0, stream, p);
    run(PH_GLU, PH_GLU + 1);
    run(PH_MIXAB, PH_MIXAB + 1);
    run(PH_OUT, PH_OUT + 1);
    p.ph_lo = p.ph_hi = 0;
    hipLaunchKernelGGL(gold_route, dim3(NTOK), dim3(64), 0, stream, p);
    for (int ph = PH_MOE1; ph < PH_END; ++ph) run(ph, ph + 1);
}
```

```cpp
#include <hip/hip_runtime.h>
#include <hip/hip_cooperative_groups.h>
#include <cstdio>
#include <cstdint>
#include <cmath>
namespace cg = cooperative_groups;

#define GAS __attribute__((address_space(1)))
#define LAS __attribute__((address_space(3)))
typedef unsigned short bf16_t;
typedef short bf16x8 __attribute__((ext_vector_type(8)));
typedef float f32x4 __attribute__((ext_vector_type(4)));
typedef float f32x2 __attribute__((ext_vector_type(2)));
typedef unsigned u32x4 __attribute__((ext_vector_type(4)));
typedef unsigned u32x2 __attribute__((ext_vector_type(2)));

constexpr int NB = 8, SEQ = 4096, NTOK = NB * SEQ, D = 1024;
constexpr int IN_W = 3784, NIN = 3840, PROJ_W = 1792, G_W = 2048;
constexpr int C_USSM = 0, C_Q = 512, C_K = 1024, C_V = 1088, C_QI = 1152, C_KI = 1664, C_WI = 1728, PROJ_USED = 1736;
constexpr int NE = 64, TOPK = 8, NCHUNK = 1, CHTOK = NTOK / NCHUNK, NPAIR = NCHUNK * NE, PAIRCAP = CHTOK, NSLOT = 9;
constexpr float Y_SCALE = 64.0f;
constexpr int HROWS_ROUTED = NTOK * TOPK, HSH_ROW0 = HROWS_ROUTED + 256;
constexpr float EPS = 1e-6f;
constexpr int NWAVES = 8, NTHR = 512;

constexpr size_t MiB = 1u << 20;
constexpr size_t WS_CTL = 0, CTL_BYTES = 1 * MiB;
constexpr size_t WS_ADA = 1 * MiB;
constexpr size_t WS_ONES = 1 * MiB + 224 * 1024;
constexpr size_t WS_A32 = 1 * MiB + 256 * 1024;
constexpr size_t WS_IDENT = 1 * MiB + 512 * 1024;
constexpr size_t WS_WRF = 1 * MiB + 768 * 1024;
constexpr size_t WS_W_IN = 2 * MiB;
constexpr size_t WS_W_GLU = 10 * MiB;
constexpr size_t WS_W_PS = 11 * MiB;
constexpr size_t WS_W_PA = 12 * MiB;
constexpr size_t WS_W_OUT = 13 * MiB;
constexpr size_t WS_W_SGU = 15 * MiB;
constexpr size_t WS_W_SD = 16 * MiB;
constexpr size_t WS_TZF = 17 * MiB, WS_WINF = 18 * MiB, WS_WOUTF = 22 * MiB;
constexpr size_t WS_W_ED = 26 * MiB;
constexpr size_t WS_W_EGU = 58 * MiB;
constexpr size_t WS_KIF = 122 * MiB;
constexpr size_t WS_U = 128 * MiB;
constexpr size_t WS_PROJ = 192 * MiB;
constexpr size_t WS_G = 304 * MiB;
constexpr size_t WS_YG = 432 * MiB;
constexpr size_t WS_YATTN = 464 * MiB;
constexpr size_t WS_MERGED = 192 * MiB;
constexpr size_t WS_Y = 58 * MiB;
constexpr size_t WS_H = 346 * MiB;
constexpr size_t WS_DSTL = 492 * MiB;
constexpr size_t WS_SS = 4 * MiB;
constexpr size_t WS_GATEL = 500 * MiB;
constexpr size_t WS_NEED = 512 * MiB;
constexpr int CW_CNT = 0;
constexpr int CW_BAR = 4096;
constexpr int CW_Q0 = 1024;

constexpr int STAGE_BYTES = 131072;
constexpr int LDS_RO = STAGE_BYTES;
constexpr int LDS_MISC = LDS_RO + 2048;
constexpr int LDS_CNT = LDS_MISC + 128;
constexpr int LDS_RS = LDS_CNT + 1024;
constexpr int LDS_TB = LDS_RS + 1040;
constexpr int LDS_TD = LDS_TB + 1040;
constexpr int LDS_META = LDS_TD + 1408 * 4;
constexpr int LDS_BYTES = 147456;
static_assert(LDS_META + 4096 <= LDS_BYTES, "LDS map");

__device__ __forceinline__ unsigned f2bf(float f) { unsigned u = __builtin_bit_cast(unsigned, f); return (u + 0x7fffu + ((u >> 16) & 1u)) >> 16; }
typedef __bf16 bf16x2_t __attribute__((ext_vector_type(2)));
__device__ __forceinline__ unsigned pk2(float lo, float hi) { const f32x2 v = {lo, hi}; const bf16x2_t r = __builtin_convertvector(v, bf16x2_t); return __builtin_bit_cast(unsigned, r); }
__device__ __forceinline__ float bf2f(unsigned short b) { return __builtin_bit_cast(float, (unsigned)b << 16); }
__device__ __forceinline__ float bflo(unsigned w) { return __builtin_bit_cast(float, w << 16); }
__device__ __forceinline__ float bfhi(unsigned w) { return __builtin_bit_cast(float, w & 0xffff0000u); }
__device__ __forceinline__ float sigmoidf_(float x) { return __builtin_amdgcn_rcpf(1.0f + __builtin_amdgcn_exp2f(-1.44269504089f * x)); }
__device__ __forceinline__ float wave_sum(float v) {
#pragma unroll
    for (int o = 1; o < 64; o <<= 1) v += __shfl_xor(v, o);
    return v;
}
__device__ __forceinline__ int tidx() { int t = threadIdx.x; asm volatile("" : "+v"(t)); return t; }
#define LDS_WAIT() asm volatile("s_waitcnt lgkmcnt(0)" ::: "memory")

namespace pg8 {
constexpr int BM = 256, BK = 64, HALF = 128, HTB = HALF * BK * 2, NXCD = 8, WGM = 8;
__host__ __device__ __forceinline__ int lds_byte(int r, int c) { const int st = (r >> 4) * 2 + (c >> 5), rr = r & 15, cc = c & 31, ob = rr * 64 + cc * 2; return st * 1024 + (ob ^ (((ob >> 9) & 1) << 5)); }
__host__ __device__ __forceinline__ void stage_rc(int b, int& R, int& C) { const int st = b / 1024, sb = b % 1024, swz = sb ^ (((sb >> 9) & 1) << 5); R = (st >> 1) * 16 + swz / 64; C = (st & 1) * 32 + (swz % 64) / 2; }
__host__ __device__ __forceinline__ int perm32(int rho) { const int n = rho >> 4, i = rho & 15; return 8 * (i >> 2) + 4 * n + (i & 3); }

struct Unit { int pm, pn; const char* A; const char* B; const int* rows; int valid; int x0; int rbase; const float* gp; };

struct DenseSched {
    int nM, nN, nwg, G, c; const char* A; const char* B; size_t tstep;
    __device__ __forceinline__ void init(const void* A_, const void* B_, int M, int N, int K, int G_, int c_) { nM = M / BM; nN = N / BM; nwg = nM * nN; G = G_; c = c_; A = (const char*)A_; B = (const char*)B_; tstep = (size_t)BM * K * 2; }
    __device__ __forceinline__ bool next(int i, Unit& u) const {
        const long L = (long)i * G + c; if (L >= nwg) return false;
        int wgid = (int)L; { const int q = nwg / NXCD, r = nwg % NXCD, xcd = wgid % NXCD, off = wgid / NXCD; wgid = (xcd < r ? xcd * (q + 1) : r * (q + 1) + (xcd - r) * q) + off; }
        const int nig = WGM * nN, gid = wgid / nig, fm = gid * WGM, gsz = (nM - fm) < WGM ? (nM - fm) : WGM;
        u.pm = fm + ((wgid % nig) % gsz); u.pn = (wgid % nig) / gsz;
        u.A = A + (size_t)u.pm * tstep; u.B = B + (size_t)u.pn * tstep; u.rows = nullptr; u.valid = 256; u.x0 = 0; u.rbase = 0; u.gp = nullptr; return true;
    }
};

template <class Epi, class Sched, bool GATHER, bool RMETA = false, bool KEEPACC = false>
__device__ __forceinline__ void gemm_phase(LAS unsigned char* lds, const int K, const Sched& S, const Epi& E) {
    int tid_ = tidx(); asm volatile("" : "+v"(tid_));
    const int tid = tid_, wid = __builtin_amdgcn_readfirstlane(tid >> 6), lane = tid & 63, wr = wid >> 2, wc = wid & 3, fr = lane & 15, fq = lane >> 4;
    const int nt = K / BK;
    unsigned voffA[2], voffB[2]; int roA[2];
#pragma unroll
    for (int i = 0; i < 2; ++i) { int R, C; stage_rc(tid * 16 + i * 8192, R, C); const int Rb = (R & ~31) + perm32(R & 31);
        voffA[i] = GATHER ? (unsigned)(C * 2) : (unsigned)(R * K + C) * 2u; voffB[i] = (unsigned)(Rb * K + C) * 2u; roA[i] = R * 4; }
    const size_t kstep = (size_t)(BK * 2);
    const size_t hstep = (size_t)HALF * K * 2;
    const unsigned ldsw = (unsigned)wid * 1024u;
    const int aoff = lds_byte(wr * 64 + fr, fq * 8), boff = lds_byte(wc * 32 + fr, fq * 8);
    LAS unsigned char* ro = lds + LDS_RO;
#define PG8_SA(b, h) (((b) * 2 + (h)) * HTB)
#define PG8_SB(b, h) ((4 + (b) * 2 + (h)) * HTB)
#define PG8_STAGE_B(bufoff, gbase) do { _Pragma("unroll") for (int _i = 0; _i < 2; ++_i) \
        __builtin_amdgcn_global_load_lds((const unsigned*)((const char*)(gbase) + voffB[_i]), (LAS unsigned*)(lds + (bufoff) + ldsw + _i * 8192), 16, 0, 0); } while (0)
#define PG8_STAGE_A(bufoff, gbase, h, slot) do { _Pragma("unroll") for (int _i = 0; _i < 2; ++_i) { \
        unsigned _vo = voffA[_i]; const char* _gb = (const char*)(gbase); \
        if (GATHER) _vo += *(const LAS unsigned*)(ro + (slot) * 1024 + (h) * 512 + roA[_i]); else _gb += (h) * hstep; \
        __builtin_amdgcn_global_load_lds((const unsigned*)(_gb + _vo), (LAS unsigned*)(lds + (bufoff) + ldsw + _i * 8192), 16, 0, 0); } } while (0)
#define PG8_LDA(dst, b, h) do { _Pragma("unroll") for (int m = 0; m < 4; ++m) _Pragma("unroll") for (int k = 0; k < 2; ++k) dst[m][k] = *(const LAS bf16x8*)(lds + PG8_SA(b, h) + aoff + m * 2048 + k * 1024); } while (0)
#define PG8_LDB(dst, b, h) do { _Pragma("unroll") for (int n = 0; n < 2; ++n) _Pragma("unroll") for (int k = 0; k < 2; ++k) dst[n][k] = *(const LAS bf16x8*)(lds + PG8_SB(b, h) + boff + n * 2048 + k * 1024); } while (0)
#define PG8_MMA(ai, bj, At, Bt) do { __builtin_amdgcn_s_setprio(1); _Pragma("unroll") for (int m = 0; m < 4; ++m) _Pragma("unroll") for (int n = 0; n < 2; ++n) _Pragma("unroll") for (int k = 0; k < 2; ++k) \
        acc[ai][bj][m][n] = __builtin_amdgcn_mfma_f32_16x16x32_bf16(Bt[n][k], At[m][k], acc[ai][bj][m][n], 0, 0, 0); __builtin_amdgcn_s_setprio(0); } while (0)
#define PG8_WAIT_V(n) asm volatile("s_waitcnt vmcnt(" #n ")" ::: "memory")
#define PG8_WAIT_L(n) asm volatile("s_waitcnt lgkmcnt(" #n ")" ::: "memory")
#define PG8_BAR __builtin_amdgcn_s_barrier()
#define PG8_SCHED __builtin_amdgcn_sched_barrier(0)
    Unit cur, nxt; int ui = 0;
    if (!S.next(0, cur)) return;
    f32x4 acc[2][2][4][2];
#pragma unroll
    for (int a = 0; a < 2; ++a)
#pragma unroll
        for (int b = 0; b < 2; ++b)
#pragma unroll
            for (int m = 0; m < 4; ++m)
#pragma unroll
                for (int n = 0; n < 2; ++n) acc[a][b][m][n] = (f32x4){0.f, 0.f, 0.f, 0.f};
    bf16x8 At[4][2], B0[2][2], B1[2][2];
    const char* cA = cur.A; const char* cB = cur.B;
    if (GATHER) {
        if (tid < 256) { const int r = tid < cur.valid ? cur.rbase + cur.rows[tid] / NSLOT : 0; *(LAS unsigned*)(ro + tid * 4) = (unsigned)r * (unsigned)(K * 2); }
        __syncthreads();
    }
    PG8_STAGE_B(PG8_SB(0, 0), cB); PG8_STAGE_B(PG8_SB(0, 1), cB + hstep); PG8_STAGE_A(PG8_SA(0, 0), cA, 0, 0); PG8_STAGE_A(PG8_SA(0, 1), cA, 1, 0);
    if (wr == 1) PG8_BAR;
    PG8_WAIT_V(2); PG8_BAR;
    PG8_STAGE_B(PG8_SB(1, 0), cB + kstep); PG8_STAGE_A(PG8_SA(1, 0), cA + kstep, 0, 0); PG8_STAGE_B(PG8_SB(1, 1), cB + hstep + kstep);
    PG8_WAIT_V(6); PG8_BAR;
    for (;;) {
        const bool has_next = S.next(ui + 1, nxt);
        const int cslot = ui & 1, nslot = has_next ? (cslot ^ 1) : cslot;
        int pre_r = 0;
        if (GATHER) { if (has_next && tid < 256 && tid < nxt.valid) pre_r = nxt.rows[tid]; }
        if (RMETA) { if (wid < 4) {
            __builtin_amdgcn_global_load_lds((const unsigned*)(cur.gp + lane + wid * 64), (LAS unsigned*)(lds + LDS_META + cslot * 1024 + wid * 256), 4, 0, 0);
            __builtin_amdgcn_global_load_lds((const unsigned*)(cur.rows + lane + wid * 64), (LAS unsigned*)(lds + LDS_META + 2048 + cslot * 1024 + wid * 256), 4, 0, 0); } }
        const char* nA = has_next ? nxt.A : cA; const char* nB = has_next ? nxt.B : cB;
#pragma unroll 1
        for (int t = 0; t < nt; t += 2) {
            const bool last = (t == nt - 2);
            const char* a1 = cA + (size_t)(t + 1) * kstep;
            const char* a2 = last ? nA : cA + (size_t)(t + 2) * kstep; const char* b2 = last ? nB : cB + (size_t)(t + 2) * kstep;
            const char* a3 = a2 + kstep; const char* b3 = b2 + kstep;
            const int slot2 = last ? nslot : cslot;
            if (t == 2 || nt == 2) {
                if (GATHER) { if (has_next && tid < 256) { const int r = tid < nxt.valid ? nxt.rbase + pre_r / NSLOT : 0; *(LAS unsigned*)(ro + nslot * 1024 + tid * 4) = (unsigned)r * (unsigned)(K * 2); } }
            }
            PG8_LDB(B0, 0, 0); PG8_LDB(B1, 0, 1); PG8_SCHED; PG8_LDA(At, 0, 0); PG8_STAGE_A(PG8_SA(1, 1), a1, 1, cslot);
            PG8_WAIT_V(8); PG8_WAIT_L(0); PG8_BAR; PG8_MMA(0, 0, At, B0); PG8_MMA(0, 1, At, B1); PG8_BAR; PG8_SCHED;
            PG8_LDA(At, 0, 1); PG8_STAGE_B(PG8_SB(0, 0), b2); PG8_STAGE_B(PG8_SB(0, 1), b2 + hstep); PG8_STAGE_A(PG8_SA(0, 0), a2, 0, slot2);
            PG8_WAIT_V(8); PG8_WAIT_L(0); PG8_BAR; PG8_MMA(1, 0, At, B0); PG8_MMA(1, 1, At, B1); PG8_BAR; PG8_SCHED;
            PG8_LDB(B0, 1, 0); PG8_LDB(B1, 1, 1); PG8_SCHED; PG8_LDA(At, 1, 0); PG8_STAGE_A(PG8_SA(0, 1), a2, 1, slot2);
            PG8_WAIT_V(8); PG8_WAIT_L(0); PG8_BAR; PG8_MMA(0, 0, At, B0); PG8_MMA(0, 1, At, B1); PG8_BAR; PG8_SCHED;
            PG8_LDA(At, 1, 1); PG8_STAGE_B(PG8_SB(1, 0), b3); PG8_STAGE_B(PG8_SB(1, 1), b3 + hstep); PG8_STAGE_A(PG8_SA(1, 0), a3, 0, slot2);
            PG8_WAIT_V(8); PG8_WAIT_L(0); PG8_BAR; PG8_MMA(1, 0, At, B0); PG8_MMA(1, 1, At, B1); PG8_BAR; PG8_SCHED;
        }
        if (wr == 0) PG8_BAR;
        E(acc, cur, wr, wc, fr, fq, lds + LDS_META + (ui & 1) * 1024);
        if (!has_next) break;
        if (!KEEPACC || nxt.x0 == 0) {
#pragma unroll
        for (int a = 0; a < 2; ++a)
#pragma unroll
            for (int b = 0; b < 2; ++b)
#pragma unroll
                for (int m = 0; m < 4; ++m)
#pragma unroll
                    for (int n = 0; n < 2; ++n) acc[a][b][m][n] = (f32x4){0.f, 0.f, 0.f, 0.f};
        }
        cur = nxt; cA = nA; cB = nB; ++ui;
        if (wr == 1) PG8_BAR;
    }
    PG8_WAIT_V(0);
    PG8_BAR;
#undef PG8_SA
#undef PG8_SB
#undef PG8_STAGE_A
#undef PG8_STAGE_B
#undef PG8_LDA
#undef PG8_LDB
#undef PG8_MMA
#undef PG8_WAIT_V
#undef PG8_WAIT_L
#undef PG8_BAR
#undef PG8_SCHED
}
}
using pg8::Unit;

#define EPI_LOOP_BEGIN \
    _Pragma("unroll") for (int ai = 0; ai < 2; ++ai) _Pragma("unroll") for (int m = 0; m < 4; ++m) { const int rl = ai * 128 + wr * 64 + m * 16 + fr; const int row = u.pm * 256 + rl; \
    _Pragma("unroll") for (int bj = 0; bj < 2; ++bj) { const int col = u.pn * 256 + bj * 128 + wc * 32 + 8 * fq; const f32x4 v0 = acc[ai][bj][m][0], v1 = acc[ai][bj][m][1]; (void)row; (void)col; (void)rl;
#define EPI_LOOP_END } if (m == 3) asm volatile("" ::: "memory"); }
__device__ __forceinline__ u32x4 pack8(const f32x4 a, const f32x4 b) { u32x4 w; w.x = pk2(a[0], a[1]); w.y = pk2(a[2], a[3]); w.z = pk2(b[0], b[1]); w.w = pk2(b[2], b[3]); return w; }
__device__ __forceinline__ void unpack8(const u32x4 w, float (&f)[8]) { f[0] = bflo(w.x); f[1] = bfhi(w.x); f[2] = bflo(w.y); f[3] = bfhi(w.y); f[4] = bflo(w.z); f[5] = bfhi(w.z); f[6] = bflo(w.w); f[7] = bfhi(w.w); }

struct EpiInProj {
    bf16_t* PROJ; bf16_t* G; bf16_t* KIF;
    __device__ __forceinline__ void operator()(const f32x4 (&acc)[2][2][4][2], const Unit& u, int wr, int wc, int fr, int fq, LAS unsigned char* meta) const {
        EPI_LOOP_BEGIN
            if (u.pn < 7) { const u32x4 w8 = pack8(v0, v1); *(u32x4*)(PROJ + (size_t)row * PROJ_W + col) = w8;
                if (u.pn == 6 && col >= C_KI && col < C_KI + 64) { const int d0 = col - C_KI, key = row & 4095, bb = row >> 12;
                    *(u32x4*)(KIF + ((size_t)((bb * 128 + (key >> 5)) * 4 + (d0 >> 4)) * 64 + (key & 31) + 32 * ((d0 >> 3) & 1)) * 8) = w8; } }
            else { f32x4 s0, s1;
#pragma unroll
                for (int j = 0; j < 4; ++j) { s0[j] = sigmoidf_(v0[j]); s1[j] = sigmoidf_(v1[j]); }
                *(u32x4*)(G + (size_t)row * G_W + (col - PROJ_W)) = pack8(s0, s1); }
        EPI_LOOP_END
    }
};
struct EpiGlu {
    const bf16_t* YG; const float* bias; bf16_t* O;
    __device__ __forceinline__ void operator()(const f32x4 (&acc)[2][2][4][2], const Unit& u, int wr, int wc, int fr, int fq, LAS unsigned char* meta) const {
        f32x4 bb[2][2];
#pragma unroll
        for (int bj = 0; bj < 2; ++bj) { const int col = u.pn * 256 + bj * 128 + wc * 32 + 8 * fq; bb[bj][0] = *(const f32x4*)(bias + col); bb[bj][1] = *(const f32x4*)(bias + col + 4); }
        EPI_LOOP_BEGIN
            float y[8]; unpack8(*(const u32x4*)(YG + (size_t)row * 512 + col), y);
            const f32x4 b0 = bb[bj][0], b1 = bb[bj][1]; f32x4 o0, o1;
#pragma unroll
            for (int j = 0; j < 4; ++j) { o0[j] = y[j] * sigmoidf_(v0[j] + b0[j]); o1[j] = y[4 + j] * sigmoidf_(v1[j] + b1[j]); }
            *(u32x4*)(O + (size_t)row * 512 + col) = pack8(o0, o1);
        EPI_LOOP_END
    }
};
struct EpiMix {
    const bf16_t* G; bf16_t* O;
    __device__ __forceinline__ void operator()(f32x4 (&acc)[2][2][4][2], const Unit& u, int wr, int wc, int fr, int fq, LAS unsigned char* meta) const {
        const size_t gbase = (size_t)(u.pm * 256 + wr * 64 + fr) * G_W + u.pn * 256 + wc * 32 + 8 * fq;
        if (u.x0 == 0) {
#pragma unroll
            for (int ai = 0; ai < 2; ++ai) {
                u32x4 q1[4][2], q2[4][2];
#pragma unroll
                for (int m = 0; m < 4; ++m)
#pragma unroll
                    for (int bj = 0; bj < 2; ++bj) { const size_t o_ = gbase + (size_t)(ai * 128 + m * 16) * G_W + bj * 128; q1[m][bj] = *(const u32x4*)(G + o_); q2[m][bj] = *(const u32x4*)(G + o_ + 1024); }
#pragma unroll
                for (int m = 0; m < 4; ++m)
#pragma unroll
                    for (int bj = 0; bj < 2; ++bj) { float g1[8], g2[8]; unpack8(q1[m][bj], g1); unpack8(q2[m][bj], g2);
#pragma unroll
                        for (int j = 0; j < 4; ++j) { acc[ai][bj][m][0][j] *= g1[j] * __builtin_amdgcn_rcpf(fmaxf(g2[j], 1e-6f)); acc[ai][bj][m][1][j] *= g1[4 + j] * __builtin_amdgcn_rcpf(fmaxf(g2[4 + j], 1e-6f)); } }
                asm volatile("" ::: "memory"); }
        } else {
            u32x4 q2[2][4][2];
#pragma unroll
            for (int ai = 0; ai < 2; ++ai)
#pragma unroll
                for (int m = 0; m < 4; ++m)
#pragma unroll
                    for (int bj = 0; bj < 2; ++bj) q2[ai][m][bj] = *(const u32x4*)(G + gbase + (size_t)(ai * 128 + m * 16) * G_W + bj * 128 + 1024);
#pragma unroll
            for (int ai = 0; ai < 2; ++ai)
#pragma unroll
                for (int m = 0; m < 4; ++m)
#pragma unroll
                    for (int bj = 0; bj < 2; ++bj) { float g2[8]; unpack8(q2[ai][m][bj], g2); f32x4 o0, o1;
#pragma unroll
                        for (int j = 0; j < 4; ++j) { o0[j] = acc[ai][bj][m][0][j] * fmaxf(g2[j], 1e-6f); o1[j] = acc[ai][bj][m][1][j] * fmaxf(g2[4 + j], 1e-6f); }
                        *(u32x4*)(O + (size_t)(u.pm * 256 + ai * 128 + wr * 64 + m * 16 + fr) * D + u.pn * 256 + bj * 128 + wc * 32 + 8 * fq) = pack8(o0, o1); }
        }
    }
};
struct MixSched {
    pg8::DenseSched D0, D1;
    __device__ __forceinline__ bool next(int i, Unit& u) const { const bool ok = (i & 1) ? D1.next(i >> 1, u) : D0.next(i >> 1, u); u.x0 = i & 1; return ok; }
};
struct EpiOut {
    const float* X; const float* ada; float* O; float* SS;
    __device__ __forceinline__ void operator()(const f32x4 (&acc)[2][2][4][2], const Unit& u, int wr, int wc, int fr, int fq, LAS unsigned char* meta) const {
        f32x4 gg[2][2];
#pragma unroll
        for (int bj = 0; bj < 2; ++bj) { const float* gp = ada + (size_t)((u.pm * 256) >> 12) * 6144 + 2048 + u.pn * 256 + bj * 128 + wc * 32 + 8 * fq; gg[bj][0] = *(const f32x4*)gp; gg[bj][1] = *(const f32x4*)(gp + 4); }
        const size_t base = (size_t)(u.pm * 256 + wr * 64 + fr) * D + u.pn * 256 + wc * 32 + 8 * fq;
        f32x4 xq[3][2][2];
#define EPO_LOAD(slot, rg) do { const size_t o_ = base + (size_t)(((rg) >> 2) * 128 + ((rg) & 3) * 16) * D; _Pragma("unroll") for (int bj = 0; bj < 2; ++bj) { xq[slot][bj][0] = *(const f32x4*)(X + o_ + bj * 128); xq[slot][bj][1] = *(const f32x4*)(X + o_ + bj * 128 + 4); } } while (0)
        EPO_LOAD(0, 0); EPO_LOAD(1, 1);
#pragma unroll
        for (int rg = 0; rg < 8; ++rg) { const int ai = rg >> 2, m = rg & 3;
            if (rg + 2 < 8) EPO_LOAD((rg + 2) % 3, rg + 2);
            const size_t o_ = base + (size_t)(ai * 128 + m * 16) * D; float ss = 0.f;
#pragma unroll
            for (int bj = 0; bj < 2; ++bj) { const f32x4 o0 = xq[rg % 3][bj][0] + gg[bj][0] * acc[ai][bj][m][0], o1 = xq[rg % 3][bj][1] + gg[bj][1] * acc[ai][bj][m][1];
                *(f32x4*)(O + o_ + bj * 128) = o0; *(f32x4*)(O + o_ + bj * 128 + 4) = o1;
                ss += (o0.x * o0.x + o0.y * o0.y) + (o0.z * o0.z + o0.w * o0.w) + (o1.x * o1.x + o1.y * o1.y) + (o1.z * o1.z + o1.w * o1.w); }
            ss += __shfl_xor(ss, 16); ss += __shfl_xor(ss, 32);
            if (fq == 0) SS[(size_t)(u.pm * 256 + ai * 128 + wr * 64 + m * 16 + fr) * 16 + u.pn * 4 + wc] = ss;
            asm volatile("" ::: "memory"); }
#undef EPO_LOAD
    }
};
struct EpiMoe1 {
    bf16_t* H;
    __device__ __forceinline__ void operator()(const f32x4 (&acc)[2][2][4][2], const Unit& u, int wr, int wc, int fr, int fq, LAS unsigned char* meta) const {
#pragma unroll
        for (int ai = 0; ai < 2; ++ai)
#pragma unroll
            for (int m = 0; m < 4; ++m) { const int rl = ai * 128 + wr * 64 + m * 16 + fr;
                if (rl < u.valid) { f32x4 o0, o1;
#pragma unroll
                    for (int j = 0; j < 4; ++j) { const float g0 = acc[ai][0][m][0][j], g1 = acc[ai][1][m][0][j]; o0[j] = g0 * sigmoidf_(g0) * acc[ai][0][m][1][j]; o1[j] = g1 * sigmoidf_(g1) * acc[ai][1][m][1][j]; }
                    *(u32x4*)(H + (size_t)(u.x0 + rl) * 256 + u.pn * 128 + wc * 32 + 8 * fq) = pack8(o0, o1); } }
    }
};
__device__ __forceinline__ void epi_stage_write(LAS unsigned char* sc, int fr, int fq, const u32x4 w0, const u32x4 w1) {
    LAS unsigned char* rowp = sc + (fr >> 3) * 8192 + (fr & 7) * 128; const int x = fr & 7;
    *(LAS u32x4*)(rowp + ((fq ^ x) * 16)) = w0; *(LAS u32x4*)(rowp + (((4 + fq) ^ x) * 16)) = w1;
}
__device__ __forceinline__ u32x4 epi_stage_read(const LAS unsigned char* sc, int q, int lane) {
    const int r = lane >> 3, c = lane & 7; return *(const LAS u32x4*)(sc + q * 8192 + r * 128 + ((c ^ r) * 16));
}
__device__ __forceinline__ unsigned pk4_fp8(float a, float b, float c, float d) {
    a = __builtin_amdgcn_fmed3f(a, -448.f, 448.f); b = __builtin_amdgcn_fmed3f(b, -448.f, 448.f); c = __builtin_amdgcn_fmed3f(c, -448.f, 448.f); d = __builtin_amdgcn_fmed3f(d, -448.f, 448.f);
    int w = 0; w = __builtin_amdgcn_cvt_pk_fp8_f32(a, b, w, false); w = __builtin_amdgcn_cvt_pk_fp8_f32(c, d, w, true); return (unsigned)w;
}
struct EpiMoe2 {
    unsigned char* Y; int skip; LAS unsigned char* lds0;
    __device__ __forceinline__ void operator()(const f32x4 (&acc)[2][2][4][2], const Unit& u, int wr, int wc, int fr, int fq, LAS unsigned char* meta) const {
        asm volatile("" : "+v"(fr), "+v"(fq));
        const int lane = fr + 16 * fq;
        LAS unsigned char* sc0 = lds0 + 3 * pg8::HTB + (wr * 4 + wc) * 1024;
#pragma unroll
        for (int ai = 0; ai < 2; ++ai)
#pragma unroll
            for (int m = 0; m < 4; ++m) { const int rl0 = ai * 128 + wr * 64 + m * 16; LAS unsigned char* sc = sc0 + (m & 1) * 8192;
                const float g = *(const LAS float*)(meta + (rl0 + fr) * 4) * Y_SCALE;
                u32x2 w0, w1;
                w0.x = pk4_fp8(acc[ai][0][m][0][0] * g, acc[ai][0][m][0][1] * g, acc[ai][0][m][0][2] * g, acc[ai][0][m][0][3] * g); w0.y = pk4_fp8(acc[ai][0][m][1][0] * g, acc[ai][0][m][1][1] * g, acc[ai][0][m][1][2] * g, acc[ai][0][m][1][3] * g);
                w1.x = pk4_fp8(acc[ai][1][m][0][0] * g, acc[ai][1][m][0][1] * g, acc[ai][1][m][0][2] * g, acc[ai][1][m][0][3] * g); w1.y = pk4_fp8(acc[ai][1][m][1][0] * g, acc[ai][1][m][1][1] * g, acc[ai][1][m][1][2] * g, acc[ai][1][m][1][3] * g);
                *(LAS u32x2*)(sc + fr * 64 + fq * 8) = w0; *(LAS u32x2*)(sc + fr * 64 + 32 + fq * 8) = w1;
                { const int r = lane >> 2, c = lane & 3, rl = rl0 + r; const u32x4 v = *(const LAS u32x4*)(sc + r * 64 + c * 16);
                  if (rl < u.valid && !skip) { const int dst = *(const LAS int*)(meta + 2048 + rl * 4); *(u32x4*)(Y + (size_t)dst * D + u.pn * 256 + wc * 64 + c * 16) = v; } } }
    }
};

__device__ __forceinline__ void build_moe_tables(LAS unsigned char* lds, const unsigned* cnt_g) {
    LAS int* CNT = (LAS int*)(lds + LDS_CNT); LAS int* RS = (LAS int*)(lds + LDS_RS); LAS int* TB = (LAS int*)(lds + LDS_TB); LAS unsigned* TD = (LAS unsigned*)(lds + LDS_TD);
    const int tid = tidx();
    __syncthreads();
    if (tid < 256) { int c = tid < NPAIR ? (int)cnt_g[tid] : 0; c = c < 0 ? 0 : (c > PAIRCAP ? PAIRCAP : c); CNT[tid] = c; }
    __syncthreads();
    if (tid < 64) {
        int c[4], rs = 0, tb = 0;
#pragma unroll
        for (int i = 0; i < 4; ++i) { c[i] = CNT[4 * tid + i]; rs += c[i]; tb += (c[i] + 255) >> 8; }
        int srs = rs, stb = tb;
#pragma unroll
        for (int o = 1; o < 64; o <<= 1) { const int a = __shfl_up(srs, o), e = __shfl_up(stb, o); if (tid >= o) { srs += a; stb += e; } }
        int ers = srs - rs, etb = stb - tb;
#pragma unroll
        for (int i = 0; i < 4; ++i) { RS[4 * tid + i] = ers; TB[4 * tid + i] = etb; ers += c[i]; etb += (c[i] + 255) >> 8; }
        if (tid == 63) { RS[256] = srs; TB[256] = stb; }
    }
    __syncthreads();
    if (tid < 256) { const int c = CNT[tid], nt = (c + 255) >> 8, tb = TB[tid]; for (int k = 0; k < nt; ++k) TD[tb + k] = (unsigned)tid | ((unsigned)k << 9); }
    __syncthreads();
}
#define RFL(x) __builtin_amdgcn_readfirstlane(x)
struct Moe1Sched {
    LAS unsigned char* lds; int G, c; const char* U2; const int* dstl; const int* ident; const char* Wegu; const char* Wsgu;
    __device__ __forceinline__ bool next(int i, Unit& u) const {
        LAS int* CNT = (LAS int*)(lds + LDS_CNT); LAS int* RS = (LAS int*)(lds + LDS_RS); LAS int* TB = (LAS int*)(lds + LDS_TB); LAS unsigned* TD = (LAS unsigned*)(lds + LDS_TD);
        const int ntr = RFL(TB[256]); const int L = i * G + c; if (L >= (ntr + 128) * 2) return false;
        const int tau = L >> 1; u.pn = L & 1; u.pm = 0; u.A = U2; u.gp = nullptr;
        if (tau < ntr) { const unsigned d = (unsigned)RFL((int)TD[tau]); const int j = d & 511, k = d >> 9; u.valid = min(256, RFL(CNT[j]) - k * 256); u.rows = dstl + (size_t)(j * PAIRCAP + k * 256); u.x0 = RFL(RS[j]) + k * 256; u.rbase = (j >> 6) * CHTOK;
            u.B = Wegu + (size_t)(j & 63) * (512 * 1024 * 2) + (size_t)u.pn * (256 * 1024 * 2); }
        else { const int k = tau - ntr; u.valid = 256; u.rows = ident + k * 256; u.x0 = HSH_ROW0 + k * 256; u.rbase = (k / (CHTOK / 256)) * CHTOK; u.B = Wsgu + (size_t)u.pn * (256 * 1024 * 2); }
        return true;
    }
};
struct Moe2Sched {
    LAS unsigned char* lds; int G, c, ch; const unsigned char* ws;
    __device__ __forceinline__ bool next(int i, Unit& u) const {
        LAS int* CNT = (LAS int*)(lds + LDS_CNT); LAS int* RS = (LAS int*)(lds + LDS_RS); LAS int* TB = (LAS int*)(lds + LDS_TB); LAS unsigned* TD = (LAS unsigned*)(lds + LDS_TD);
        constexpr int NSH = CHTOK / 256;
        const int t0 = RFL(TB[64 * ch]), ntr = RFL(TB[64 * ch + 64]) - t0; const int L = i * G + c; if (L >= (ntr + NSH) * 4) return false;
        const int tau = L >> 2; u.pn = L & 3; u.pm = 0; u.rbase = 0; u.x0 = 0;
        if (tau < ntr) { const unsigned d = (unsigned)RFL((int)TD[t0 + tau]); const int j = d & 511, k = d >> 9; u.valid = min(256, RFL(CNT[j]) - k * 256);
            u.A = (const char*)(ws + WS_H) + (size_t)(RFL(RS[j]) + k * 256) * 512; u.rows = (const int*)(ws + WS_DSTL) + (size_t)(j * PAIRCAP + k * 256); u.gp = (const float*)(ws + WS_GATEL) + (size_t)(j * PAIRCAP + k * 256);
            u.B = (const char*)(ws + WS_W_ED) + (size_t)(j & 63) * (1024 * 256 * 2) + (size_t)u.pn * (256 * 256 * 2); }
        else { const int k = NSH * ch + (tau - ntr); u.valid = 256; u.A = (const char*)(ws + WS_H) + (size_t)(HSH_ROW0 + k * 256) * 512; u.rows = (const int*)(ws + WS_IDENT) + k * 256; u.gp = (const float*)(ws + WS_ONES); u.B = (const char*)(ws + WS_W_SD) + (size_t)u.pn * (256 * 256 * 2); }
        return true;
    }
};

struct Params { const float* in[29]; float* out; unsigned char* ws; int ph_lo, ph_hi; };

__device__ __forceinline__ void s5_tables_item(const Params& p, LAS unsigned char* lds, int item) {
    const int g = item >> 3, part = item & 7, tid = tidx();
    LAS float* AP = (LAS float*)lds;
    LAS float* BB = AP + 64 * 33 * 2;
    LAS float* CC = BB + 64 * 16 * 2;
    const float dt = expf(p.in[8][g]);
    __syncthreads();
    for (int i = tid; i < 64 * 33; i += NTHR) { const int pp = i / 33, tau = i - pp * 33; const float lr = p.in[6][g * 64 + pp], li = p.in[7][g * 64 + pp];
        const float mag = expf(lr * dt * (float)tau), th = li * dt * (float)tau; AP[i * 2] = mag * cosf(th); AP[i * 2 + 1] = mag * sinf(th); }
    for (int i = tid; i < 64 * 16; i += NTHR) { const int pp = i >> 4; const float lr = p.in[6][g * 64 + pp], li = p.in[7][g * 64 + pp];
        const float mag = expf(lr * dt); const float a_re = mag * cosf(li * dt), a_im = mag * sinf(li * dt);
        const float den = lr * lr + li * li, n_re = a_re - 1.0f; const float f_re = (n_re * lr + a_im * li) / den, f_im = (a_im * lr - n_re * li) / den;
        const float br = p.in[9][(size_t)(g * 64) * 16 + i], bi = p.in[10][(size_t)(g * 64) * 16 + i];
        BB[i * 2] = f_re * br - f_im * bi; BB[i * 2 + 1] = f_re * bi + f_im * br; }
    for (int i = tid; i < 16 * 64; i += NTHR) { CC[i * 2] = p.in[11][(size_t)g * 1024 + i]; CC[i * 2 + 1] = p.in[12][(size_t)g * 1024 + i]; }
    __syncthreads();
    if (part == 0 && tid < 64) { float* a32 = (float*)(p.ws + WS_A32); a32[(g * 64 + tid) * 2] = AP[(tid * 33 + 32) * 2]; a32[(g * 64 + tid) * 2 + 1] = AP[(tid * 33 + 32) * 2 + 1]; }
    {
        const int jh = tid >> 8, t2 = tid & 255;
        const int fr = t2 >> 6, l = t2 & 63, delta = part * 4 + fr, ho = l & 15, q = l >> 4, tau = delta - (q >> 1); float v[4];
#pragma unroll 1
        for (int jj = 0; jj < 4; ++jj) { const int j = jh * 4 + jj; const int hi = (q & 1) * 8 + j; float acc = 0.f;
            if (tau >= 0) { for (int pp = 0; pp < 64; ++pp) { const float ar = AP[(pp * 33 + tau) * 2], ai = AP[(pp * 33 + tau) * 2 + 1], br = BB[(pp * 16 + hi) * 2], bi = BB[(pp * 16 + hi) * 2 + 1], cr = CC[(ho * 64 + pp) * 2], ci = CC[(ho * 64 + pp) * 2 + 1];
                    acc += cr * (ar * br - ai * bi) - ci * (ar * bi + ai * br); }
                if (tau == 0 && ho == hi) acc += p.in[13][g * 16 + ho]; }
            v[jj] = acc; }
        u32x2 o; o.x = pk2(v[0], v[1]); o.y = pk2(v[2], v[3]);
        *(u32x2*)((bf16_t*)(p.ws + WS_TZF) + ((size_t)(g * 32 + delta) * 64 + l) * 8 + jh * 4) = o;
    }
    for (int u = tid; u < 1024; u += NTHR) {
        const int ks = u >> 6, l = u & 63, n = part * 16 + (l & 15), q = l >> 4, ri = n >> 6, pp = n & 63; float v[8];
#pragma unroll
        for (int j = 0; j < 8; ++j) { const int k = ks * 32 + q * 8 + j, sidx = k >> 4, hi = k & 15;
            const float ar = AP[(pp * 33 + 31 - sidx) * 2], ai = AP[(pp * 33 + 31 - sidx) * 2 + 1], br = BB[(pp * 16 + hi) * 2], bi = BB[(pp * 16 + hi) * 2 + 1];
            v[j] = ri ? (ar * bi + ai * br) : (ar * br - ai * bi); }
        u32x4 o; o.x = pk2(v[0], v[1]); o.y = pk2(v[2], v[3]); o.z = pk2(v[4], v[5]); o.w = pk2(v[6], v[7]);
        *(u32x4*)((bf16_t*)(p.ws + WS_WINF) + ((size_t)((g * 8 + part) * 16 + ks) * 64 + l) * 8) = o;
    }
    for (int u = tid; u < 1024; u += NTHR) {
        const int fr = u >> 6, l = u & 63, t = part * 4 + (fr >> 2), ksp = fr & 3, ho = l & 15, q = l >> 4; float v[8];
#pragma unroll
        for (int j = 0; j < 8; ++j) { const int kp = ksp * 32 + q * 8 + j, ri = kp >> 6, pp = kp & 63;
            const float cr = CC[(ho * 64 + pp) * 2], ci = CC[(ho * 64 + pp) * 2 + 1], ar = AP[(pp * 33 + t + 1) * 2], ai = AP[(pp * 33 + t + 1) * 2 + 1];
            v[j] = ri ? -(cr * ai + ci * ar) : (cr * ar - ci * ai); }
        u32x4 o; o.x = pk2(v[0], v[1]); o.y = pk2(v[2], v[3]); o.z = pk2(v[4], v[5]); o.w = pk2(v[6], v[7]);
        *(u32x4*)((bf16_t*)(p.ws + WS_WOUTF) + ((size_t)((g * 32 + t) * 4 + ksp) * 64 + l) * 8) = o;
    }
    __syncthreads();
}

__device__ __forceinline__ float gelu_tanh(float y) { const float z = 0.7978845608028654f * (y + 0.044715f * y * y * y); const float e = __expf(2.0f * z); const float th = 1.0f - 2.0f / (e + 1.0f); return 0.5f * y * (1.0f + th); }

__device__ __forceinline__ void s5_item(const Params& p, LAS unsigned char* lds, int item) {
    const int b = item >> 5, g = item & 31;
    const int tid = tidx(), lane = tid & 63, wave = __builtin_amdgcn_readfirstlane(tid >> 6), hd = lane & 15, qd = lane >> 4;
    const bf16_t* PROJ = (const bf16_t*)(p.ws + WS_PROJ); bf16_t* YG = (bf16_t*)(p.ws + WS_YG);
    LAS float* SL = (LAS float*)lds;
    LAS unsigned char* WO = lds + 65536;
    const char* WoutG = (const char*)(p.ws + WS_WOUTF) + (size_t)g * 32 * 4 * 1024;
#define S5_WO_DMA(h) do { _Pragma("unroll") for (int j_ = 0; j_ < 8; ++j_) \
        __builtin_amdgcn_global_load_lds((const unsigned*)(WoutG + (size_t)(h) * 65536 + (j_ * 512 + tid) * 16), (LAS unsigned*)(WO + j_ * 8192 + wave * 1024), 16, 0, 0); } while (0)
    const int c = 16 * wave + hd;
    __syncthreads();
    S5_WO_DMA(0);
    bf16x8 Uf[16];
#pragma unroll
    for (int ks = 0; ks < 16; ++ks) Uf[ks] = *(const bf16x8*)(PROJ + ((size_t)b * SEQ + c * 32 + 2 * ks + (qd >> 1)) * PROJ_W + C_USSM + g * 16 + (qd & 1) * 8);
    { const bf16x8* WinF = (const bf16x8*)(p.ws + WS_WINF) + (size_t)g * 8 * 16 * 64 + lane;
      bf16x8 wc_[8], wn_[8];
#pragma unroll
      for (int ks = 0; ks < 8; ++ks) wc_[ks] = WinF[ks * 64];
      f32x4 a = (f32x4){0.f, 0.f, 0.f, 0.f};
#pragma unroll 2
      for (int j = 0; j < 16; ++j) { const int jn = (j < 15) ? j + 1 : j;
#pragma unroll
          for (int i = 0; i < 8; ++i) wn_[i] = WinF[(jn * 8 + i) * 64];
          if ((j & 1) == 0) {
#pragma unroll
              for (int i = 0; i < 8; ++i) a = __builtin_amdgcn_mfma_f32_16x16x32_bf16(wc_[i], Uf[i], a, 0, 0, 0); }
          else {
#pragma unroll
              for (int i = 0; i < 8; ++i) a = __builtin_amdgcn_mfma_f32_16x16x32_bf16(wc_[i], Uf[8 + i], a, 0, 0, 0);
              *(LAS f32x4*)(SL + c * 128 + (j >> 1) * 16 + qd * 4) = a; a = (f32x4){0.f, 0.f, 0.f, 0.f}; }
#pragma unroll
          for (int i = 0; i < 8; ++i) wc_[i] = wn_[i]; } }
    __syncthreads();
    if (wave == 0) { const float* a32 = (const float*)(p.ws + WS_A32); const float ar = a32[(g * 64 + lane) * 2], ai = a32[(g * 64 + lane) * 2 + 1]; float hr = 0.f, hi = 0.f;
#pragma unroll 4
        for (int cc = 0; cc < 128; ++cc) { const float sr = SL[cc * 128 + lane], si = SL[cc * 128 + 64 + lane]; const float nr = ar * hr - ai * hi + sr, ni = ar * hi + ai * hr + si; hr = nr; hi = ni; SL[cc * 128 + lane] = hr; SL[cc * 128 + 64 + lane] = hi; } }
    __syncthreads();
    bf16x8 Hf[4];
#pragma unroll
    for (int ks = 0; ks < 4; ++ks) { if (c >= 1) { const f32x4 x0 = *(const LAS f32x4*)(SL + (c - 1) * 128 + ks * 32 + qd * 8), x1 = *(const LAS f32x4*)(SL + (c - 1) * 128 + ks * 32 + qd * 8 + 4); Hf[ks] = __builtin_bit_cast(bf16x8, pack8(x0, x1)); }
        else Hf[ks] = (bf16x8){0, 0, 0, 0, 0, 0, 0, 0}; }
    const bf16x8* TzF = (const bf16x8*)(p.ws + WS_TZF) + (size_t)g * 32 * 64 + lane;
#pragma unroll
    for (int half = 0; half < 2; ++half) {
        f32x4 acc[16];
#pragma unroll
        for (int tt = 0; tt < 16; ++tt) acc[tt] = (f32x4){0.f, 0.f, 0.f, 0.f};
        const int ndelta = half * 16 + 16;
        bf16x8 fr[4];
#pragma unroll
        for (int i = 0; i < 4; ++i) fr[i] = TzF[i * 64];
#pragma unroll
        for (int delta = 0; delta < 32; ++delta) {
            if (delta < ndelta) {
                const bf16x8 f0 = fr[delta & 3];
                if (delta + 4 < ndelta) fr[delta & 3] = TzF[(delta + 4) * 64];
#pragma unroll
                for (int ks = 0; ks < 16; ++ks) { const int t = delta + 2 * ks; if (t >= half * 16 && t < half * 16 + 16) acc[t - half * 16] = __builtin_amdgcn_mfma_f32_16x16x32_bf16(f0, Uf[ks], acc[t - half * 16], 0, 0, 0); }
            }
        }
        asm volatile("s_waitcnt vmcnt(0)" ::: "memory");
        __syncthreads();
#pragma unroll
        for (int tt = 0; tt < 16; ++tt) { const int t = half * 16 + tt;
#pragma unroll
            for (int ks = 0; ks < 4; ++ks) acc[tt] = __builtin_amdgcn_mfma_f32_16x16x32_bf16(*(const LAS bf16x8*)(WO + (tt * 4 + ks) * 1024 + lane * 16), Hf[ks], acc[tt], 0, 0, 0);
            u32x2 w; w.x = pk2(gelu_tanh(acc[tt][0]), gelu_tanh(acc[tt][1])); w.y = pk2(gelu_tanh(acc[tt][2]), gelu_tanh(acc[tt][3]));
            *(u32x2*)(YG + ((size_t)b * SEQ + c * 32 + t) * 512 + g * 16 + qd * 4) = w;
            if ((tt & 1) == 1) asm volatile("" ::: "memory"); }
        if (half == 0) { asm volatile("s_waitcnt lgkmcnt(0)" ::: "memory"); __syncthreads(); S5_WO_DMA(1); }
    }
#undef S5_WO_DMA
    __syncthreads();
}

struct TDesc { const float* W; bf16_t* WT; int K, N, item, kind; };
__device__ __forceinline__ void t_load(const TDesc& d, int lane, f32x4 (&v)[16]) {
    const int nblk = (d.N + 63) >> 6, kb = d.item / nblk, nb = d.item - kb * nblk, k0 = 64 * kb, n0 = 64 * nb;
    const int lr = lane >> 4, lc = (lane & 15) * 4;
#pragma unroll
    for (int i = 0; i < 16; ++i) v[i] = (n0 + lc < d.N) ? *(const f32x4*)(d.W + (size_t)(k0 + 4 * i + lr) * d.N + n0 + lc) : (f32x4){0.f, 0.f, 0.f, 0.f};
}
struct RmId { __device__ int operator()(int n) const { return n; } };
struct RmWave { __device__ int operator()(int n) const { const int L = n & 255; return (n & ~255) + 128 * ((L >> 5) & 1) + 32 * (L >> 6) + (L & 31); } };
struct RmIn { __device__ int operator()(int n) const { return n < PROJ_USED ? n : n + (PROJ_W - PROJ_USED); } };
struct RmGate { __device__ int operator()(int n) const { const int hl = n & 127; return 256 * (n >> 7) + 128 * ((hl >> 2) & 1) + 32 * (hl >> 5) + 8 * ((hl >> 3) & 3) + (hl & 3); } };
struct RmUp { __device__ int operator()(int n) const { const int hl = n & 127; return 256 * (n >> 7) + 128 * ((hl >> 2) & 1) + 32 * (hl >> 5) + 8 * ((hl >> 3) & 3) + 4 + (hl & 3); } };
__device__ __forceinline__ int t_rowmap(int kind, int n) { return kind == 0 ? n : kind == 1 ? RmWave()(n) : kind == 2 ? RmIn()(n) : kind == 3 ? RmGate()(n) : RmUp()(n); }
__device__ __forceinline__ void t_store(const TDesc& d, const f32x4 (&v)[16], LAS float* scr, int lane) {
    const int nblk = (d.N + 63) >> 6, kb = d.item / nblk, nb = d.item - kb * nblk, k0 = 64 * kb, n0 = 64 * nb;
    const int lr = lane >> 4, lc = (lane & 15) * 4;
#pragma unroll
    for (int i = 0; i < 16; ++i) { LAS float* dd = scr + (4 * i + lr) * 65 + lc; dd[0] = v[i].x; dd[1] = v[i].y; dd[2] = v[i].z; dd[3] = v[i].w; }
    LDS_WAIT(); asm volatile("" ::: "memory");
    const int nl = lane >> 3, kc = (lane & 7) * 8;
#pragma unroll
    for (int j = 0; j < 8; ++j) { const int n = nl + 8 * j; const LAS float* sp = scr + kc * 65 + n;
        u32x4 o; o.x = pk2(sp[0 * 65], sp[1 * 65]); o.y = pk2(sp[2 * 65], sp[3 * 65]); o.z = pk2(sp[4 * 65], sp[5 * 65]); o.w = pk2(sp[6 * 65], sp[7 * 65]);
        if (n0 + n < d.N) *(u32x4*)(d.WT + (size_t)t_rowmap(d.kind, n0 + n) * d.K + k0 + kc) = o; }
    LDS_WAIT(); asm volatile("" ::: "memory");
}

constexpr int T_I_IN = 16 * 60, T_I_GLU = 8 * 8, T_I_PS = 8 * 16, T_I_OUT = 16 * 16, T_I_SG = 16 * 4, T_I_SD = 4 * 16, T_I_EG = 64 * 64;
constexpr int T_NITEMS = T_I_IN + T_I_GLU + 2 * T_I_PS + T_I_OUT + 2 * T_I_SG + T_I_SD + 3 * T_I_EG;
constexpr int T_LATE = 5 * 128 * NWAVES;
constexpr int T_LATE2 = T_I_EG;
static_assert(T_LATE + T_LATE2 <= 3 * T_I_EG, "late items are expert matrices");
__device__ __forceinline__ TDesc tdesc_of(const Params& p, unsigned char* ws, int r) { TDesc d;
    if (r < T_I_IN) { d = TDesc{p.in[5], (bf16_t*)(ws + WS_W_IN), 1024, IN_W, r, 2}; return d; } r -= T_I_IN;
    if (r < T_I_GLU) { d = TDesc{p.in[14], (bf16_t*)(ws + WS_W_GLU), 512, 512, r, 0}; return d; } r -= T_I_GLU;
    if (r < T_I_PS) { d = TDesc{p.in[16], (bf16_t*)(ws + WS_W_PS), 512, 1024, r, 0}; return d; } r -= T_I_PS;
    if (r < T_I_PS) { d = TDesc{p.in[17], (bf16_t*)(ws + WS_W_PA), 512, 1024, r, 0}; return d; } r -= T_I_PS;
    if (r < T_I_OUT) { d = TDesc{p.in[18], (bf16_t*)(ws + WS_W_OUT), 1024, 1024, r, 0}; return d; } r -= T_I_OUT;
    if (r < T_I_SG) { d = TDesc{p.in[25], (bf16_t*)(ws + WS_W_SGU), 1024, 256, r, 3}; return d; } r -= T_I_SG;
    if (r < T_I_SG) { d = TDesc{p.in[26], (bf16_t*)(ws + WS_W_SGU), 1024, 256, r, 4}; return d; } r -= T_I_SG;
    if (r < T_I_SD) { d = TDesc{p.in[27], (bf16_t*)(ws + WS_W_SD), 256, 1024, r, 1}; return d; } r -= T_I_SD;
    if (r < T_I_EG) { const int e = r >> 6; d = TDesc{p.in[22] + (size_t)e * 262144, (bf16_t*)(ws + WS_W_EGU) + (size_t)e * 524288, 1024, 256, r & 63, 3}; return d; } r -= T_I_EG;
    if (r < T_I_EG) { const int e = r >> 6; d = TDesc{p.in[23] + (size_t)e * 262144, (bf16_t*)(ws + WS_W_EGU) + (size_t)e * 524288, 1024, 256, r & 63, 4}; return d; } r -= T_I_EG;
    { const int e = r >> 6; d = TDesc{p.in[24] + (size_t)e * 262144, (bf16_t*)(ws + WS_W_ED) + (size_t)e * 262144, 256, 1024, r & 63, 1}; return d; } }
__device__ __forceinline__ void run_transposes(const Params& p, unsigned char* ws, LAS unsigned char* lds, int r0, int r1, int widx, int nw) {
    const int lane = tidx() & 63, wave = __builtin_amdgcn_readfirstlane(tidx() >> 6);
    LAS float* scr = (LAS float*)(lds + wave * 16640);
    int r = r1 - 1 - widx;
    if (r < r0) return;
    TDesc d0 = tdesc_of(p, ws, r), d1 = d0, d2 = d0; f32x4 v0[16], v1[16], v2[16];
    t_load(d0, lane, v0);
    bool h1 = (r - nw >= r0);
    if (h1) { d1 = tdesc_of(p, ws, r - nw); t_load(d1, lane, v1); }
    for (;;) {
        const bool h2 = h1 && (r - 2 * nw >= r0);
        if (h2) { d2 = tdesc_of(p, ws, r - 2 * nw); t_load(d2, lane, v2); }
        t_store(d0, v0, scr, lane);
        if (!h1) break;
        d0 = d1; d1 = d2; r -= nw; h1 = h2;
#pragma unroll
        for (int i = 0; i < 16; ++i) { v0[i] = v1[i]; v1[i] = v2[i]; }
    }
}
__device__ __forceinline__ void p0_prep(const Params& p, LAS unsigned char* lds, int vcu, int G) {
    const int tid = tidx(), lane = tid & 63, wave = __builtin_amdgcn_readfirstlane(tid >> 6);
    unsigned char* ws = p.ws;
    for (int it = vcu; it < 256; it += G) s5_tables_item(p, lds, it);
    {
        LAS float* sc = (LAS float*)lds;
        LAS float* red = (LAS float*)(lds + 32768);
        const float* c = p.in[1]; const float* w = p.in[2]; const float* bb = p.in[3]; float* ada = (float*)(ws + WS_ADA);
        bool loaded = false;
        for (int it = vcu; it < 96; it += G) {
            if (!loaded) { for (int i = tid; i < 8192; i += NTHR) { const float v = c[i]; sc[i] = v * sigmoidf_(v); } loaded = true; }
            __syncthreads();
            const int kq = tid >> 6, col = it * 64 + lane; float a[8];
#pragma unroll
            for (int b = 0; b < 8; ++b) a[b] = 0.f;
#pragma unroll 16
            for (int k = kq * 128; k < kq * 128 + 128; ++k) { const float wv = w[(size_t)k * 6144 + col];
#pragma unroll
                for (int b = 0; b < 8; ++b) a[b] += sc[b * 1024 + k] * wv; }
#pragma unroll
            for (int b = 0; b < 8; ++b) red[(kq * 8 + b) * 64 + lane] = a[b];
            __syncthreads();
            { const int b = tid >> 6; float s = bb[col];
#pragma unroll
              for (int q = 0; q < 8; ++q) s += red[(q * 8 + b) * 64 + lane];
              ada[b * 6144 + col] = s; }
            __syncthreads();
        }
        __syncthreads();
    }
    run_transposes(p, ws, lds, 0, T_NITEMS - T_LATE2 - ((G == 256) ? T_LATE : 0), vcu * NWAVES + wave, G * NWAVES);
    { const int gt = vcu * NTHR + tid, NGT = G * NTHR;
      u32x4* z = (u32x4*)(ws + WS_W_IN + (size_t)PROJ_USED * 1024 * 2);
      for (int i = gt; i < (PROJ_W - PROJ_USED) * 1024 * 2 / 16; i += NGT) z[i] = (u32x4){0u, 0u, 0u, 0u};
      int* id = (int*)(ws + WS_IDENT); for (int i = gt; i < NTOK; i += NGT) id[i] = (i % CHTOK) * NSLOT + 8;
      if (gt < 256) ((float*)(ws + WS_ONES))[gt] = 1.0f;
      for (int u = gt; u < 32 * 4 * 64; u += NGT) { const int l = u & 63, nt = (u >> 6) & 3, ks = u >> 8; const int n = nt * 16 + (l & 15), q = l >> 4; float hi[8], lo[8];
#pragma unroll
          for (int j = 0; j < 8; ++j) { const float w = p.in[20][(size_t)(ks * 32 + q * 8 + j) * 64 + n]; const float h = bf2f((unsigned short)f2bf(w)); hi[j] = h; lo[j] = w - h; }
          u32x4 o; o.x = pk2(hi[0], hi[1]); o.y = pk2(hi[2], hi[3]); o.z = pk2(hi[4], hi[5]); o.w = pk2(hi[6], hi[7]);
          *(u32x4*)((bf16_t*)(ws + WS_WRF) + (size_t)u * 8) = o;
          o.x = pk2(lo[0], lo[1]); o.y = pk2(lo[2], lo[3]); o.z = pk2(lo[4], lo[5]); o.w = pk2(lo[6], lo[7]);
          *(u32x4*)((bf16_t*)(ws + WS_WRF) + (size_t)(32 * 4 * 64 + u) * 8) = o; } }
}

__device__ __forceinline__ void p1_modulate(const Params& p, int vcu, int G) {
    const int tid = tidx(), lane = tid & 63, wave = tid >> 6; const int gw = vcu * NWAVES + wave, NGW = G * NWAVES;
    const float* ada = (const float*)(p.ws + WS_ADA); const float* g1 = p.in[4]; bf16_t* U = (bf16_t*)(p.ws + WS_U);
    f32x4 v[4];
    { const f32x4* xr = (const f32x4*)(p.in[0] + (size_t)(gw < NTOK ? gw : 0) * D) + lane;
#pragma unroll
      for (int j = 0; j < 4; ++j) v[j] = xr[64 * j]; }
    for (int m = gw; m < NTOK; m += NGW) {
        const int b = m >> 12; float s = 0.f;
#pragma unroll
        for (int j = 0; j < 4; ++j) s += (v[j].x * v[j].x + v[j].y * v[j].y) + (v[j].z * v[j].z + v[j].w * v[j].w);
        f32x4 vn[4];
        { const int mn = (m + NGW < NTOK) ? m + NGW : m; const f32x4* xr = (const f32x4*)(p.in[0] + (size_t)mn * D) + lane;
#pragma unroll
          for (int j = 0; j < 4; ++j) vn[j] = xr[64 * j]; }
        const float rstd = 1.0f / sqrtf(wave_sum(s) * (1.f / D) + EPS);
        unsigned long long* o8 = (unsigned long long*)(U + (size_t)m * D) + lane;
#pragma unroll
        for (int j = 0; j < 4; ++j) { const int c0 = 4 * lane + 256 * j;
            const f32x4 gg = *(const f32x4*)(g1 + c0), sh = *(const f32x4*)(ada + b * 6144 + c0), scl = *(const f32x4*)(ada + b * 6144 + 1024 + c0);
            const f32x4 y = v[j] * rstd * gg * (scl + 1.0f) + sh;
            o8[64 * j] = (unsigned long long)pk2(y.x, y.y) | ((unsigned long long)pk2(y.z, y.w) << 32); }
#pragma unroll
        for (int j = 0; j < 4; ++j) v[j] = vn[j];
    }
}

__device__ __forceinline__ void p_combine(const Params& p, int vcu, int G, int ch) {
    const int tid = tidx(), lane = tid & 63, wave = tid >> 6; const int gw = vcu * NWAVES + wave, NGW = G * NWAVES;
    const float* ada = (const float*)(p.ws + WS_ADA); const float* gf = p.in[28];
    const unsigned char* Y = (const unsigned char*)(p.ws + WS_Y);
    u32x4 w[NSLOT];
    { const int mi0 = gw < CHTOK ? gw : 0; const unsigned char* yp = Y + (size_t)mi0 * NSLOT * D + lane * 16;
#pragma unroll
      for (int k = 0; k < NSLOT; ++k) w[k] = *(const u32x4*)(yp + (size_t)k * D); }
    f32x4 h[4];
    { const float* hp = p.out + (size_t)(ch * CHTOK + (gw < CHTOK ? gw : 0)) * D + lane * 16;
#pragma unroll
      for (int q = 0; q < 4; ++q) h[q] = *(const f32x4*)(hp + 4 * q); }
    for (int mi = gw; mi < CHTOK; mi += NGW) {
        const int m = ch * CHTOK + mi; const int b = m >> 12;
        float* orow = p.out + (size_t)m * D + lane * 16;
        f32x4 g2[4], hn[4];
#pragma unroll
        for (int q = 0; q < 4; ++q) g2[q] = *(const f32x4*)(ada + b * 6144 + 5120 + lane * 16 + 4 * q);
        { const int mn = (mi + NGW < CHTOK) ? mi + NGW : mi; const float* hp = p.out + (size_t)(ch * CHTOK + mn) * D + lane * 16;
#pragma unroll
          for (int q = 0; q < 4; ++q) hn[q] = *(const f32x4*)(hp + 4 * q); }
        float a[16];
#pragma unroll
        for (int j = 0; j < 16; ++j) a[j] = 0.f;
#pragma unroll
        for (int k = 0; k < NSLOT; ++k)
#pragma unroll
            for (int q = 0; q < 4; ++q) { const f32x2 lo = __builtin_amdgcn_cvt_pk_f32_fp8((int)w[k][q], false), hi = __builtin_amdgcn_cvt_pk_f32_fp8((int)w[k][q], true);
                a[4 * q] += lo.x; a[4 * q + 1] += lo.y; a[4 * q + 2] += hi.x; a[4 * q + 3] += hi.y; }
        { const int mn = (mi + NGW < CHTOK) ? mi + NGW : mi; const unsigned char* yp = Y + (size_t)mn * NSLOT * D + lane * 16;
#pragma unroll
          for (int k = 0; k < NSLOT; ++k) w[k] = *(const u32x4*)(yp + (size_t)k * D); }
        float r[16]; float s = 0.f;
#pragma unroll
        for (int i = 0; i < 4; ++i)
#pragma unroll
            for (int j = 0; j < 4; ++j) { const float v = h[i][j] + g2[i][j] * (a[i * 4 + j] * (1.0f / Y_SCALE)); r[i * 4 + j] = v; s += v * v; }
        const float rstd = 1.0f / sqrtf(wave_sum(s) * (1.f / D) + EPS);
#pragma unroll
        for (int q = 0; q < 4; ++q) { const f32x4 g = *(const f32x4*)(gf + lane * 16 + 4 * q); f32x4 o;
#pragma unroll
            for (int j = 0; j < 4; ++j) o[j] = r[q * 4 + j] * rstd * g[j];
            *(f32x4*)(orow + 4 * q) = o; }
#pragma unroll
        for (int q = 0; q < 4; ++q) h[q] = hn[q];
    }
}

__device__ __forceinline__ unsigned fkey(float x) { const unsigned u = __builtin_bit_cast(unsigned, x); return (u & 0x80000000u) ? ~u : (u | 0x80000000u); }

__device__ __forceinline__ void gold_s5(const Params& p, int item, int lane) {
    const int b = item >> 5, g = item & 31;
    const bf16_t* PROJ = (const bf16_t*)(p.ws + WS_PROJ); bf16_t* YG = (bf16_t*)(p.ws + WS_YG);
    const float dt = expf(p.in[8][g]); const float lr = p.in[6][g * 64 + lane], li = p.in[7][g * 64 + lane];
    const float mag = expf(lr * dt); const float a_re = mag * cosf(li * dt), a_im = mag * sinf(li * dt);
    const float den = lr * lr + li * li, n_re = a_re - 1.0f;
    const float f_re = (n_re * lr + a_im * li) / den, f_im = (a_im * lr - n_re * li) / den;
    float bbr[16], bbi[16], cr[16], ci[16];
#pragma unroll
    for (int h = 0; h < 16; ++h) { const float br = p.in[9][(g * 64 + lane) * 16 + h], bi = p.in[10][(g * 64 + lane) * 16 + h];
        bbr[h] = f_re * br - f_im * bi; bbi[h] = f_re * bi + f_im * br;
        cr[h] = p.in[11][(g * 16 + h) * 64 + lane]; ci[h] = p.in[12][(g * 16 + h) * 64 + lane]; }
    const float dsk = p.in[13][g * 16 + (lane & 15)];
    float hr = 0.f, hi = 0.f;
    for (int t = 0; t < SEQ; ++t) {
        const size_t row = (size_t)b * SEQ + t;
        const u32x4 w0 = *(const u32x4*)(PROJ + row * PROJ_W + C_USSM + g * 16), w1 = *(const u32x4*)(PROJ + row * PROJ_W + C_USSM + g * 16 + 8);
        float u[16]; { float f[8]; unpack8(w0, f);
#pragma unroll
            for (int j = 0; j < 8; ++j) u[j] = f[j];
            unpack8(w1, f);
#pragma unroll
            for (int j = 0; j < 8; ++j) u[8 + j] = f[j]; }
        float bur = 0.f, bui = 0.f;
#pragma unroll
        for (int h = 0; h < 16; ++h) { bur += bbr[h] * u[h]; bui += bbi[h] * u[h]; }
        const float nr = a_re * hr - a_im * hi + bur, ni = a_re * hi + a_im * hr + bui; hr = nr; hi = ni;
        float y = 0.f, um = 0.f;
#pragma unroll
        for (int h = 0; h < 16; ++h) { const float v = wave_sum(cr[h] * hr - ci[h] * hi); if ((lane & 15) == h) { y = v; um = u[h]; } }
        y += dsk * um;
        const float gl = 0.5f * y * (1.0f + tanhf(0.7978845608028654f * (y + 0.044715f * y * y * y)));
        if (lane < 16) YG[row * 512 + g * 16 + lane] = (bf16_t)f2bf(gl);
    }
}

__device__ __forceinline__ void gold_attn_pair(const Params& p, LAS unsigned char* lds, int pairid) {
    const int half = tidx() >> 8, tid = tidx() & 255;
    LAS unsigned char* base = lds + half * 32768;
    LAS float* qi = (LAS float*)base; LAS float* qv = qi + 512; LAS float* sc = qv + 512; LAS float* lg = sc + 4096;
    LAS float* wi = lg + 2048; LAS float* mx = wi + 8; LAS float* sm = mx + 8; LAS int* sel = (LAS int*)(sm + 8); LAS int* red = sel + 256; LAS int* cntp = red + 256;
    const int qid = pairid * 2 + half; const int b = qid >> 12, t = qid & 4095;
    const bf16_t* PROJ = (const bf16_t*)(p.ws + WS_PROJ); bf16_t* YA = (bf16_t*)(p.ws + WS_YATTN);
    const size_t qrow = (size_t)qid * PROJ_W;
    __syncthreads();
    for (int i = tid; i < 512; i += 256) { qi[i] = bf2f(PROJ[qrow + C_QI + i]); qv[i] = bf2f(PROJ[qrow + C_Q + i]); }
    if (tid < 8) wi[tid] = bf2f(PROJ[qrow + C_WI + tid]);
    if (tid == 0) cntp[0] = 0;
    __syncthreads();
    const int n = t + 1;
    for (int s = tid; s < n; s += 256) {
        const bf16_t* kp = PROJ + ((size_t)b * SEQ + s) * PROJ_W + C_KI; float kk[64];
#pragma unroll
        for (int c8 = 0; c8 < 8; ++c8) { float f[8]; unpack8(*(const u32x4*)(kp + c8 * 8), f);
#pragma unroll
            for (int j = 0; j < 8; ++j) kk[c8 * 8 + j] = f[j]; }
        float score = 0.f;
        for (int h = 0; h < 8; ++h) { float d = 0.f;
#pragma unroll
            for (int j = 0; j < 64; ++j) d += qi[h * 64 + j] * kk[j];
            score += wi[h] * fmaxf(d, 0.f); }
        sc[s] = score;
    }
    __syncthreads();
    const bool small = (t | 1) <= 255;
    if (small) { if (tid < n) sel[tid] = tid; if (tid == 0) cntp[0] = n; __syncthreads(); }
    else {
        unsigned thr = 0u;
        for (int bit = 31; bit >= 0; --bit) {
            const unsigned cand = thr | (1u << bit); int c = 0;
            for (int s = tid; s < n; s += 256) c += (fkey(sc[s]) >= cand) ? 1 : 0;
            red[tid] = c; __syncthreads();
            for (int o = 128; o > 0; o >>= 1) { if (tid < o) red[tid] += red[tid + o]; __syncthreads(); }
            if (red[0] >= 256) thr = cand;
            __syncthreads();
        }
        for (int s = tid; s < n; s += 256) if (fkey(sc[s]) > thr) { const int ps = atomicAdd((int*)cntp, 1); sel[ps] = s; }
        __syncthreads();
        if (tid == 0) { int c = cntp[0]; for (int s = 0; s < n && c < 256; ++s) if (fkey(sc[s]) == thr) sel[c++] = s; cntp[0] = c; }
        __syncthreads();
    }
    const int ns = cntp[0];
    { const int j = tid; const int s = (j < ns) ? sel[j] : 0;
      const bf16_t* kp = PROJ + ((size_t)b * SEQ + s) * PROJ_W + C_K; float kk[64];
#pragma unroll
      for (int c8 = 0; c8 < 8; ++c8) { float f[8]; unpack8(*(const u32x4*)(kp + c8 * 8), f);
#pragma unroll
          for (int jj = 0; jj < 8; ++jj) kk[c8 * 8 + jj] = f[jj]; }
      for (int h = 0; h < 8; ++h) { float d = 0.f;
#pragma unroll
          for (int jj = 0; jj < 64; ++jj) d += qv[h * 64 + jj] * kk[jj];
          const float slope = exp2f(-(float)(h + 1));
          lg[h * 256 + j] = (j < ns) ? d * 0.125f - slope * (float)(t - s) : -INFINITY; } }
    __syncthreads();
    if (tid < 8) { float m = -INFINITY; for (int j = 0; j < 256; ++j) m = fmaxf(m, lg[tid * 256 + j]); float sum = 0.f; for (int j = 0; j < 256; ++j) sum += __expf(lg[tid * 256 + j] - m); mx[tid] = m; sm[tid] = sum; }
    __syncthreads();
    for (int i = tid; i < 2048; i += 256) { const int h = i >> 8; lg[i] = __expf(lg[i] - mx[h]) / sm[h]; }
    __syncthreads();
    { const int h = tid >> 5, d0 = (tid & 31) * 2; float o0 = 0.f, o1 = 0.f;
      for (int j = 0; j < ns; ++j) { const unsigned w = *(const unsigned*)(PROJ + ((size_t)b * SEQ + sel[j]) * PROJ_W + C_V + d0); const float pj = lg[h * 256 + j]; o0 += pj * bflo(w); o1 += pj * bfhi(w); }
      *(unsigned*)(YA + (size_t)qid * 512 + h * 64 + d0) = pk2(o0, o1); }
}

typedef float f32x16 __attribute__((ext_vector_type(16)));
typedef _Float16 f16_t;
constexpr int AT_SC = 0;
constexpr int AT_V = 65536;
constexpr int AT_SEL = LDS_CNT;
static_assert(AT_V + 8 * 2 * 4096 <= STAGE_BYTES && AT_SEL + 8 * 1152 <= LDS_BYTES, "attention LDS map");

__device__ __forceinline__ float relu_i(float x) { const int xi = __builtin_bit_cast(int, x); return __builtin_bit_cast(float, xi > 0 ? xi : 0); }
__device__ __forceinline__ u32x2 tr_read16(unsigned addr) { u32x2 r; asm volatile("ds_read_b64_tr_b16 %0, %1" : "=v"(r) : "v"(addr) : "memory"); return r; }

__device__ __forceinline__ void attn_item(const Params& p, LAS unsigned char* lds, int b, int qblk) {
    const int tid = tidx(), lane = tid & 63, wave = __builtin_amdgcn_readfirstlane(tid >> 6);
    const int q0 = qblk * 8;
    const bf16_t* PROJ = (const bf16_t*)(p.ws + WS_PROJ); bf16_t* YA = (bf16_t*)(p.ws + WS_YATTN);
    const size_t tok0 = (size_t)b * SEQ + q0;
    LAS unsigned short* SC = (LAS unsigned short*)(lds + AT_SC);
    LAS unsigned short* SELq = (LAS unsigned short*)(lds + AT_SEL) + wave * 576;
    const int nkt = (q0 + 8 + 31) >> 5;
    const int nchmax = (q0 + 8 + 511) >> 9;
    __syncthreads();
    for (int i = nkt * 32 + lane; i < nchmax * 512; i += 64) SC[wave * 4096 + i] = 0xFC00u;
    __syncthreads();
#ifndef AT_REP_A
#define AT_REP_A 1
#endif
#ifndef AT_REP_B
#define AT_REP_B 1
#endif
#ifndef AT_REP_C
#define AT_REP_C 1
#endif
#ifndef AT_SKIP_A
    for (int ra_ = 0; ra_ < AT_REP_A; ++ra_) {
        const int hf = lane >> 5, l32 = lane & 31;
        const int rq = 2 * ((l32 >> 2) & 1) + ((l32 >> 4) & 1), rh = (l32 & 3) + 4 * ((l32 >> 3) & 1);
        bf16x8 Af[2][4]; float wgt[2][16];
#pragma unroll
        for (int qg = 0; qg < 2; ++qg) { const bf16_t* qp = PROJ + (tok0 + 4 * qg + rq) * PROJ_W + C_QI + rh * 64 + hf * 8;
#pragma unroll
            for (int s = 0; s < 4; ++s) Af[qg][s] = *(const bf16x8*)(qp + s * 16);
#pragma unroll
            for (int qq = 0; qq < 2; ++qq) { const u32x4 w = *(const u32x4*)(PROJ + (tok0 + 4 * qg + 2 * hf + qq) * PROJ_W + C_WI); float f[8]; unpack8(w, f);
#pragma unroll
                for (int h = 0; h < 8; ++h) wgt[qg][qq * 8 + h] = f[h]; } }
        const bf16x8* KIF = (const bf16x8*)(p.ws + WS_KIF) + (size_t)b * 128 * 4 * 64 + lane;
        bf16x8 B0[4], B1[4];
        { const int kt0 = wave < nkt ? wave : 0, kt1 = wave + 8 < nkt ? wave + 8 : kt0;
#pragma unroll
          for (int s = 0; s < 4; ++s) { B0[s] = KIF[(kt0 * 4 + s) * 64]; B1[s] = KIF[(kt1 * 4 + s) * 64]; } }
#define STEP_A_TILE(BF, KT) do { const int key = (KT) * 32 + l32; \
            _Pragma("unroll") for (int qg = 0; qg < 2; ++qg) { \
                f32x16 c; _Pragma("unroll") for (int j = 0; j < 16; ++j) c[j] = 0.f; \
                _Pragma("unroll") for (int s = 0; s < 4; ++s) c = __builtin_amdgcn_mfma_f32_32x32x16_bf16(Af[qg][s], BF[s], c, 0, 0, 0); \
                float sa = 0.f, sb = 0.f; \
                _Pragma("unroll") for (int h = 0; h < 8; ++h) { sa += wgt[qg][h] * relu_i(c[h]); sb += wgt[qg][8 + h] * relu_i(c[8 + h]); } \
                const int qa = 4 * qg + 2 * hf; \
                sa = fminf(fmaxf(sa * 0.0441941738f, -60000.f), 60000.f); sb = fminf(fmaxf(sb * 0.0441941738f, -60000.f), 60000.f); \
                if (key > q0 + qa) sa = -INFINITY; \
                if (key > q0 + qa + 1) sb = -INFINITY; \
                const f16_t ha = (f16_t)sa, hb = (f16_t)sb; \
                SC[qa * 4096 + key] = __builtin_bit_cast(unsigned short, ha); SC[(qa + 1) * 4096 + key] = __builtin_bit_cast(unsigned short, hb); } } while (0)
        for (int kt = wave; kt < nkt; kt += 16) {
            STEP_A_TILE(B0, kt);
            { const int ktn = (kt + 16 < nkt) ? kt + 16 : kt;
#pragma unroll
              for (int s = 0; s < 4; ++s) B0[s] = KIF[(ktn * 4 + s) * 64]; }
            if (kt + 8 < nkt) {
                STEP_A_TILE(B1, kt + 8);
                { const int ktn = (kt + 24 < nkt) ? kt + 24 : kt;
#pragma unroll
                  for (int s = 0; s < 4; ++s) B1[s] = KIF[(ktn * 4 + s) * 64]; } }
        }
#undef STEP_A_TILE
    }
#endif
    __syncthreads();
    const int t = q0 + wave, n = t + 1;
    int ns;
    for (int rb_ = 0; rb_ < AT_REP_B; ++rb_) {
#ifdef AT_SKIP_B
    if (true) {
#else
    if (n <= 256) {
#endif
#pragma unroll
        for (int i = 0; i < 4; ++i) { const int pos = lane + 64 * i; SELq[pos] = (unsigned short)(pos < n ? pos : 0); }
        ns = n;
    } else {
        const int nch = (n + 511) >> 9;
        unsigned XH[32], XL[32];
        LAS unsigned char* row = lds + AT_SC + wave * 8192;
#pragma unroll
        for (int i = 0; i < 8; ++i) {
            if (i < nch) { const u32x4 w = *(const LAS u32x4*)(row + i * 1024 + lane * 16);
#pragma unroll
                for (int e2 = 0; e2 < 4; ++e2) { const unsigned x = w[e2]; const unsigned sg = (x & 0x80008000u) >> 15; const unsigned k2 = x ^ ((sg * 0xffffu) | 0x80008000u);
                    XH[i * 4 + e2] = k2; XL[i * 4 + e2] = k2 << 16; } }
            else {
#pragma unroll
                for (int e2 = 0; e2 < 4; ++e2) { XH[i * 4 + e2] = 0u; XL[i * 4 + e2] = 0u; } }
        }
        LAS unsigned* H1 = (LAS unsigned*)(lds + 65536 + wave * 8192);
        LAS unsigned* H2 = (LAS unsigned*)((LAS unsigned char*)SELq + 640);
        LAS unsigned* H1p = H1 + (lane & 1) * 1024;
#pragma unroll
        for (int i = 0; i < 8; ++i) *(LAS u32x4*)(H1 + (i * 64 + lane) * 4) = (u32x4){0u, 0u, 0u, 0u};
        H2[lane] = 0u;
        LDS_WAIT(); __builtin_amdgcn_wave_barrier();
#pragma unroll
        for (int i = 0; i < 8; ++i) if (i < nch) {
#pragma unroll
            for (int e2 = 0; e2 < 4; ++e2) { const unsigned x = XH[i * 4 + e2];
                __hip_atomic_fetch_add(H1p + (x >> 22), 1u, __ATOMIC_RELAXED, __HIP_MEMORY_SCOPE_WORKGROUP);
                __hip_atomic_fetch_add(H1p + ((x >> 6) & 1023u), 1u, __ATOMIC_RELAXED, __HIP_MEMORY_SCOPE_WORKGROUP); } }
        LDS_WAIT(); __builtin_amdgcn_wave_barrier();
        unsigned B1, cabove; const unsigned dummy = 64u + (unsigned)lane;
        {
            unsigned hb[16];
#pragma unroll
            for (int i = 0; i < 4; ++i) { const u32x4 w = *(const LAS u32x4*)(H1 + lane * 16 + i * 4), w2 = *(const LAS u32x4*)(H1 + 1024 + lane * 16 + i * 4); hb[4 * i] = w.x + w2.x; hb[4 * i + 1] = w.y + w2.y; hb[4 * i + 2] = w.z + w2.z; hb[4 * i + 3] = w.w + w2.w; }
            unsigned sl_ = 0u;
#pragma unroll
            for (int i = 0; i < 16; ++i) sl_ += hb[i];
            unsigned suf = sl_;
#pragma unroll
            for (int o = 1; o < 64; o <<= 1) { const unsigned a_ = __shfl_down(suf, o); if (lane + o < 64) suf += a_; }
            const unsigned above = suf - sl_;
            const bool mine = above < 256u && suf >= 256u;
            unsigned bsel = 0u, cab = 0u;
            if (mine) { unsigned run = above; bool done = false;
#pragma unroll
                for (int i = 15; i >= 0; --i) { if (!done && run + hb[i] >= 256u) { bsel = (unsigned)(lane * 16 + i); cab = run; done = true; } run += hb[i]; } }
            const unsigned long long mk = __ballot(mine); const int src = (int)__builtin_ctzll(mk);
            B1 = (unsigned)__shfl((int)bsel, src); cabove = (unsigned)__shfl((int)cab, src);
        }
#pragma unroll
        for (int i = 0; i < 8; ++i) if (i < nch) {
#pragma unroll
            for (int e2 = 0; e2 < 4; ++e2) { const unsigned x = XH[i * 4 + e2];
                const unsigned ah = ((x >> 22) == B1) ? ((x >> 16) & 63u) : dummy, al = (((x >> 6) & 1023u) == B1) ? (x & 63u) : dummy;
                __hip_atomic_fetch_add(H2 + ah, 1u, __ATOMIC_RELAXED, __HIP_MEMORY_SCOPE_WORKGROUP);
                __hip_atomic_fetch_add(H2 + al, 1u, __ATOMIC_RELAXED, __HIP_MEMORY_SCOPE_WORKGROUP); } }
        LDS_WAIT(); __builtin_amdgcn_wave_barrier();
        unsigned thr;
        {   const unsigned h2 = H2[lane]; unsigned suf = h2;
#pragma unroll
            for (int o = 1; o < 64; o <<= 1) { const unsigned a_ = __shfl_down(suf, o); if (lane + o < 64) suf += a_; }
            const unsigned need = 256u - cabove;
            const bool mine = (suf - h2) < need && suf >= need;
            const unsigned long long mk = __ballot(mine); const unsigned B2 = (unsigned)__builtin_ctzll(mk);
            thr = (B1 << 6) | B2; }
        const unsigned c32 = thr << 16, c32h = c32 | 0xffffu;
#define TIE2(a, b) asm volatile("" : "+v"(a), "+v"(b))
        int cgt = 0, ceq = 0;
#pragma unroll
        for (int j = 0; j < 32; ++j) { unsigned xh = XH[j], xl = XL[j]; TIE2(xh, cgt); TIE2(xl, ceq);
            cgt += (xh > c32h) ? 1 : 0; cgt += (xl > c32) ? 1 : 0; ceq += ((xh >> 16) == thr) ? 1 : 0; ceq += (xl == c32) ? 1 : 0; }
        int sgt = cgt, seq = ceq;
#pragma unroll
        for (int o = 1; o < 64; o <<= 1) { const int a = __shfl_up(sgt, o), e = __shfl_up(seq, o); if (lane >= o) { sgt += a; seq += e; } }
        const int tot_gt = __shfl(sgt, 63);
        int o1 = sgt - cgt, o2 = tot_gt + seq - ceq;
        const int trash = 256 + lane;
#pragma unroll
        for (int i = 0; i < 8; ++i) if (i < nch) {
#pragma unroll
            for (int e2 = 0; e2 < 4; ++e2) { const int j = i * 4 + e2; const int idx = i * 512 + lane * 8 + 2 * e2;
                unsigned xl = XL[j], xh = XH[j]; TIE2(xl, o1); TIE2(xh, o2);
                { const bool gt = xl > c32, eq = xl == c32; const int a2 = (eq && o2 < 256) ? o2 : trash, a1 = gt ? o1 : a2; SELq[a1] = (unsigned short)idx; o1 += gt ? 1 : 0; o2 += eq ? 1 : 0; }
                TIE2(xh, o1);
                { const bool gt = xh > c32h, eq = (xh >> 16) == thr; const int a2 = (eq && o2 < 256) ? o2 : trash, a1 = gt ? o1 : a2; SELq[a1] = (unsigned short)(idx + 1); o1 += gt ? 1 : 0; o2 += eq ? 1 : 0; } } }
        ns = 256;
    }
    LDS_WAIT(); __builtin_amdgcn_wave_barrier(); }
    __syncthreads();
    {
        const int hd = lane & 15, qd = lane >> 4;
        const size_t tok = tok0 + wave;
        LAS unsigned char* vb = lds + wave * 16384;
        const unsigned vb_addr = (unsigned)(size_t)vb;
        const int vrow = lane >> 3, vch = lane & 7;
        const char* bbase = (const char*)(PROJ + (size_t)b * SEQ * PROJ_W);
        const unsigned voff0 = (unsigned)(C_V * 2 + vch * 16), koff0 = (unsigned)(C_K * 2 + qd * 16);
        unsigned roff[32];
#pragma unroll
        for (int j_ = 0; j_ < 32; ++j_) roff[j_] = (unsigned)SELq[(j_ >> 2) * 32 + vrow + 8 * (j_ & 3)] * (unsigned)(PROJ_W * 2);
#define V_DMA(sl) do { _Pragma("unroll") for (int i_ = 0; i_ < 4; ++i_) { \
            __builtin_amdgcn_global_load_lds((const unsigned*)(bbase + (roff[(sl) * 4 + i_] + voff0)), (LAS unsigned*)(vb + ((sl) & 3) * 4096 + i_ * 1024), 16, 0, 0); } } while (0)
        bf16x8 Qf[2];
#pragma unroll
        for (int ks = 0; ks < 2; ++ks) { if (hd < 8) Qf[ks] = *(const bf16x8*)(PROJ + tok * PROJ_W + C_Q + hd * 64 + ks * 32 + qd * 8); else Qf[ks] = (bf16x8){0, 0, 0, 0, 0, 0, 0, 0}; }
#define KSWZ(row) ((unsigned)(((row) & 3) | ((((row) >> 3) & 1) << 2)))
#define K_DMA(sl) do { _Pragma("unroll") for (int i_ = 0; i_ < 4; ++i_) { const int row_ = i_ * 8 + vrow; \
            __builtin_amdgcn_global_load_lds((const unsigned*)(bbase + (roff[(sl) * 4 + i_] + (unsigned)(C_K * 2) + (((unsigned)vch ^ KSWZ(row_)) * 16u))), (LAS unsigned*)(vb + ((sl) & 3) * 4096 + i_ * 1024), 16, 0, 0); } } while (0)
        (void)koff0;
        K_DMA(0); K_DMA(1); K_DMA(2); K_DMA(3);
        f32x4 S[16];
#pragma unroll
        for (int sl = 0; sl < 8; ++sl) {
            asm volatile("s_waitcnt vmcnt(12)" ::: "memory");
#pragma unroll
            for (int Th = 0; Th < 2; ++Th) { const int prow = (hd >> 2) * 8 + Th * 4 + (hd & 3); const unsigned fp = KSWZ(prow);
                const LAS unsigned char* ka = vb + (sl & 3) * 4096 + prow * 128;
                const bf16x8 K0 = *(const LAS bf16x8*)(ka + (((unsigned)qd ^ fp) * 16u)), K1 = *(const LAS bf16x8*)(ka + (((unsigned)(4 + qd) ^ fp) * 16u));
                f32x4 a = (f32x4){0.f, 0.f, 0.f, 0.f};
                a = __builtin_amdgcn_mfma_f32_16x16x32_bf16(K0, Qf[0], a, 0, 0, 0); a = __builtin_amdgcn_mfma_f32_16x16x32_bf16(K1, Qf[1], a, 0, 0, 0); S[2 * sl + Th] = a; }
            asm volatile("s_waitcnt lgkmcnt(0)" ::: "memory");
            if (sl + 4 < 8) K_DMA(sl + 4); else V_DMA(sl - 4);
        }
        const float slope = exp2f(-(float)((hd & 7) + 1)), abase = -slope * (float)t;
        float mx = -INFINITY;
#pragma unroll
        for (int sl = 0; sl < 8; ++sl) { const u32x4 w = *(const LAS u32x4*)((LAS unsigned char*)SELq + (sl * 32 + qd * 8) * 2);
#pragma unroll
            for (int e = 0; e < 8; ++e) { const int T = sl * 2 + (e >> 2), r = e & 3; const unsigned ww = w[e >> 1]; const float sf = (float)((e & 1) ? (ww >> 16) : (ww & 0xffffu));
                const float lgv = __builtin_fmaf(S[T][r], 0.125f, __builtin_fmaf(slope, sf, abase)); S[T][r] = lgv; } }
        if (ns < 256) {
#pragma unroll
            for (int sl = 0; sl < 8; ++sl)
#pragma unroll
                for (int e = 0; e < 8; ++e) { if (sl * 32 + qd * 8 + e >= ns) S[sl * 2 + (e >> 2)][e & 3] = -INFINITY; } }
#pragma unroll
        for (int T = 0; T < 16; ++T) { asm("v_max3_f32 %0, %0, %1, %2" : "+v"(mx) : "v"(S[T][0]), "v"(S[T][1])); asm("v_max3_f32 %0, %0, %1, %2" : "+v"(mx) : "v"(S[T][2]), "v"(S[T][3])); }
        mx = fmaxf(mx, __shfl_xor(mx, 16)); mx = fmaxf(mx, __shfl_xor(mx, 32));
        float sum = 0.f;
        const float mxl = mx * 1.44269504089f;
#pragma unroll
        for (int T = 0; T < 16; ++T)
#pragma unroll
            for (int r = 0; r < 4; ++r) { const float e = __builtin_amdgcn_exp2f(S[T][r] * 1.44269504089f - mxl); S[T][r] = e; sum += e; }
        sum += __shfl_xor(sum, 16); sum += __shfl_xor(sum, 32);
        u32x4 Pk[8];
#pragma unroll
        for (int sl = 0; sl < 8; ++sl) { Pk[sl].x = pk2(S[2 * sl][0], S[2 * sl][1]); Pk[sl].y = pk2(S[2 * sl][2], S[2 * sl][3]); Pk[sl].z = pk2(S[2 * sl + 1][0], S[2 * sl + 1][1]); Pk[sl].w = pk2(S[2 * sl + 1][2], S[2 * sl + 1][3]); }
        f32x4 O[4];
#pragma unroll
        for (int dt = 0; dt < 4; ++dt) O[dt] = (f32x4){0.f, 0.f, 0.f, 0.f};
#pragma unroll
        for (int sl = 0; sl < 8; ++sl) {
            if (sl <= 4) asm volatile("s_waitcnt vmcnt(12)" ::: "memory"); else if (sl == 5) asm volatile("s_waitcnt vmcnt(8)" ::: "memory"); else if (sl == 6) asm volatile("s_waitcnt vmcnt(4)" ::: "memory"); else asm volatile("s_waitcnt vmcnt(0)" ::: "memory");
            const unsigned a0 = vb_addr + (sl & 3) * 4096 + (8 * qd + (hd >> 2)) * 128 + (hd & 3) * 8;
            u32x2 tr[4][2];
            asm volatile("ds_read_b64_tr_b16 %0, %8\n\tds_read_b64_tr_b16 %1, %8 offset:512\n\tds_read_b64_tr_b16 %2, %8 offset:32\n\tds_read_b64_tr_b16 %3, %8 offset:544\n\t"
                         "ds_read_b64_tr_b16 %4, %8 offset:64\n\tds_read_b64_tr_b16 %5, %8 offset:576\n\tds_read_b64_tr_b16 %6, %8 offset:96\n\tds_read_b64_tr_b16 %7, %8 offset:608\n\ts_waitcnt lgkmcnt(0)"
                         : "=&v"(tr[0][0]), "=&v"(tr[0][1]), "=&v"(tr[1][0]), "=&v"(tr[1][1]), "=&v"(tr[2][0]), "=&v"(tr[2][1]), "=&v"(tr[3][0]), "=&v"(tr[3][1]) : "v"(a0) : "memory");
            if (sl + 4 < 8) V_DMA(sl + 4);
            const bf16x8 Pf = __builtin_bit_cast(bf16x8, Pk[sl]);
#pragma unroll
            for (int dt = 0; dt < 4; ++dt) { u32x4 vw; vw.x = tr[dt][0].x; vw.y = tr[dt][0].y; vw.z = tr[dt][1].x; vw.w = tr[dt][1].y;
                O[dt] = __builtin_amdgcn_mfma_f32_16x16x32_bf16(__builtin_bit_cast(bf16x8, vw), Pf, O[dt], 0, 0, 0); }
        }
#undef V_DMA
        const float inv = 1.0f / sum;
        if (hd < 8) {
#pragma unroll
            for (int dt = 0; dt < 4; ++dt) { u32x2 w; w.x = pk2(O[dt][0] * inv, O[dt][1] * inv); w.y = pk2(O[dt][2] * inv, O[dt][3] * inv);
                *(u32x2*)(YA + tok * 512 + hd * 64 + dt * 16 + qd * 4) = w; } }
    }
}

#define DPP_F(v, ctrl, rmask) __builtin_bit_cast(float, __builtin_amdgcn_update_dpp(__builtin_bit_cast(int, v), __builtin_bit_cast(int, v), ctrl, rmask, 0xf, false))
__device__ __forceinline__ float wave_max_dpp(float v) {
    asm volatile("s_nop 1\n\tv_max_f32_dpp %0, %0, %0 row_shr:1 row_mask:0xf bank_mask:0xf\n\ts_nop 1\n\tv_max_f32_dpp %0, %0, %0 row_shr:2 row_mask:0xf bank_mask:0xf\n\ts_nop 1\n\t"
                 "v_max_f32_dpp %0, %0, %0 row_shr:3 row_mask:0xf bank_mask:0xf\n\ts_nop 1\n\tv_max_f32_dpp %0, %0, %0 row_shr:4 row_mask:0xf bank_mask:0xf\n\ts_nop 1\n\t"
                 "v_max_f32_dpp %0, %0, %0 row_shr:8 row_mask:0xf bank_mask:0xf\n\ts_nop 1\n\tv_max_f32_dpp %0, %0, %0 row_bcast:15 row_mask:0xa bank_mask:0xf\n\ts_nop 1\n\t"
                 "v_max_f32_dpp %0, %0, %0 row_bcast:31 row_mask:0xc bank_mask:0xf\n\ts_nop 1" : "+v"(v));
    return __builtin_bit_cast(float, __builtin_amdgcn_readlane(__builtin_bit_cast(int, v), 63));
}
#define DPP_Z(v, ctrl, rmask, bmask) __builtin_bit_cast(float, __builtin_amdgcn_update_dpp(0, __builtin_bit_cast(int, v), ctrl, rmask, bmask, false))
__device__ __forceinline__ float wave_sum_dpp(float v0) {
    float v1 = v0 + DPP_Z(v0, 0x111, 0xf, 0xf); v1 += DPP_Z(v0, 0x112, 0xf, 0xf); v1 += DPP_Z(v0, 0x113, 0xf, 0xf);
    v1 += DPP_Z(v1, 0x114, 0xf, 0xe); v1 += DPP_Z(v1, 0x118, 0xf, 0xc);
    v1 += DPP_Z(v1, 0x142, 0xa, 0xf); v1 += DPP_Z(v1, 0x143, 0xc, 0xf);
    return __builtin_bit_cast(float, __builtin_amdgcn_readlane(__builtin_bit_cast(int, v1), 63));
}
constexpr int RT_LG = 0;
constexpr int RT_ENT = 32768;
constexpr int RT_HIST = RT_ENT + 8 * 128 * 12;
constexpr int RT_NV = 49152;
__device__ __forceinline__ void route_tile(const Params& p, LAS unsigned char* lds, int tile, int skip) {
    const int tid = tidx(), lane = tid & 63, wave = __builtin_amdgcn_readfirstlane(tid >> 6), hd = lane & 15, qd = lane >> 4;
    const float* ada = (const float*)(p.ws + WS_ADA); const float* g2 = p.in[19];
    bf16_t* U2 = (bf16_t*)(p.ws + WS_U);
    LAS int* hist = (LAS int*)(lds + RT_HIST);
    LAS float* LGT = (LAS float*)(lds + RT_LG);
    LAS int* ENT = (LAS int*)(lds + RT_ENT) + wave * 384;
    const int b = (tile * 128) >> 12;
    __syncthreads();
    if (tid < 64) hist[tid] = 0;
    if (tid == 64) hist[128] = 0;
    { LAS float* NV = (LAS float*)(lds + RT_NV);
      for (int i = tid; i < 256; i += NTHR) { const f32x4 g = *(const f32x4*)(g2 + 4 * i), sc = *(const f32x4*)(ada + b * 6144 + 4096 + 4 * i), sh = *(const f32x4*)(ada + b * 6144 + 3072 + 4 * i);
          *(LAS f32x4*)(NV + 4 * i) = g * (sc + 1.0f); *(LAS f32x4*)(NV + 1024 + 4 * i) = sh; } }
    __syncthreads();
    if (wave < 4) {
        const int tokw = tile * 128 + wave * 32;
        float rstd[2]; const float* hrow[2];
#pragma unroll
        for (int rt = 0; rt < 2; ++rt) { const int m = tokw + rt * 16 + hd; hrow[rt] = p.out + (size_t)m * D + qd * 8;
            const f32x4 q4 = *(const f32x4*)((const float*)(p.ws + WS_SS) + (size_t)m * 16 + qd * 4); float ss = (q4.x + q4.y) + (q4.z + q4.w);
            ss += __shfl_xor(ss, 16); ss += __shfl_xor(ss, 32); rstd[rt] = 1.0f / sqrtf(ss * (1.f / D) + EPS); }
        const bf16x8* WH = (const bf16x8*)(p.ws + WS_WRF) + lane; const bf16x8* WL = WH + 32 * 4 * 64;
        f32x4 acc[2][4];
#pragma unroll
        for (int rt = 0; rt < 2; ++rt)
#pragma unroll
            for (int nt = 0; nt < 4; ++nt) acc[rt][nt] = (f32x4){0.f, 0.f, 0.f, 0.f};
        bf16x8 wh[4], wl[4], whn[4], wln[4]; f32x4 xa[2][2], xn[2][2];
#pragma unroll
        for (int nt = 0; nt < 4; ++nt) { wh[nt] = WH[nt * 64]; wl[nt] = WL[nt * 64]; }
#pragma unroll
        for (int rt = 0; rt < 2; ++rt) { xa[rt][0] = *(const f32x4*)(hrow[rt]); xa[rt][1] = *(const f32x4*)(hrow[rt] + 4); }
#pragma unroll 2
        for (int ks = 0; ks < 32; ++ks) {
            const int kn = (ks + 1 < 32) ? ks + 1 : ks;
#pragma unroll
            for (int nt = 0; nt < 4; ++nt) { whn[nt] = WH[(kn * 4 + nt) * 64]; wln[nt] = WL[(kn * 4 + nt) * 64]; }
#pragma unroll
            for (int rt = 0; rt < 2; ++rt) { xn[rt][0] = *(const f32x4*)(hrow[rt] + kn * 32); xn[rt][1] = *(const f32x4*)(hrow[rt] + kn * 32 + 4); }
            const int c0 = ks * 32 + qd * 8;
            const LAS float* NV = (const LAS float*)(lds + RT_NV);
            const f32x4 ma = *(const LAS f32x4*)(NV + c0), mb = *(const LAS f32x4*)(NV + c0 + 4), ha = *(const LAS f32x4*)(NV + 1024 + c0), hb = *(const LAS f32x4*)(NV + 1024 + c0 + 4);
#pragma unroll
            for (int rt = 0; rt < 2; ++rt) {
                const f32x4 y0 = xa[rt][0] * rstd[rt] * ma + ha, y1 = xa[rt][1] * rstd[rt] * mb + hb;
                const u32x4 hi = pack8(y0, y1);
                f32x4 r0, r1; r0.x = y0.x - bflo(hi.x); r0.y = y0.y - bfhi(hi.x); r0.z = y0.z - bflo(hi.y); r0.w = y0.w - bfhi(hi.y);
                r1.x = y1.x - bflo(hi.z); r1.y = y1.y - bfhi(hi.z); r1.z = y1.z - bflo(hi.w); r1.w = y1.w - bfhi(hi.w);
                const bf16x8 uh = __builtin_bit_cast(bf16x8, hi), ul = __builtin_bit_cast(bf16x8, pack8(r0, r1));
#pragma unroll
                for (int nt = 0; nt < 4; ++nt) {
                    acc[rt][nt] = __builtin_amdgcn_mfma_f32_16x16x32_bf16(wh[nt], uh, acc[rt][nt], 0, 0, 0);
                    acc[rt][nt] = __builtin_amdgcn_mfma_f32_16x16x32_bf16(wl[nt], uh, acc[rt][nt], 0, 0, 0);
                    acc[rt][nt] = __builtin_amdgcn_mfma_f32_16x16x32_bf16(wh[nt], ul, acc[rt][nt], 0, 0, 0); } }
#pragma unroll
            for (int nt = 0; nt < 4; ++nt) { wh[nt] = whn[nt]; wl[nt] = wln[nt]; }
#pragma unroll
            for (int rt = 0; rt < 2; ++rt) { xa[rt][0] = xn[rt][0]; xa[rt][1] = xn[rt][1]; }
        }
#pragma unroll
        for (int rt = 0; rt < 2; ++rt)
#pragma unroll
            for (int nt = 0; nt < 4; ++nt) *(LAS f32x4*)(LGT + (wave * 32 + rt * 16 + hd) * 64 + nt * 16 + qd * 4) = acc[rt][nt];
    }
    {
        LAS int* rowctr = hist + 128;
        LAS const float* NV = (LAS const float*)(lds + RT_NV);
        auto claim = [&]() -> int { int r = 0; if (lane == 0) r = __hip_atomic_fetch_add(rowctr, 1, __ATOMIC_RELAXED, __HIP_MEMORY_SCOPE_WORKGROUP); return __builtin_amdgcn_readfirstlane(r); };
        int r = claim(); f32x4 v[4]; float ssl = 0.f;
        if (r < 128) { const int m = tile * 128 + r; const f32x4* xr = (const f32x4*)(p.out + (size_t)m * D) + lane;
#pragma unroll
            for (int j = 0; j < 4; ++j) v[j] = xr[64 * j];
            ssl = ((const float*)(p.ws + WS_SS))[(size_t)m * 16 + (lane & 15)]; }
        while (r < 128) {
            const int rn = claim(); f32x4 vn[4]; float ssn = 0.f;
            if (rn < 128) { const int mn = tile * 128 + rn; const f32x4* xr = (const f32x4*)(p.out + (size_t)mn * D) + lane;
#pragma unroll
                for (int j = 0; j < 4; ++j) vn[j] = xr[64 * j];
                ssn = ((const float*)(p.ws + WS_SS))[(size_t)mn * 16 + (lane & 15)]; }
            else {
#pragma unroll
                for (int j = 0; j < 4; ++j) vn[j] = v[j]; }
            float ss = ssl; ss += __shfl_xor(ss, 1); ss += __shfl_xor(ss, 2); ss += __shfl_xor(ss, 4); ss += __shfl_xor(ss, 8);
            const float rstd = 1.0f / sqrtf(ss * (1.f / D) + EPS);
            unsigned long long* o8 = (unsigned long long*)(U2 + (size_t)(tile * 128 + r) * D) + lane;
#pragma unroll
            for (int j = 0; j < 4; ++j) { const int c0 = 4 * lane + 256 * j; const f32x4 ma = *(LAS const f32x4*)(NV + c0), sh = *(LAS const f32x4*)(NV + 1024 + c0);
                const f32x4 y = v[j] * rstd * ma + sh;
                o8[64 * j] = (unsigned long long)pk2(y.x, y.y) | ((unsigned long long)pk2(y.z, y.w) << 32); }
#pragma unroll
            for (int j = 0; j < 4; ++j) v[j] = vn[j];
            ssl = ssn; r = rn;
        }
    }
    __syncthreads();
    const int tok0 = tile * 128 + wave * 16;
    LAS float* LG = LGT + wave * 1024;
    const float rbias = p.in[21][lane];
#pragma unroll 1
    for (int mi = 0; mi < 16; ++mi) {
        const float score = sigmoidf_(LG[mi * 64 + lane]); const float biased = score + rbias;
        float m1 = biased;
        m1 = fmaxf(m1, DPP_F(m1, 0xb1, 0xf)); m1 = fmaxf(m1, DPP_F(m1, 0x4e, 0xf)); m1 = fmaxf(m1, DPP_F(m1, 0x141, 0xf));
        const unsigned long long bal = __ballot(biased == m1); const int grp = lane >> 3;
        const unsigned gm = (unsigned)((bal >> (grp * 8)) & 0xffull); const int first = __ffs((int)gm) - 1;
        float v2 = ((lane & 7) == first) ? -INFINITY : biased;
        v2 = fmaxf(v2, DPP_F(v2, 0xb1, 0xf)); v2 = fmaxf(v2, DPP_F(v2, 0x4e, 0xf)); v2 = fmaxf(v2, DPP_F(v2, 0x141, 0xf));
        const float gscore = m1 + v2;
        int grank = 0;
#pragma unroll
        for (int og = 0; og < 8; ++og) { const float o = __builtin_bit_cast(float, __builtin_amdgcn_readlane(__builtin_bit_cast(int, gscore), og * 8)); grank += (o > gscore || (o == gscore && og < grp)) ? 1 : 0; }
        float mv = (grank < 4) ? biased : -INFINITY;
        unsigned long long chosen_m = 0ull;
#pragma unroll 1
        for (int it = 0; it < 8; ++it) { const float mxv = wave_max_dpp(mv); const unsigned long long e = __ballot(mv == mxv); const int w = (int)__builtin_ctzll(e); chosen_m |= 1ull << w; if (lane == w) mv = -INFINITY; }
        const bool chosen = (chosen_m >> lane) & 1ull;
        const int rank = (int)__builtin_amdgcn_mbcnt_hi((unsigned)(chosen_m >> 32), __builtin_amdgcn_mbcnt_lo((unsigned)chosen_m, 0u));
        const float gsum = wave_sum_dpp(chosen ? score : 0.f);
        if (chosen) { const int lpos = __hip_atomic_fetch_add(hist + lane, 1, __ATOMIC_RELAXED, __HIP_MEMORY_SCOPE_WORKGROUP);   const int e = mi * 8 + rank; ENT[e * 3] = lane; ENT[e * 3 + 1] = lpos; ENT[e * 3 + 2] = __builtin_bit_cast(int, score / gsum * 2.5f); }
    }
    __syncthreads();
    const int ch = (tile * 128) / CHTOK;
    if (skip) return;
    if (tid < 64) { const int c = hist[tid]; int base = 0; if (c > 0) base = (int)atomicAdd((unsigned*)(p.ws + WS_CTL) + CW_CNT + ch * NE + tid, (unsigned)c); hist[64 + tid] = base; }
    __syncthreads();
#pragma unroll
    for (int i = 0; i < 2; ++i) { const int e = lane + 64 * i; const int ex = ENT[e * 3], lpos = ENT[e * 3 + 1]; const float gate = __builtin_bit_cast(float, ENT[e * 3 + 2]);
        const int m = tok0 + (e >> 3), rk = e & 7, pair = ch * NE + ex, ps = hist[64 + ex] + lpos;
        ((int*)(p.ws + WS_DSTL))[(size_t)pair * PAIRCAP + ps] = (m - ch * CHTOK) * NSLOT + rk; ((float*)(p.ws + WS_GATEL))[(size_t)pair * PAIRCAP + ps] = gate; }
}

#define XB_TMO      128
#define XB_XCNT(j)  (256  + 64 * (j))
#define XB_XSUB(j)  (1280 + 64 * (j))
#define XB_XGEN(j)  (2304 + 64 * (j))
#define XB_TOP      3328
#define XB_TOPGEN   3392
#define XCD_BAR_WORDS 3456
#define XB_SPIN_CAP (1u << 22)
__device__ __forceinline__ unsigned xb_ld(unsigned* p)              { return __hip_atomic_load(p, __ATOMIC_RELAXED, __HIP_MEMORY_SCOPE_AGENT); }
__device__ __forceinline__ unsigned xb_add(unsigned* p, unsigned v) { return __hip_atomic_fetch_add(p, v, __ATOMIC_RELAXED, __HIP_MEMORY_SCOPE_AGENT); }
__device__ __forceinline__ unsigned xb_xcc_id() { return (unsigned)__builtin_amdgcn_s_getreg((3 << 11) | 20) & 0xFu; }
#define XB_SPIN(cond, bar) do { unsigned _sp = 0; while (cond) { __builtin_amdgcn_s_sleep(1); \
    if ((++_sp & 255u) == 0u) { if (xb_ld(&(bar)[XB_TMO])) break; if (_sp > XB_SPIN_CAP) { atomicAdd(&(bar)[XB_TMO], 1u); break; } } } } while (0)
struct XcdBarrier { unsigned* bar; unsigned x; volatile LAS unsigned* st; };
__device__ __forceinline__ XcdBarrier xcd_barrier_post(unsigned* bar, volatile LAS unsigned* st) {
    XcdBarrier b; b.bar = bar; b.x = xb_xcc_id(); b.st = st;
    if (tidx() == 0) (void)xb_add(&bar[XB_XCNT(b.x)], 1u);
    return b;
}
__device__ __forceinline__ void xcd_barrier_complete(unsigned* bar, unsigned x, unsigned& nloc, unsigned& nx) {
    const unsigned G = gridDim.x * gridDim.y * gridDim.z;
    unsigned sum, cnt, mine, sp = 0u;
    for (;;) {
        sum = 0u; cnt = 0u; mine = 0u;
#pragma unroll
        for (unsigned j = 0; j < 16; ++j) { const unsigned c = xb_ld(&bar[XB_XCNT(j)]); sum += c; cnt += (c > 0u) ? 1u : 0u; mine = (j == x) ? c : mine; }
        if (sum == G) break;
        __builtin_amdgcn_s_sleep(1);
        if ((++sp & 255u) == 0u) { if (xb_ld(&bar[XB_TMO])) break; if (sp > XB_SPIN_CAP) { atomicAdd(&bar[XB_TMO], 1u); break; } }
    }
    nloc = mine > 0u ? mine : 1u; nx = cnt > 0u ? cnt : 1u;
}
__device__ __forceinline__ void xcd_barrier(const XcdBarrier& b) {
    asm volatile("s_waitcnt vmcnt(0)" ::: "memory");
    __syncthreads();
    if (tidx() == 0) {
        unsigned* bar = b.bar;
        __builtin_amdgcn_s_waitcnt(0);
        unsigned nloc = b.st[0], nx = b.st[1];
        if (nloc == 0u) { xcd_barrier_complete(bar, b.x, nloc, nx); b.st[0] = nloc; b.st[1] = nx; }
        const unsigned old = xb_add(&bar[XB_XSUB(b.x)], 1u);
        const unsigned gen = old / nloc;
        if (old + 1u == (gen + 1u) * nloc) {
            __builtin_amdgcn_fence(__ATOMIC_RELEASE, "agent");
            asm volatile("s_waitcnt vmcnt(0)" ::: "memory");
            const unsigned og = xb_add(&bar[XB_TOP], 1u);
            const unsigned tg = og / nx;
            if (og + 1u == (tg + 1u) * nx) xb_add(&bar[XB_TOPGEN], 1u);
            else XB_SPIN(xb_ld(&bar[XB_TOPGEN]) == tg, bar);
            __builtin_amdgcn_fence(__ATOMIC_ACQUIRE, "agent");
            xb_add(&bar[XB_XGEN(b.x)], 1u);
            asm volatile("s_waitcnt vmcnt(0)" ::: "memory");
        } else {
            XB_SPIN(xb_ld(&bar[XB_XGEN(b.x)]) == gen, bar);
            __builtin_amdgcn_fence(__ATOMIC_ACQUIRE, "agent");
            asm volatile("s_waitcnt vmcnt(0)" ::: "memory");
        }
    }
    __syncthreads();
}

enum { PH_PREP = 0, PH_MOD, PH_INPROJ, PH_MIX  , PH_GLU, PH_MIXAB, PH_OUT, PH_ROUTE  , PH_MOE1, PH_MOE2_0, PH_COMB_0, PH_END };

#ifndef USE_CG_SYNC
#define USE_CG_SYNC 0
#endif
__global__ void __launch_bounds__(NTHR, 2) mega(Params p_arg) {
    extern __shared__ __attribute__((aligned(16))) unsigned char lds_raw[];
    LAS unsigned char* lds = (LAS unsigned char*)lds_raw;
    const int G = gridDim.x, bx = blockIdx.x;
    const int vcu = (G % 8 == 0) ? (bx % 8) * (G / 8) + bx / 8 : bx;
    const int tid = tidx(), lane = tid & 63, wave = __builtin_amdgcn_readfirstlane(tid >> 6);
    unsigned char* const ws_ = p_arg.ws; unsigned char* ws = ws_; (void)ws;
    if (tid < 32) ((LAS unsigned*)(lds + LDS_MISC))[tid] = 0u;
    __syncthreads();
#if USE_CG_SYNC
    cg::grid_group grid = cg::this_grid();
#define GRID_SYNC() grid.sync()
#else
    XcdBarrier xbar = xcd_barrier_post((unsigned*)(ws + WS_CTL) + CW_BAR, (volatile LAS unsigned*)(lds + LDS_MISC) + 8);
#define GRID_SYNC() xcd_barrier(xbar)
#endif
#ifndef ONLY_PH
#define ONLY_PH -1
#endif
#define IN(k) (ONLY_PH < 0 || ONLY_PH == (k))
#define SEAM(k) do { if ((k) + 1 < PH_END) GRID_SYNC(); } while (0)
#ifndef REP_PH
#define REP_PH -1
#endif
#ifndef REP_N
#define REP_N 3
#endif
#ifndef PROBE_NOSTORE
#define PROBE_NOSTORE 0
#endif
#define PHASE(k, ...) do { if (IN(k)) { { const int PROBE_SKIP = 0; unsigned zoff_ = 0u; asm volatile("" : "+s"(zoff_)); unsigned char* ws = ws_ + zoff_; const Params& p = *(const Params*)((const char*)&p_arg + zoff_); __VA_ARGS__ } if ((REP_PH) == (k)) { GRID_SYNC(); { const int PROBE_SKIP = PROBE_NOSTORE; unsigned zoff_ = 0u; asm volatile("" : "+s"(zoff_)); unsigned char* ws = ws_ + zoff_; const Params& p = *(const Params*)((const char*)&p_arg + zoff_); __VA_ARGS__ } GRID_SYNC(); { const int PROBE_SKIP = PROBE_NOSTORE; unsigned zoff_ = 0u; asm volatile("" : "+s"(zoff_)); unsigned char* ws = ws_ + zoff_; const Params& p = *(const Params*)((const char*)&p_arg + zoff_); __VA_ARGS__ } } } SEAM(k); } while (0)
    PHASE(PH_PREP, p0_prep(p, lds, vcu, G););
    PHASE(PH_MOD, p1_modulate(p, vcu, G););
    PHASE(PH_INPROJ, {
        pg8::DenseSched S; S.init(ws + WS_U, ws + WS_W_IN, NTOK, NIN, 1024, G, bx);
        EpiInProj E{(bf16_t*)(ws + WS_PROJ), (bf16_t*)(ws + WS_G), (bf16_t*)(ws + WS_KIF)};
        pg8::gemm_phase<EpiInProj, pg8::DenseSched, false>(lds, 1024, S, E);
        if (G == 256 && bx >= 128) { __syncthreads(); run_transposes(p, ws, lds, T_NITEMS - T_LATE2 - T_LATE, T_NITEMS - T_LATE2, (bx - 128) * NWAVES + wave, 128 * NWAVES); } });
    PHASE(PH_MIX, {
#ifdef GOLD_S5
        for (int it = vcu + G * wave; it < 256; it += G * NWAVES) gold_s5(p, it, lane);
#else
#ifndef REP_S5
#define REP_S5 1
#endif
#ifndef REP_ATTN
#define REP_ATTN 1
#endif
        for (int r_ = 0; r_ < REP_S5; ++r_) for (int it = vcu; it < 256; it += G) s5_item(p, lds, it);
#endif
#ifdef GOLD_ATTN
        for (int pr = vcu; pr < NTOK / 2; pr += G) gold_attn_pair(p, lds, pr);
#else
        for (int r_ = 0; r_ < REP_ATTN; ++r_) {
            for (int k = 0; ; ++k) { int ab, aq;
                if (G == 256) { if (k >= 16) break; ab = vcu >> 5; aq = 511 - ((vcu & 31) + 32 * k); }
                else { const int it = vcu + k * G; if (it >= NTOK / 8) break; ab = it & 7; aq = 511 - (it >> 3); }
                attn_item(p, lds, ab, aq); } }
#endif
        __syncthreads(); });
    PHASE(PH_GLU, {
        pg8::DenseSched S; S.init(ws + WS_YG, ws + WS_W_GLU, NTOK, 512, 512, G, bx);
        EpiGlu E{(const bf16_t*)(ws + WS_YG), p.in[15], (bf16_t*)(ws + WS_U)};
        pg8::gemm_phase<EpiGlu, pg8::DenseSched, false>(lds, 512, S, E); });
    PHASE(PH_MIXAB, {
        MixSched S; S.D0.init(ws + WS_U, ws + WS_W_PS, NTOK, 1024, 512, G, bx); S.D1.init(ws + WS_YATTN, ws + WS_W_PA, NTOK, 1024, 512, G, bx);
        EpiMix E{(const bf16_t*)(ws + WS_G), (bf16_t*)(ws + WS_MERGED)};
        pg8::gemm_phase<EpiMix, MixSched, false, false, true>(lds, 512, S, E); });
    PHASE(PH_OUT, {
        pg8::DenseSched S; S.init(ws + WS_MERGED, ws + WS_W_OUT, NTOK, 1024, 1024, G, bx);
        EpiOut E{p.in[0], (const float*)(ws + WS_ADA), p.out, (float*)(ws + WS_SS)};
        pg8::gemm_phase<EpiOut, pg8::DenseSched, false>(lds, 1024, S, E); });
    PHASE(PH_ROUTE, { for (int tile = vcu; tile < NTOK / 128; tile += G) route_tile(p, lds, tile, PROBE_SKIP); });
    PHASE(PH_MOE1, {
        build_moe_tables(lds, (const unsigned*)(ws + WS_CTL) + CW_CNT);
        Moe1Sched S{lds, G, vcu, (const char*)(ws + WS_U), (const int*)(ws + WS_DSTL), (const int*)(ws + WS_IDENT), (const char*)(ws + WS_W_EGU), (const char*)(ws + WS_W_SGU)};
        EpiMoe1 E{(bf16_t*)(ws + WS_H)};
        pg8::gemm_phase<EpiMoe1, Moe1Sched, true>(lds, 1024, S, E);
        { LAS int* TB_ = (LAS int*)(lds + LDS_TB); const int total = (RFL(TB_[256]) + 128) * 2, rem = total % G, nidle = rem ? G - rem : 0;
          __syncthreads();
          if (nidle == 0) run_transposes(p, ws, lds, T_NITEMS - T_LATE2, T_NITEMS, vcu * NWAVES + wave, G * NWAVES);
          else if (vcu >= rem) run_transposes(p, ws, lds, T_NITEMS - T_LATE2, T_NITEMS, (vcu - rem) * NWAVES + wave, nidle * NWAVES); } });
#pragma unroll
    for (int ch = 0; ch < NCHUNK; ++ch) {
        PHASE(PH_MOE2_0 + 2 * ch, {
            build_moe_tables(lds, (const unsigned*)(ws + WS_CTL) + CW_CNT);
            Moe2Sched S{lds, G, vcu, ch, ws};
            EpiMoe2 E{(unsigned char*)(ws + WS_Y), PROBE_SKIP, lds};
            pg8::gemm_phase<EpiMoe2, Moe2Sched, false, true>(lds, 256, S, E); });
        PHASE(PH_COMB_0 + 2 * ch, { p_combine(p, vcu, G, ch); });
    }
#undef IN
}

extern "C" void kernel_launch(void* const* d_in, const int* in_sizes, int n_in, void* d_out, int out_size, void* d_ws, size_t ws_size, hipStream_t stream) {
    static int grid = 0;
    if (grid == 0) {
        if (n_in != 29 || out_size != NTOK * D || ws_size < WS_NEED) { fprintf(stderr, "kernel_launch: unexpected shapes n_in %d out %d ws %zu\n", n_in, out_size, ws_size); grid = -1; return; }
        int dev = 0, cus = 0, per_cu = 0;
        hipGetDevice(&dev); hipDeviceGetAttribute(&cus, hipDeviceAttributeMultiprocessorCount, dev);
        hipFuncSetAttribute((const void*)mega, hipFuncAttributeMaxDynamicSharedMemorySize, LDS_BYTES);
        hipOccupancyMaxActiveBlocksPerMultiprocessor(&per_cu, (const void*)mega, NTHR, LDS_BYTES);
        (void)hipGetLastError();
        grid = (per_cu >= 1) ? cus : -1;
        if (grid < 0) { fprintf(stderr, "kernel_launch: occupancy query says %d blocks/CU\n", per_cu); return; }
    }
    if (grid < 0) return;
    hipMemsetAsync((char*)d_ws + WS_CTL, 0, CTL_BYTES, stream);
    Params p{};
    for (int i = 0; i < 29; ++i) p.in[i] = (const float*)d_in[i];
    p.out = (float*)d_out; p.ws = (unsigned char*)d_ws;
    p.ph_lo = 0; p.ph_hi = PH_END;
    void* args[] = {&p};
    hipError_t e = hipLaunchCooperativeKernel((const void*)mega, dim3(grid), dim3(NTHR), args, LDS_BYTES, stream);
    if (e != hipSuccess) fprintf(stderr, "kernel_launch: cooperative launch failed: %s (grid %d)\n", hipGetErrorString(e), grid);
}
```

```cpp
#include <hip/hip_runtime.h>
#include <hip/hip_cooperative_groups.h>
#include <cstdio>
#include <cstdint>
#include <cmath>
namespace cg = cooperative_groups;

#define GAS __attribute__((address_space(1)))
#define LAS __attribute__((address_space(3)))
typedef unsigned short bf16_t;
typedef short bf16x8 __attribute__((ext_vector_type(8)));
typedef float f32x4 __attribute__((ext_vector_type(4)));
typedef float f32x2 __attribute__((ext_vector_type(2)));
typedef unsigned u32x4 __attribute__((ext_vector_type(4)));
typedef unsigned u32x2 __attribute__((ext_vector_type(2)));

constexpr int NB = 8, SEQ = 4096, NTOK = NB * SEQ, D = 1024;
constexpr int IN_W = 3784, NIN = 3840, PROJ_W = 1792, G_W = 2048;
constexpr int C_USSM = 0, C_Q = 512, C_K = 1024, C_V = 1088, C_QI = 1152, C_KI = 1664, C_WI = 1728, PROJ_USED = 1736;
constexpr int NE = 64, TOPK = 8, NCHUNK = 1, CHTOK = NTOK / NCHUNK, NPAIR = NCHUNK * NE, PAIRCAP = CHTOK, NSLOT = 9;
constexpr float Y_SCALE = 64.0f;
constexpr int HROWS_ROUTED = NTOK * TOPK, HSH_ROW0 = HROWS_ROUTED + 256;
constexpr float EPS = 1e-6f;
constexpr int NWAVES = 8, NTHR = 512;

constexpr size_t MiB = 1u << 20;
constexpr size_t WS_CTL = 0, CTL_BYTES = 1 * MiB;
constexpr size_t WS_ADA = 1 * MiB;
constexpr size_t WS_ONES = 1 * MiB + 224 * 1024;
constexpr size_t WS_A32 = 1 * MiB + 256 * 1024;
constexpr size_t WS_IDENT = 1 * MiB + 512 * 1024;
constexpr size_t WS_WRF = 1 * MiB + 768 * 1024;
constexpr size_t WS_W_IN = 2 * MiB;
constexpr size_t WS_W_GLU = 10 * MiB;
constexpr size_t WS_W_PS = 11 * MiB;
constexpr size_t WS_W_PA = 12 * MiB;
constexpr size_t WS_W_OUT = 13 * MiB;
constexpr size_t WS_W_SGU = 15 * MiB;
constexpr size_t WS_W_SD = 16 * MiB;
constexpr size_t WS_TZF = 17 * MiB, WS_WINF = 18 * MiB, WS_WOUTF = 22 * MiB;
constexpr size_t WS_W_ED = 26 * MiB;
constexpr size_t WS_W_EGU = 58 * MiB;
constexpr size_t WS_KIF = 122 * MiB;
constexpr size_t WS_U = 128 * MiB;
constexpr size_t WS_PROJ = 192 * MiB;
constexpr size_t WS_G = 304 * MiB;
constexpr size_t WS_YG = 432 * MiB;
constexpr size_t WS_YATTN = 464 * MiB;
constexpr size_t WS_MERGED = 192 * MiB;
constexpr size_t WS_Y = 58 * MiB;
constexpr size_t WS_H = 346 * MiB;
constexpr size_t WS_DSTL = 492 * MiB;
constexpr size_t WS_SS = 4 * MiB;
constexpr size_t WS_GATEL = 500 * MiB;
constexpr size_t WS_NEED = 512 * MiB;
constexpr int CW_CNT = 0;
constexpr int CW_BAR = 4096;
constexpr int CW_Q0 = 1024;

constexpr int STAGE_BYTES = 131072;
constexpr int LDS_RO = STAGE_BYTES;
constexpr int LDS_MISC = LDS_RO + 2048;
constexpr int LDS_CNT = LDS_MISC + 128;
constexpr int LDS_RS = LDS_CNT + 1024;
constexpr int LDS_TB = LDS_RS + 1040;
constexpr int LDS_TD = LDS_TB + 1040;
constexpr int LDS_META = LDS_TD + 1408 * 4;
constexpr int LDS_BYTES = 147456;
static_assert(LDS_META + 4096 <= LDS_BYTES, "LDS map");

__device__ __forceinline__ unsigned f2bf(float f) { unsigned u = __builtin_bit_cast(unsigned, f); return (u + 0x7fffu + ((u >> 16) & 1u)) >> 16; }
typedef __bf16 bf16x2_t __attribute__((ext_vector_type(2)));
__device__ __forceinline__ unsigned pk2(float lo, float hi) { const f32x2 v = {lo, hi}; const bf16x2_t r = __builtin_convertvector(v, bf16x2_t); return __builtin_bit_cast(unsigned, r); }
__device__ __forceinline__ float bf2f(unsigned short b) { return __builtin_bit_cast(float, (unsigned)b << 16); }
__device__ __forceinline__ float bflo(unsigned w) { return __builtin_bit_cast(float, w << 16); }
__device__ __forceinline__ float bfhi(unsigned w) { return __builtin_bit_cast(float, w & 0xffff0000u); }
__device__ __forceinline__ float sigmoidf_(float x) { return __builtin_amdgcn_rcpf(1.0f + __builtin_amdgcn_exp2f(-1.44269504089f * x)); }
__device__ __forceinline__ float wave_sum(float v) {
#pragma unroll
    for (int o = 1; o < 64; o <<= 1) v += __shfl_xor(v, o);
    return v;
}
__device__ __forceinline__ int tidx() { int t = threadIdx.x; asm volatile("" : "+v"(t)); return t; }
#define LDS_WAIT() asm volatile("s_waitcnt lgkmcnt(0)" ::: "memory")

namespace pg8 {
constexpr int BM = 256, BK = 64, HALF = 128, HTB = HALF * BK * 2, NXCD = 8, WGM = 8;
__host__ __device__ __forceinline__ int lds_byte(int r, int c) { const int st = (r >> 4) * 2 + (c >> 5), rr = r & 15, cc = c & 31, ob = rr * 64 + cc * 2; return st * 1024 + (ob ^ (((ob >> 9) & 1) << 5)); }
__host__ __device__ __forceinline__ void stage_rc(int b, int& R, int& C) { const int st = b / 1024, sb = b % 1024, swz = sb ^ (((sb >> 9) & 1) << 5); R = (st >> 1) * 16 + swz / 64; C = (st & 1) * 32 + (swz % 64) / 2; }
__host__ __device__ __forceinline__ int perm32(int rho) { const int n = rho >> 4, i = rho & 15; return 8 * (i >> 2) + 4 * n + (i & 3); }

struct Unit { int pm, pn; const char* A; const char* B; const int* rows; int valid; int x0; int rbase; const float* gp; };

struct DenseSched {
    int nM, nN, nwg, G, c; const char* A; const char* B; size_t tstep;
    __device__ __forceinline__ void init(const void* A_, const void* B_, int M, int N, int K, int G_, int c_) { nM = M / BM; nN = N / BM; nwg = nM * nN; G = G_; c = c_; A = (const char*)A_; B = (const char*)B_; tstep = (size_t)BM * K * 2; }
    __device__ __forceinline__ bool next(int i, Unit& u) const {
        const long L = (long)i * G + c; if (L >= nwg) return false;
        int wgid = (int)L; { const int q = nwg / NXCD, r = nwg % NXCD, xcd = wgid % NXCD, off = wgid / NXCD; wgid = (xcd < r ? xcd * (q + 1) : r * (q + 1) + (xcd - r) * q) + off; }
        const int nig = WGM * nN, gid = wgid / nig, fm = gid * WGM, gsz = (nM - fm) < WGM ? (nM - fm) : WGM;
        u.pm = fm + ((wgid % nig) % gsz); u.pn = (wgid % nig) / gsz;
        u.A = A + (size_t)u.pm * tstep; u.B = B + (size_t)u.pn * tstep; u.rows = nullptr; u.valid = 256; u.x0 = 0; u.rbase = 0; u.gp = nullptr; return true;
    }
};

template <class Epi, class Sched, bool GATHER, bool RMETA = false, bool KEEPACC = false>
__device__ __forceinline__ void gemm_phase(LAS unsigned char* lds, const int K, const Sched& S, const Epi& E) {
    int tid_ = tidx(); asm volatile("" : "+v"(tid_));
    const int tid = tid_, wid = __builtin_amdgcn_readfirstlane(tid >> 6), lane = tid & 63, wr = wid >> 2, wc = wid & 3, fr = lane & 15, fq = lane >> 4;
    const int nt = K / BK;
    unsigned voffA[2], voffB[2]; int roA[2];
#pragma unroll
    for (int i = 0; i < 2; ++i) { int R, C; stage_rc(tid * 16 + i * 8192, R, C); const int Rb = (R & ~31) + perm32(R & 31);
        voffA[i] = GATHER ? (unsigned)(C * 2) : (unsigned)(R * K + C) * 2u; voffB[i] = (unsigned)(Rb * K + C) * 2u; roA[i] = R * 4; }
    const size_t kstep = (size_t)(BK * 2);
    const size_t hstep = (size_t)HALF * K * 2;
    const unsigned ldsw = (unsigned)wid * 1024u;
    const int aoff = lds_byte(wr * 64 + fr, fq * 8), boff = lds_byte(wc * 32 + fr, fq * 8);
    LAS unsigned char* ro = lds + LDS_RO;
#define PG8_SA(b, h) (((b) * 2 + (h)) * HTB)
#define PG8_SB(b, h) ((4 + (b) * 2 + (h)) * HTB)
#define PG8_STAGE_B(bufoff, gbase) do { _Pragma("unroll") for (int _i = 0; _i < 2; ++_i) \
        __builtin_amdgcn_global_load_lds((const unsigned*)((const char*)(gbase) + voffB[_i]), (LAS unsigned*)(lds + (bufoff) + ldsw + _i * 8192), 16, 0, 0); } while (0)
#define PG8_STAGE_A(bufoff, gbase, h, slot) do { _Pragma("unroll") for (int _i = 0; _i < 2; ++_i) { \
        unsigned _vo = voffA[_i]; const char* _gb = (const char*)(gbase); \
        if (GATHER) _vo += *(const LAS unsigned*)(ro + (slot) * 1024 + (h) * 512 + roA[_i]); else _gb += (h) * hstep; \
        __builtin_amdgcn_global_load_lds((const unsigned*)(_gb + _vo), (LAS unsigned*)(lds + (bufoff) + ldsw + _i * 8192), 16, 0, 0); } } while (0)
#define PG8_LDA(dst, b, h) do { _Pragma("unroll") for (int m = 0; m < 4; ++m) _Pragma("unroll") for (int k = 0; k < 2; ++k) dst[m][k] = *(const LAS bf16x8*)(lds + PG8_SA(b, h) + aoff + m * 2048 + k * 1024); } while (0)
#define PG8_LDB(dst, b, h) do { _Pragma("unroll") for (int n = 0; n < 2; ++n) _Pragma("unroll") for (int k = 0; k < 2; ++k) dst[n][k] = *(const LAS bf16x8*)(lds + PG8_SB(b, h) + boff + n * 2048 + k * 1024); } while (0)
#define PG8_MMA(ai, bj, At, Bt) do { __builtin_amdgcn_s_setprio(1); _Pragma("unroll") for (int m = 0; m < 4; ++m) _Pragma("unroll") for (int n = 0; n < 2; ++n) _Pragma("unroll") for (int k = 0; k < 2; ++k) \
        acc[ai][bj][m][n] = __builtin_amdgcn_mfma_f32_16x16x32_bf16(Bt[n][k], At[m][k], acc[ai][bj][m][n], 0, 0, 0); __builtin_amdgcn_s_setprio(0); } while (0)
#define PG8_WAIT_V(n) asm volatile("s_waitcnt vmcnt(" #n ")" ::: "memory")
#define PG8_WAIT_L(n) asm volatile("s_waitcnt lgkmcnt(" #n ")" ::: "memory")
#define PG8_BAR __builtin_amdgcn_s_barrier()
#define PG8_SCHED __builtin_amdgcn_sched_barrier(0)
    Unit cur, nxt; int ui = 0;
    if (!S.next(0, cur)) return;
    f32x4 acc[2][2][4][2];
#pragma unroll
    for (int a = 0; a < 2; ++a)
#pragma unroll
        for (int b = 0; b < 2; ++b)
#pragma unroll
            for (int m = 0; m < 4; ++m)
#pragma unroll
                for (int n = 0; n < 2; ++n) acc[a][b][m][n] = (f32x4){0.f, 0.f, 0.f, 0.f};
    bf16x8 At[4][2], B0[2][2], B1[2][2];
    const char* cA = cur.A; const char* cB = cur.B;
    if (GATHER) {
        if (tid < 256) { const int r = tid < cur.valid ? cur.rbase + cur.rows[tid] / NSLOT : 0; *(LAS unsigned*)(ro + tid * 4) = (unsigned)r * (unsigned)(K * 2); }
        __syncthreads();
    }
    PG8_STAGE_B(PG8_SB(0, 0), cB); PG8_STAGE_B(PG8_SB(0, 1), cB + hstep); PG8_STAGE_A(PG8_SA(0, 0), cA, 0, 0); PG8_STAGE_A(PG8_SA(0, 1), cA, 1, 0);
    if (wr == 1) PG8_BAR;
    PG8_WAIT_V(2); PG8_BAR;
    PG8_STAGE_B(PG8_SB(1, 0), cB + kstep); PG8_STAGE_A(PG8_SA(1, 0), cA + kstep, 0, 0); PG8_STAGE_B(PG8_SB(1, 1), cB + hstep + kstep);
    PG8_WAIT_V(6); PG8_BAR;
    for (;;) {
        const bool has_next = S.next(ui + 1, nxt);
        const int cslot = ui & 1, nslot = has_next ? (cslot ^ 1) : cslot;
        int pre_r = 0;
        if (GATHER) { if (has_next && tid < 256 && tid < nxt.valid) pre_r = nxt.rows[tid]; }
        if (RMETA) { if (wid < 4) {
            __builtin_amdgcn_global_load_lds((const unsigned*)(cur.gp + lane + wid * 64), (LAS unsigned*)(lds + LDS_META + cslot * 1024 + wid * 256), 4, 0, 0);
            __builtin_amdgcn_global_load_lds((const unsigned*)(cur.rows + lane + wid * 64), (LAS unsigned*)(lds + LDS_META + 2048 + cslot * 1024 + wid * 256), 4, 0, 0); } }
        const char* nA = has_next ? nxt.A : cA; const char* nB = has_next ? nxt.B : cB;
#pragma unroll 1
        for (int t = 0; t < nt; t += 2) {
            const bool last = (t == nt - 2);
            const char* a1 = cA + (size_t)(t + 1) * kstep;
            const char* a2 = last ? nA : cA + (size_t)(t + 2) * kstep; const char* b2 = last ? nB : cB + (size_t)(t + 2) * kstep;
            const char* a3 = a2 + kstep; const char* b3 = b2 + kstep;
            const int slot2 = last ? nslot : cslot;
            if (t == 2 || nt == 2) {
                if (GATHER) { if (has_next && tid < 256) { const int r = tid < nxt.valid ? nxt.rbase + pre_r / NSLOT : 0; *(LAS unsigned*)(ro + nslot * 1024 + tid * 4) = (unsigned)r * (unsigned)(K * 2); } }
            }
            PG8_LDB(B0, 0, 0); PG8_LDB(B1, 0, 1); PG8_SCHED; PG8_LDA(At, 0, 0); PG8_STAGE_A(PG8_SA(1, 1), a1, 1, cslot);
            PG8_WAIT_V(8); PG8_WAIT_L(0); PG8_BAR; PG8_MMA(0, 0, At, B0); PG8_MMA(0, 1, At, B1); PG8_BAR; PG8_SCHED;
            PG8_LDA(At, 0, 1); PG8_STAGE_B(PG8_SB(0, 0), b2); PG8_STAGE_B(PG8_SB(0, 1), b2 + hstep); PG8_STAGE_A(PG8_SA(0, 0), a2, 0, slot2);
            PG8_WAIT_V(8); PG8_WAIT_L(0); PG8_BAR; PG8_MMA(1, 0, At, B0); PG8_MMA(1, 1, At, B1); PG8_BAR; PG8_SCHED;
            PG8_LDB(B0, 1, 0); PG8_LDB(B1, 1, 1); PG8_SCHED; PG8_LDA(At, 1, 0); PG8_STAGE_A(PG8_SA(0, 1), a2, 1, slot2);
            PG8_WAIT_V(8); PG8_WAIT_L(0); PG8_BAR; PG8_MMA(0, 0, At, B0); PG8_MMA(0, 1, At, B1); PG8_BAR; PG8_SCHED;
            PG8_LDA(At, 1, 1); PG8_STAGE_B(PG8_SB(1, 0), b3); PG8_STAGE_B(PG8_SB(1, 1), b3 + hstep); PG8_STAGE_A(PG8_SA(1, 0), a3, 0, slot2);
            PG8_WAIT_V(8); PG8_WAIT_L(0); PG8_BAR; PG8_MMA(1, 0, At, B0); PG8_MMA(1, 1, At, B1); PG8_BAR; PG8_SCHED;
        }
        if (wr == 0) PG8_BAR;
        E(acc, cur, wr, wc, fr, fq, lds + LDS_META + (ui & 1) * 1024);
        if (!has_next) break;
        if (!KEEPACC || nxt.x0 == 0) {
#pragma unroll
        for (int a = 0; a < 2; ++a)
#pragma unroll
            for (int b = 0; b < 2; ++b)
#pragma unroll
                for (int m = 0; m < 4; ++m)
#pragma unroll
                    for (int n = 0; n < 2; ++n) acc[a][b][m][n] = (f32x4){0.f, 0.f, 0.f, 0.f};
        }
        cur = nxt; cA = nA; cB = nB; ++ui;
        if (wr == 1) PG8_BAR;
    }
    PG8_WAIT_V(0);
    PG8_BAR;
#undef PG8_SA
#undef PG8_SB
#undef PG8_STAGE_A
#undef PG8_STAGE_B
#undef PG8_LDA
#undef PG8_LDB
#undef PG8_MMA
#undef PG8_WAIT_V
#undef PG8_WAIT_L
#undef PG8_BAR
#undef PG8_SCHED
}
}
using pg8::Unit;

#define EPI_LOOP_BEGIN \
    _Pragma("unroll") for (int ai = 0; ai < 2; ++ai) _Pragma("unroll") for (int m = 0; m < 4; ++m) { const int rl = ai * 128 + wr * 64 + m * 16 + fr; const int row = u.pm * 256 + rl; \
    _Pragma("unroll") for (int bj = 0; bj < 2; ++bj) { const int col = u.pn * 256 + bj * 128 + wc * 32 + 8 * fq; const f32x4 v0 = acc[ai][bj][m][0], v1 = acc[ai][bj][m][1]; (void)row; (void)col; (void)rl;
#define EPI_LOOP_END } if (m == 3) asm volatile("" ::: "memory"); }
__device__ __forceinline__ u32x4 pack8(const f32x4 a, const f32x4 b) { u32x4 w; w.x = pk2(a[0], a[1]); w.y = pk2(a[2], a[3]); w.z = pk2(b[0], b[1]); w.w = pk2(b[2], b[3]); return w; }
__device__ __forceinline__ void unpack8(const u32x4 w, float (&f)[8]) { f[0] = bflo(w.x); f[1] = bfhi(w.x); f[2] = bflo(w.y); f[3] = bfhi(w.y); f[4] = bflo(w.z); f[5] = bfhi(w.z); f[6] = bflo(w.w); f[7] = bfhi(w.w); }

struct EpiInProj {
    bf16_t* PROJ; bf16_t* G; bf16_t* KIF;
    __device__ __forceinline__ void operator()(const f32x4 (&acc)[2][2][4][2], const Unit& u, int wr, int wc, int fr, int fq, LAS unsigned char* meta) const {
        EPI_LOOP_BEGIN
            if (u.pn < 7) { const u32x4 w8 = pack8(v0, v1); *(u32x4*)(PROJ + (size_t)row * PROJ_W + col) = w8;
                if (u.pn == 6 && col >= C_KI && col < C_KI + 64) { const int d0 = col - C_KI, key = row & 4095, bb = row >> 12;
                    *(u32x4*)(KIF + ((size_t)((bb * 128 + (key >> 5)) * 4 + (d0 >> 4)) * 64 + (key & 31) + 32 * ((d0 >> 3) & 1)) * 8) = w8; } }
            else { f32x4 s0, s1;
#pragma unroll
                for (int j = 0; j < 4; ++j) { s0[j] = sigmoidf_(v0[j]); s1[j] = sigmoidf_(v1[j]); }
                *(u32x4*)(G + (size_t)row * G_W + (col - PROJ_W)) = pack8(s0, s1); }
        EPI_LOOP_END
    }
};
struct EpiGlu {
    const bf16_t* YG; const float* bias; bf16_t* O;
    __device__ __forceinline__ void operator()(const f32x4 (&acc)[2][2][4][2], const Unit& u, int wr, int wc, int fr, int fq, LAS unsigned char* meta) const {
        f32x4 bb[2][2];
#pragma unroll
        for (int bj = 0; bj < 2; ++bj) { const int col = u.pn * 256 + bj * 128 + wc * 32 + 8 * fq; bb[bj][0] = *(const f32x4*)(bias + col); bb[bj][1] = *(const f32x4*)(bias + col + 4); }
        EPI_LOOP_BEGIN
            float y[8]; unpack8(*(const u32x4*)(YG + (size_t)row * 512 + col), y);
            const f32x4 b0 = bb[bj][0], b1 = bb[bj][1]; f32x4 o0, o1;
#pragma unroll
            for (int j = 0; j < 4; ++j) { o0[j] = y[j] * sigmoidf_(v0[j] + b0[j]); o1[j] = y[4 + j] * sigmoidf_(v1[j] + b1[j]); }
            *(u32x4*)(O + (size_t)row * 512 + col) = pack8(o0, o1);
        EPI_LOOP_END
    }
};
struct EpiMix {
    const bf16_t* G; bf16_t* O;
    __device__ __forceinline__ void operator()(f32x4 (&acc)[2][2][4][2], const Unit& u, int wr, int wc, int fr, int fq, LAS unsigned char* meta) const {
        const size_t gbase = (size_t)(u.pm * 256 + wr * 64 + fr) * G_W + u.pn * 256 + wc * 32 + 8 * fq;
        if (u.x0 == 0) {
#pragma unroll
            for (int ai = 0; ai < 2; ++ai) {
                u32x4 q1[4][2], q2[4][2];
#pragma unroll
                for (int m = 0; m < 4; ++m)
#pragma unroll
                    for (int bj = 0; bj < 2; ++bj) { const size_t o_ = gbase + (size_t)(ai * 128 + m * 16) * G_W + bj * 128; q1[m][bj] = *(const u32x4*)(G + o_); q2[m][bj] = *(const u32x4*)(G + o_ + 1024); }
#pragma unroll
                for (int m = 0; m < 4; ++m)
#pragma unroll
                    for (int bj = 0; bj < 2; ++bj) { float g1[8], g2[8]; unpack8(q1[m][bj], g1); unpack8(q2[m][bj], g2);
#pragma unroll
                        for (int j = 0; j < 4; ++j) { acc[ai][bj][m][0][j] *= g1[j] * __builtin_amdgcn_rcpf(fmaxf(g2[j], 1e-6f)); acc[ai][bj][m][1][j] *= g1[4 + j] * __builtin_amdgcn_rcpf(fmaxf(g2[4 + j], 1e-6f)); } }
                asm volatile("" ::: "memory"); }
        } else {
            u32x4 q2[2][4][2];
#pragma unroll
            for (int ai = 0; ai < 2; ++ai)
#pragma unroll
                for (int m = 0; m < 4; ++m)
#pragma unroll
                    for (int bj = 0; bj < 2; ++bj) q2[ai][m][bj] = *(const u32x4*)(G + gbase + (size_t)(ai * 128 + m * 16) * G_W + bj * 128 + 1024);
#pragma unroll
            for (int ai = 0; ai < 2; ++ai)
#pragma unroll
                for (int m = 0; m < 4; ++m)
#pragma unroll
                    for (int bj = 0; bj < 2; ++bj) { float g2[8]; unpack8(q2[ai][m][bj], g2); f32x4 o0, o1;
#pragma unroll
                        for (int j = 0; j < 4; ++j) { o0[j] = acc[ai][bj][m][0][j] * fmaxf(g2[j], 1e-6f); o1[j] = acc[ai][bj][m][1][j] * fmaxf(g2[4 + j], 1e-6f); }
                        *(u32x4*)(O + (size_t)(u.pm * 256 + ai * 128 + wr * 64 + m * 16 + fr) * D + u.pn * 256 + bj * 128 + wc * 32 + 8 * fq) = pack8(o0, o1); }
        }
    }
};
struct MixSched {
    pg8::DenseSched D0, D1;
    __device__ __forceinline__ bool next(int i, Unit& u) const { const bool ok = (i & 1) ? D1.next(i >> 1, u) : D0.next(i >> 1, u); u.x0 = i & 1; return ok; }
};
struct EpiOut {
    const float* X; const float* ada; float* O; float* SS;
    __device__ __forceinline__ void operator()(const f32x4 (&acc)[2][2][4][2], const Unit& u, int wr, int wc, int fr, int fq, LAS unsigned char* meta) const {
        f32x4 gg[2][2];
#pragma unroll
        for (int bj = 0; bj < 2; ++bj) { const float* gp = ada + (size_t)((u.pm * 256) >> 12) * 6144 + 2048 + u.pn * 256 + bj * 128 + wc * 32 + 8 * fq; gg[bj][0] = *(const f32x4*)gp; gg[bj][1] = *(const f32x4*)(gp + 4); }
        const size_t base = (size_t)(u.pm * 256 + wr * 64 + fr) * D + u.pn * 256 + wc * 32 + 8 * fq;
        f32x4 xq[3][2][2];
#define EPO_LOAD(slot, rg) do { const size_t o_ = base + (size_t)(((rg) >> 2) * 128 + ((rg) & 3) * 16) * D; _Pragma("unroll") for (int bj = 0; bj < 2; ++bj) { xq[slot][bj][0] = *(const f32x4*)(X + o_ + bj * 128); xq[slot][bj][1] = *(const f32x4*)(X + o_ + bj * 128 + 4); } } while (0)
        EPO_LOAD(0, 0); EPO_LOAD(1, 1);
#pragma unroll
        for (int rg = 0; rg < 8; ++rg) { const int ai = rg >> 2, m = rg & 3;
            if (rg + 2 < 8) EPO_LOAD((rg + 2) % 3, rg + 2);
            const size_t o_ = base + (size_t)(ai * 128 + m * 16) * D; float ss = 0.f;
#pragma unroll
            for (int bj = 0; bj < 2; ++bj) { const f32x4 o0 = xq[rg % 3][bj][0] + gg[bj][0] * acc[ai][bj][m][0], o1 = xq[rg % 3][bj][1] + gg[bj][1] * acc[ai][bj][m][1];
                *(u32x4*)((bf16_t*)O + 2 * (o_ - (size_t)(u.pn * 256 + wc * 32 + 8 * fq)) + (u.pn * 256 + wc * 32 + 8 * fq) + bj * 128) = pack8(o0, o1);
                ss += (o0.x * o0.x + o0.y * o0.y) + (o0.z * o0.z + o0.w * o0.w) + (o1.x * o1.x + o1.y * o1.y) + (o1.z * o1.z + o1.w * o1.w); }
            ss += __shfl_xor(ss, 16); ss += __shfl_xor(ss, 32);
            if (fq == 0) SS[(size_t)(u.pm * 256 + ai * 128 + wr * 64 + m * 16 + fr) * 16 + u.pn * 4 + wc] = ss;
            asm volatile("" ::: "memory"); }
#undef EPO_LOAD
    }
};
struct EpiMoe1 {
    bf16_t* H;
    __device__ __forceinline__ void operator()(const f32x4 (&acc)[2][2][4][2], const Unit& u, int wr, int wc, int fr, int fq, LAS unsigned char* meta) const {
#pragma unroll
        for (int ai = 0; ai < 2; ++ai)
#pragma unroll
            for (int m = 0; m < 4; ++m) { const int rl = ai * 128 + wr * 64 + m * 16 + fr;
                if (rl < u.valid) { f32x4 o0, o1;
#pragma unroll
                    for (int j = 0; j < 4; ++j) { const float g0 = acc[ai][0][m][0][j], g1 = acc[ai][1][m][0][j]; o0[j] = g0 * sigmoidf_(g0) * acc[ai][0][m][1][j]; o1[j] = g1 * sigmoidf_(g1) * acc[ai][1][m][1][j]; }
                    *(u32x4*)(H + (size_t)(u.x0 + rl) * 256 + u.pn * 128 + wc * 32 + 8 * fq) = pack8(o0, o1); } }
    }
};
__device__ __forceinline__ void epi_stage_write(LAS unsigned char* sc, int fr, int fq, const u32x4 w0, const u32x4 w1) {
    LAS unsigned char* rowp = sc + (fr >> 3) * 8192 + (fr & 7) * 128; const int x = fr & 7;
    *(LAS u32x4*)(rowp + ((fq ^ x) * 16)) = w0; *(LAS u32x4*)(rowp + (((4 + fq) ^ x) * 16)) = w1;
}
__device__ __forceinline__ u32x4 epi_stage_read(const LAS unsigned char* sc, int q, int lane) {
    const int r = lane >> 3, c = lane & 7; return *(const LAS u32x4*)(sc + q * 8192 + r * 128 + ((c ^ r) * 16));
}
__device__ __forceinline__ unsigned pk4_fp8(float a, float b, float c, float d) {
    a = __builtin_amdgcn_fmed3f(a, -448.f, 448.f); b = __builtin_amdgcn_fmed3f(b, -448.f, 448.f); c = __builtin_amdgcn_fmed3f(c, -448.f, 448.f); d = __builtin_amdgcn_fmed3f(d, -448.f, 448.f);
    int w = 0; w = __builtin_amdgcn_cvt_pk_fp8_f32(a, b, w, false); w = __builtin_amdgcn_cvt_pk_fp8_f32(c, d, w, true); return (unsigned)w;
}
struct EpiMoe2 {
    unsigned char* Y; int skip; LAS unsigned char* lds0;
    __device__ __forceinline__ void operator()(const f32x4 (&acc)[2][2][4][2], const Unit& u, int wr, int wc, int fr, int fq, LAS unsigned char* meta) const {
        asm volatile("" : "+v"(fr), "+v"(fq));
        const int lane = fr + 16 * fq;
        LAS unsigned char* sc0 = lds0 + 3 * pg8::HTB + (wr * 4 + wc) * 1024;
#pragma unroll
        for (int ai = 0; ai < 2; ++ai)
#pragma unroll
            for (int m = 0; m < 4; ++m) { const int rl0 = ai * 128 + wr * 64 + m * 16; LAS unsigned char* sc = sc0 + (m & 1) * 8192;
                const float g = *(const LAS float*)(meta + (rl0 + fr) * 4) * Y_SCALE;
                u32x2 w0, w1;
                w0.x = pk4_fp8(acc[ai][0][m][0][0] * g, acc[ai][0][m][0][1] * g, acc[ai][0][m][0][2] * g, acc[ai][0][m][0][3] * g); w0.y = pk4_fp8(acc[ai][0][m][1][0] * g, acc[ai][0][m][1][1] * g, acc[ai][0][m][1][2] * g, acc[ai][0][m][1][3] * g);
                w1.x = pk4_fp8(acc[ai][1][m][0][0] * g, acc[ai][1][m][0][1] * g, acc[ai][1][m][0][2] * g, acc[ai][1][m][0][3] * g); w1.y = pk4_fp8(acc[ai][1][m][1][0] * g, acc[ai][1][m][1][1] * g, acc[ai][1][m][1][2] * g, acc[ai][1][m][1][3] * g);
                *(LAS u32x2*)(sc + fr * 64 + fq * 8) = w0; *(LAS u32x2*)(sc + fr * 64 + 32 + fq * 8) = w1;
                { const int r = lane >> 2, c = lane & 3, rl = rl0 + r; const u32x4 v = *(const LAS u32x4*)(sc + r * 64 + c * 16);
                  if (rl < u.valid && !skip) { const int dst = *(const LAS int*)(meta + 2048 + rl * 4); *(u32x4*)(Y + (size_t)dst * D + u.pn * 256 + wc * 64 + c * 16) = v; } } }
    }
};

__device__ __forceinline__ void build_moe_tables(LAS unsigned char* lds, const unsigned* cnt_g) {
    LAS int* CNT = (LAS int*)(lds + LDS_CNT); LAS int* RS = (LAS int*)(lds + LDS_RS); LAS int* TB = (LAS int*)(lds + LDS_TB); LAS unsigned* TD = (LAS unsigned*)(lds + LDS_TD);
    const int tid = tidx();
    __syncthreads();
    if (tid < 256) { int c = tid < NPAIR ? (int)cnt_g[tid] : 0; c = c < 0 ? 0 : (c > PAIRCAP ? PAIRCAP : c); CNT[tid] = c; }
    __syncthreads();
    if (tid < 64) {
        int c[4], rs = 0, tb = 0;
#pragma unroll
        for (int i = 0; i < 4; ++i) { c[i] = CNT[4 * tid + i]; rs += c[i]; tb += (c[i] + 255) >> 8; }
        int srs = rs, stb = tb;
#pragma unroll
        for (int o = 1; o < 64; o <<= 1) { const int a = __shfl_up(srs, o), e = __shfl_up(stb, o); if (tid >= o) { srs += a; stb += e; } }
        int ers = srs - rs, etb = stb - tb;
#pragma unroll
        for (int i = 0; i < 4; ++i) { RS[4 * tid + i] = ers; TB[4 * tid + i] = etb; ers += c[i]; etb += (c[i] + 255) >> 8; }
        if (tid == 63) { RS[256] = srs; TB[256] = stb; }
    }
    __syncthreads();
    if (tid < 256) { const int c = CNT[tid], nt = (c + 255) >> 8, tb = TB[tid]; for (int k = 0; k < nt; ++k) TD[tb + k] = (unsigned)tid | ((unsigned)k << 9); }
    __syncthreads();
}
#define RFL(x) __builtin_amdgcn_readfirstlane(x)
struct Moe1Sched {
    LAS unsigned char* lds; int G, c; const char* U2; const int* dstl; const int* ident; const char* Wegu; const char* Wsgu;
    __device__ __forceinline__ bool next(int i, Unit& u) const {
        LAS int* CNT = (LAS int*)(lds + LDS_CNT); LAS int* RS = (LAS int*)(lds + LDS_RS); LAS int* TB = (LAS int*)(lds + LDS_TB); LAS unsigned* TD = (LAS unsigned*)(lds + LDS_TD);
        const int ntr = RFL(TB[256]); const int L = i * G + c; if (L >= (ntr + 128) * 2) return false;
        const int tau = L >> 1; u.pn = L & 1; u.pm = 0; u.A = U2; u.gp = nullptr;
        if (tau < ntr) { const unsigned d = (unsigned)RFL((int)TD[tau]); const int j = d & 511, k = d >> 9; u.valid = min(256, RFL(CNT[j]) - k * 256); u.rows = dstl + (size_t)(j * PAIRCAP + k * 256); u.x0 = RFL(RS[j]) + k * 256; u.rbase = (j >> 6) * CHTOK;
            u.B = Wegu + (size_t)(j & 63) * (512 * 1024 * 2) + (size_t)u.pn * (256 * 1024 * 2); }
        else { const int k = tau - ntr; u.valid = 256; u.rows = ident + k * 256; u.x0 = HSH_ROW0 + k * 256; u.rbase = (k / (CHTOK / 256)) * CHTOK; u.B = Wsgu + (size_t)u.pn * (256 * 1024 * 2); }
        return true;
    }
};
struct Moe2Sched {
    LAS unsigned char* lds; int G, c, ch; const unsigned char* ws;
    __device__ __forceinline__ bool next(int i, Unit& u) const {
        LAS int* CNT = (LAS int*)(lds + LDS_CNT); LAS int* RS = (LAS int*)(lds + LDS_RS); LAS int* TB = (LAS int*)(lds + LDS_TB); LAS unsigned* TD = (LAS unsigned*)(lds + LDS_TD);
        constexpr int NSH = CHTOK / 256;
        const int t0 = RFL(TB[64 * ch]), ntr = RFL(TB[64 * ch + 64]) - t0; const int L = i * G + c; if (L >= (ntr + NSH) * 4) return false;
        const int tau = L >> 2; u.pn = L & 3; u.pm = 0; u.rbase = 0; u.x0 = 0;
        if (tau < ntr) { const unsigned d = (unsigned)RFL((int)TD[t0 + tau]); const int j = d & 511, k = d >> 9; u.valid = min(256, RFL(CNT[j]) - k * 256);
            u.A = (const char*)(ws + WS_H) + (size_t)(RFL(RS[j]) + k * 256) * 512; u.rows = (const int*)(ws + WS_DSTL) + (size_t)(j * PAIRCAP + k * 256); u.gp = (const float*)(ws + WS_GATEL) + (size_t)(j * PAIRCAP + k * 256);
            u.B = (const char*)(ws + WS_W_ED) + (size_t)(j & 63) * (1024 * 256 * 2) + (size_t)u.pn * (256 * 256 * 2); }
        else { const int k = NSH * ch + (tau - ntr); u.valid = 256; u.A = (const char*)(ws + WS_H) + (size_t)(HSH_ROW0 + k * 256) * 512; u.rows = (const int*)(ws + WS_IDENT) + k * 256; u.gp = (const float*)(ws + WS_ONES); u.B = (const char*)(ws + WS_W_SD) + (size_t)u.pn * (256 * 256 * 2); }
        return true;
    }
};

struct Params { const float* in[29]; float* out; unsigned char* ws; int ph_lo, ph_hi; };

__device__ __forceinline__ void s5_tables_item(const Params& p, LAS unsigned char* lds, int item) {
    const int g = item >> 3, part = item & 7, tid = tidx();
    LAS float* AP = (LAS float*)lds;
    LAS float* BB = AP + 64 * 33 * 2;
    LAS float* CC = BB + 64 * 16 * 2;
    const float dt = expf(p.in[8][g]);
    __syncthreads();
    for (int i = tid; i < 64 * 33; i += NTHR) { const int pp = i / 33, tau = i - pp * 33; const float lr = p.in[6][g * 64 + pp], li = p.in[7][g * 64 + pp];
        const float mag = expf(lr * dt * (float)tau), th = li * dt * (float)tau; AP[i * 2] = mag * cosf(th); AP[i * 2 + 1] = mag * sinf(th); }
    for (int i = tid; i < 64 * 16; i += NTHR) { const int pp = i >> 4; const float lr = p.in[6][g * 64 + pp], li = p.in[7][g * 64 + pp];
        const float mag = expf(lr * dt); const float a_re = mag * cosf(li * dt), a_im = mag * sinf(li * dt);
        const float den = lr * lr + li * li, n_re = a_re - 1.0f; const float f_re = (n_re * lr + a_im * li) / den, f_im = (a_im * lr - n_re * li) / den;
        const float br = p.in[9][(size_t)(g * 64) * 16 + i], bi = p.in[10][(size_t)(g * 64) * 16 + i];
        BB[i * 2] = f_re * br - f_im * bi; BB[i * 2 + 1] = f_re * bi + f_im * br; }
    for (int i = tid; i < 16 * 64; i += NTHR) { CC[i * 2] = p.in[11][(size_t)g * 1024 + i]; CC[i * 2 + 1] = p.in[12][(size_t)g * 1024 + i]; }
    __syncthreads();
    if (part == 0 && tid < 64) { float* a32 = (float*)(p.ws + WS_A32); a32[(g * 64 + tid) * 2] = AP[(tid * 33 + 32) * 2]; a32[(g * 64 + tid) * 2 + 1] = AP[(tid * 33 + 32) * 2 + 1]; }
    {
        const int jh = tid >> 8, t2 = tid & 255;
        const int fr = t2 >> 6, l = t2 & 63, delta = part * 4 + fr, ho = l & 15, q = l >> 4, tau = delta - (q >> 1); float v[4];
#pragma unroll 1
        for (int jj = 0; jj < 4; ++jj) { const int j = jh * 4 + jj; const int hi = (q & 1) * 8 + j; float acc = 0.f;
            if (tau >= 0) { for (int pp = 0; pp < 64; ++pp) { const float ar = AP[(pp * 33 + tau) * 2], ai = AP[(pp * 33 + tau) * 2 + 1], br = BB[(pp * 16 + hi) * 2], bi = BB[(pp * 16 + hi) * 2 + 1], cr = CC[(ho * 64 + pp) * 2], ci = CC[(ho * 64 + pp) * 2 + 1];
                    acc += cr * (ar * br - ai * bi) - ci * (ar * bi + ai * br); }
                if (tau == 0 && ho == hi) acc += p.in[13][g * 16 + ho]; }
            v[jj] = acc; }
        u32x2 o; o.x = pk2(v[0], v[1]); o.y = pk2(v[2], v[3]);
        *(u32x2*)((bf16_t*)(p.ws + WS_TZF) + ((size_t)(g * 32 + delta) * 64 + l) * 8 + jh * 4) = o;
    }
    for (int u = tid; u < 1024; u += NTHR) {
        const int ks = u >> 6, l = u & 63, n = part * 16 + (l & 15), q = l >> 4, ri = n >> 6, pp = n & 63; float v[8];
#pragma unroll
        for (int j = 0; j < 8; ++j) { const int k = ks * 32 + q * 8 + j, sidx = k >> 4, hi = k & 15;
            const float ar = AP[(pp * 33 + 31 - sidx) * 2], ai = AP[(pp * 33 + 31 - sidx) * 2 + 1], br = BB[(pp * 16 + hi) * 2], bi = BB[(pp * 16 + hi) * 2 + 1];
            v[j] = ri ? (ar * bi + ai * br) : (ar * br - ai * bi); }
        u32x4 o; o.x = pk2(v[0], v[1]); o.y = pk2(v[2], v[3]); o.z = pk2(v[4], v[5]); o.w = pk2(v[6], v[7]);
        *(u32x4*)((bf16_t*)(p.ws + WS_WINF) + ((size_t)((g * 8 + part) * 16 + ks) * 64 + l) * 8) = o;
    }
    for (int u = tid; u < 1024; u += NTHR) {
        const int fr = u >> 6, l = u & 63, t = part * 4 + (fr >> 2), ksp = fr & 3, ho = l & 15, q = l >> 4; float v[8];
#pragma unroll
        for (int j = 0; j < 8; ++j) { const int kp = ksp * 32 + q * 8 + j, ri = kp >> 6, pp = kp & 63;
            const float cr = CC[(ho * 64 + pp) * 2], ci = CC[(ho * 64 + pp) * 2 + 1], ar = AP[(pp * 33 + t + 1) * 2], ai = AP[(pp * 33 + t + 1) * 2 + 1];
            v[j] = ri ? -(cr * ai + ci * ar) : (cr * ar - ci * ai); }
        u32x4 o; o.x = pk2(v[0], v[1]); o.y = pk2(v[2], v[3]); o.z = pk2(v[4], v[5]); o.w = pk2(v[6], v[7]);
        *(u32x4*)((bf16_t*)(p.ws + WS_WOUTF) + ((size_t)((g * 32 + t) * 4 + ksp) * 64 + l) * 8) = o;
    }
    __syncthreads();
}

__device__ __forceinline__ float gelu_tanh(float y) { const float z = 0.7978845608028654f * (y + 0.044715f * y * y * y); const float e = __expf(2.0f * z); const float th = 1.0f - 2.0f / (e + 1.0f); return 0.5f * y * (1.0f + th); }

__device__ __forceinline__ void s5_item(const Params& p, LAS unsigned char* lds, int item) {
    const int b = item >> 5, g = item & 31;
    const int tid = tidx(), lane = tid & 63, wave = __builtin_amdgcn_readfirstlane(tid >> 6), hd = lane & 15, qd = lane >> 4;
    const bf16_t* PROJ = (const bf16_t*)(p.ws + WS_PROJ); bf16_t* YG = (bf16_t*)(p.ws + WS_YG);
    LAS float* SL = (LAS float*)lds;
    LAS unsigned char* WO = lds + 65536;
    const char* WoutG = (const char*)(p.ws + WS_WOUTF) + (size_t)g * 32 * 4 * 1024;
#define S5_WO_DMA(h) do { _Pragma("unroll") for (int j_ = 0; j_ < 8; ++j_) \
        __builtin_amdgcn_global_load_lds((const unsigned*)(WoutG + (size_t)(h) * 65536 + (j_ * 512 + tid) * 16), (LAS unsigned*)(WO + j_ * 8192 + wave * 1024), 16, 0, 0); } while (0)
    const int c = 16 * wave + hd;
    __syncthreads();
    S5_WO_DMA(0);
    bf16x8 Uf[16];
#pragma unroll
    for (int ks = 0; ks < 16; ++ks) Uf[ks] = *(const bf16x8*)(PROJ + ((size_t)b * SEQ + c * 32 + 2 * ks + (qd >> 1)) * PROJ_W + C_USSM + g * 16 + (qd & 1) * 8);
    { const bf16x8* WinF = (const bf16x8*)(p.ws + WS_WINF) + (size_t)g * 8 * 16 * 64 + lane;
      bf16x8 wc_[8], wn_[8];
#pragma unroll
      for (int ks = 0; ks < 8; ++ks) wc_[ks] = WinF[ks * 64];
      f32x4 a = (f32x4){0.f, 0.f, 0.f, 0.f};
#pragma unroll 2
      for (int j = 0; j < 16; ++j) { const int jn = (j < 15) ? j + 1 : j;
#pragma unroll
          for (int i = 0; i < 8; ++i) wn_[i] = WinF[(jn * 8 + i) * 64];
          if ((j & 1) == 0) {
#pragma unroll
              for (int i = 0; i < 8; ++i) a = __builtin_amdgcn_mfma_f32_16x16x32_bf16(wc_[i], Uf[i], a, 0, 0, 0); }
          else {
#pragma unroll
              for (int i = 0; i < 8; ++i) a = __builtin_amdgcn_mfma_f32_16x16x32_bf16(wc_[i], Uf[8 + i], a, 0, 0, 0);
              *(LAS f32x4*)(SL + c * 128 + (j >> 1) * 16 + qd * 4) = a; a = (f32x4){0.f, 0.f, 0.f, 0.f}; }
#pragma unroll
          for (int i = 0; i < 8; ++i) wc_[i] = wn_[i]; } }
    __syncthreads();
    if (wave == 0) { const float* a32 = (const float*)(p.ws + WS_A32); const float ar = a32[(g * 64 + lane) * 2], ai = a32[(g * 64 + lane) * 2 + 1]; float hr = 0.f, hi = 0.f;
#pragma unroll 4
        for (int cc = 0; cc < 128; ++cc) { const float sr = SL[cc * 128 + lane], si = SL[cc * 128 + 64 + lane]; const float nr = ar * hr - ai * hi + sr, ni = ar * hi + ai * hr + si; hr = nr; hi = ni; SL[cc * 128 + lane] = hr; SL[cc * 128 + 64 + lane] = hi; } }
    __syncthreads();
    bf16x8 Hf[4];
#pragma unroll
    for (int ks = 0; ks < 4; ++ks) { if (c >= 1) { const f32x4 x0 = *(const LAS f32x4*)(SL + (c - 1) * 128 + ks * 32 + qd * 8), x1 = *(const LAS f32x4*)(SL + (c - 1) * 128 + ks * 32 + qd * 8 + 4); Hf[ks] = __builtin_bit_cast(bf16x8, pack8(x0, x1)); }
        else Hf[ks] = (bf16x8){0, 0, 0, 0, 0, 0, 0, 0}; }
    const bf16x8* TzF = (const bf16x8*)(p.ws + WS_TZF) + (size_t)g * 32 * 64 + lane;
#pragma unroll
    for (int half = 0; half < 2; ++half) {
        f32x4 acc[16];
#pragma unroll
        for (int tt = 0; tt < 16; ++tt) acc[tt] = (f32x4){0.f, 0.f, 0.f, 0.f};
        const int ndelta = half * 16 + 16;
        bf16x8 fr[4];
#pragma unroll
        for (int i = 0; i < 4; ++i) fr[i] = TzF[i * 64];
#pragma unroll
        for (int delta = 0; delta < 32; ++delta) {
            if (delta < ndelta) {
                const bf16x8 f0 = fr[delta & 3];
                if (delta + 4 < ndelta) fr[delta & 3] = TzF[(delta + 4) * 64];
#pragma unroll
                for (int ks = 0; ks < 16; ++ks) { const int t = delta + 2 * ks; if (t >= half * 16 && t < half * 16 + 16) acc[t - half * 16] = __builtin_amdgcn_mfma_f32_16x16x32_bf16(f0, Uf[ks], acc[t - half * 16], 0, 0, 0); }
            }
        }
        asm volatile("s_waitcnt vmcnt(0)" ::: "memory");
        __syncthreads();
#pragma unroll
        for (int tt = 0; tt < 16; ++tt) { const int t = half * 16 + tt;
#pragma unroll
            for (int ks = 0; ks < 4; ++ks) acc[tt] = __builtin_amdgcn_mfma_f32_16x16x32_bf16(*(const LAS bf16x8*)(WO + (tt * 4 + ks) * 1024 + lane * 16), Hf[ks], acc[tt], 0, 0, 0);
            u32x2 w; w.x = pk2(gelu_tanh(acc[tt][0]), gelu_tanh(acc[tt][1])); w.y = pk2(gelu_tanh(acc[tt][2]), gelu_tanh(acc[tt][3]));
            *(u32x2*)(YG + ((size_t)b * SEQ + c * 32 + t) * 512 + g * 16 + qd * 4) = w;
            if ((tt & 1) == 1) asm volatile("" ::: "memory"); }
        if (half == 0) { asm volatile("s_waitcnt lgkmcnt(0)" ::: "memory"); __syncthreads(); S5_WO_DMA(1); }
    }
#undef S5_WO_DMA
    __syncthreads();
}

struct TDesc { const float* W; bf16_t* WT; int K, N, item, kind; };
__device__ __forceinline__ void t_load(const TDesc& d, int lane, f32x4 (&v)[16]) {
    const int nblk = (d.N + 63) >> 6, kb = d.item / nblk, nb = d.item - kb * nblk, k0 = 64 * kb, n0 = 64 * nb;
    const int lr = lane >> 4, lc = (lane & 15) * 4;
#pragma unroll
    for (int i = 0; i < 16; ++i) v[i] = (n0 + lc < d.N) ? *(const f32x4*)(d.W + (size_t)(k0 + 4 * i + lr) * d.N + n0 + lc) : (f32x4){0.f, 0.f, 0.f, 0.f};
}
struct RmId { __device__ int operator()(int n) const { return n; } };
struct RmWave { __device__ int operator()(int n) const { const int L = n & 255; return (n & ~255) + 128 * ((L >> 5) & 1) + 32 * (L >> 6) + (L & 31); } };
struct RmIn { __device__ int operator()(int n) const { return n < PROJ_USED ? n : n + (PROJ_W - PROJ_USED); } };
struct RmGate { __device__ int operator()(int n) const { const int hl = n & 127; return 256 * (n >> 7) + 128 * ((hl >> 2) & 1) + 32 * (hl >> 5) + 8 * ((hl >> 3) & 3) + (hl & 3); } };
struct RmUp { __device__ int operator()(int n) const { const int hl = n & 127; return 256 * (n >> 7) + 128 * ((hl >> 2) & 1) + 32 * (hl >> 5) + 8 * ((hl >> 3) & 3) + 4 + (hl & 3); } };
__device__ __forceinline__ int t_rowmap(int kind, int n) { return kind == 0 ? n : kind == 1 ? RmWave()(n) : kind == 2 ? RmIn()(n) : kind == 3 ? RmGate()(n) : RmUp()(n); }
__device__ __forceinline__ void t_store(const TDesc& d, const f32x4 (&v)[16], LAS float* scr, int lane) {
    const int nblk = (d.N + 63) >> 6, kb = d.item / nblk, nb = d.item - kb * nblk, k0 = 64 * kb, n0 = 64 * nb;
    const int lr = lane >> 4, lc = (lane & 15) * 4;
#pragma unroll
    for (int i = 0; i < 16; ++i) { LAS float* dd = scr + (4 * i + lr) * 65 + lc; dd[0] = v[i].x; dd[1] = v[i].y; dd[2] = v[i].z; dd[3] = v[i].w; }
    LDS_WAIT(); asm volatile("" ::: "memory");
    const int nl = lane >> 3, kc = (lane & 7) * 8;
#pragma unroll
    for (int j = 0; j < 8; ++j) { const int n = nl + 8 * j; const LAS float* sp = scr + kc * 65 + n;
        u32x4 o; o.x = pk2(sp[0 * 65], sp[1 * 65]); o.y = pk2(sp[2 * 65], sp[3 * 65]); o.z = pk2(sp[4 * 65], sp[5 * 65]); o.w = pk2(sp[6 * 65], sp[7 * 65]);
        if (n0 + n < d.N) *(u32x4*)(d.WT + (size_t)t_rowmap(d.kind, n0 + n) * d.K + k0 + kc) = o; }
    LDS_WAIT(); asm volatile("" ::: "memory");
}

constexpr int T_I_IN = 16 * 60, T_I_GLU = 8 * 8, T_I_PS = 8 * 16, T_I_OUT = 16 * 16, T_I_SG = 16 * 4, T_I_SD = 4 * 16, T_I_EG = 64 * 64;
constexpr int T_NITEMS = T_I_IN + T_I_GLU + 2 * T_I_PS + T_I_OUT + 2 * T_I_SG + T_I_SD + 3 * T_I_EG;
constexpr int T_LATE = 5 * 128 * NWAVES;
constexpr int T_LATE2 = T_I_EG;
static_assert(T_LATE + T_LATE2 <= 3 * T_I_EG, "late items are expert matrices");
__device__ __forceinline__ TDesc tdesc_of(const Params& p, unsigned char* ws, int r) { TDesc d;
    if (r < T_I_IN) { d = TDesc{p.in[5], (bf16_t*)(ws + WS_W_IN), 1024, IN_W, r, 2}; return d; } r -= T_I_IN;
    if (r < T_I_GLU) { d = TDesc{p.in[14], (bf16_t*)(ws + WS_W_GLU), 512, 512, r, 0}; return d; } r -= T_I_GLU;
    if (r < T_I_PS) { d = TDesc{p.in[16], (bf16_t*)(ws + WS_W_PS), 512, 1024, r, 0}; return d; } r -= T_I_PS;
    if (r < T_I_PS) { d = TDesc{p.in[17], (bf16_t*)(ws + WS_W_PA), 512, 1024, r, 0}; return d; } r -= T_I_PS;
    if (r < T_I_OUT) { d = TDesc{p.in[18], (bf16_t*)(ws + WS_W_OUT), 1024, 1024, r, 0}; return d; } r -= T_I_OUT;
    if (r < T_I_SG) { d = TDesc{p.in[25], (bf16_t*)(ws + WS_W_SGU), 1024, 256, r, 3}; return d; } r -= T_I_SG;
    if (r < T_I_SG) { d = TDesc{p.in[26], (bf16_t*)(ws + WS_W_SGU), 1024, 256, r, 4}; return d; } r -= T_I_SG;
    if (r < T_I_SD) { d = TDesc{p.in[27], (bf16_t*)(ws + WS_W_SD), 256, 1024, r, 1}; return d; } r -= T_I_SD;
    if (r < T_I_EG) { const int e = r >> 6; d = TDesc{p.in[22] + (size_t)e * 262144, (bf16_t*)(ws + WS_W_EGU) + (size_t)e * 524288, 1024, 256, r & 63, 3}; return d; } r -= T_I_EG;
    if (r < T_I_EG) { const int e = r >> 6; d = TDesc{p.in[23] + (size_t)e * 262144, (bf16_t*)(ws + WS_W_EGU) + (size_t)e * 524288, 1024, 256, r & 63, 4}; return d; } r -= T_I_EG;
    { const int e = r >> 6; d = TDesc{p.in[24] + (size_t)e * 262144, (bf16_t*)(ws + WS_W_ED) + (size_t)e * 262144, 256, 1024, r & 63, 1}; return d; } }
__device__ __forceinline__ void run_transposes(const Params& p, unsigned char* ws, LAS unsigned char* lds, int r0, int r1, int widx, int nw) {
    const int lane = tidx() & 63, wave = __builtin_amdgcn_readfirstlane(tidx() >> 6);
    LAS float* scr = (LAS float*)(lds + wave * 16640);
    int r = r1 - 1 - widx;
    if (r < r0) return;
    TDesc d0 = tdesc_of(p, ws, r), d1 = d0, d2 = d0; f32x4 v0[16], v1[16], v2[16];
    t_load(d0, lane, v0);
    bool h1 = (r - nw >= r0);
    if (h1) { d1 = tdesc_of(p, ws, r - nw); t_load(d1, lane, v1); }
    for (;;) {
        const bool h2 = h1 && (r - 2 * nw >= r0);
        if (h2) { d2 = tdesc_of(p, ws, r - 2 * nw); t_load(d2, lane, v2); }
        t_store(d0, v0, scr, lane);
        if (!h1) break;
        d0 = d1; d1 = d2; r -= nw; h1 = h2;
#pragma unroll
        for (int i = 0; i < 16; ++i) { v0[i] = v1[i]; v1[i] = v2[i]; }
    }
}
__device__ __forceinline__ void p0_prep(const Params& p, LAS unsigned char* lds, int vcu, int G) {
    const int tid = tidx(), lane = tid & 63, wave = __builtin_amdgcn_readfirstlane(tid >> 6);
    unsigned char* ws = p.ws;
    for (int it = vcu; it < 256; it += G) s5_tables_item(p, lds, it);
    {
        LAS float* sc = (LAS float*)lds;
        LAS float* red = (LAS float*)(lds + 32768);
        const float* c = p.in[1]; const float* w = p.in[2]; const float* bb = p.in[3]; float* ada = (float*)(ws + WS_ADA);
        bool loaded = false;
        for (int it = vcu; it < 96; it += G) {
            if (!loaded) { for (int i = tid; i < 8192; i += NTHR) { const float v = c[i]; sc[i] = v * sigmoidf_(v); } loaded = true; }
            __syncthreads();
            const int kq = tid >> 6, col = it * 64 + lane; float a[8];
#pragma unroll
            for (int b = 0; b < 8; ++b) a[b] = 0.f;
#pragma unroll 16
            for (int k = kq * 128; k < kq * 128 + 128; ++k) { const float wv = w[(size_t)k * 6144 + col];
#pragma unroll
                for (int b = 0; b < 8; ++b) a[b] += sc[b * 1024 + k] * wv; }
#pragma unroll
            for (int b = 0; b < 8; ++b) red[(kq * 8 + b) * 64 + lane] = a[b];
            __syncthreads();
            { const int b = tid >> 6; float s = bb[col];
#pragma unroll
              for (int q = 0; q < 8; ++q) s += red[(q * 8 + b) * 64 + lane];
              ada[b * 6144 + col] = s; }
            __syncthreads();
        }
        __syncthreads();
    }
    run_transposes(p, ws, lds, 0, T_NITEMS - T_LATE2 - ((G == 256) ? T_LATE : 0), vcu * NWAVES + wave, G * NWAVES);
    { const int gt = vcu * NTHR + tid, NGT = G * NTHR;
      u32x4* z = (u32x4*)(ws + WS_W_IN + (size_t)PROJ_USED * 1024 * 2);
      for (int i = gt; i < (PROJ_W - PROJ_USED) * 1024 * 2 / 16; i += NGT) z[i] = (u32x4){0u, 0u, 0u, 0u};
      int* id = (int*)(ws + WS_IDENT); for (int i = gt; i < NTOK; i += NGT) id[i] = (i % CHTOK) * NSLOT + 8;
      if (gt < 256) ((float*)(ws + WS_ONES))[gt] = 1.0f;
      for (int u = gt; u < 32 * 4 * 64; u += NGT) { const int l = u & 63, nt = (u >> 6) & 3, ks = u >> 8; const int n = nt * 16 + (l & 15), q = l >> 4; float hi[8], lo[8];
#pragma unroll
          for (int j = 0; j < 8; ++j) { const float w = p.in[20][(size_t)(ks * 32 + q * 8 + j) * 64 + n]; const float h = bf2f((unsigned short)f2bf(w)); hi[j] = h; lo[j] = w - h; }
          u32x4 o; o.x = pk2(hi[0], hi[1]); o.y = pk2(hi[2], hi[3]); o.z = pk2(hi[4], hi[5]); o.w = pk2(hi[6], hi[7]);
          *(u32x4*)((bf16_t*)(ws + WS_WRF) + (size_t)u * 8) = o;
          o.x = pk2(lo[0], lo[1]); o.y = pk2(lo[2], lo[3]); o.z = pk2(lo[4], lo[5]); o.w = pk2(lo[6], lo[7]);
          *(u32x4*)((bf16_t*)(ws + WS_WRF) + (size_t)(32 * 4 * 64 + u) * 8) = o; } }
}

__device__ __forceinline__ void p1_modulate(const Params& p, int vcu, int G) {
    const int tid = tidx(), lane = tid & 63, wave = tid >> 6; const int gw = vcu * NWAVES + wave, NGW = G * NWAVES;
    const float* ada = (const float*)(p.ws + WS_ADA); const float* g1 = p.in[4]; bf16_t* U = (bf16_t*)(p.ws + WS_U);
    for (int m = gw; m < NTOK; m += NGW) {
        const f32x4* xr = (const f32x4*)(p.in[0] + (size_t)m * D) + lane; const int b = m >> 12;
        f32x4 v[4]; float s = 0.f;
#pragma unroll
        for (int j = 0; j < 4; ++j) { v[j] = xr[64 * j]; s += (v[j].x * v[j].x + v[j].y * v[j].y) + (v[j].z * v[j].z + v[j].w * v[j].w); }
        const float rstd = 1.0f / sqrtf(wave_sum(s) * (1.f / D) + EPS);
        unsigned long long* o8 = (unsigned long long*)(U + (size_t)m * D) + lane;
#pragma unroll
        for (int j = 0; j < 4; ++j) { const int c0 = 4 * lane + 256 * j;
            const f32x4 gg = *(const f32x4*)(g1 + c0), sh = *(const f32x4*)(ada + b * 6144 + c0), scl = *(const f32x4*)(ada + b * 6144 + 1024 + c0);
            const f32x4 y = v[j] * rstd * gg * (scl + 1.0f) + sh;
            o8[64 * j] = (unsigned long long)pk2(y.x, y.y) | ((unsigned long long)pk2(y.z, y.w) << 32); }
    }
}

__device__ __forceinline__ void p_combine(const Params& p, int vcu, int G, int ch) {
    const int tid = tidx(), lane = tid & 63, wave = tid >> 6; const int gw = vcu * NWAVES + wave, NGW = G * NWAVES;
    const float* ada = (const float*)(p.ws + WS_ADA); const float* gf = p.in[28];
    const unsigned char* Y = (const unsigned char*)(p.ws + WS_Y);
    u32x4 w[NSLOT];
    { const int mi0 = gw < CHTOK ? gw : 0; const unsigned char* yp = Y + (size_t)mi0 * NSLOT * D + lane * 16;
#pragma unroll
      for (int k = 0; k < NSLOT; ++k) w[k] = *(const u32x4*)(yp + (size_t)k * D); }
    for (int mi = gw; mi < CHTOK; mi += NGW) {
        const int m = ch * CHTOK + mi; const int b = m >> 12;
        float* orow = p.out + (size_t)m * D + lane * 16;
        f32x4 h[4], g2[4];
        { const u32x4* hp = (const u32x4*)((const bf16_t*)(p.out + (size_t)m * D) + lane * 16); const u32x4 h0 = hp[0], h1 = hp[1];
          h[0] = (f32x4){bflo(h0.x), bfhi(h0.x), bflo(h0.y), bfhi(h0.y)}; h[1] = (f32x4){bflo(h0.z), bfhi(h0.z), bflo(h0.w), bfhi(h0.w)};
          h[2] = (f32x4){bflo(h1.x), bfhi(h1.x), bflo(h1.y), bfhi(h1.y)}; h[3] = (f32x4){bflo(h1.z), bfhi(h1.z), bflo(h1.w), bfhi(h1.w)}; }
#pragma unroll
        for (int q = 0; q < 4; ++q) g2[q] = *(const f32x4*)(ada + b * 6144 + 5120 + lane * 16 + 4 * q);
        float a[16];
#pragma unroll
        for (int j = 0; j < 16; ++j) a[j] = 0.f;
#pragma unroll
        for (int k = 0; k < NSLOT; ++k)
#pragma unroll
            for (int q = 0; q < 4; ++q) { const f32x2 lo = __builtin_amdgcn_cvt_pk_f32_fp8((int)w[k][q], false), hi = __builtin_amdgcn_cvt_pk_f32_fp8((int)w[k][q], true);
                a[4 * q] += lo.x; a[4 * q + 1] += lo.y; a[4 * q + 2] += hi.x; a[4 * q + 3] += hi.y; }
        { const int mn = (mi + NGW < CHTOK) ? mi + NGW : mi; const unsigned char* yp = Y + (size_t)mn * NSLOT * D + lane * 16;
#pragma unroll
          for (int k = 0; k < NSLOT; ++k) w[k] = *(const u32x4*)(yp + (size_t)k * D); }
        float r[16]; float s = 0.f;
#pragma unroll
        for (int i = 0; i < 4; ++i)
#pragma unroll
            for (int j = 0; j < 4; ++j) { const float v = h[i][j] + g2[i][j] * (a[i * 4 + j] * (1.0f / Y_SCALE)); r[i * 4 + j] = v; s += v * v; }
        const float rstd = 1.0f / sqrtf(wave_sum(s) * (1.f / D) + EPS);
#pragma unroll
        for (int q = 0; q < 4; ++q) { const f32x4 g = *(const f32x4*)(gf + lane * 16 + 4 * q); f32x4 o;
#pragma unroll
            for (int j = 0; j < 4; ++j) o[j] = r[q * 4 + j] * rstd * g[j];
            *(f32x4*)(orow + 4 * q) = o; }
    }
}

__device__ __forceinline__ unsigned fkey(float x) { const unsigned u = __builtin_bit_cast(unsigned, x); return (u & 0x80000000u) ? ~u : (u | 0x80000000u); }

__device__ __forceinline__ void gold_s5(const Params& p, int item, int lane) {
    const int b = item >> 5, g = item & 31;
    const bf16_t* PROJ = (const bf16_t*)(p.ws + WS_PROJ); bf16_t* YG = (bf16_t*)(p.ws + WS_YG);
    const float dt = expf(p.in[8][g]); const float lr = p.in[6][g * 64 + lane], li = p.in[7][g * 64 + lane];
    const float mag = expf(lr * dt); const float a_re = mag * cosf(li * dt), a_im = mag * sinf(li * dt);
    const float den = lr * lr + li * li, n_re = a_re - 1.0f;
    const float f_re = (n_re * lr + a_im * li) / den, f_im = (a_im * lr - n_re * li) / den;
    float bbr[16], bbi[16], cr[16], ci[16];
#pragma unroll
    for (int h = 0; h < 16; ++h) { const float br = p.in[9][(g * 64 + lane) * 16 + h], bi = p.in[10][(g * 64 + lane) * 16 + h];
        bbr[h] = f_re * br - f_im * bi; bbi[h] = f_re * bi + f_im * br;
        cr[h] = p.in[11][(g * 16 + h) * 64 + lane]; ci[h] = p.in[12][(g * 16 + h) * 64 + lane]; }
    const float dsk = p.in[13][g * 16 + (lane & 15)];
    float hr = 0.f, hi = 0.f;
    for (int t = 0; t < SEQ; ++t) {
        const size_t row = (size_t)b * SEQ + t;
        const u32x4 w0 = *(const u32x4*)(PROJ + row * PROJ_W + C_USSM + g * 16), w1 = *(const u32x4*)(PROJ + row * PROJ_W + C_USSM + g * 16 + 8);
        float u[16]; { float f[8]; unpack8(w0, f);
#pragma unroll
            for (int j = 0; j < 8; ++j) u[j] = f[j];
            unpack8(w1, f);
#pragma unroll
            for (int j = 0; j < 8; ++j) u[8 + j] = f[j]; }
        float bur = 0.f, bui = 0.f;
#pragma unroll
        for (int h = 0; h < 16; ++h) { bur += bbr[h] * u[h]; bui += bbi[h] * u[h]; }
        const float nr = a_re * hr - a_im * hi + bur, ni = a_re * hi + a_im * hr + bui; hr = nr; hi = ni;
        float y = 0.f, um = 0.f;
#pragma unroll
        for (int h = 0; h < 16; ++h) { const float v = wave_sum(cr[h] * hr - ci[h] * hi); if ((lane & 15) == h) { y = v; um = u[h]; } }
        y += dsk * um;
        const float gl = 0.5f * y * (1.0f + tanhf(0.7978845608028654f * (y + 0.044715f * y * y * y)));
        if (lane < 16) YG[row * 512 + g * 16 + lane] = (bf16_t)f2bf(gl);
    }
}

__device__ __forceinline__ void gold_attn_pair(const Params& p, LAS unsigned char* lds, int pairid) {
    const int half = tidx() >> 8, tid = tidx() & 255;
    LAS unsigned char* base = lds + half * 32768;
    LAS float* qi = (LAS float*)base; LAS float* qv = qi + 512; LAS float* sc = qv + 512; LAS float* lg = sc + 4096;
    LAS float* wi = lg + 2048; LAS float* mx = wi + 8; LAS float* sm = mx + 8; LAS int* sel = (LAS int*)(sm + 8); LAS int* red = sel + 256; LAS int* cntp = red + 256;
    const int qid = pairid * 2 + half; const int b = qid >> 12, t = qid & 4095;
    const bf16_t* PROJ = (const bf16_t*)(p.ws + WS_PROJ); bf16_t* YA = (bf16_t*)(p.ws + WS_YATTN);
    const size_t qrow = (size_t)qid * PROJ_W;
    __syncthreads();
    for (int i = tid; i < 512; i += 256) { qi[i] = bf2f(PROJ[qrow + C_QI + i]); qv[i] = bf2f(PROJ[qrow + C_Q + i]); }
    if (tid < 8) wi[tid] = bf2f(PROJ[qrow + C_WI + tid]);
    if (tid == 0) cntp[0] = 0;
    __syncthreads();
    const int n = t + 1;
    for (int s = tid; s < n; s += 256) {
        const bf16_t* kp = PROJ + ((size_t)b * SEQ + s) * PROJ_W + C_KI; float kk[64];
#pragma unroll
        for (int c8 = 0; c8 < 8; ++c8) { float f[8]; unpack8(*(const u32x4*)(kp + c8 * 8), f);
#pragma unroll
            for (int j = 0; j < 8; ++j) kk[c8 * 8 + j] = f[j]; }
        float score = 0.f;
        for (int h = 0; h < 8; ++h) { float d = 0.f;
#pragma unroll
            for (int j = 0; j < 64; ++j) d += qi[h * 64 + j] * kk[j];
            score += wi[h] * fmaxf(d, 0.f); }
        sc[s] = score;
    }
    __syncthreads();
    const bool small = (t | 1) <= 255;
    if (small) { if (tid < n) sel[tid] = tid; if (tid == 0) cntp[0] = n; __syncthreads(); }
    else {
        unsigned thr = 0u;
        for (int bit = 31; bit >= 0; --bit) {
            const unsigned cand = thr | (1u << bit); int c = 0;
            for (int s = tid; s < n; s += 256) c += (fkey(sc[s]) >= cand) ? 1 : 0;
            red[tid] = c; __syncthreads();
            for (int o = 128; o > 0; o >>= 1) { if (tid < o) red[tid] += red[tid + o]; __syncthreads(); }
            if (red[0] >= 256) thr = cand;
            __syncthreads();
        }
        for (int s = tid; s < n; s += 256) if (fkey(sc[s]) > thr) { const int ps = atomicAdd((int*)cntp, 1); sel[ps] = s; }
        __syncthreads();
        if (tid == 0) { int c = cntp[0]; for (int s = 0; s < n && c < 256; ++s) if (fkey(sc[s]) == thr) sel[c++] = s; cntp[0] = c; }
        __syncthreads();
    }
    const int ns = cntp[0];
    { const int j = tid; const int s = (j < ns) ? sel[j] : 0;
      const bf16_t* kp = PROJ + ((size_t)b * SEQ + s) * PROJ_W + C_K; float kk[64];
#pragma unroll
      for (int c8 = 0; c8 < 8; ++c8) { float f[8]; unpack8(*(const u32x4*)(kp + c8 * 8), f);
#pragma unroll
          for (int jj = 0; jj < 8; ++jj) kk[c8 * 8 + jj] = f[jj]; }
      for (int h = 0; h < 8; ++h) { float d = 0.f;
#pragma unroll
          for (int jj = 0; jj < 64; ++jj) d += qv[h * 64 + jj] * kk[jj];
          const float slope = exp2f(-(float)(h + 1));
          lg[h * 256 + j] = (j < ns) ? d * 0.125f - slope * (float)(t - s) : -INFINITY; } }
    __syncthreads();
    if (tid < 8) { float m = -INFINITY; for (int j = 0; j < 256; ++j) m = fmaxf(m, lg[tid * 256 + j]); float sum = 0.f; for (int j = 0; j < 256; ++j) sum += __expf(lg[tid * 256 + j] - m); mx[tid] = m; sm[tid] = sum; }
    __syncthreads();
    for (int i = tid; i < 2048; i += 256) { const int h = i >> 8; lg[i] = __expf(lg[i] - mx[h]) / sm[h]; }
    __syncthreads();
    { const int h = tid >> 5, d0 = (tid & 31) * 2; float o0 = 0.f, o1 = 0.f;
      for (int j = 0; j < ns; ++j) { const unsigned w = *(const unsigned*)(PROJ + ((size_t)b * SEQ + sel[j]) * PROJ_W + C_V + d0); const float pj = lg[h * 256 + j]; o0 += pj * bflo(w); o1 += pj * bfhi(w); }
      *(unsigned*)(YA + (size_t)qid * 512 + h * 64 + d0) = pk2(o0, o1); }
}

typedef float f32x16 __attribute__((ext_vector_type(16)));
typedef _Float16 f16_t;
constexpr int AT_SC = 0;
constexpr int AT_V = 65536;
constexpr int AT_SEL = LDS_CNT;
static_assert(AT_V + 8 * 2 * 4096 <= STAGE_BYTES && AT_SEL + 8 * 1152 <= LDS_BYTES, "attention LDS map");

__device__ __forceinline__ float relu_i(float x) { const int xi = __builtin_bit_cast(int, x); return __builtin_bit_cast(float, xi > 0 ? xi : 0); }
__device__ __forceinline__ u32x2 tr_read16(unsigned addr) { u32x2 r; asm volatile("ds_read_b64_tr_b16 %0, %1" : "=v"(r) : "v"(addr) : "memory"); return r; }

__device__ __forceinline__ void attn_item(const Params& p, LAS unsigned char* lds, int b, int qblk) {
    const int tid = tidx(), lane = tid & 63, wave = __builtin_amdgcn_readfirstlane(tid >> 6);
    const int q0 = qblk * 8;
    const bf16_t* PROJ = (const bf16_t*)(p.ws + WS_PROJ); bf16_t* YA = (bf16_t*)(p.ws + WS_YATTN);
    const size_t tok0 = (size_t)b * SEQ + q0;
    LAS unsigned short* SC = (LAS unsigned short*)(lds + AT_SC);
    LAS unsigned short* SELq = (LAS unsigned short*)(lds + AT_SEL) + wave * 576;
    const int nkt = (q0 + 8 + 31) >> 5;
    const int nchmax = (q0 + 8 + 511) >> 9;
    __syncthreads();
    for (int i = nkt * 32 + lane; i < nchmax * 512; i += 64) SC[wave * 4096 + i] = 0xFC00u;
    __syncthreads();
#ifndef AT_REP_A
#define AT_REP_A 1
#endif
#ifndef AT_REP_B
#define AT_REP_B 1
#endif
#ifndef AT_REP_C
#define AT_REP_C 1
#endif
#ifndef AT_SKIP_A
    for (int ra_ = 0; ra_ < AT_REP_A; ++ra_) {
        const int hf = lane >> 5, l32 = lane & 31;
        const int rq = 2 * ((l32 >> 2) & 1) + ((l32 >> 4) & 1), rh = (l32 & 3) + 4 * ((l32 >> 3) & 1);
        bf16x8 Af[2][4]; float wgt[2][16];
#pragma unroll
        for (int qg = 0; qg < 2; ++qg) { const bf16_t* qp = PROJ + (tok0 + 4 * qg + rq) * PROJ_W + C_QI + rh * 64 + hf * 8;
#pragma unroll
            for (int s = 0; s < 4; ++s) Af[qg][s] = *(const bf16x8*)(qp + s * 16);
#pragma unroll
            for (int qq = 0; qq < 2; ++qq) { const u32x4 w = *(const u32x4*)(PROJ + (tok0 + 4 * qg + 2 * hf + qq) * PROJ_W + C_WI); float f[8]; unpack8(w, f);
#pragma unroll
                for (int h = 0; h < 8; ++h) wgt[qg][qq * 8 + h] = f[h]; } }
        const bf16x8* KIF = (const bf16x8*)(p.ws + WS_KIF) + (size_t)b * 128 * 4 * 64 + lane;
        bf16x8 B0[4], B1[4];
        { const int kt0 = wave < nkt ? wave : 0, kt1 = wave + 8 < nkt ? wave + 8 : kt0;
#pragma unroll
          for (int s = 0; s < 4; ++s) { B0[s] = KIF[(kt0 * 4 + s) * 64]; B1[s] = KIF[(kt1 * 4 + s) * 64]; } }
#define STEP_A_TILE(BF, KT) do { const int key = (KT) * 32 + l32; \
            _Pragma("unroll") for (int qg = 0; qg < 2; ++qg) { \
                f32x16 c; _Pragma("unroll") for (int j = 0; j < 16; ++j) c[j] = 0.f; \
                _Pragma("unroll") for (int s = 0; s < 4; ++s) c = __builtin_amdgcn_mfma_f32_32x32x16_bf16(Af[qg][s], BF[s], c, 0, 0, 0); \
                float sa = 0.f, sb = 0.f; \
                _Pragma("unroll") for (int h = 0; h < 8; ++h) { sa += wgt[qg][h] * relu_i(c[h]); sb += wgt[qg][8 + h] * relu_i(c[8 + h]); } \
                const int qa = 4 * qg + 2 * hf; \
                sa = fminf(fmaxf(sa * 0.0441941738f, -60000.f), 60000.f); sb = fminf(fmaxf(sb * 0.0441941738f, -60000.f), 60000.f); \
                if (key > q0 + qa) sa = -INFINITY; \
                if (key > q0 + qa + 1) sb = -INFINITY; \
                const f16_t ha = (f16_t)sa, hb = (f16_t)sb; \
                SC[qa * 4096 + key] = __builtin_bit_cast(unsigned short, ha); SC[(qa + 1) * 4096 + key] = __builtin_bit_cast(unsigned short, hb); } } while (0)
        for (int kt = wave; kt < nkt; kt += 16) {
            STEP_A_TILE(B0, kt);
            { const int ktn = (kt + 16 < nkt) ? kt + 16 : kt;
#pragma unroll
              for (int s = 0; s < 4; ++s) B0[s] = KIF[(ktn * 4 + s) * 64]; }
            if (kt + 8 < nkt) {
                STEP_A_TILE(B1, kt + 8);
                { const int ktn = (kt + 24 < nkt) ? kt + 24 : kt;
#pragma unroll
                  for (int s = 0; s < 4; ++s) B1[s] = KIF[(ktn * 4 + s) * 64]; } }
        }
#undef STEP_A_TILE
    }
#endif
    __syncthreads();
    const int t = q0 + wave, n = t + 1;
    int ns;
    for (int rb_ = 0; rb_ < AT_REP_B; ++rb_) {
#ifdef AT_SKIP_B
    if (true) {
#else
    if (n <= 256) {
#endif
#pragma unroll
        for (int i = 0; i < 4; ++i) { const int pos = lane + 64 * i; SELq[pos] = (unsigned short)(pos < n ? pos : 0); }
        ns = n;
    } else {
        const int nch = (n + 511) >> 9;
        unsigned XH[32], XL[32];
        LAS unsigned char* row = lds + AT_SC + wave * 8192;
#pragma unroll
        for (int i = 0; i < 8; ++i) {
            if (i < nch) { const u32x4 w = *(const LAS u32x4*)(row + i * 1024 + lane * 16);
#pragma unroll
                for (int e2 = 0; e2 < 4; ++e2) { const unsigned x = w[e2]; const unsigned sg = (x & 0x80008000u) >> 15; const unsigned k2 = x ^ ((sg * 0xffffu) | 0x80008000u);
                    XH[i * 4 + e2] = k2; XL[i * 4 + e2] = k2 << 16; } }
            else {
#pragma unroll
                for (int e2 = 0; e2 < 4; ++e2) { XH[i * 4 + e2] = 0u; XL[i * 4 + e2] = 0u; } }
        }
        LAS unsigned* H1 = (LAS unsigned*)(lds + 65536 + wave * 8192);
        LAS unsigned* H2 = (LAS unsigned*)((LAS unsigned char*)SELq + 640);
        LAS unsigned* H1p = H1 + (lane & 1) * 1024;
#pragma unroll
        for (int i = 0; i < 8; ++i) *(LAS u32x4*)(H1 + (i * 64 + lane) * 4) = (u32x4){0u, 0u, 0u, 0u};
        H2[lane] = 0u;
        LDS_WAIT(); __builtin_amdgcn_wave_barrier();
#pragma unroll
        for (int i = 0; i < 8; ++i) if (i < nch) {
#pragma unroll
            for (int e2 = 0; e2 < 4; ++e2) { const unsigned x = XH[i * 4 + e2];
                __hip_atomic_fetch_add(H1p + (x >> 22), 1u, __ATOMIC_RELAXED, __HIP_MEMORY_SCOPE_WORKGROUP);
                __hip_atomic_fetch_add(H1p + ((x >> 6) & 1023u), 1u, __ATOMIC_RELAXED, __HIP_MEMORY_SCOPE_WORKGROUP); } }
        LDS_WAIT(); __builtin_amdgcn_wave_barrier();
        unsigned B1, cabove; const unsigned dummy = 64u + (unsigned)lane;
        {
            unsigned hb[16];
#pragma unroll
            for (int i = 0; i < 4; ++i) { const u32x4 w = *(const LAS u32x4*)(H1 + lane * 16 + i * 4), w2 = *(const LAS u32x4*)(H1 + 1024 + lane * 16 + i * 4); hb[4 * i] = w.x + w2.x; hb[4 * i + 1] = w.y + w2.y; hb[4 * i + 2] = w.z + w2.z; hb[4 * i + 3] = w.w + w2.w; }
            unsigned sl_ = 0u;
#pragma unroll
            for (int i = 0; i < 16; ++i) sl_ += hb[i];
            unsigned suf = sl_;
#pragma unroll
            for (int o = 1; o < 64; o <<= 1) { const unsigned a_ = __shfl_down(suf, o); if (lane + o < 64) suf += a_; }
            const unsigned above = suf - sl_;
            const bool mine = above < 256u && suf >= 256u;
            unsigned bsel = 0u, cab = 0u;
            if (mine) { unsigned run = above; bool done = false;
#pragma unroll
                for (int i = 15; i >= 0; --i) { if (!done && run + hb[i] >= 256u) { bsel = (unsigned)(lane * 16 + i); cab = run; done = true; } run += hb[i]; } }
            const unsigned long long mk = __ballot(mine); const int src = (int)__builtin_ctzll(mk);
            B1 = (unsigned)__shfl((int)bsel, src); cabove = (unsigned)__shfl((int)cab, src);
        }
#pragma unroll
        for (int i = 0; i < 8; ++i) if (i < nch) {
#pragma unroll
            for (int e2 = 0; e2 < 4; ++e2) { const unsigned x = XH[i * 4 + e2];
                const unsigned ah = ((x >> 22) == B1) ? ((x >> 16) & 63u) : dummy, al = (((x >> 6) & 1023u) == B1) ? (x & 63u) : dummy;
                __hip_atomic_fetch_add(H2 + ah, 1u, __ATOMIC_RELAXED, __HIP_MEMORY_SCOPE_WORKGROUP);
                __hip_atomic_fetch_add(H2 + al, 1u, __ATOMIC_RELAXED, __HIP_MEMORY_SCOPE_WORKGROUP); } }
        LDS_WAIT(); __builtin_amdgcn_wave_barrier();
        unsigned thr;
        {   const unsigned h2 = H2[lane]; unsigned suf = h2;
#pragma unroll
            for (int o = 1; o < 64; o <<= 1) { const unsigned a_ = __shfl_down(suf, o); if (lane + o < 64) suf += a_; }
            const unsigned need = 256u - cabove;
            const bool mine = (suf - h2) < need && suf >= need;
            const unsigned long long mk = __ballot(mine); const unsigned B2 = (unsigned)__builtin_ctzll(mk);
            thr = (B1 << 6) | B2; }
        const unsigned c32 = thr << 16, c32h = c32 | 0xffffu;
#define TIE2(a, b) asm volatile("" : "+v"(a), "+v"(b))
        int cgt = 0, ceq = 0;
#pragma unroll
        for (int j = 0; j < 32; ++j) { unsigned xh = XH[j], xl = XL[j]; TIE2(xh, cgt); TIE2(xl, ceq);
            cgt += (xh > c32h) ? 1 : 0; cgt += (xl > c32) ? 1 : 0; ceq += ((xh >> 16) == thr) ? 1 : 0; ceq += (xl == c32) ? 1 : 0; }
        int sgt = cgt, seq = ceq;
#pragma unroll
        for (int o = 1; o < 64; o <<= 1) { const int a = __shfl_up(sgt, o), e = __shfl_up(seq, o); if (lane >= o) { sgt += a; seq += e; } }
        const int tot_gt = __shfl(sgt, 63);
        int o1 = sgt - cgt, o2 = tot_gt + seq - ceq;
        const int trash = 256 + lane;
#pragma unroll
        for (int i = 0; i < 8; ++i) if (i < nch) {
#pragma unroll
            for (int e2 = 0; e2 < 4; ++e2) { const int j = i * 4 + e2; const int idx = i * 512 + lane * 8 + 2 * e2;
                unsigned xl = XL[j], xh = XH[j]; TIE2(xl, o1); TIE2(xh, o2);
                { const bool gt = xl > c32, eq = xl == c32; const int a2 = (eq && o2 < 256) ? o2 : trash, a1 = gt ? o1 : a2; SELq[a1] = (unsigned short)idx; o1 += gt ? 1 : 0; o2 += eq ? 1 : 0; }
                TIE2(xh, o1);
                { const bool gt = xh > c32h, eq = (xh >> 16) == thr; const int a2 = (eq && o2 < 256) ? o2 : trash, a1 = gt ? o1 : a2; SELq[a1] = (unsigned short)(idx + 1); o1 += gt ? 1 : 0; o2 += eq ? 1 : 0; } } }
        ns = 256;
    }
    LDS_WAIT(); __builtin_amdgcn_wave_barrier(); }
    __syncthreads();
    {
        const int hd = lane & 15, qd = lane >> 4;
        const size_t tok = tok0 + wave;
        LAS unsigned char* vb = lds + wave * 16384;
        const unsigned vb_addr = (unsigned)(size_t)vb;
        const int vrow = lane >> 3, vch = lane & 7;
        const char* bbase = (const char*)(PROJ + (size_t)b * SEQ * PROJ_W);
        const unsigned voff0 = (unsigned)(C_V * 2 + vch * 16), koff0 = (unsigned)(C_K * 2 + qd * 16);
        unsigned roff[32];
#pragma unroll
        for (int j_ = 0; j_ < 32; ++j_) roff[j_] = (unsigned)SELq[(j_ >> 2) * 32 + vrow + 8 * (j_ & 3)] * (unsigned)(PROJ_W * 2);
#define V_DMA(sl) do { _Pragma("unroll") for (int i_ = 0; i_ < 4; ++i_) { \
            __builtin_amdgcn_global_load_lds((const unsigned*)(bbase + (roff[(sl) * 4 + i_] + voff0)), (LAS unsigned*)(vb + ((sl) & 3) * 4096 + i_ * 1024), 16, 0, 0); } } while (0)
        bf16x8 Qf[2];
#pragma unroll
        for (int ks = 0; ks < 2; ++ks) { if (hd < 8) Qf[ks] = *(const bf16x8*)(PROJ + tok * PROJ_W + C_Q + hd * 64 + ks * 32 + qd * 8); else Qf[ks] = (bf16x8){0, 0, 0, 0, 0, 0, 0, 0}; }
#define KSWZ(row) ((unsigned)(((row) & 3) | ((((row) >> 3) & 1) << 2)))
#define K_DMA(sl) do { _Pragma("unroll") for (int i_ = 0; i_ < 4; ++i_) { const int row_ = i_ * 8 + vrow; \
            __builtin_amdgcn_global_load_lds((const unsigned*)(bbase + (roff[(sl) * 4 + i_] + (unsigned)(C_K * 2) + (((unsigned)vch ^ KSWZ(row_)) * 16u))), (LAS unsigned*)(vb + ((sl) & 3) * 4096 + i_ * 1024), 16, 0, 0); } } while (0)
        (void)koff0;
        K_DMA(0); K_DMA(1); K_DMA(2); K_DMA(3);
        f32x4 S[16];
#pragma unroll
        for (int sl = 0; sl < 8; ++sl) {
            asm volatile("s_waitcnt vmcnt(12)" ::: "memory");
#pragma unroll
            for (int Th = 0; Th < 2; ++Th) { const int prow = (hd >> 2) * 8 + Th * 4 + (hd & 3); const unsigned fp = KSWZ(prow);
                const LAS unsigned char* ka = vb + (sl & 3) * 4096 + prow * 128;
                const bf16x8 K0 = *(const LAS bf16x8*)(ka + (((unsigned)qd ^ fp) * 16u)), K1 = *(const LAS bf16x8*)(ka + (((unsigned)(4 + qd) ^ fp) * 16u));
                f32x4 a = (f32x4){0.f, 0.f, 0.f, 0.f};
                a = __builtin_amdgcn_mfma_f32_16x16x32_bf16(K0, Qf[0], a, 0, 0, 0); a = __builtin_amdgcn_mfma_f32_16x16x32_bf16(K1, Qf[1], a, 0, 0, 0); S[2 * sl + Th] = a; }
            asm volatile("s_waitcnt lgkmcnt(0)" ::: "memory");
            if (sl + 4 < 8) K_DMA(sl + 4); else V_DMA(sl - 4);
        }
        const float slope = exp2f(-(float)((hd & 7) + 1)), abase = -slope * (float)t;
        float mx = -INFINITY;
#pragma unroll
        for (int sl = 0; sl < 8; ++sl) { const u32x4 w = *(const LAS u32x4*)((LAS unsigned char*)SELq + (sl * 32 + qd * 8) * 2);
#pragma unroll
            for (int e = 0; e < 8; ++e) { const int T = sl * 2 + (e >> 2), r = e & 3; const unsigned ww = w[e >> 1]; const float sf = (float)((e & 1) ? (ww >> 16) : (ww & 0xffffu));
                const float lgv = __builtin_fmaf(S[T][r], 0.125f, __builtin_fmaf(slope, sf, abase)); S[T][r] = lgv; } }
        if (ns < 256) {
#pragma unroll
            for (int sl = 0; sl < 8; ++sl)
#pragma unroll
                for (int e = 0; e < 8; ++e) { if (sl * 32 + qd * 8 + e >= ns) S[sl * 2 + (e >> 2)][e & 3] = -INFINITY; } }
#pragma unroll
        for (int T = 0; T < 16; ++T) { asm("v_max3_f32 %0, %0, %1, %2" : "+v"(mx) : "v"(S[T][0]), "v"(S[T][1])); asm("v_max3_f32 %0, %0, %1, %2" : "+v"(mx) : "v"(S[T][2]), "v"(S[T][3])); }
        mx = fmaxf(mx, __shfl_xor(mx, 16)); mx = fmaxf(mx, __shfl_xor(mx, 32));
        float sum = 0.f;
        const float mxl = mx * 1.44269504089f;
#pragma unroll
        for (int T = 0; T < 16; ++T)
#pragma unroll
            for (int r = 0; r < 4; ++r) { const float e = __builtin_amdgcn_exp2f(S[T][r] * 1.44269504089f - mxl); S[T][r] = e; sum += e; }
        sum += __shfl_xor(sum, 16); sum += __shfl_xor(sum, 32);
        u32x4 Pk[8];
#pragma unroll
        for (int sl = 0; sl < 8; ++sl) { Pk[sl].x = pk2(S[2 * sl][0], S[2 * sl][1]); Pk[sl].y = pk2(S[2 * sl][2], S[2 * sl][3]); Pk[sl].z = pk2(S[2 * sl + 1][0], S[2 * sl + 1][1]); Pk[sl].w = pk2(S[2 * sl + 1][2], S[2 * sl + 1][3]); }
        f32x4 O[4];
#pragma unroll
        for (int dt = 0; dt < 4; ++dt) O[dt] = (f32x4){0.f, 0.f, 0.f, 0.f};
#pragma unroll
        for (int sl = 0; sl < 8; ++sl) {
            if (sl <= 4) asm volatile("s_waitcnt vmcnt(12)" ::: "memory"); else if (sl == 5) asm volatile("s_waitcnt vmcnt(8)" ::: "memory"); else if (sl == 6) asm volatile("s_waitcnt vmcnt(4)" ::: "memory"); else asm volatile("s_waitcnt vmcnt(0)" ::: "memory");
            const unsigned a0 = vb_addr + (sl & 3) * 4096 + (8 * qd + (hd >> 2)) * 128 + (hd & 3) * 8;
            u32x2 tr[4][2];
            asm volatile("ds_read_b64_tr_b16 %0, %8\n\tds_read_b64_tr_b16 %1, %8 offset:512\n\tds_read_b64_tr_b16 %2, %8 offset:32\n\tds_read_b64_tr_b16 %3, %8 offset:544\n\t"
                         "ds_read_b64_tr_b16 %4, %8 offset:64\n\tds_read_b64_tr_b16 %5, %8 offset:576\n\tds_read_b64_tr_b16 %6, %8 offset:96\n\tds_read_b64_tr_b16 %7, %8 offset:608\n\ts_waitcnt lgkmcnt(0)"
                         : "=&v"(tr[0][0]), "=&v"(tr[0][1]), "=&v"(tr[1][0]), "=&v"(tr[1][1]), "=&v"(tr[2][0]), "=&v"(tr[2][1]), "=&v"(tr[3][0]), "=&v"(tr[3][1]) : "v"(a0) : "memory");
            if (sl + 4 < 8) V_DMA(sl + 4);
            const bf16x8 Pf = __builtin_bit_cast(bf16x8, Pk[sl]);
#pragma unroll
            for (int dt = 0; dt < 4; ++dt) { u32x4 vw; vw.x = tr[dt][0].x; vw.y = tr[dt][0].y; vw.z = tr[dt][1].x; vw.w = tr[dt][1].y;
                O[dt] = __builtin_amdgcn_mfma_f32_16x16x32_bf16(__builtin_bit_cast(bf16x8, vw), Pf, O[dt], 0, 0, 0); }
        }
#undef V_DMA
        const float inv = 1.0f / sum;
        if (hd < 8) {
#pragma unroll
            for (int dt = 0; dt < 4; ++dt) { u32x2 w; w.x = pk2(O[dt][0] * inv, O[dt][1] * inv); w.y = pk2(O[dt][2] * inv, O[dt][3] * inv);
                *(u32x2*)(YA + tok * 512 + hd * 64 + dt * 16 + qd * 4) = w; } }
    }
}

#define DPP_F(v, ctrl, rmask) __builtin_bit_cast(float, __builtin_amdgcn_update_dpp(__builtin_bit_cast(int, v), __builtin_bit_cast(int, v), ctrl, rmask, 0xf, false))
__device__ __forceinline__ float wave_max_dpp(float v) {
    asm volatile("s_nop 1\n\tv_max_f32_dpp %0, %0, %0 row_shr:1 row_mask:0xf bank_mask:0xf\n\ts_nop 1\n\tv_max_f32_dpp %0, %0, %0 row_shr:2 row_mask:0xf bank_mask:0xf\n\ts_nop 1\n\t"
                 "v_max_f32_dpp %0, %0, %0 row_shr:3 row_mask:0xf bank_mask:0xf\n\ts_nop 1\n\tv_max_f32_dpp %0, %0, %0 row_shr:4 row_mask:0xf bank_mask:0xf\n\ts_nop 1\n\t"
                 "v_max_f32_dpp %0, %0, %0 row_shr:8 row_mask:0xf bank_mask:0xf\n\ts_nop 1\n\tv_max_f32_dpp %0, %0, %0 row_bcast:15 row_mask:0xa bank_mask:0xf\n\ts_nop 1\n\t"
                 "v_max_f32_dpp %0, %0, %0 row_bcast:31 row_mask:0xc bank_mask:0xf\n\ts_nop 1" : "+v"(v));
    return __builtin_bit_cast(float, __builtin_amdgcn_readlane(__builtin_bit_cast(int, v), 63));
}
#define DPP_Z(v, ctrl, rmask, bmask) __builtin_bit_cast(float, __builtin_amdgcn_update_dpp(0, __builtin_bit_cast(int, v), ctrl, rmask, bmask, false))
__device__ __forceinline__ float wave_sum_dpp(float v0) {
    float v1 = v0 + DPP_Z(v0, 0x111, 0xf, 0xf); v1 += DPP_Z(v0, 0x112, 0xf, 0xf); v1 += DPP_Z(v0, 0x113, 0xf, 0xf);
    v1 += DPP_Z(v1, 0x114, 0xf, 0xe); v1 += DPP_Z(v1, 0x118, 0xf, 0xc);
    v1 += DPP_Z(v1, 0x142, 0xa, 0xf); v1 += DPP_Z(v1, 0x143, 0xc, 0xf);
    return __builtin_bit_cast(float, __builtin_amdgcn_readlane(__builtin_bit_cast(int, v1), 63));
}
constexpr int RT_LG = 0;
constexpr int RT_ENT = 32768;
constexpr int RT_HIST = RT_ENT + 8 * 128 * 12;
constexpr int RT_NV = 49152;
__device__ __forceinline__ void route_tile(const Params& p, LAS unsigned char* lds, int tile, int skip) {
    const int tid = tidx(), lane = tid & 63, wave = __builtin_amdgcn_readfirstlane(tid >> 6), hd = lane & 15, qd = lane >> 4;
    const float* ada = (const float*)(p.ws + WS_ADA); const float* g2 = p.in[19];
    bf16_t* U2 = (bf16_t*)(p.ws + WS_U);
    LAS int* hist = (LAS int*)(lds + RT_HIST);
    LAS float* LGT = (LAS float*)(lds + RT_LG);
    LAS int* ENT = (LAS int*)(lds + RT_ENT) + wave * 384;
    const int b = (tile * 128) >> 12;
    __syncthreads();
    if (tid < 64) hist[tid] = 0;
    if (tid == 64) hist[128] = 0;
    { LAS float* NV = (LAS float*)(lds + RT_NV);
      for (int i = tid; i < 256; i += NTHR) { const f32x4 g = *(const f32x4*)(g2 + 4 * i), sc = *(const f32x4*)(ada + b * 6144 + 4096 + 4 * i), sh = *(const f32x4*)(ada + b * 6144 + 3072 + 4 * i);
          *(LAS f32x4*)(NV + 4 * i) = g * (sc + 1.0f); *(LAS f32x4*)(NV + 1024 + 4 * i) = sh; } }
    __syncthreads();
    if (wave < 4) {
        const int tokw = tile * 128 + wave * 32;
        float rstd[2]; const bf16_t* hrow[2];
#pragma unroll
        for (int rt = 0; rt < 2; ++rt) { const int m = tokw + rt * 16 + hd; hrow[rt] = (const bf16_t*)(p.out + (size_t)m * D) + qd * 8;
            const f32x4 q4 = *(const f32x4*)((const float*)(p.ws + WS_SS) + (size_t)m * 16 + qd * 4); float ss = (q4.x + q4.y) + (q4.z + q4.w);
            ss += __shfl_xor(ss, 16); ss += __shfl_xor(ss, 32); rstd[rt] = 1.0f / sqrtf(ss * (1.f / D) + EPS); }
        const bf16x8* WH = (const bf16x8*)(p.ws + WS_WRF) + lane; const bf16x8* WL = WH + 32 * 4 * 64;
        f32x4 acc[2][4];
#pragma unroll
        for (int rt = 0; rt < 2; ++rt)
#pragma unroll
            for (int nt = 0; nt < 4; ++nt) acc[rt][nt] = (f32x4){0.f, 0.f, 0.f, 0.f};
        bf16x8 wh[4], wl[4], whn[4], wln[4]; u32x4 xa[2], xn[2];
#pragma unroll
        for (int nt = 0; nt < 4; ++nt) { wh[nt] = WH[nt * 64]; wl[nt] = WL[nt * 64]; }
#pragma unroll
        for (int rt = 0; rt < 2; ++rt) xa[rt] = *(const u32x4*)(hrow[rt]);
#pragma unroll 2
        for (int ks = 0; ks < 32; ++ks) {
            const int kn = (ks + 1 < 32) ? ks + 1 : ks;
#pragma unroll
            for (int nt = 0; nt < 4; ++nt) { whn[nt] = WH[(kn * 4 + nt) * 64]; wln[nt] = WL[(kn * 4 + nt) * 64]; }
#pragma unroll
            for (int rt = 0; rt < 2; ++rt) xn[rt] = *(const u32x4*)(hrow[rt] + kn * 32);
            const int c0 = ks * 32 + qd * 8;
            const LAS float* NV = (const LAS float*)(lds + RT_NV);
            const f32x4 ma = *(const LAS f32x4*)(NV + c0), mb = *(const LAS f32x4*)(NV + c0 + 4), ha = *(const LAS f32x4*)(NV + 1024 + c0), hb = *(const LAS f32x4*)(NV + 1024 + c0 + 4);
#pragma unroll
            for (int rt = 0; rt < 2; ++rt) {
                const f32x4 x0 = {bflo(xa[rt].x), bfhi(xa[rt].x), bflo(xa[rt].y), bfhi(xa[rt].y)}, x1 = {bflo(xa[rt].z), bfhi(xa[rt].z), bflo(xa[rt].w), bfhi(xa[rt].w)};
                const f32x4 y0 = x0 * rstd[rt] * ma + ha, y1 = x1 * rstd[rt] * mb + hb;
                const u32x4 hi = pack8(y0, y1);
                f32x4 r0, r1; r0.x = y0.x - bflo(hi.x); r0.y = y0.y - bfhi(hi.x); r0.z = y0.z - bflo(hi.y); r0.w = y0.w - bfhi(hi.y);
                r1.x = y1.x - bflo(hi.z); r1.y = y1.y - bfhi(hi.z); r1.z = y1.z - bflo(hi.w); r1.w = y1.w - bfhi(hi.w);
                const bf16x8 uh = __builtin_bit_cast(bf16x8, hi), ul = __builtin_bit_cast(bf16x8, pack8(r0, r1));
#pragma unroll
                for (int nt = 0; nt < 4; ++nt) {
                    acc[rt][nt] = __builtin_amdgcn_mfma_f32_16x16x32_bf16(wh[nt], uh, acc[rt][nt], 0, 0, 0);
                    acc[rt][nt] = __builtin_amdgcn_mfma_f32_16x16x32_bf16(wl[nt], uh, acc[rt][nt], 0, 0, 0);
                    acc[rt][nt] = __builtin_amdgcn_mfma_f32_16x16x32_bf16(wh[nt], ul, acc[rt][nt], 0, 0, 0); } }
#pragma unroll
            for (int nt = 0; nt < 4; ++nt) { wh[nt] = whn[nt]; wl[nt] = wln[nt]; }
#pragma unroll
            for (int rt = 0; rt < 2; ++rt) xa[rt] = xn[rt];
        }
#pragma unroll
        for (int rt = 0; rt < 2; ++rt)
#pragma unroll
            for (int nt = 0; nt < 4; ++nt) *(LAS f32x4*)(LGT + (wave * 32 + rt * 16 + hd) * 64 + nt * 16 + qd * 4) = acc[rt][nt];
    }
    {
        LAS int* rowctr = hist + 128;
        LAS const float* NV = (LAS const float*)(lds + RT_NV);
        auto claim = [&]() -> int { int r = 0; if (lane == 0) r = __hip_atomic_fetch_add(rowctr, 1, __ATOMIC_RELAXED, __HIP_MEMORY_SCOPE_WORKGROUP); return __builtin_amdgcn_readfirstlane(r); };
        int r = claim(); u32x4 v[2]; float ssl = 0.f;
        if (r < 128) { const int m = tile * 128 + r; const u32x4* xr = (const u32x4*)(p.out + (size_t)m * D) + lane;
#pragma unroll
            for (int j = 0; j < 2; ++j) v[j] = xr[64 * j];
            ssl = ((const float*)(p.ws + WS_SS))[(size_t)m * 16 + (lane & 15)]; }
        while (r < 128) {
            const int rn = claim(); u32x4 vn[2]; float ssn = 0.f;
            if (rn < 128) { const int mn = tile * 128 + rn; const u32x4* xr = (const u32x4*)(p.out + (size_t)mn * D) + lane;
#pragma unroll
                for (int j = 0; j < 2; ++j) vn[j] = xr[64 * j];
                ssn = ((const float*)(p.ws + WS_SS))[(size_t)mn * 16 + (lane & 15)]; }
            else {
#pragma unroll
                for (int j = 0; j < 2; ++j) vn[j] = v[j]; }
            float ss = ssl; ss += __shfl_xor(ss, 1); ss += __shfl_xor(ss, 2); ss += __shfl_xor(ss, 4); ss += __shfl_xor(ss, 8);
            const float rstd = 1.0f / sqrtf(ss * (1.f / D) + EPS);
            u32x4* o16 = (u32x4*)(U2 + (size_t)(tile * 128 + r) * D) + lane;
#pragma unroll
            for (int j = 0; j < 2; ++j) { const int c0 = 8 * lane + 512 * j;
                const f32x4 ma = *(LAS const f32x4*)(NV + c0), mb = *(LAS const f32x4*)(NV + c0 + 4), sh = *(LAS const f32x4*)(NV + 1024 + c0), sb = *(LAS const f32x4*)(NV + 1024 + c0 + 4);
                const f32x4 x0 = {bflo(v[j].x), bfhi(v[j].x), bflo(v[j].y), bfhi(v[j].y)}, x1 = {bflo(v[j].z), bfhi(v[j].z), bflo(v[j].w), bfhi(v[j].w)};
                o16[64 * j] = pack8(x0 * rstd * ma + sh, x1 * rstd * mb + sb); }
#pragma unroll
            for (int j = 0; j < 2; ++j) v[j] = vn[j];
            ssl = ssn; r = rn;
        }
    }
    __syncthreads();
    const int tok0 = tile * 128 + wave * 16;
    LAS float* LG = LGT + wave * 1024;
    const float rbias = p.in[21][lane];
#pragma unroll 1
    for (int mi = 0; mi < 16; ++mi) {
        const float score = sigmoidf_(LG[mi * 64 + lane]); const float biased = score + rbias;
        float m1 = biased;
        m1 = fmaxf(m1, DPP_F(m1, 0xb1, 0xf)); m1 = fmaxf(m1, DPP_F(m1, 0x4e, 0xf)); m1 = fmaxf(m1, DPP_F(m1, 0x141, 0xf));
        const unsigned long long bal = __ballot(biased == m1); const int grp = lane >> 3;
        const unsigned gm = (unsigned)((bal >> (grp * 8)) & 0xffull); const int first = __ffs((int)gm) - 1;
        float v2 = ((lane & 7) == first) ? -INFINITY : biased;
        v2 = fmaxf(v2, DPP_F(v2, 0xb1, 0xf)); v2 = fmaxf(v2, DPP_F(v2, 0x4e, 0xf)); v2 = fmaxf(v2, DPP_F(v2, 0x141, 0xf));
        const float gscore = m1 + v2;
        int grank = 0;
#pragma unroll
        for (int og = 0; og < 8; ++og) { const float o = __builtin_bit_cast(float, __builtin_amdgcn_readlane(__builtin_bit_cast(int, gscore), og * 8)); grank += (o > gscore || (o == gscore && og < grp)) ? 1 : 0; }
        float mv = (grank < 4) ? biased : -INFINITY;
        unsigned long long chosen_m = 0ull;
#pragma unroll 1
        for (int it = 0; it < 8; ++it) { const float mxv = wave_max_dpp(mv); const unsigned long long e = __ballot(mv == mxv); const int w = (int)__builtin_ctzll(e); chosen_m |= 1ull << w; if (lane == w) mv = -INFINITY; }
        const bool chosen = (chosen_m >> lane) & 1ull;
        const int rank = (int)__builtin_amdgcn_mbcnt_hi((unsigned)(chosen_m >> 32), __builtin_amdgcn_mbcnt_lo((unsigned)chosen_m, 0u));
        const float gsum = wave_sum_dpp(chosen ? score : 0.f);
        if (chosen) { const int lpos = __hip_atomic_fetch_add(hist + lane, 1, __ATOMIC_RELAXED, __HIP_MEMORY_SCOPE_WORKGROUP);   const int e = mi * 8 + rank; ENT[e * 3] = lane; ENT[e * 3 + 1] = lpos; ENT[e * 3 + 2] = __builtin_bit_cast(int, score / gsum * 2.5f); }
    }
    __syncthreads();
    const int ch = (tile * 128) / CHTOK;
    if (skip) return;
    if (tid < 64) { const int c = hist[tid]; int base = 0; if (c > 0) base = (int)atomicAdd((unsigned*)(p.ws + WS_CTL) + CW_CNT + ch * NE + tid, (unsigned)c); hist[64 + tid] = base; }
    __syncthreads();
#pragma unroll
    for (int i = 0; i < 2; ++i) { const int e = lane + 64 * i; const int ex = ENT[e * 3], lpos = ENT[e * 3 + 1]; const float gate = __builtin_bit_cast(float, ENT[e * 3 + 2]);
        const int m = tok0 + (e >> 3), rk = e & 7, pair = ch * NE + ex, ps = hist[64 + ex] + lpos;
        ((int*)(p.ws + WS_DSTL))[(size_t)pair * PAIRCAP + ps] = (m - ch * CHTOK) * NSLOT + rk; ((float*)(p.ws + WS_GATEL))[(size_t)pair * PAIRCAP + ps] = gate; }
}

#define XB_TMO      128
#define XB_XCNT(j)  (256  + 64 * (j))
#define XB_XSUB(j)  (1280 + 64 * (j))
#define XB_XGEN(j)  (2304 + 64 * (j))
#define XB_TOP      3328
#define XB_TOPGEN   3392
#define XCD_BAR_WORDS 3456
#define XB_SPIN_CAP (1u << 22)
__device__ __forceinline__ unsigned xb_ld(unsigned* p)              { return __hip_atomic_load(p, __ATOMIC_RELAXED, __HIP_MEMORY_SCOPE_AGENT); }
__device__ __forceinline__ unsigned xb_add(unsigned* p, unsigned v) { return __hip_atomic_fetch_add(p, v, __ATOMIC_RELAXED, __HIP_MEMORY_SCOPE_AGENT); }
__device__ __forceinline__ unsigned xb_xcc_id() { return (unsigned)__builtin_amdgcn_s_getreg((3 << 11) | 20) & 0xFu; }
#define XB_SPIN(cond, bar) do { unsigned _sp = 0; while (cond) { __builtin_amdgcn_s_sleep(1); \
    if ((++_sp & 255u) == 0u) { if (xb_ld(&(bar)[XB_TMO])) break; if (_sp > XB_SPIN_CAP) { atomicAdd(&(bar)[XB_TMO], 1u); break; } } } } while (0)
struct XcdBarrier { unsigned* bar; unsigned x; volatile LAS unsigned* st; };
__device__ __forceinline__ XcdBarrier xcd_barrier_post(unsigned* bar, volatile LAS unsigned* st) {
    XcdBarrier b; b.bar = bar; b.x = xb_xcc_id(); b.st = st;
    if (tidx() == 0) (void)xb_add(&bar[XB_XCNT(b.x)], 1u);
    return b;
}
__device__ __forceinline__ void xcd_barrier_complete(unsigned* bar, unsigned x, unsigned& nloc, unsigned& nx) {
    const unsigned G = gridDim.x * gridDim.y * gridDim.z;
    unsigned sum, cnt, mine, sp = 0u;
    for (;;) {
        sum = 0u; cnt = 0u; mine = 0u;
#pragma unroll
        for (unsigned j = 0; j < 16; ++j) { const unsigned c = xb_ld(&bar[XB_XCNT(j)]); sum += c; cnt += (c > 0u) ? 1u : 0u; mine = (j == x) ? c : mine; }
        if (sum == G) break;
        __builtin_amdgcn_s_sleep(1);
        if ((++sp & 255u) == 0u) { if (xb_ld(&bar[XB_TMO])) break; if (sp > XB_SPIN_CAP) { atomicAdd(&bar[XB_TMO], 1u); break; } }
    }
    nloc = mine > 0u ? mine : 1u; nx = cnt > 0u ? cnt : 1u;
}
__device__ __forceinline__ void xcd_barrier(const XcdBarrier& b) {
    asm volatile("s_waitcnt vmcnt(0)" ::: "memory");
    __syncthreads();
    if (tidx() == 0) {
        unsigned* bar = b.bar;
        __builtin_amdgcn_s_waitcnt(0);
        unsigned nloc = b.st[0], nx = b.st[1];
        if (nloc == 0u) { xcd_barrier_complete(bar, b.x, nloc, nx); b.st[0] = nloc; b.st[1] = nx; }
        const unsigned old = xb_add(&bar[XB_XSUB(b.x)], 1u);
        const unsigned gen = old / nloc;
        if (old + 1u == (gen + 1u) * nloc) {
            __builtin_amdgcn_fence(__ATOMIC_RELEASE, "agent");
            asm volatile("s_waitcnt vmcnt(0)" ::: "memory");
            const unsigned og = xb_add(&bar[XB_TOP], 1u);
            const unsigned tg = og / nx;
            if (og + 1u == (tg + 1u) * nx) xb_add(&bar[XB_TOPGEN], 1u);
            else XB_SPIN(xb_ld(&bar[XB_TOPGEN]) == tg, bar);
            __builtin_amdgcn_fence(__ATOMIC_ACQUIRE, "agent");
            xb_add(&bar[XB_XGEN(b.x)], 1u);
            asm volatile("s_waitcnt vmcnt(0)" ::: "memory");
        } else {
            XB_SPIN(xb_ld(&bar[XB_XGEN(b.x)]) == gen, bar);
            __builtin_amdgcn_fence(__ATOMIC_ACQUIRE, "agent");
            asm volatile("s_waitcnt vmcnt(0)" ::: "memory");
        }
    }
    __syncthreads();
}

enum { PH_PREP = 0, PH_MOD, PH_INPROJ, PH_MIX  , PH_GLU, PH_MIXAB, PH_OUT, PH_ROUTE  , PH_MOE1, PH_MOE2_0, PH_COMB_0, PH_END };

#ifndef USE_CG_SYNC
#define USE_CG_SYNC 0
#endif
__global__ void __launch_bounds__(NTHR, 2) mega(Params p_arg) {
    extern __shared__ __attribute__((aligned(16))) unsigned char lds_raw[];
    LAS unsigned char* lds = (LAS unsigned char*)lds_raw;
    const int G = gridDim.x, bx = blockIdx.x;
    const int vcu = (G % 8 == 0) ? (bx % 8) * (G / 8) + bx / 8 : bx;
    const int tid = tidx(), lane = tid & 63, wave = __builtin_amdgcn_readfirstlane(tid >> 6);
    unsigned char* const ws_ = p_arg.ws; unsigned char* ws = ws_; (void)ws;
    if (tid < 32) ((LAS unsigned*)(lds + LDS_MISC))[tid] = 0u;
    __syncthreads();
#if USE_CG_SYNC
    cg::grid_group grid = cg::this_grid();
#define GRID_SYNC() grid.sync()
#else
    XcdBarrier xbar = xcd_barrier_post((unsigned*)(ws + WS_CTL) + CW_BAR, (volatile LAS unsigned*)(lds + LDS_MISC) + 8);
#define GRID_SYNC() xcd_barrier(xbar)
#endif
#ifndef ONLY_PH
#define ONLY_PH -1
#endif
#define IN(k) (ONLY_PH < 0 || ONLY_PH == (k))
#define SEAM(k) do { if ((k) + 1 < PH_END) GRID_SYNC(); } while (0)
#ifndef REP_PH
#define REP_PH -1
#endif
#ifndef REP_N
#define REP_N 3
#endif
#ifndef PROBE_NOSTORE
#define PROBE_NOSTORE 0
#endif
#define PHASE(k, ...) do { if (IN(k)) { { const int PROBE_SKIP = 0; unsigned zoff_ = 0u; asm volatile("" : "+s"(zoff_)); unsigned char* ws = ws_ + zoff_; const Params& p = *(const Params*)((const char*)&p_arg + zoff_); __VA_ARGS__ } if ((REP_PH) == (k)) { GRID_SYNC(); { const int PROBE_SKIP = PROBE_NOSTORE; unsigned zoff_ = 0u; asm volatile("" : "+s"(zoff_)); unsigned char* ws = ws_ + zoff_; const Params& p = *(const Params*)((const char*)&p_arg + zoff_); __VA_ARGS__ } GRID_SYNC(); { const int PROBE_SKIP = PROBE_NOSTORE; unsigned zoff_ = 0u; asm volatile("" : "+s"(zoff_)); unsigned char* ws = ws_ + zoff_; const Params& p = *(const Params*)((const char*)&p_arg + zoff_); __VA_ARGS__ } } } SEAM(k); } while (0)
    PHASE(PH_PREP, p0_prep(p, lds, vcu, G););
    PHASE(PH_MOD, p1_modulate(p, vcu, G););
    PHASE(PH_INPROJ, {
        pg8::DenseSched S; S.init(ws + WS_U, ws + WS_W_IN, NTOK, NIN, 1024, G, bx);
        EpiInProj E{(bf16_t*)(ws + WS_PROJ), (bf16_t*)(ws + WS_G), (bf16_t*)(ws + WS_KIF)};
        pg8::gemm_phase<EpiInProj, pg8::DenseSched, false>(lds, 1024, S, E);
        if (G == 256 && bx >= 128) { __syncthreads(); run_transposes(p, ws, lds, T_NITEMS - T_LATE2 - T_LATE, T_NITEMS - T_LATE2, (bx - 128) * NWAVES + wave, 128 * NWAVES); } });
    PHASE(PH_MIX, {
#ifdef GOLD_S5
        for (int it = vcu + G * wave; it < 256; it += G * NWAVES) gold_s5(p, it, lane);
#else
#ifndef REP_S5
#define REP_S5 1
#endif
#ifndef REP_ATTN
#define REP_ATTN 1
#endif
        for (int r_ = 0; r_ < REP_S5; ++r_) for (int it = vcu; it < 256; it += G) s5_item(p, lds, it);
#endif
#ifdef GOLD_ATTN
        for (int pr = vcu; pr < NTOK / 2; pr += G) gold_attn_pair(p, lds, pr);
#else
        for (int r_ = 0; r_ < REP_ATTN; ++r_) {
            for (int k = 0; ; ++k) { int ab, aq;
                if (G == 256) { if (k >= 16) break; ab = vcu >> 5; aq = 511 - ((vcu & 31) + 32 * k); }
                else { const int it = vcu + k * G; if (it >= NTOK / 8) break; ab = it & 7; aq = 511 - (it >> 3); }
                attn_item(p, lds, ab, aq); } }
#endif
        __syncthreads(); });
    PHASE(PH_GLU, {
        pg8::DenseSched S; S.init(ws + WS_YG, ws + WS_W_GLU, NTOK, 512, 512, G, bx);
        EpiGlu E{(const bf16_t*)(ws + WS_YG), p.in[15], (bf16_t*)(ws + WS_U)};
        pg8::gemm_phase<EpiGlu, pg8::DenseSched, false>(lds, 512, S, E); });
    PHASE(PH_MIXAB, {
        MixSched S; S.D0.init(ws + WS_U, ws + WS_W_PS, NTOK, 1024, 512, G, bx); S.D1.init(ws + WS_YATTN, ws + WS_W_PA, NTOK, 1024, 512, G, bx);
        EpiMix E{(const bf16_t*)(ws + WS_G), (bf16_t*)(ws + WS_MERGED)};
        pg8::gemm_phase<EpiMix, MixSched, false, false, true>(lds, 512, S, E); });
    PHASE(PH_OUT, {
        pg8::DenseSched S; S.init(ws + WS_MERGED, ws + WS_W_OUT, NTOK, 1024, 1024, G, bx);
        EpiOut E{p.in[0], (const float*)(ws + WS_ADA), p.out, (float*)(ws + WS_SS)};
        pg8::gemm_phase<EpiOut, pg8::DenseSched, false>(lds, 1024, S, E); });
    PHASE(PH_ROUTE, { for (int tile = vcu; tile < NTOK / 128; tile += G) route_tile(p, lds, tile, PROBE_SKIP); });
    PHASE(PH_MOE1, {
        build_moe_tables(lds, (const unsigned*)(ws + WS_CTL) + CW_CNT);
        Moe1Sched S{lds, G, vcu, (const char*)(ws + WS_U), (const int*)(ws + WS_DSTL), (const int*)(ws + WS_IDENT), (const char*)(ws + WS_W_EGU), (const char*)(ws + WS_W_SGU)};
        EpiMoe1 E{(bf16_t*)(ws + WS_H)};
        pg8::gemm_phase<EpiMoe1, Moe1Sched, true>(lds, 1024, S, E);
        { LAS int* TB_ = (LAS int*)(lds + LDS_TB); const int total = (RFL(TB_[256]) + 128) * 2, rem = total % G, nidle = rem ? G - rem : 0;
          __syncthreads();
          if (nidle == 0) run_transposes(p, ws, lds, T_NITEMS - T_LATE2, T_NITEMS, vcu * NWAVES + wave, G * NWAVES);
          else if (vcu >= rem) run_transposes(p, ws, lds, T_NITEMS - T_LATE2, T_NITEMS, (vcu - rem) * NWAVES + wave, nidle * NWAVES); } });
#pragma unroll
    for (int ch = 0; ch < NCHUNK; ++ch) {
        PHASE(PH_MOE2_0 + 2 * ch, {
            build_moe_tables(lds, (const unsigned*)(ws + WS_CTL) + CW_CNT);
            Moe2Sched S{lds, G, vcu, ch, ws};
            EpiMoe2 E{(unsigned char*)(ws + WS_Y), PROBE_SKIP, lds};
            pg8::gemm_phase<EpiMoe2, Moe2Sched, false, true>(lds, 256, S, E); });
        PHASE(PH_COMB_0 + 2 * ch, { p_combine(p, vcu, G, ch); });
    }
#undef IN
}

extern "C" void kernel_launch(void* const* d_in, const int* in_sizes, int n_in, void* d_out, int out_size, void* d_ws, size_t ws_size, hipStream_t stream) {
    static int grid = 0;
    if (grid == 0) {
        if (n_in != 29 || out_size != NTOK * D || ws_size < WS_NEED) { fprintf(stderr, "kernel_launch: unexpected shapes n_in %d out %d ws %zu\n", n_in, out_size, ws_size); grid = -1; return; }
        int dev = 0, cus = 0, per_cu = 0;
        hipGetDevice(&dev); hipDeviceGetAttribute(&cus, hipDeviceAttributeMultiprocessorCount, dev);
        hipFuncSetAttribute((const void*)mega, hipFuncAttributeMaxDynamicSharedMemorySize, LDS_BYTES);
        hipOccupancyMaxActiveBlocksPerMultiprocessor(&per_cu, (const void*)mega, NTHR, LDS_BYTES);
        (void)hipGetLastError();
        grid = (per_cu >= 1) ? cus : -1;
        if (grid < 0) { fprintf(stderr, "kernel_launch: occupancy query says %d blocks/CU\n", per_cu); return; }
    }
    if (grid < 0) return;
    hipMemsetAsync((char*)d_ws + WS_CTL, 0, CTL_BYTES, stream);
    Params p{};
    for (int i = 0; i < 29; ++i) p.in[i] = (const float*)d_in[i];
    p.out = (float*)d_out; p.ws = (unsigned char*)d_ws;
    p.ph_lo = 0; p.ph_hi = PH_END;
    void* args[] = {&p};
    hipError_t e = hipLaunchCooperativeKernel((const void*)mega, dim3(grid), dim3(NTHR), args, LDS_BYTES, stream);
    if (e != hipSuccess) fprintf(stderr, "kernel_launch: cooperative launch failed: %s (grid %d)\n", hipGetErrorString(e), grid);
}
```

```cpp
#include <hip/hip_runtime.h>
#include <hip/hip_cooperative_groups.h>
#include <cstdio>
#include <cstdint>
#include <cmath>
namespace cg = cooperative_groups;

#define GAS __attribute__((address_space(1)))
#define LAS __attribute__((address_space(3)))
typedef unsigned short bf16_t;
typedef short bf16x8 __attribute__((ext_vector_type(8)));
typedef float f32x4 __attribute__((ext_vector_type(4)));
typedef float f32x2 __attribute__((ext_vector_type(2)));
typedef unsigned u32x4 __attribute__((ext_vector_type(4)));
typedef unsigned u32x2 __attribute__((ext_vector_type(2)));

constexpr int NB = 8, SEQ = 4096, NTOK = NB * SEQ, D = 1024;
constexpr int IN_W = 3784, NIN = 3840, PROJ_W = 1792, G_W = 2048;
constexpr int C_USSM = 0, C_Q = 512, C_K = 1024, C_V = 1088, C_QI = 1152, C_KI = 1664, C_WI = 1728, PROJ_USED = 1736;
constexpr int NE = 64, TOPK = 8, NCHUNK = 1, CHTOK = NTOK / NCHUNK, NPAIR = NCHUNK * NE, PAIRCAP = CHTOK, NSLOT = 9;
constexpr float Y_SCALE = 64.0f;
constexpr int HROWS_ROUTED = NTOK * TOPK, HSH_ROW0 = HROWS_ROUTED + 256;
constexpr float EPS = 1e-6f;
constexpr int NWAVES = 8, NTHR = 512;

constexpr size_t MiB = 1u << 20;
constexpr size_t WS_CTL = 0, CTL_BYTES = 1 * MiB;
constexpr size_t WS_ADA = 1 * MiB;
constexpr size_t WS_ONES = 1 * MiB + 224 * 1024;
constexpr size_t WS_A32 = 1 * MiB + 256 * 1024;
constexpr size_t WS_IDENT = 1 * MiB + 512 * 1024;
constexpr size_t WS_WRF = 1 * MiB + 768 * 1024;
constexpr size_t WS_W_IN = 2 * MiB;
constexpr size_t WS_W_GLU = 10 * MiB;
constexpr size_t WS_W_PS = 11 * MiB;
constexpr size_t WS_W_PA = 12 * MiB;
constexpr size_t WS_W_OUT = 13 * MiB;
constexpr size_t WS_W_SGU = 15 * MiB;
constexpr size_t WS_W_SD = 16 * MiB;
constexpr size_t WS_TZF = 17 * MiB, WS_WINF = 18 * MiB, WS_WOUTF = 22 * MiB;
constexpr size_t WS_W_ED = 26 * MiB;
constexpr size_t WS_W_EGU = 58 * MiB;
constexpr size_t WS_KIF = 122 * MiB;
constexpr size_t WS_U = 128 * MiB;
constexpr size_t WS_PROJ = 192 * MiB;
constexpr size_t WS_G = 304 * MiB;
constexpr size_t WS_YG = 432 * MiB;
constexpr size_t WS_YATTN = 464 * MiB;
constexpr size_t WS_MERGED = 192 * MiB;
constexpr size_t WS_Y = 58 * MiB;
constexpr size_t WS_H = 346 * MiB;
constexpr size_t WS_DSTL = 492 * MiB;
constexpr size_t WS_SS = 4 * MiB;
constexpr size_t WS_GATEL = 500 * MiB;
constexpr size_t WS_NEED = 512 * MiB;
constexpr int CW_CNT = 0;
constexpr int CW_BAR = 4096;
constexpr int CW_Q0 = 1024;

constexpr int STAGE_BYTES = 131072;
constexpr int LDS_RO = STAGE_BYTES;
constexpr int LDS_MISC = LDS_RO + 2048;
constexpr int LDS_CNT = LDS_MISC + 128;
constexpr int LDS_RS = LDS_CNT + 1024;
constexpr int LDS_TB = LDS_RS + 1040;
constexpr int LDS_TD = LDS_TB + 1040;
constexpr int LDS_META = LDS_TD + 1408 * 4;
constexpr int LDS_BYTES = 147456;
static_assert(LDS_META + 4096 <= LDS_BYTES, "LDS map");

__device__ __forceinline__ unsigned f2bf(float f) { unsigned u = __builtin_bit_cast(unsigned, f); return (u + 0x7fffu + ((u >> 16) & 1u)) >> 16; }
typedef __bf16 bf16x2_t __attribute__((ext_vector_type(2)));
__device__ __forceinline__ unsigned pk2(float lo, float hi) { const f32x2 v = {lo, hi}; const bf16x2_t r = __builtin_convertvector(v, bf16x2_t); return __builtin_bit_cast(unsigned, r); }
__device__ __forceinline__ float bf2f(unsigned short b) { return __builtin_bit_cast(float, (unsigned)b << 16); }
__device__ __forceinline__ float bflo(unsigned w) { return __builtin_bit_cast(float, w << 16); }
__device__ __forceinline__ float bfhi(unsigned w) { return __builtin_bit_cast(float, w & 0xffff0000u); }
__device__ __forceinline__ float sigmoidf_(float x) { return __builtin_amdgcn_rcpf(1.0f + __builtin_amdgcn_exp2f(-1.44269504089f * x)); }
__device__ __forceinline__ float wave_sum(float v) {
#pragma unroll
    for (int o = 1; o < 64; o <<= 1) v += __shfl_xor(v, o);
    return v;
}
__device__ __forceinline__ int tidx() { int t = threadIdx.x; asm volatile("" : "+v"(t)); return t; }
#define LDS_WAIT() asm volatile("s_waitcnt lgkmcnt(0)" ::: "memory")

namespace pg8 {
constexpr int BM = 256, BK = 64, HALF = 128, HTB = HALF * BK * 2, NXCD = 8, WGM = 8;
__host__ __device__ __forceinline__ int lds_byte(int r, int c) { const int st = (r >> 4) * 2 + (c >> 5), rr = r & 15, cc = c & 31, ob = rr * 64 + cc * 2; return st * 1024 + (ob ^ (((ob >> 9) & 1) << 5)); }
__host__ __device__ __forceinline__ void stage_rc(int b, int& R, int& C) { const int st = b / 1024, sb = b % 1024, swz = sb ^ (((sb >> 9) & 1) << 5); R = (st >> 1) * 16 + swz / 64; C = (st & 1) * 32 + (swz % 64) / 2; }
__host__ __device__ __forceinline__ int perm32(int rho) { const int n = rho >> 4, i = rho & 15; return 8 * (i >> 2) + 4 * n + (i & 3); }

struct Unit { int pm, pn; const char* A; const char* B; const int* rows; int valid; int x0; int rbase; const float* gp; };

struct DenseSched {
    int nM, nN, nwg, G, c; const char* A; const char* B; size_t tstep;
    __device__ __forceinline__ void init(const void* A_, const void* B_, int M, int N, int K, int G_, int c_) { nM = M / BM; nN = N / BM; nwg = nM * nN; G = G_; c = c_; A = (const char*)A_; B = (const char*)B_; tstep = (size_t)BM * K * 2; }
    __device__ __forceinline__ bool next(int i, Unit& u) const {
        const long L = (long)i * G + c; if (L >= nwg) return false;
        int wgid = (int)L; { const int q = nwg / NXCD, r = nwg % NXCD, xcd = wgid % NXCD, off = wgid / NXCD; wgid = (xcd < r ? xcd * (q + 1) : r * (q + 1) + (xcd - r) * q) + off; }
        const int nig = WGM * nN, gid = wgid / nig, fm = gid * WGM, gsz = (nM - fm) < WGM ? (nM - fm) : WGM;
        u.pm = fm + ((wgid % nig) % gsz); u.pn = (wgid % nig) / gsz;
        u.A = A + (size_t)u.pm * tstep; u.B = B + (size_t)u.pn * tstep; u.rows = nullptr; u.valid = 256; u.x0 = 0; u.rbase = 0; u.gp = nullptr; return true;
    }
};

template <class Epi, class Sched, bool GATHER, bool RMETA = false, bool KEEPACC = false>
__device__ __forceinline__ void gemm_phase(LAS unsigned char* lds, const int K, const Sched& S, const Epi& E) {
    int tid_ = tidx(); asm volatile("" : "+v"(tid_));
    const int tid = tid_, wid = __builtin_amdgcn_readfirstlane(tid >> 6), lane = tid & 63, wr = wid >> 2, wc = wid & 3, fr = lane & 15, fq = lane >> 4;
    const int nt = K / BK;
    unsigned voffA[2], voffB[2]; int roA[2];
#pragma unroll
    for (int i = 0; i < 2; ++i) { int R, C; stage_rc(tid * 16 + i * 8192, R, C); const int Rb = (R & ~31) + perm32(R & 31);
        voffA[i] = GATHER ? (unsigned)(C * 2) : (unsigned)(R * K + C) * 2u; voffB[i] = (unsigned)(Rb * K + C) * 2u; roA[i] = R * 4; }
    const size_t kstep = (size_t)(BK * 2);
    const size_t hstep = (size_t)HALF * K * 2;
    const unsigned ldsw = (unsigned)wid * 1024u;
    const int aoff = lds_byte(wr * 64 + fr, fq * 8), boff = lds_byte(wc * 32 + fr, fq * 8);
    LAS unsigned char* ro = lds + LDS_RO;
#define PG8_SA(b, h) (((b) * 2 + (h)) * HTB)
#define PG8_SB(b, h) ((4 + (b) * 2 + (h)) * HTB)
#define PG8_STAGE_B(bufoff, gbase) do { _Pragma("unroll") for (int _i = 0; _i < 2; ++_i) \
        __builtin_amdgcn_global_load_lds((const unsigned*)((const char*)(gbase) + voffB[_i]), (LAS unsigned*)(lds + (bufoff) + ldsw + _i * 8192), 16, 0, 0); } while (0)
#define PG8_STAGE_A(bufoff, gbase, h, slot) do { _Pragma("unroll") for (int _i = 0; _i < 2; ++_i) { \
        unsigned _vo = voffA[_i]; const char* _gb = (const char*)(gbase); \
        if (GATHER) _vo += *(const LAS unsigned*)(ro + (slot) * 1024 + (h) * 512 + roA[_i]); else _gb += (h) * hstep; \
        __builtin_amdgcn_global_load_lds((const unsigned*)(_gb + _vo), (LAS unsigned*)(lds + (bufoff) + ldsw + _i * 8192), 16, 0, 0); } } while (0)
#define PG8_LDA(dst, b, h) do { _Pragma("unroll") for (int m = 0; m < 4; ++m) _Pragma("unroll") for (int k = 0; k < 2; ++k) dst[m][k] = *(const LAS bf16x8*)(lds + PG8_SA(b, h) + aoff + m * 2048 + k * 1024); } while (0)
#define PG8_LDB(dst, b, h) do { _Pragma("unroll") for (int n = 0; n < 2; ++n) _Pragma("unroll") for (int k = 0; k < 2; ++k) dst[n][k] = *(const LAS bf16x8*)(lds + PG8_SB(b, h) + boff + n * 2048 + k * 1024); } while (0)
#define PG8_MMA(ai, bj, At, Bt) do { __builtin_amdgcn_s_setprio(1); _Pragma("unroll") for (int m = 0; m < 4; ++m) _Pragma("unroll") for (int n = 0; n < 2; ++n) _Pragma("unroll") for (int k = 0; k < 2; ++k) \
        acc[ai][bj][m][n] = __builtin_amdgcn_mfma_f32_16x16x32_bf16(Bt[n][k], At[m][k], acc[ai][bj][m][n], 0, 0, 0); __builtin_amdgcn_s_setprio(0); } while (0)
#define PG8_WAIT_V(n) asm volatile("s_waitcnt vmcnt(" #n ")" ::: "memory")
#define PG8_WAIT_L(n) asm volatile("s_waitcnt lgkmcnt(" #n ")" ::: "memory")
#define PG8_BAR __builtin_amdgcn_s_barrier()
#define PG8_SCHED __builtin_amdgcn_sched_barrier(0)
    Unit cur, nxt; int ui = 0;
    if (!S.next(0, cur)) return;
    f32x4 acc[2][2][4][2];
#pragma unroll
    for (int a = 0; a < 2; ++a)
#pragma unroll
        for (int b = 0; b < 2; ++b)
#pragma unroll
            for (int m = 0; m < 4; ++m)
#pragma unroll
                for (int n = 0; n < 2; ++n) acc[a][b][m][n] = (f32x4){0.f, 0.f, 0.f, 0.f};
    bf16x8 At[4][2], B0[2][2], B1[2][2];
    const char* cA = cur.A; const char* cB = cur.B;
    if (GATHER) {
        if (tid < 256) { const int r = tid < cur.valid ? cur.rbase + cur.rows[tid] / NSLOT : 0; *(LAS unsigned*)(ro + tid * 4) = (unsigned)r * (unsigned)(K * 2); }
        __syncthreads();
    }
    PG8_STAGE_B(PG8_SB(0, 0), cB); PG8_STAGE_B(PG8_SB(0, 1), cB + hstep); PG8_STAGE_A(PG8_SA(0, 0), cA, 0, 0); PG8_STAGE_A(PG8_SA(0, 1), cA, 1, 0);
    if (wr == 1) PG8_BAR;
    PG8_WAIT_V(2); PG8_BAR;
    PG8_STAGE_B(PG8_SB(1, 0), cB + kstep); PG8_STAGE_A(PG8_SA(1, 0), cA + kstep, 0, 0); PG8_STAGE_B(PG8_SB(1, 1), cB + hstep + kstep);
    PG8_WAIT_V(6); PG8_BAR;
    for (;;) {
        const bool has_next = S.next(ui + 1, nxt);
        const int cslot = ui & 1, nslot = has_next ? (cslot ^ 1) : cslot;
        int pre_r = 0;
        if (GATHER) { if (has_next && tid < 256 && tid < nxt.valid) pre_r = nxt.rows[tid]; }
        if (RMETA) { if (wid < 4) {
            __builtin_amdgcn_global_load_lds((const unsigned*)(cur.gp + lane + wid * 64), (LAS unsigned*)(lds + LDS_META + cslot * 1024 + wid * 256), 4, 0, 0);
            __builtin_amdgcn_global_load_lds((const unsigned*)(cur.rows + lane + wid * 64), (LAS unsigned*)(lds + LDS_META + 2048 + cslot * 1024 + wid * 256), 4, 0, 0); } }
        const char* nA = has_next ? nxt.A : cA; const char* nB = has_next ? nxt.B : cB;
#pragma unroll 1
        for (int t = 0; t < nt; t += 2) {
            const bool last = (t == nt - 2);
            const char* a1 = cA + (size_t)(t + 1) * kstep;
            const char* a2 = last ? nA : cA + (size_t)(t + 2) * kstep; const char* b2 = last ? nB : cB + (size_t)(t + 2) * kstep;
            const char* a3 = a2 + kstep; const char* b3 = b2 + kstep;
            const int slot2 = last ? nslot : cslot;
            if (t == 2 || nt == 2) {
                if (GATHER) { if (has_next && tid < 256) { const int r = tid < nxt.valid ? nxt.rbase + pre_r / NSLOT : 0; *(LAS unsigned*)(ro + nslot * 1024 + tid * 4) = (unsigned)r * (unsigned)(K * 2); } }
            }
            PG8_LDB(B0, 0, 0); PG8_LDB(B1, 0, 1); PG8_SCHED; PG8_LDA(At, 0, 0); PG8_STAGE_A(PG8_SA(1, 1), a1, 1, cslot);
            PG8_WAIT_V(8); PG8_WAIT_L(0); PG8_BAR; PG8_MMA(0, 0, At, B0); PG8_MMA(0, 1, At, B1); PG8_BAR; PG8_SCHED;
            PG8_LDA(At, 0, 1); PG8_STAGE_B(PG8_SB(0, 0), b2); PG8_STAGE_B(PG8_SB(0, 1), b2 + hstep); PG8_STAGE_A(PG8_SA(0, 0), a2, 0, slot2);
            PG8_WAIT_V(8); PG8_WAIT_L(0); PG8_BAR; PG8_MMA(1, 0, At, B0); PG8_MMA(1, 1, At, B1); PG8_BAR; PG8_SCHED;
            PG8_LDB(B0, 1, 0); PG8_LDB(B1, 1, 1); PG8_SCHED; PG8_LDA(At, 1, 0); PG8_STAGE_A(PG8_SA(0, 1), a2, 1, slot2);
            PG8_WAIT_V(8); PG8_WAIT_L(0); PG8_BAR; PG8_MMA(0, 0, At, B0); PG8_MMA(0, 1, At, B1); PG8_BAR; PG8_SCHED;
            PG8_LDA(At, 1, 1); PG8_STAGE_B(PG8_SB(1, 0), b3); PG8_STAGE_B(PG8_SB(1, 1), b3 + hstep); PG8_STAGE_A(PG8_SA(1, 0), a3, 0, slot2);
            PG8_WAIT_V(8); PG8_WAIT_L(0); PG8_BAR; PG8_MMA(1, 0, At, B0); PG8_MMA(1, 1, At, B1); PG8_BAR; PG8_SCHED;
        }
        if (wr == 0) PG8_BAR;
        E(acc, cur, wr, wc, fr, fq, lds + LDS_META + (ui & 1) * 1024);
        if (!has_next) break;
        if (!KEEPACC || nxt.x0 == 0) {
#pragma unroll
        for (int a = 0; a < 2; ++a)
#pragma unroll
            for (int b = 0; b < 2; ++b)
#pragma unroll
                for (int m = 0; m < 4; ++m)
#pragma unroll
                    for (int n = 0; n < 2; ++n) acc[a][b][m][n] = (f32x4){0.f, 0.f, 0.f, 0.f};
        }
        cur = nxt; cA = nA; cB = nB; ++ui;
        if (wr == 1) PG8_BAR;
    }
    PG8_WAIT_V(0);
    PG8_BAR;
#undef PG8_SA
#undef PG8_SB
#undef PG8_STAGE_A
#undef PG8_STAGE_B
#undef PG8_LDA
#undef PG8_LDB
#undef PG8_MMA
#undef PG8_WAIT_V
#undef PG8_WAIT_L
#undef PG8_BAR
#undef PG8_SCHED
}
}
using pg8::Unit;

#define EPI_LOOP_BEGIN \
    _Pragma("unroll") for (int ai = 0; ai < 2; ++ai) _Pragma("unroll") for (int m = 0; m < 4; ++m) { const int rl = ai * 128 + wr * 64 + m * 16 + fr; const int row = u.pm * 256 + rl; \
    _Pragma("unroll") for (int bj = 0; bj < 2; ++bj) { const int col = u.pn * 256 + bj * 128 + wc * 32 + 8 * fq; const f32x4 v0 = acc[ai][bj][m][0], v1 = acc[ai][bj][m][1]; (void)row; (void)col; (void)rl;
#define EPI_LOOP_END } if (m == 3) asm volatile("" ::: "memory"); }
__device__ __forceinline__ u32x4 pack8(const f32x4 a, const f32x4 b) { u32x4 w; w.x = pk2(a[0], a[1]); w.y = pk2(a[2], a[3]); w.z = pk2(b[0], b[1]); w.w = pk2(b[2], b[3]); return w; }
__device__ __forceinline__ void unpack8(const u32x4 w, float (&f)[8]) { f[0] = bflo(w.x); f[1] = bfhi(w.x); f[2] = bflo(w.y); f[3] = bfhi(w.y); f[4] = bflo(w.z); f[5] = bfhi(w.z); f[6] = bflo(w.w); f[7] = bfhi(w.w); }

struct EpiInProj {
    bf16_t* PROJ; bf16_t* G; bf16_t* KIF;
    __device__ __forceinline__ void operator()(const f32x4 (&acc)[2][2][4][2], const Unit& u, int wr, int wc, int fr, int fq, LAS unsigned char* meta) const {
        EPI_LOOP_BEGIN
            if (u.pn < 7) { const u32x4 w8 = pack8(v0, v1); *(u32x4*)(PROJ + (size_t)row * PROJ_W + col) = w8;
                if (u.pn == 6 && col >= C_KI && col < C_KI + 64) { const int d0 = col - C_KI, key = row & 4095, bb = row >> 12;
                    *(u32x4*)(KIF + ((size_t)((bb * 128 + (key >> 5)) * 4 + (d0 >> 4)) * 64 + (key & 31) + 32 * ((d0 >> 3) & 1)) * 8) = w8; } }
            else { f32x4 s0, s1;
#pragma unroll
                for (int j = 0; j < 4; ++j) { s0[j] = sigmoidf_(v0[j]); s1[j] = sigmoidf_(v1[j]); }
                *(u32x4*)(G + (size_t)row * G_W + (col - PROJ_W)) = pack8(s0, s1); }
        EPI_LOOP_END
    }
};
struct EpiGlu {
    const bf16_t* YG; const float* bias; bf16_t* O;
    __device__ __forceinline__ void operator()(const f32x4 (&acc)[2][2][4][2], const Unit& u, int wr, int wc, int fr, int fq, LAS unsigned char* meta) const {
        f32x4 bb[2][2];
#pragma unroll
        for (int bj = 0; bj < 2; ++bj) { const int col = u.pn * 256 + bj * 128 + wc * 32 + 8 * fq; bb[bj][0] = *(const f32x4*)(bias + col); bb[bj][1] = *(const f32x4*)(bias + col + 4); }
        EPI_LOOP_BEGIN
            float y[8]; unpack8(*(const u32x4*)(YG + (size_t)row * 512 + col), y);
            const f32x4 b0 = bb[bj][0], b1 = bb[bj][1]; f32x4 o0, o1;
#pragma unroll
            for (int j = 0; j < 4; ++j) { o0[j] = y[j] * sigmoidf_(v0[j] + b0[j]); o1[j] = y[4 + j] * sigmoidf_(v1[j] + b1[j]); }
            *(u32x4*)(O + (size_t)row * 512 + col) = pack8(o0, o1);
        EPI_LOOP_END
    }
};
struct EpiMix {
    const bf16_t* G; bf16_t* O;
    __device__ __forceinline__ void operator()(f32x4 (&acc)[2][2][4][2], const Unit& u, int wr, int wc, int fr, int fq, LAS unsigned char* meta) const {
        const size_t gbase = (size_t)(u.pm * 256 + wr * 64 + fr) * G_W + u.pn * 256 + wc * 32 + 8 * fq;
        if (u.x0 == 0) {
#pragma unroll
            for (int ai = 0; ai < 2; ++ai) {
                u32x4 q1[4][2], q2[4][2];
#pragma unroll
                for (int m = 0; m < 4; ++m)
#pragma unroll
                    for (int bj = 0; bj < 2; ++bj) { const size_t o_ = gbase + (size_t)(ai * 128 + m * 16) * G_W + bj * 128; q1[m][bj] = *(const u32x4*)(G + o_); q2[m][bj] = *(const u32x4*)(G + o_ + 1024); }
#pragma unroll
                for (int m = 0; m < 4; ++m)
#pragma unroll
                    for (int bj = 0; bj < 2; ++bj) { float g1[8], g2[8]; unpack8(q1[m][bj], g1); unpack8(q2[m][bj], g2);
#pragma unroll
                        for (int j = 0; j < 4; ++j) { acc[ai][bj][m][0][j] *= g1[j] * __builtin_amdgcn_rcpf(fmaxf(g2[j], 1e-6f)); acc[ai][bj][m][1][j] *= g1[4 + j] * __builtin_amdgcn_rcpf(fmaxf(g2[4 + j], 1e-6f)); } }
                asm volatile("" ::: "memory"); }
        } else {
            u32x4 q2[2][4][2];
#pragma unroll
            for (int ai = 0; ai < 2; ++ai)
#pragma unroll
                for (int m = 0; m < 4; ++m)
#pragma unroll
                    for (int bj = 0; bj < 2; ++bj) q2[ai][m][bj] = *(const u32x4*)(G + gbase + (size_t)(ai * 128 + m * 16) * G_W + bj * 128 + 1024);
#pragma unroll
            for (int ai = 0; ai < 2; ++ai)
#pragma unroll
                for (int m = 0; m < 4; ++m)
#pragma unroll
                    for (int bj = 0; bj < 2; ++bj) { float g2[8]; unpack8(q2[ai][m][bj], g2); f32x4 o0, o1;
#pragma unroll
                        for (int j = 0; j < 4; ++j) { o0[j] = acc[ai][bj][m][0][j] * fmaxf(g2[j], 1e-6f); o1[j] = acc[ai][bj][m][1][j] * fmaxf(g2[4 + j], 1e-6f); }
                        *(u32x4*)(O + (size_t)(u.pm * 256 + ai * 128 + wr * 64 + m * 16 + fr) * D + u.pn * 256 + bj * 128 + wc * 32 + 8 * fq) = pack8(o0, o1); }
        }
    }
};
struct MixSched {
    pg8::DenseSched D0, D1;
    __device__ __forceinline__ bool next(int i, Unit& u) const { const bool ok = (i & 1) ? D1.next(i >> 1, u) : D0.next(i >> 1, u); u.x0 = i & 1; return ok; }
};
struct EpiOut {
    const float* X; const float* ada; float* O; float* SS;
    __device__ __forceinline__ void operator()(const f32x4 (&acc)[2][2][4][2], const Unit& u, int wr, int wc, int fr, int fq, LAS unsigned char* meta) const {
        f32x4 gg[2][2];
#pragma unroll
        for (int bj = 0; bj < 2; ++bj) { const float* gp = ada + (size_t)((u.pm * 256) >> 12) * 6144 + 2048 + u.pn * 256 + bj * 128 + wc * 32 + 8 * fq; gg[bj][0] = *(const f32x4*)gp; gg[bj][1] = *(const f32x4*)(gp + 4); }
        const size_t base = (size_t)(u.pm * 256 + wr * 64 + fr) * D + u.pn * 256 + wc * 32 + 8 * fq;
        f32x4 xq[3][2][2];
#define EPO_LOAD(slot, rg) do { const size_t o_ = base + (size_t)(((rg) >> 2) * 128 + ((rg) & 3) * 16) * D; _Pragma("unroll") for (int bj = 0; bj < 2; ++bj) { xq[slot][bj][0] = *(const f32x4*)(X + o_ + bj * 128); xq[slot][bj][1] = *(const f32x4*)(X + o_ + bj * 128 + 4); } } while (0)
        EPO_LOAD(0, 0); EPO_LOAD(1, 1);
#pragma unroll
        for (int rg = 0; rg < 8; ++rg) { const int ai = rg >> 2, m = rg & 3;
            if (rg + 2 < 8) EPO_LOAD((rg + 2) % 3, rg + 2);
            const size_t o_ = base + (size_t)(ai * 128 + m * 16) * D; float ss = 0.f;
#pragma unroll
            for (int bj = 0; bj < 2; ++bj) { const f32x4 o0 = xq[rg % 3][bj][0] + gg[bj][0] * acc[ai][bj][m][0], o1 = xq[rg % 3][bj][1] + gg[bj][1] * acc[ai][bj][m][1];
                *(u32x4*)((bf16_t*)O + 2 * (o_ - (size_t)(u.pn * 256 + wc * 32 + 8 * fq)) + (u.pn * 256 + wc * 32 + 8 * fq) + bj * 128) = pack8(o0, o1);
                ss += (o0.x * o0.x + o0.y * o0.y) + (o0.z * o0.z + o0.w * o0.w) + (o1.x * o1.x + o1.y * o1.y) + (o1.z * o1.z + o1.w * o1.w); }
            ss += __shfl_xor(ss, 16); ss += __shfl_xor(ss, 32);
            if (fq == 0) SS[(size_t)(u.pm * 256 + ai * 128 + wr * 64 + m * 16 + fr) * 16 + u.pn * 4 + wc] = ss;
            asm volatile("" ::: "memory"); }
#undef EPO_LOAD
    }
};
struct EpiMoe1 {
    bf16_t* H;
    __device__ __forceinline__ void operator()(const f32x4 (&acc)[2][2][4][2], const Unit& u, int wr, int wc, int fr, int fq, LAS unsigned char* meta) const {
#pragma unroll
        for (int ai = 0; ai < 2; ++ai)
#pragma unroll
            for (int m = 0; m < 4; ++m) { const int rl = ai * 128 + wr * 64 + m * 16 + fr;
                if (rl < u.valid) { f32x4 o0, o1;
#pragma unroll
                    for (int j = 0; j < 4; ++j) { const float g0 = acc[ai][0][m][0][j], g1 = acc[ai][1][m][0][j]; o0[j] = g0 * sigmoidf_(g0) * acc[ai][0][m][1][j]; o1[j] = g1 * sigmoidf_(g1) * acc[ai][1][m][1][j]; }
                    *(u32x4*)(H + (size_t)(u.x0 + rl) * 256 + u.pn * 128 + wc * 32 + 8 * fq) = pack8(o0, o1); } }
    }
};
__device__ __forceinline__ void epi_stage_write(LAS unsigned char* sc, int fr, int fq, const u32x4 w0, const u32x4 w1) {
    LAS unsigned char* rowp = sc + (fr >> 3) * 8192 + (fr & 7) * 128; const int x = fr & 7;
    *(LAS u32x4*)(rowp + ((fq ^ x) * 16)) = w0; *(LAS u32x4*)(rowp + (((4 + fq) ^ x) * 16)) = w1;
}
__device__ __forceinline__ u32x4 epi_stage_read(const LAS unsigned char* sc, int q, int lane) {
    const int r = lane >> 3, c = lane & 7; return *(const LAS u32x4*)(sc + q * 8192 + r * 128 + ((c ^ r) * 16));
}
__device__ __forceinline__ unsigned pk4_fp8(float a, float b, float c, float d) {
    a = __builtin_amdgcn_fmed3f(a, -448.f, 448.f); b = __builtin_amdgcn_fmed3f(b, -448.f, 448.f); c = __builtin_amdgcn_fmed3f(c, -448.f, 448.f); d = __builtin_amdgcn_fmed3f(d, -448.f, 448.f);
    int w = 0; w = __builtin_amdgcn_cvt_pk_fp8_f32(a, b, w, false); w = __builtin_amdgcn_cvt_pk_fp8_f32(c, d, w, true); return (unsigned)w;
}
struct EpiMoe2 {
    unsigned char* Y; int skip; LAS unsigned char* lds0;
    __device__ __forceinline__ void operator()(const f32x4 (&acc)[2][2][4][2], const Unit& u, int wr, int wc, int fr, int fq, LAS unsigned char* meta) const {
        asm volatile("" : "+v"(fr), "+v"(fq));
        const int lane = fr + 16 * fq;
        LAS unsigned char* sc0 = lds0 + 3 * pg8::HTB + (wr * 4 + wc) * 1024;
#pragma unroll
        for (int ai = 0; ai < 2; ++ai)
#pragma unroll
            for (int m = 0; m < 4; ++m) { const int rl0 = ai * 128 + wr * 64 + m * 16; LAS unsigned char* sc = sc0 + (m & 1) * 8192;
                const float g = *(const LAS float*)(meta + (rl0 + fr) * 4) * Y_SCALE;
                u32x2 w0, w1;
                w0.x = pk4_fp8(acc[ai][0][m][0][0] * g, acc[ai][0][m][0][1] * g, acc[ai][0][m][0][2] * g, acc[ai][0][m][0][3] * g); w0.y = pk4_fp8(acc[ai][0][m][1][0] * g, acc[ai][0][m][1][1] * g, acc[ai][0][m][1][2] * g, acc[ai][0][m][1][3] * g);
                w1.x = pk4_fp8(acc[ai][1][m][0][0] * g, acc[ai][1][m][0][1] * g, acc[ai][1][m][0][2] * g, acc[ai][1][m][0][3] * g); w1.y = pk4_fp8(acc[ai][1][m][1][0] * g, acc[ai][1][m][1][1] * g, acc[ai][1][m][1][2] * g, acc[ai][1][m][1][3] * g);
                *(LAS u32x2*)(sc + fr * 64 + fq * 8) = w0; *(LAS u32x2*)(sc + fr * 64 + 32 + fq * 8) = w1;
                { const int r = lane >> 2, c = lane & 3, rl = rl0 + r; const u32x4 v = *(const LAS u32x4*)(sc + r * 64 + c * 16);
                  if (rl < u.valid && !skip) { const int dst = *(const LAS int*)(meta + 2048 + rl * 4); *(u32x4*)(Y + (size_t)dst * D + u.pn * 256 + wc * 64 + c * 16) = v; } } }
    }
};

__device__ __forceinline__ void build_moe_tables(LAS unsigned char* lds, const unsigned* cnt_g) {
    LAS int* CNT = (LAS int*)(lds + LDS_CNT); LAS int* RS = (LAS int*)(lds + LDS_RS); LAS int* TB = (LAS int*)(lds + LDS_TB); LAS unsigned* TD = (LAS unsigned*)(lds + LDS_TD);
    const int tid = tidx();
    __syncthreads();
    if (tid < 256) { int c = tid < NPAIR ? (int)cnt_g[tid] : 0; c = c < 0 ? 0 : (c > PAIRCAP ? PAIRCAP : c); CNT[tid] = c; }
    __syncthreads();
    if (tid < 64) {
        int c[4], rs = 0, tb = 0;
#pragma unroll
        for (int i = 0; i < 4; ++i) { c[i] = CNT[4 * tid + i]; rs += c[i]; tb += (c[i] + 255) >> 8; }
        int srs = rs, stb = tb;
#pragma unroll
        for (int o = 1; o < 64; o <<= 1) { const int a = __shfl_up(srs, o), e = __shfl_up(stb, o); if (tid >= o) { srs += a; stb += e; } }
        int ers = srs - rs, etb = stb - tb;
#pragma unroll
        for (int i = 0; i < 4; ++i) { RS[4 * tid + i] = ers; TB[4 * tid + i] = etb; ers += c[i]; etb += (c[i] + 255) >> 8; }
        if (tid == 63) { RS[256] = srs; TB[256] = stb; }
    }
    __syncthreads();
    if (tid < 256) { const int c = CNT[tid], nt = (c + 255) >> 8, tb = TB[tid]; for (int k = 0; k < nt; ++k) TD[tb + k] = (unsigned)tid | ((unsigned)k << 9); }
    __syncthreads();
}
#define RFL(x) __builtin_amdgcn_readfirstlane(x)
struct Moe1Sched {
    LAS unsigned char* lds; int G, c; const char* U2; const int* dstl; const int* ident; const char* Wegu; const char* Wsgu;
    __device__ __forceinline__ bool next(int i, Unit& u) const {
        LAS int* CNT = (LAS int*)(lds + LDS_CNT); LAS int* RS = (LAS int*)(lds + LDS_RS); LAS int* TB = (LAS int*)(lds + LDS_TB); LAS unsigned* TD = (LAS unsigned*)(lds + LDS_TD);
        const int ntr = RFL(TB[256]); const int L = i * G + c; if (L >= (ntr + 128) * 2) return false;
        const int tau = L >> 1; u.pn = L & 1; u.pm = 0; u.A = U2; u.gp = nullptr;
        if (tau < ntr) { const unsigned d = (unsigned)RFL((int)TD[tau]); const int j = d & 511, k = d >> 9; u.valid = min(256, RFL(CNT[j]) - k * 256); u.rows = dstl + (size_t)(j * PAIRCAP + k * 256); u.x0 = RFL(RS[j]) + k * 256; u.rbase = (j >> 6) * CHTOK;
            u.B = Wegu + (size_t)(j & 63) * (512 * 1024 * 2) + (size_t)u.pn * (256 * 1024 * 2); }
        else { const int k = tau - ntr; u.valid = 256; u.rows = ident + k * 256; u.x0 = HSH_ROW0 + k * 256; u.rbase = (k / (CHTOK / 256)) * CHTOK; u.B = Wsgu + (size_t)u.pn * (256 * 1024 * 2); }
        return true;
    }
};
struct Moe2Sched {
    LAS unsigned char* lds; int G, c, ch; const unsigned char* ws;
    __device__ __forceinline__ bool next(int i, Unit& u) const {
        LAS int* CNT = (LAS int*)(lds + LDS_CNT); LAS int* RS = (LAS int*)(lds + LDS_RS); LAS int* TB = (LAS int*)(lds + LDS_TB); LAS unsigned* TD = (LAS unsigned*)(lds + LDS_TD);
        constexpr int NSH = CHTOK / 256;
        const int t0 = RFL(TB[64 * ch]), ntr = RFL(TB[64 * ch + 64]) - t0; const int L = i * G + c; if (L >= (ntr + NSH) * 4) return false;
        const int tau = L >> 2; u.pn = L & 3; u.pm = 0; u.rbase = 0; u.x0 = 0;
        if (tau < ntr) { const unsigned d = (unsigned)RFL((int)TD[t0 + tau]); const int j = d & 511, k = d >> 9; u.valid = min(256, RFL(CNT[j]) - k * 256);
            u.A = (const char*)(ws + WS_H) + (size_t)(RFL(RS[j]) + k * 256) * 512; u.rows = (const int*)(ws + WS_DSTL) + (size_t)(j * PAIRCAP + k * 256); u.gp = (const float*)(ws + WS_GATEL) + (size_t)(j * PAIRCAP + k * 256);
            u.B = (const char*)(ws + WS_W_ED) + (size_t)(j & 63) * (1024 * 256 * 2) + (size_t)u.pn * (256 * 256 * 2); }
        else { const int k = NSH * ch + (tau - ntr); u.valid = 256; u.A = (const char*)(ws + WS_H) + (size_t)(HSH_ROW0 + k * 256) * 512; u.rows = (const int*)(ws + WS_IDENT) + k * 256; u.gp = (const float*)(ws + WS_ONES); u.B = (const char*)(ws + WS_W_SD) + (size_t)u.pn * (256 * 256 * 2); }
        return true;
    }
};

struct Params { const float* in[29]; float* out; unsigned char* ws; int ph_lo, ph_hi; };

__device__ __forceinline__ void s5_tables_item(const Params& p, LAS unsigned char* lds, int item) {
    const int g = item >> 3, part = item & 7, tid = tidx();
    LAS float* AP = (LAS float*)lds;
    LAS float* BB = AP + 64 * 33 * 2;
    LAS float* CC = BB + 64 * 16 * 2;
    const float dt = expf(p.in[8][g]);
    __syncthreads();
    for (int i = tid; i < 64 * 33; i += NTHR) { const int pp = i / 33, tau = i - pp * 33; const float lr = p.in[6][g * 64 + pp], li = p.in[7][g * 64 + pp];
        const float mag = expf(lr * dt * (float)tau), th = li * dt * (float)tau; AP[i * 2] = mag * cosf(th); AP[i * 2 + 1] = mag * sinf(th); }
    for (int i = tid; i < 64 * 16; i += NTHR) { const int pp = i >> 4; const float lr = p.in[6][g * 64 + pp], li = p.in[7][g * 64 + pp];
        const float mag = expf(lr * dt); const float a_re = mag * cosf(li * dt), a_im = mag * sinf(li * dt);
        const float den = lr * lr + li * li, n_re = a_re - 1.0f; const float f_re = (n_re * lr + a_im * li) / den, f_im = (a_im * lr - n_re * li) / den;
        const float br = p.in[9][(size_t)(g * 64) * 16 + i], bi = p.in[10][(size_t)(g * 64) * 16 + i];
        BB[i * 2] = f_re * br - f_im * bi; BB[i * 2 + 1] = f_re * bi + f_im * br; }
    for (int i = tid; i < 16 * 64; i += NTHR) { CC[i * 2] = p.in[11][(size_t)g * 1024 + i]; CC[i * 2 + 1] = p.in[12][(size_t)g * 1024 + i]; }
    __syncthreads();
    if (part == 0 && tid < 64) { float* a32 = (float*)(p.ws + WS_A32); a32[(g * 64 + tid) * 2] = AP[(tid * 33 + 32) * 2]; a32[(g * 64 + tid) * 2 + 1] = AP[(tid * 33 + 32) * 2 + 1]; }
    {
        const int jh = tid >> 8, t2 = tid & 255;
        const int fr = t2 >> 6, l = t2 & 63, delta = part * 4 + fr, ho = l & 15, q = l >> 4, tau = delta - (q >> 1); float v[4];
#pragma unroll 1
        for (int jj = 0; jj < 4; ++jj) { const int j = jh * 4 + jj; const int hi = (q & 1) * 8 + j; float acc = 0.f;
            if (tau >= 0) { for (int pp = 0; pp < 64; ++pp) { const float ar = AP[(pp * 33 + tau) * 2], ai = AP[(pp * 33 + tau) * 2 + 1], br = BB[(pp * 16 + hi) * 2], bi = BB[(pp * 16 + hi) * 2 + 1], cr = CC[(ho * 64 + pp) * 2], ci = CC[(ho * 64 + pp) * 2 + 1];
                    acc += cr * (ar * br - ai * bi) - ci * (ar * bi + ai * br); }
                if (tau == 0 && ho == hi) acc += p.in[13][g * 16 + ho]; }
            v[jj] = acc; }
        u32x2 o; o.x = pk2(v[0], v[1]); o.y = pk2(v[2], v[3]);
        *(u32x2*)((bf16_t*)(p.ws + WS_TZF) + ((size_t)(g * 32 + delta) * 64 + l) * 8 + jh * 4) = o;
    }
    for (int u = tid; u < 1024; u += NTHR) {
        const int ks = u >> 6, l = u & 63, n = part * 16 + (l & 15), q = l >> 4, ri = n >> 6, pp = n & 63; float v[8];
#pragma unroll
        for (int j = 0; j < 8; ++j) { const int k = ks * 32 + q * 8 + j, sidx = k >> 4, hi = k & 15;
            const float ar = AP[(pp * 33 + 31 - sidx) * 2], ai = AP[(pp * 33 + 31 - sidx) * 2 + 1], br = BB[(pp * 16 + hi) * 2], bi = BB[(pp * 16 + hi) * 2 + 1];
            v[j] = ri ? (ar * bi + ai * br) : (ar * br - ai * bi); }
        u32x4 o; o.x = pk2(v[0], v[1]); o.y = pk2(v[2], v[3]); o.z = pk2(v[4], v[5]); o.w = pk2(v[6], v[7]);
        *(u32x4*)((bf16_t*)(p.ws + WS_WINF) + ((size_t)((g * 8 + part) * 16 + ks) * 64 + l) * 8) = o;
    }
    for (int u = tid; u < 1024; u += NTHR) {
        const int fr = u >> 6, l = u & 63, t = part * 4 + (fr >> 2), ksp = fr & 3, ho = l & 15, q = l >> 4; float v[8];
#pragma unroll
        for (int j = 0; j < 8; ++j) { const int kp = ksp * 32 + q * 8 + j, ri = kp >> 6, pp = kp & 63;
            const float cr = CC[(ho * 64 + pp) * 2], ci = CC[(ho * 64 + pp) * 2 + 1], ar = AP[(pp * 33 + t + 1) * 2], ai = AP[(pp * 33 + t + 1) * 2 + 1];
            v[j] = ri ? -(cr * ai + ci * ar) : (cr * ar - ci * ai); }
        u32x4 o; o.x = pk2(v[0], v[1]); o.y = pk2(v[2], v[3]); o.z = pk2(v[4], v[5]); o.w = pk2(v[6], v[7]);
        *(u32x4*)((bf16_t*)(p.ws + WS_WOUTF) + ((size_t)((g * 32 + t) * 4 + ksp) * 64 + l) * 8) = o;
    }
    __syncthreads();
}

__device__ __forceinline__ float gelu_tanh(float y) { const float z = 0.7978845608028654f * (y + 0.044715f * y * y * y); const float e = __expf(2.0f * z); const float th = 1.0f - 2.0f / (e + 1.0f); return 0.5f * y * (1.0f + th); }

__device__ __forceinline__ void s5_item(const Params& p, LAS unsigned char* lds, int item) {
    const int b = item >> 5, g = item & 31;
    const int tid = tidx(), lane = tid & 63, wave = __builtin_amdgcn_readfirstlane(tid >> 6), hd = lane & 15, qd = lane >> 4;
    const bf16_t* PROJ = (const bf16_t*)(p.ws + WS_PROJ); bf16_t* YG = (bf16_t*)(p.ws + WS_YG);
    LAS float* SL = (LAS float*)lds;
    LAS unsigned char* WO = lds + 65536;
    const char* WoutG = (const char*)(p.ws + WS_WOUTF) + (size_t)g * 32 * 4 * 1024;
#define S5_WO_DMA(h) do { _Pragma("unroll") for (int j_ = 0; j_ < 8; ++j_) \
        __builtin_amdgcn_global_load_lds((const unsigned*)(WoutG + (size_t)(h) * 65536 + (j_ * 512 + tid) * 16), (LAS unsigned*)(WO + j_ * 8192 + wave * 1024), 16, 0, 0); } while (0)
    const int c = 16 * wave + hd;
    __syncthreads();
    S5_WO_DMA(0);
    bf16x8 Uf[16];
#pragma unroll
    for (int ks = 0; ks < 16; ++ks) Uf[ks] = *(const bf16x8*)(PROJ + ((size_t)b * SEQ + c * 32 + 2 * ks + (qd >> 1)) * PROJ_W + C_USSM + g * 16 + (qd & 1) * 8);
    { const bf16x8* WinF = (const bf16x8*)(p.ws + WS_WINF) + (size_t)g * 8 * 16 * 64 + lane;
      bf16x8 wc_[8], wn_[8];
#pragma unroll
      for (int ks = 0; ks < 8; ++ks) wc_[ks] = WinF[ks * 64];
      f32x4 a = (f32x4){0.f, 0.f, 0.f, 0.f};
#pragma unroll 2
      for (int j = 0; j < 16; ++j) { const int jn = (j < 15) ? j + 1 : j;
#pragma unroll
          for (int i = 0; i < 8; ++i) wn_[i] = WinF[(jn * 8 + i) * 64];
          if ((j & 1) == 0) {
#pragma unroll
              for (int i = 0; i < 8; ++i) a = __builtin_amdgcn_mfma_f32_16x16x32_bf16(wc_[i], Uf[i], a, 0, 0, 0); }
          else {
#pragma unroll
              for (int i = 0; i < 8; ++i) a = __builtin_amdgcn_mfma_f32_16x16x32_bf16(wc_[i], Uf[8 + i], a, 0, 0, 0);
              *(LAS f32x4*)(SL + c * 128 + (j >> 1) * 16 + qd * 4) = a; a = (f32x4){0.f, 0.f, 0.f, 0.f}; }
#pragma unroll
          for (int i = 0; i < 8; ++i) wc_[i] = wn_[i]; } }
    __syncthreads();
    if (wave == 0) { const float* a32 = (const float*)(p.ws + WS_A32); const float ar = a32[(g * 64 + lane) * 2], ai = a32[(g * 64 + lane) * 2 + 1]; float hr = 0.f, hi = 0.f;
#pragma unroll 4
        for (int cc = 0; cc < 128; ++cc) { const float sr = SL[cc * 128 + lane], si = SL[cc * 128 + 64 + lane]; const float nr = ar * hr - ai * hi + sr, ni = ar * hi + ai * hr + si; hr = nr; hi = ni; SL[cc * 128 + lane] = hr; SL[cc * 128 + 64 + lane] = hi; } }
    __syncthreads();
    bf16x8 Hf[4];
#pragma unroll
    for (int ks = 0; ks < 4; ++ks) { if (c >= 1) { const f32x4 x0 = *(const LAS f32x4*)(SL + (c - 1) * 128 + ks * 32 + qd * 8), x1 = *(const LAS f32x4*)(SL + (c - 1) * 128 + ks * 32 + qd * 8 + 4); Hf[ks] = __builtin_bit_cast(bf16x8, pack8(x0, x1)); }
        else Hf[ks] = (bf16x8){0, 0, 0, 0, 0, 0, 0, 0}; }
    const bf16x8* TzF = (const bf16x8*)(p.ws + WS_TZF) + (size_t)g * 32 * 64 + lane;
#pragma unroll
    for (int half = 0; half < 2; ++half) {
        f32x4 acc[16];
#pragma unroll
        for (int tt = 0; tt < 16; ++tt) acc[tt] = (f32x4){0.f, 0.f, 0.f, 0.f};
        const int ndelta = half * 16 + 16;
        bf16x8 fr[4];
#pragma unroll
        for (int i = 0; i < 4; ++i) fr[i] = TzF[i * 64];
#pragma unroll
        for (int delta = 0; delta < 32; ++delta) {
            if (delta < ndelta) {
                const bf16x8 f0 = fr[delta & 3];
                if (delta + 4 < ndelta) fr[delta & 3] = TzF[(delta + 4) * 64];
#pragma unroll
                for (int ks = 0; ks < 16; ++ks) { const int t = delta + 2 * ks; if (t >= half * 16 && t < half * 16 + 16) acc[t - half * 16] = __builtin_amdgcn_mfma_f32_16x16x32_bf16(f0, Uf[ks], acc[t - half * 16], 0, 0, 0); }
            }
        }
        asm volatile("s_waitcnt vmcnt(0)" ::: "memory");
        __syncthreads();
#pragma unroll
        for (int tt = 0; tt < 16; ++tt) { const int t = half * 16 + tt;
#pragma unroll
            for (int ks = 0; ks < 4; ++ks) acc[tt] = __builtin_amdgcn_mfma_f32_16x16x32_bf16(*(const LAS bf16x8*)(WO + (tt * 4 + ks) * 1024 + lane * 16), Hf[ks], acc[tt], 0, 0, 0);
            u32x2 w; w.x = pk2(gelu_tanh(acc[tt][0]), gelu_tanh(acc[tt][1])); w.y = pk2(gelu_tanh(acc[tt][2]), gelu_tanh(acc[tt][3]));
            *(u32x2*)(YG + ((size_t)b * SEQ + c * 32 + t) * 512 + g * 16 + qd * 4) = w;
            if ((tt & 1) == 1) asm volatile("" ::: "memory"); }
        if (half == 0) { asm volatile("s_waitcnt lgkmcnt(0)" ::: "memory"); __syncthreads(); S5_WO_DMA(1); }
    }
#undef S5_WO_DMA
    __syncthreads();
}

struct TDesc { const float* W; bf16_t* WT; int K, N, item, kind; };
__device__ __forceinline__ void t_load(const TDesc& d, int lane, f32x4 (&v)[16]) {
    const int nblk = (d.N + 63) >> 6, kb = d.item / nblk, nb = d.item - kb * nblk, k0 = 64 * kb, n0 = 64 * nb;
    const int lr = lane >> 4, lc = (lane & 15) * 4;
#pragma unroll
    for (int i = 0; i < 16; ++i) v[i] = (n0 + lc < d.N) ? *(const f32x4*)(d.W + (size_t)(k0 + 4 * i + lr) * d.N + n0 + lc) : (f32x4){0.f, 0.f, 0.f, 0.f};
}
struct RmId { __device__ int operator()(int n) const { return n; } };
struct RmWave { __device__ int operator()(int n) const { const int L = n & 255; return (n & ~255) + 128 * ((L >> 5) & 1) + 32 * (L >> 6) + (L & 31); } };
struct RmIn { __device__ int operator()(int n) const { return n < PROJ_USED ? n : n + (PROJ_W - PROJ_USED); } };
struct RmGate { __device__ int operator()(int n) const { const int hl = n & 127; return 256 * (n >> 7) + 128 * ((hl >> 2) & 1) + 32 * (hl >> 5) + 8 * ((hl >> 3) & 3) + (hl & 3); } };
struct RmUp { __device__ int operator()(int n) const { const int hl = n & 127; return 256 * (n >> 7) + 128 * ((hl >> 2) & 1) + 32 * (hl >> 5) + 8 * ((hl >> 3) & 3) + 4 + (hl & 3); } };
__device__ __forceinline__ int t_rowmap(int kind, int n) { return kind == 0 ? n : kind == 1 ? RmWave()(n) : kind == 2 ? RmIn()(n) : kind == 3 ? RmGate()(n) : RmUp()(n); }
__device__ __forceinline__ void t_store(const TDesc& d, const f32x4 (&v)[16], LAS float* scr, int lane) {
    const int nblk = (d.N + 63) >> 6, kb = d.item / nblk, nb = d.item - kb * nblk, k0 = 64 * kb, n0 = 64 * nb;
    const int lr = lane >> 4, lc = (lane & 15) * 4;
#pragma unroll
    for (int i = 0; i < 16; ++i) { LAS float* dd = scr + (4 * i + lr) * 65 + lc; dd[0] = v[i].x; dd[1] = v[i].y; dd[2] = v[i].z; dd[3] = v[i].w; }
    LDS_WAIT(); asm volatile("" ::: "memory");
    const int nl = lane >> 3, kc = (lane & 7) * 8;
#pragma unroll
    for (int j = 0; j < 8; ++j) { const int n = nl + 8 * j; const LAS float* sp = scr + kc * 65 + n;
        u32x4 o; o.x = pk2(sp[0 * 65], sp[1 * 65]); o.y = pk2(sp[2 * 65], sp[3 * 65]); o.z = pk2(sp[4 * 65], sp[5 * 65]); o.w = pk2(sp[6 * 65], sp[7 * 65]);
        if (n0 + n < d.N) *(u32x4*)(d.WT + (size_t)t_rowmap(d.kind, n0 + n) * d.K + k0 + kc) = o; }
    LDS_WAIT(); asm volatile("" ::: "memory");
}

constexpr int T_I_IN = 16 * 60, T_I_GLU = 8 * 8, T_I_PS = 8 * 16, T_I_OUT = 16 * 16, T_I_SG = 16 * 4, T_I_SD = 4 * 16, T_I_EG = 64 * 64;
constexpr int T_NITEMS = T_I_IN + T_I_GLU + 2 * T_I_PS + T_I_OUT + 2 * T_I_SG + T_I_SD + 3 * T_I_EG;
constexpr int T_LATE = 5 * 128 * NWAVES;
constexpr int T_LATE2 = T_I_EG;
static_assert(T_LATE + T_LATE2 <= 3 * T_I_EG, "late items are expert matrices");
__device__ __forceinline__ TDesc tdesc_of(const Params& p, unsigned char* ws, int r) { TDesc d;
    if (r < T_I_IN) { d = TDesc{p.in[5], (bf16_t*)(ws + WS_W_IN), 1024, IN_W, r, 2}; return d; } r -= T_I_IN;
    if (r < T_I_GLU) { d = TDesc{p.in[14], (bf16_t*)(ws + WS_W_GLU), 512, 512, r, 0}; return d; } r -= T_I_GLU;
    if (r < T_I_PS) { d = TDesc{p.in[16], (bf16_t*)(ws + WS_W_PS), 512, 1024, r, 0}; return d; } r -= T_I_PS;
    if (r < T_I_PS) { d = TDesc{p.in[17], (bf16_t*)(ws + WS_W_PA), 512, 1024, r, 0}; return d; } r -= T_I_PS;
    if (r < T_I_OUT) { d = TDesc{p.in[18], (bf16_t*)(ws + WS_W_OUT), 1024, 1024, r, 0}; return d; } r -= T_I_OUT;
    if (r < T_I_SG) { d = TDesc{p.in[25], (bf16_t*)(ws + WS_W_SGU), 1024, 256, r, 3}; return d; } r -= T_I_SG;
    if (r < T_I_SG) { d = TDesc{p.in[26], (bf16_t*)(ws + WS_W_SGU), 1024, 256, r, 4}; return d; } r -= T_I_SG;
    if (r < T_I_SD) { d = TDesc{p.in[27], (bf16_t*)(ws + WS_W_SD), 256, 1024, r, 1}; return d; } r -= T_I_SD;
    if (r < T_I_EG) { const int e = r >> 6; d = TDesc{p.in[22] + (size_t)e * 262144, (bf16_t*)(ws + WS_W_EGU) + (size_t)e * 524288, 1024, 256, r & 63, 3}; return d; } r -= T_I_EG;
    if (r < T_I_EG) { const int e = r >> 6; d = TDesc{p.in[23] + (size_t)e * 262144, (bf16_t*)(ws + WS_W_EGU) + (size_t)e * 524288, 1024, 256, r & 63, 4}; return d; } r -= T_I_EG;
    { const int e = r >> 6; d = TDesc{p.in[24] + (size_t)e * 262144, (bf16_t*)(ws + WS_W_ED) + (size_t)e * 262144, 256, 1024, r & 63, 1}; return d; } }
__device__ __forceinline__ void run_transposes(const Params& p, unsigned char* ws, LAS unsigned char* lds, int r0, int r1, int widx, int nw) {
    const int lane = tidx() & 63, wave = __builtin_amdgcn_readfirstlane(tidx() >> 6);
    LAS float* scr = (LAS float*)(lds + wave * 16640);
    int r = r1 - 1 - widx;
    if (r < r0) return;
    TDesc d0 = tdesc_of(p, ws, r), d1 = d0, d2 = d0; f32x4 v0[16], v1[16], v2[16];
    t_load(d0, lane, v0);
    bool h1 = (r - nw >= r0);
    if (h1) { d1 = tdesc_of(p, ws, r - nw); t_load(d1, lane, v1); }
    for (;;) {
        const bool h2 = h1 && (r - 2 * nw >= r0);
        if (h2) { d2 = tdesc_of(p, ws, r - 2 * nw); t_load(d2, lane, v2); }
        t_store(d0, v0, scr, lane);
        if (!h1) break;
        d0 = d1; d1 = d2; r -= nw; h1 = h2;
#pragma unroll
        for (int i = 0; i < 16; ++i) { v0[i] = v1[i]; v1[i] = v2[i]; }
    }
}
__device__ __forceinline__ void p0_prep(const Params& p, LAS unsigned char* lds, int vcu, int G) {
    const int tid = tidx(), lane = tid & 63, wave = __builtin_amdgcn_readfirstlane(tid >> 6);
    unsigned char* ws = p.ws;
    for (int it = vcu; it < 256; it += G) s5_tables_item(p, lds, it);
    {
        LAS float* sc = (LAS float*)lds;
        LAS float* red = (LAS float*)(lds + 32768);
        const float* c = p.in[1]; const float* w = p.in[2]; const float* bb = p.in[3]; float* ada = (float*)(ws + WS_ADA);
        bool loaded = false;
        for (int it = vcu; it < 96; it += G) {
            if (!loaded) { for (int i = tid; i < 8192; i += NTHR) { const float v = c[i]; sc[i] = v * sigmoidf_(v); } loaded = true; }
            __syncthreads();
            const int kq = tid >> 6, col = it * 64 + lane; float a[8];
#pragma unroll
            for (int b = 0; b < 8; ++b) a[b] = 0.f;
#pragma unroll 16
            for (int k = kq * 128; k < kq * 128 + 128; ++k) { const float wv = w[(size_t)k * 6144 + col];
#pragma unroll
                for (int b = 0; b < 8; ++b) a[b] += sc[b * 1024 + k] * wv; }
#pragma unroll
            for (int b = 0; b < 8; ++b) red[(kq * 8 + b) * 64 + lane] = a[b];
            __syncthreads();
            { const int b = tid >> 6; float s = bb[col];
#pragma unroll
              for (int q = 0; q < 8; ++q) s += red[(q * 8 + b) * 64 + lane];
              ada[b * 6144 + col] = s; }
            __syncthreads();
        }
        __syncthreads();
    }
    run_transposes(p, ws, lds, 0, T_NITEMS - T_LATE2 - ((G == 256) ? T_LATE : 0), vcu * NWAVES + wave, G * NWAVES);
    { const int gt = vcu * NTHR + tid, NGT = G * NTHR;
      u32x4* z = (u32x4*)(ws + WS_W_IN + (size_t)PROJ_USED * 1024 * 2);
      for (int i = gt; i < (PROJ_W - PROJ_USED) * 1024 * 2 / 16; i += NGT) z[i] = (u32x4){0u, 0u, 0u, 0u};
      int* id = (int*)(ws + WS_IDENT); for (int i = gt; i < NTOK; i += NGT) id[i] = (i % CHTOK) * NSLOT + 8;
      if (gt < 256) ((float*)(ws + WS_ONES))[gt] = 1.0f;
      for (int u = gt; u < 32 * 4 * 64; u += NGT) { const int l = u & 63, nt = (u >> 6) & 3, ks = u >> 8; const int n = nt * 16 + (l & 15), q = l >> 4; float hi[8], lo[8];
#pragma unroll
          for (int j = 0; j < 8; ++j) { const float w = p.in[20][(size_t)(ks * 32 + q * 8 + j) * 64 + n]; const float h = bf2f((unsigned short)f2bf(w)); hi[j] = h; lo[j] = w - h; }
          u32x4 o; o.x = pk2(hi[0], hi[1]); o.y = pk2(hi[2], hi[3]); o.z = pk2(hi[4], hi[5]); o.w = pk2(hi[6], hi[7]);
          *(u32x4*)((bf16_t*)(ws + WS_WRF) + (size_t)u * 8) = o;
          o.x = pk2(lo[0], lo[1]); o.y = pk2(lo[2], lo[3]); o.z = pk2(lo[4], lo[5]); o.w = pk2(lo[6], lo[7]);
          *(u32x4*)((bf16_t*)(ws + WS_WRF) + (size_t)(32 * 4 * 64 + u) * 8) = o; } }
}

__device__ __forceinline__ void p1_modulate(const Params& p, int vcu, int G) {
    const int tid = tidx(), lane = tid & 63, wave = tid >> 6; const int gw = vcu * NWAVES + wave, NGW = G * NWAVES;
    const float* ada = (const float*)(p.ws + WS_ADA); const float* g1 = p.in[4]; bf16_t* U = (bf16_t*)(p.ws + WS_U);
    for (int m = gw; m < NTOK; m += NGW) {
        const f32x4* xr = (const f32x4*)(p.in[0] + (size_t)m * D) + lane; const int b = m >> 12;
        f32x4 v[4]; float s = 0.f;
#pragma unroll
        for (int j = 0; j < 4; ++j) { v[j] = xr[64 * j]; s += (v[j].x * v[j].x + v[j].y * v[j].y) + (v[j].z * v[j].z + v[j].w * v[j].w); }
        const float rstd = 1.0f / sqrtf(wave_sum(s) * (1.f / D) + EPS);
        unsigned long long* o8 = (unsigned long long*)(U + (size_t)m * D) + lane;
#pragma unroll
        for (int j = 0; j < 4; ++j) { const int c0 = 4 * lane + 256 * j;
            const f32x4 gg = *(const f32x4*)(g1 + c0), sh = *(const f32x4*)(ada + b * 6144 + c0), scl = *(const f32x4*)(ada + b * 6144 + 1024 + c0);
            const f32x4 y = v[j] * rstd * gg * (scl + 1.0f) + sh;
            o8[64 * j] = (unsigned long long)pk2(y.x, y.y) | ((unsigned long long)pk2(y.z, y.w) << 32); }
    }
}

__device__ __forceinline__ void p_combine(const Params& p, int vcu, int G, int ch) {
    const int tid = tidx(), lane = tid & 63, wave = tid >> 6; const int gw = vcu * NWAVES + wave, NGW = G * NWAVES;
    const float* ada = (const float*)(p.ws + WS_ADA); const float* gf = p.in[28];
    const unsigned char* Y = (const unsigned char*)(p.ws + WS_Y);
    u32x4 w[NSLOT];
    { const int mi0 = gw < CHTOK ? gw : 0; const unsigned char* yp = Y + (size_t)mi0 * NSLOT * D + lane * 16;
#pragma unroll
      for (int k = 0; k < NSLOT; ++k) w[k] = *(const u32x4*)(yp + (size_t)k * D); }
    for (int mi = gw; mi < CHTOK; mi += NGW) {
        const int m = ch * CHTOK + mi; const int b = m >> 12;
        float* orow = p.out + (size_t)m * D + lane * 16;
        f32x4 h[4], g2[4];
        { const u32x4* hp = (const u32x4*)((const bf16_t*)(p.out + (size_t)m * D) + lane * 16); const u32x4 h0 = hp[0], h1 = hp[1];
          h[0] = (f32x4){bflo(h0.x), bfhi(h0.x), bflo(h0.y), bfhi(h0.y)}; h[1] = (f32x4){bflo(h0.z), bfhi(h0.z), bflo(h0.w), bfhi(h0.w)};
          h[2] = (f32x4){bflo(h1.x), bfhi(h1.x), bflo(h1.y), bfhi(h1.y)}; h[3] = (f32x4){bflo(h1.z), bfhi(h1.z), bflo(h1.w), bfhi(h1.w)}; }
#pragma unroll
        for (int q = 0; q < 4; ++q) g2[q] = *(const f32x4*)(ada + b * 6144 + 5120 + lane * 16 + 4 * q);
        float a[16];
#pragma unroll
        for (int j = 0; j < 16; ++j) a[j] = 0.f;
#pragma unroll
        for (int k = 0; k < NSLOT; ++k)
#pragma unroll
            for (int q = 0; q < 4; ++q) { const f32x2 lo = __builtin_amdgcn_cvt_pk_f32_fp8((int)w[k][q], false), hi = __builtin_amdgcn_cvt_pk_f32_fp8((int)w[k][q], true);
                a[4 * q] += lo.x; a[4 * q + 1] += lo.y; a[4 * q + 2] += hi.x; a[4 * q + 3] += hi.y; }
        { const int mn = (mi + NGW < CHTOK) ? mi + NGW : mi; const unsigned char* yp = Y + (size_t)mn * NSLOT * D + lane * 16;
#pragma unroll
          for (int k = 0; k < NSLOT; ++k) w[k] = *(const u32x4*)(yp + (size_t)k * D); }
        float r[16]; float s = 0.f;
#pragma unroll
        for (int i = 0; i < 4; ++i)
#pragma unroll
            for (int j = 0; j < 4; ++j) { const float v = h[i][j] + g2[i][j] * (a[i * 4 + j] * (1.0f / Y_SCALE)); r[i * 4 + j] = v; s += v * v; }
        const float rstd = 1.0f / sqrtf(wave_sum(s) * (1.f / D) + EPS);
#pragma unroll
        for (int q = 0; q < 4; ++q) { const f32x4 g = *(const f32x4*)(gf + lane * 16 + 4 * q); f32x4 o;
#pragma unroll
            for (int j = 0; j < 4; ++j) o[j] = r[q * 4 + j] * rstd * g[j];
            *(f32x4*)(orow + 4 * q) = o; }
    }
}

__device__ __forceinline__ unsigned fkey(float x) { const unsigned u = __builtin_bit_cast(unsigned, x); return (u & 0x80000000u) ? ~u : (u | 0x80000000u); }

__device__ __forceinline__ void gold_s5(const Params& p, int item, int lane) {
    const int b = item >> 5, g = item & 31;
    const bf16_t* PROJ = (const bf16_t*)(p.ws + WS_PROJ); bf16_t* YG = (bf16_t*)(p.ws + WS_YG);
    const float dt = expf(p.in[8][g]); const float lr = p.in[6][g * 64 + lane], li = p.in[7][g * 64 + lane];
    const float mag = expf(lr * dt); const float a_re = mag * cosf(li * dt), a_im = mag * sinf(li * dt);
    const float den = lr * lr + li * li, n_re = a_re - 1.0f;
    const float f_re = (n_re * lr + a_im * li) / den, f_im = (a_im * lr - n_re * li) / den;
    float bbr[16], bbi[16], cr[16], ci[16];
#pragma unroll
    for (int h = 0; h < 16; ++h) { const float br = p.in[9][(g * 64 + lane) * 16 + h], bi = p.in[10][(g * 64 + lane) * 16 + h];
        bbr[h] = f_re * br - f_im * bi; bbi[h] = f_re * bi + f_im * br;
        cr[h] = p.in[11][(g * 16 + h) * 64 + lane]; ci[h] = p.in[12][(g * 16 + h) * 64 + lane]; }
    const float dsk = p.in[13][g * 16 + (lane & 15)];
    float hr = 0.f, hi = 0.f;
    for (int t = 0; t < SEQ; ++t) {
        const size_t row = (size_t)b * SEQ + t;
        const u32x4 w0 = *(const u32x4*)(PROJ + row * PROJ_W + C_USSM + g * 16), w1 = *(const u32x4*)(PROJ + row * PROJ_W + C_USSM + g * 16 + 8);
        float u[16]; { float f[8]; unpack8(w0, f);
#pragma unroll
            for (int j = 0; j < 8; ++j) u[j] = f[j];
            unpack8(w1, f);
#pragma unroll
            for (int j = 0; j < 8; ++j) u[8 + j] = f[j]; }
        float bur = 0.f, bui = 0.f;
#pragma unroll
        for (int h = 0; h < 16; ++h) { bur += bbr[h] * u[h]; bui += bbi[h] * u[h]; }
        const float nr = a_re * hr - a_im * hi + bur, ni = a_re * hi + a_im * hr + bui; hr = nr; hi = ni;
        float y = 0.f, um = 0.f;
#pragma unroll
        for (int h = 0; h < 16; ++h) { const float v = wave_sum(cr[h] * hr - ci[h] * hi); if ((lane & 15) == h) { y = v; um = u[h]; } }
        y += dsk * um;
        const float gl = 0.5f * y * (1.0f + tanhf(0.7978845608028654f * (y + 0.044715f * y * y * y)));
        if (lane < 16) YG[row * 512 + g * 16 + lane] = (bf16_t)f2bf(gl);
    }
}

__device__ __forceinline__ void gold_attn_pair(const Params& p, LAS unsigned char* lds, int pairid) {
    const int half = tidx() >> 8, tid = tidx() & 255;
    LAS unsigned char* base = lds + half * 32768;
    LAS float* qi = (LAS float*)base; LAS float* qv = qi + 512; LAS float* sc = qv + 512; LAS float* lg = sc + 4096;
    LAS float* wi = lg + 2048; LAS float* mx = wi + 8; LAS float* sm = mx + 8; LAS int* sel = (LAS int*)(sm + 8); LAS int* red = sel + 256; LAS int* cntp = red + 256;
    const int qid = pairid * 2 + half; const int b = qid >> 12, t = qid & 4095;
    const bf16_t* PROJ = (const bf16_t*)(p.ws + WS_PROJ); bf16_t* YA = (bf16_t*)(p.ws + WS_YATTN);
    const size_t qrow = (size_t)qid * PROJ_W;
    __syncthreads();
    for (int i = tid; i < 512; i += 256) { qi[i] = bf2f(PROJ[qrow + C_QI + i]); qv[i] = bf2f(PROJ[qrow + C_Q + i]); }
    if (tid < 8) wi[tid] = bf2f(PROJ[qrow + C_WI + tid]);
    if (tid == 0) cntp[0] = 0;
    __syncthreads();
    const int n = t + 1;
    for (int s = tid; s < n; s += 256) {
        const bf16_t* kp = PROJ + ((size_t)b * SEQ + s) * PROJ_W + C_KI; float kk[64];
#pragma unroll
        for (int c8 = 0; c8 < 8; ++c8) { float f[8]; unpack8(*(const u32x4*)(kp + c8 * 8), f);
#pragma unroll
            for (int j = 0; j < 8; ++j) kk[c8 * 8 + j] = f[j]; }
        float score = 0.f;
        for (int h = 0; h < 8; ++h) { float d = 0.f;
#pragma unroll
            for (int j = 0; j < 64; ++j) d += qi[h * 64 + j] * kk[j];
            score += wi[h] * fmaxf(d, 0.f); }
        sc[s] = score;
    }
    __syncthreads();
    const bool small = (t | 1) <= 255;
    if (small) { if (tid < n) sel[tid] = tid; if (tid == 0) cntp[0] = n; __syncthreads(); }
    else {
        unsigned thr = 0u;
        for (int bit = 31; bit >= 0; --bit) {
            const unsigned cand = thr | (1u << bit); int c = 0;
            for (int s = tid; s < n; s += 256) c += (fkey(sc[s]) >= cand) ? 1 : 0;
            red[tid] = c; __syncthreads();
            for (int o = 128; o > 0; o >>= 1) { if (tid < o) red[tid] += red[tid + o]; __syncthreads(); }
            if (red[0] >= 256) thr = cand;
            __syncthreads();
        }
        for (int s = tid; s < n; s += 256) if (fkey(sc[s]) > thr) { const int ps = atomicAdd((int*)cntp, 1); sel[ps] = s; }
        __syncthreads();
        if (tid == 0) { int c = cntp[0]; for (int s = 0; s < n && c < 256; ++s) if (fkey(sc[s]) == thr) sel[c++] = s; cntp[0] = c; }
        __syncthreads();
    }
    const int ns = cntp[0];
    { const int j = tid; const int s = (j < ns) ? sel[j] : 0;
      const bf16_t* kp = PROJ + ((size_t)b * SEQ + s) * PROJ_W + C_K; float kk[64];
#pragma unroll
      for (int c8 = 0; c8 < 8; ++c8) { float f[8]; unpack8(*(const u32x4*)(kp + c8 * 8), f);
#pragma unroll
          for (int jj = 0; jj < 8; ++jj) kk[c8 * 8 + jj] = f[jj]; }
      for (int h = 0; h < 8; ++h) { float d = 0.f;
#pragma unroll
          for (int jj = 0; jj < 64; ++jj) d += qv[h * 64 + jj] * kk[jj];
          const float slope = exp2f(-(float)(h + 1));
          lg[h * 256 + j] = (j < ns) ? d * 0.125f - slope * (float)(t - s) : -INFINITY; } }
    __syncthreads();
    if (tid < 8) { float m = -INFINITY; for (int j = 0; j < 256; ++j) m = fmaxf(m, lg[tid * 256 + j]); float sum = 0.f; for (int j = 0; j < 256; ++j) sum += __expf(lg[tid * 256 + j] - m); mx[tid] = m; sm[tid] = sum; }
    __syncthreads();
    for (int i = tid; i < 2048; i += 256) { const int h = i >> 8; lg[i] = __expf(lg[i] - mx[h]) / sm[h]; }
    __syncthreads();
    { const int h = tid >> 5, d0 = (tid & 31) * 2; float o0 = 0.f, o1 = 0.f;
      for (int j = 0; j < ns; ++j) { const unsigned w = *(const unsigned*)(PROJ + ((size_t)b * SEQ + sel[j]) * PROJ_W + C_V + d0); const float pj = lg[h * 256 + j]; o0 += pj * bflo(w); o1 += pj * bfhi(w); }
      *(unsigned*)(YA + (size_t)qid * 512 + h * 64 + d0) = pk2(o0, o1); }
}

typedef float f32x16 __attribute__((ext_vector_type(16)));
typedef _Float16 f16_t;
constexpr int AT_SC = 0;
constexpr int AT_V = 65536;
constexpr int AT_SEL = LDS_CNT;
static_assert(AT_V + 8 * 2 * 4096 <= STAGE_BYTES && AT_SEL + 8 * 1152 <= LDS_BYTES, "attention LDS map");

__device__ __forceinline__ float relu_i(float x) { const int xi = __builtin_bit_cast(int, x); return __builtin_bit_cast(float, xi > 0 ? xi : 0); }
__device__ __forceinline__ u32x2 tr_read16(unsigned addr) { u32x2 r; asm volatile("ds_read_b64_tr_b16 %0, %1" : "=v"(r) : "v"(addr) : "memory"); return r; }

__device__ __forceinline__ void attn_item(const Params& p, LAS unsigned char* lds, int b, int qblk) {
    const int tid = tidx(), lane = tid & 63, wave = __builtin_amdgcn_readfirstlane(tid >> 6);
    const int q0 = qblk * 8;
    const bf16_t* PROJ = (const bf16_t*)(p.ws + WS_PROJ); bf16_t* YA = (bf16_t*)(p.ws + WS_YATTN);
    const size_t tok0 = (size_t)b * SEQ + q0;
    LAS unsigned short* SC = (LAS unsigned short*)(lds + AT_SC);
    LAS unsigned short* SELq = (LAS unsigned short*)(lds + AT_SEL) + wave * 576;
    const int nkt = (q0 + 8 + 31) >> 5;
    const int nchmax = (q0 + 8 + 511) >> 9;
    __syncthreads();
    for (int i = nkt * 32 + lane; i < nchmax * 512; i += 64) SC[wave * 4096 + i] = 0xFC00u;
    __syncthreads();
#ifndef AT_REP_A
#define AT_REP_A 1
#endif
#ifndef AT_REP_B
#define AT_REP_B 1
#endif
#ifndef AT_REP_C
#define AT_REP_C 1
#endif
#ifndef AT_SKIP_A
    for (int ra_ = 0; ra_ < AT_REP_A; ++ra_) {
        const int hf = lane >> 5, l32 = lane & 31;
        const int rq = 2 * ((l32 >> 2) & 1) + ((l32 >> 4) & 1), rh = (l32 & 3) + 4 * ((l32 >> 3) & 1);
        bf16x8 Af[2][4]; float wgt[2][16];
#pragma unroll
        for (int qg = 0; qg < 2; ++qg) { const bf16_t* qp = PROJ + (tok0 + 4 * qg + rq) * PROJ_W + C_QI + rh * 64 + hf * 8;
#pragma unroll
            for (int s = 0; s < 4; ++s) Af[qg][s] = *(const bf16x8*)(qp + s * 16);
#pragma unroll
            for (int qq = 0; qq < 2; ++qq) { const u32x4 w = *(const u32x4*)(PROJ + (tok0 + 4 * qg + 2 * hf + qq) * PROJ_W + C_WI); float f[8]; unpack8(w, f);
#pragma unroll
                for (int h = 0; h < 8; ++h) wgt[qg][qq * 8 + h] = f[h]; } }
        const bf16x8* KIF = (const bf16x8*)(p.ws + WS_KIF) + (size_t)b * 128 * 4 * 64 + lane;
        bf16x8 B0[4], B1[4];
        { const int kt0 = wave < nkt ? wave : 0, kt1 = wave + 8 < nkt ? wave + 8 : kt0;
#pragma unroll
          for (int s = 0; s < 4; ++s) { B0[s] = KIF[(kt0 * 4 + s) * 64]; B1[s] = KIF[(kt1 * 4 + s) * 64]; } }
#define STEP_A_TILE(BF, KT) do { const int key = (KT) * 32 + l32; \
            _Pragma("unroll") for (int qg = 0; qg < 2; ++qg) { \
                f32x16 c; _Pragma("unroll") for (int j = 0; j < 16; ++j) c[j] = 0.f; \
                _Pragma("unroll") for (int s = 0; s < 4; ++s) c = __builtin_amdgcn_mfma_f32_32x32x16_bf16(Af[qg][s], BF[s], c, 0, 0, 0); \
                float sa = 0.f, sb = 0.f; \
                _Pragma("unroll") for (int h = 0; h < 8; ++h) { sa += wgt[qg][h] * relu_i(c[h]); sb += wgt[qg][8 + h] * relu_i(c[8 + h]); } \
                const int qa = 4 * qg + 2 * hf; \
                sa = fminf(fmaxf(sa * 0.0441941738f, -60000.f), 60000.f); sb = fminf(fmaxf(sb * 0.0441941738f, -60000.f), 60000.f); \
                if (key > q0 + qa) sa = -INFINITY; \
                if (key > q0 + qa + 1) sb = -INFINITY; \
                const f16_t ha = (f16_t)sa, hb = (f16_t)sb; \
                SC[qa * 4096 + key] = __builtin_bit_cast(unsigned short, ha); SC[(qa + 1) * 4096 + key] = __builtin_bit_cast(unsigned short, hb); } } while (0)
        for (int kt = wave; kt < nkt; kt += 16) {
            STEP_A_TILE(B0, kt);
            { const int ktn = (kt + 16 < nkt) ? kt + 16 : kt;
#pragma unroll
              for (int s = 0; s < 4; ++s) B0[s] = KIF[(ktn * 4 + s) * 64]; }
            if (kt + 8 < nkt) {
                STEP_A_TILE(B1, kt + 8);
                { const int ktn = (kt + 24 < nkt) ? kt + 24 : kt;
#pragma unroll
                  for (int s = 0; s < 4; ++s) B1[s] = KIF[(ktn * 4 + s) * 64]; } }
        }
#undef STEP_A_TILE
    }
#endif
    __syncthreads();
    const int t = q0 + wave, n = t + 1;
    int ns;
    for (int rb_ = 0; rb_ < AT_REP_B; ++rb_) {
#ifdef AT_SKIP_B
    if (true) {
#else
    if (n <= 256) {
#endif
#pragma unroll
        for (int i = 0; i < 4; ++i) { const int pos = lane + 64 * i; SELq[pos] = (unsigned short)(pos < n ? pos : 0); }
        ns = n;
    } else {
        const int nch = (n + 511) >> 9;
        unsigned XH[32], XL[32];
        LAS unsigned char* row = lds + AT_SC + wave * 8192;
#pragma unroll
        for (int i = 0; i < 8; ++i) {
            if (i < nch) { const u32x4 w = *(const LAS u32x4*)(row + i * 1024 + lane * 16);
#pragma unroll
                for (int e2 = 0; e2 < 4; ++e2) { const unsigned x = w[e2]; const unsigned sg = (x & 0x80008000u) >> 15; const unsigned k2 = x ^ ((sg * 0xffffu) | 0x80008000u);
                    XH[i * 4 + e2] = k2; XL[i * 4 + e2] = k2 << 16; } }
            else {
#pragma unroll
                for (int e2 = 0; e2 < 4; ++e2) { XH[i * 4 + e2] = 0u; XL[i * 4 + e2] = 0u; } }
        }
        LAS unsigned* H1 = (LAS unsigned*)(lds + 65536 + wave * 8192);
        LAS unsigned* H2 = (LAS unsigned*)((LAS unsigned char*)SELq + 640);
        LAS unsigned* H1p = H1 + (lane & 1) * 1024;
#pragma unroll
        for (int i = 0; i < 8; ++i) *(LAS u32x4*)(H1 + (i * 64 + lane) * 4) = (u32x4){0u, 0u, 0u, 0u};
        H2[lane] = 0u;
        LDS_WAIT(); __builtin_amdgcn_wave_barrier();
#pragma unroll
        for (int i = 0; i < 8; ++i) if (i < nch) {
#pragma unroll
            for (int e2 = 0; e2 < 4; ++e2) { const unsigned x = XH[i * 4 + e2];
                __hip_atomic_fetch_add(H1p + (x >> 22), 1u, __ATOMIC_RELAXED, __HIP_MEMORY_SCOPE_WORKGROUP);
                __hip_atomic_fetch_add(H1p + ((x >> 6) & 1023u), 1u, __ATOMIC_RELAXED, __HIP_MEMORY_SCOPE_WORKGROUP); } }
        LDS_WAIT(); __builtin_amdgcn_wave_barrier();
        unsigned B1, cabove; const unsigned dummy = 64u + (unsigned)lane;
        {
            unsigned hb[16];
#pragma unroll
            for (int i = 0; i < 4; ++i) { const u32x4 w = *(const LAS u32x4*)(H1 + lane * 16 + i * 4), w2 = *(const LAS u32x4*)(H1 + 1024 + lane * 16 + i * 4); hb[4 * i] = w.x + w2.x; hb[4 * i + 1] = w.y + w2.y; hb[4 * i + 2] = w.z + w2.z; hb[4 * i + 3] = w.w + w2.w; }
            unsigned sl_ = 0u;
#pragma unroll
            for (int i = 0; i < 16; ++i) sl_ += hb[i];
            unsigned suf = sl_;
#pragma unroll
            for (int o = 1; o < 64; o <<= 1) { const unsigned a_ = __shfl_down(suf, o); if (lane + o < 64) suf += a_; }
            const unsigned above = suf - sl_;
            const bool mine = above < 256u && suf >= 256u;
            unsigned bsel = 0u, cab = 0u;
            if (mine) { unsigned run = above; bool done = false;
#pragma unroll
                for (int i = 15; i >= 0; --i) { if (!done && run + hb[i] >= 256u) { bsel = (unsigned)(lane * 16 + i); cab = run; done = true; } run += hb[i]; } }
            const unsigned long long mk = __ballot(mine); const int src = (int)__builtin_ctzll(mk);
            B1 = (unsigned)__shfl((int)bsel, src); cabove = (unsigned)__shfl((int)cab, src);
        }
#pragma unroll
        for (int i = 0; i < 8; ++i) if (i < nch) {
#pragma unroll
            for (int e2 = 0; e2 < 4; ++e2) { const unsigned x = XH[i * 4 + e2];
                const unsigned ah = ((x >> 22) == B1) ? ((x >> 16) & 63u) : dummy, al = (((x >> 6) & 1023u) == B1) ? (x & 63u) : dummy;
                __hip_atomic_fetch_add(H2 + ah, 1u, __ATOMIC_RELAXED, __HIP_MEMORY_SCOPE_WORKGROUP);
                __hip_atomic_fetch_add(H2 + al, 1u, __ATOMIC_RELAXED, __HIP_MEMORY_SCOPE_WORKGROUP); } }
        LDS_WAIT(); __builtin_amdgcn_wave_barrier();
        unsigned thr;
        {   const unsigned h2 = H2[lane]; unsigned suf = h2;
#pragma unroll
            for (int o = 1; o < 64; o <<= 1) { const unsigned a_ = __shfl_down(suf, o); if (lane + o < 64) suf += a_; }
            const unsigned need = 256u - cabove;
            const bool mine = (suf - h2) < need && suf >= need;
            const unsigned long long mk = __ballot(mine); const unsigned B2 = (unsigned)__builtin_ctzll(mk);
            thr = (B1 << 6) | B2; }
        const unsigned c32 = thr << 16, c32h = c32 | 0xffffu;
#define TIE2(a, b) asm volatile("" : "+v"(a), "+v"(b))
        int cgt = 0, ceq = 0;
#pragma unroll
        for (int j = 0; j < 32; ++j) { unsigned xh = XH[j], xl = XL[j]; TIE2(xh, cgt); TIE2(xl, ceq);
            cgt += (xh > c32h) ? 1 : 0; cgt += (xl > c32) ? 1 : 0; ceq += ((xh >> 16) == thr) ? 1 : 0; ceq += (xl == c32) ? 1 : 0; }
        int sgt = cgt, seq = ceq;
#pragma unroll
        for (int o = 1; o < 64; o <<= 1) { const int a = __shfl_up(sgt, o), e = __shfl_up(seq, o); if (lane >= o) { sgt += a; seq += e; } }
        const int tot_gt = __shfl(sgt, 63);
        int o1 = sgt - cgt, o2 = tot_gt + seq - ceq;
        const int trash = 256 + lane;
#pragma unroll
        for (int i = 0; i < 8; ++i) if (i < nch) {
#pragma unroll
            for (int e2 = 0; e2 < 4; ++e2) { const int j = i * 4 + e2; const int idx = i * 512 + lane * 8 + 2 * e2;
                unsigned xl = XL[j], xh = XH[j]; TIE2(xl, o1); TIE2(xh, o2);
                { const bool gt = xl > c32, eq = xl == c32; const int a2 = (eq && o2 < 256) ? o2 : trash, a1 = gt ? o1 : a2; SELq[a1] = (unsigned short)idx; o1 += gt ? 1 : 0; o2 += eq ? 1 : 0; }
                TIE2(xh, o1);
                { const bool gt = xh > c32h, eq = (xh >> 16) == thr; const int a2 = (eq && o2 < 256) ? o2 : trash, a1 = gt ? o1 : a2; SELq[a1] = (unsigned short)(idx + 1); o1 += gt ? 1 : 0; o2 += eq ? 1 : 0; } } }
        ns = 256;
    }
    LDS_WAIT(); __builtin_amdgcn_wave_barrier(); }
    __syncthreads();
    {
        const int hd = lane & 15, qd = lane >> 4;
        const size_t tok = tok0 + wave;
        LAS unsigned char* vb = lds + wave * 16384;
        const unsigned vb_addr = (unsigned)(size_t)vb;
        const int vrow = lane >> 3, vch = lane & 7;
        const char* bbase = (const char*)(PROJ + (size_t)b * SEQ * PROJ_W);
        const unsigned voff0 = (unsigned)(C_V * 2 + vch * 16), koff0 = (unsigned)(C_K * 2 + qd * 16);
        unsigned roff[32];
#pragma unroll
        for (int j_ = 0; j_ < 32; ++j_) roff[j_] = (unsigned)SELq[(j_ >> 2) * 32 + vrow + 8 * (j_ & 3)] * (unsigned)(PROJ_W * 2);
#define V_DMA(sl) do { _Pragma("unroll") for (int i_ = 0; i_ < 4; ++i_) { \
            __builtin_amdgcn_global_load_lds((const unsigned*)(bbase + (roff[(sl) * 4 + i_] + voff0)), (LAS unsigned*)(vb + ((sl) & 3) * 4096 + i_ * 1024), 16, 0, 0); } } while (0)
        bf16x8 Qf[2];
#pragma unroll
        for (int ks = 0; ks < 2; ++ks) { if (hd < 8) Qf[ks] = *(const bf16x8*)(PROJ + tok * PROJ_W + C_Q + hd * 64 + ks * 32 + qd * 8); else Qf[ks] = (bf16x8){0, 0, 0, 0, 0, 0, 0, 0}; }
#define KSWZ(row) ((unsigned)(((row) & 3) | ((((row) >> 3) & 1) << 2)))
#define K_DMA(sl) do { _Pragma("unroll") for (int i_ = 0; i_ < 4; ++i_) { const int row_ = i_ * 8 + vrow; \
            __builtin_amdgcn_global_load_lds((const unsigned*)(bbase + (roff[(sl) * 4 + i_] + (unsigned)(C_K * 2) + (((unsigned)vch ^ KSWZ(row_)) * 16u))), (LAS unsigned*)(vb + ((sl) & 3) * 4096 + i_ * 1024), 16, 0, 0); } } while (0)
        (void)koff0;
        K_DMA(0); K_DMA(1); K_DMA(2); K_DMA(3);
        f32x4 S[16];
#pragma unroll
        for (int sl = 0; sl < 8; ++sl) {
            asm volatile("s_waitcnt vmcnt(12)" ::: "memory");
#pragma unroll
            for (int Th = 0; Th < 2; ++Th) { const int prow = (hd >> 2) * 8 + Th * 4 + (hd & 3); const unsigned fp = KSWZ(prow);
                const LAS unsigned char* ka = vb + (sl & 3) * 4096 + prow * 128;
                const bf16x8 K0 = *(const LAS bf16x8*)(ka + (((unsigned)qd ^ fp) * 16u)), K1 = *(const LAS bf16x8*)(ka + (((unsigned)(4 + qd) ^ fp) * 16u));
                f32x4 a = (f32x4){0.f, 0.f, 0.f, 0.f};
                a = __builtin_amdgcn_mfma_f32_16x16x32_bf16(K0, Qf[0], a, 0, 0, 0); a = __builtin_amdgcn_mfma_f32_16x16x32_bf16(K1, Qf[1], a, 0, 0, 0); S[2 * sl + Th] = a; }
            asm volatile("s_waitcnt lgkmcnt(0)" ::: "memory");
            if (sl + 4 < 8) K_DMA(sl + 4); else V_DMA(sl - 4);
        }
        const float slope = exp2f(-(float)((hd & 7) + 1)), abase = -slope * (float)t;
        float mx = -INFINITY;
#pragma unroll
        for (int sl = 0; sl < 8; ++sl) { const u32x4 w = *(const LAS u32x4*)((LAS unsigned char*)SELq + (sl * 32 + qd * 8) * 2);
#pragma unroll
            for (int e = 0; e < 8; ++e) { const int T = sl * 2 + (e >> 2), r = e & 3; const unsigned ww = w[e >> 1]; const float sf = (float)((e & 1) ? (ww >> 16) : (ww & 0xffffu));
                const float lgv = __builtin_fmaf(S[T][r], 0.125f, __builtin_fmaf(slope, sf, abase)); S[T][r] = lgv; } }
        if (ns < 256) {
#pragma unroll
            for (int sl = 0; sl < 8; ++sl)
#pragma unroll
                for (int e = 0; e < 8; ++e) { if (sl * 32 + qd * 8 + e >= ns) S[sl * 2 + (e >> 2)][e & 3] = -INFINITY; } }
#pragma unroll
        for (int T = 0; T < 16; ++T) { asm("v_max3_f32 %0, %0, %1, %2" : "+v"(mx) : "v"(S[T][0]), "v"(S[T][1])); asm("v_max3_f32 %0, %0, %1, %2" : "+v"(mx) : "v"(S[T][2]), "v"(S[T][3])); }
        mx = fmaxf(mx, __shfl_xor(mx, 16)); mx = fmaxf(mx, __shfl_xor(mx, 32));
        float sum = 0.f;
        const float mxl = mx * 1.44269504089f;
#pragma unroll
        for (int T = 0; T < 16; ++T)
#pragma unroll
            for (int r = 0; r < 4; ++r) { const float e = __builtin_amdgcn_exp2f(S[T][r] * 1.44269504089f - mxl); S[T][r] = e; sum += e; }
        sum += __shfl_xor(sum, 16); sum += __shfl_xor(sum, 32);
        u32x4 Pk[8];
#pragma unroll
        for (int sl = 0; sl < 8; ++sl) { Pk[sl].x = pk2(S[2 * sl][0], S[2 * sl][1]); Pk[sl].y = pk2(S[2 * sl][2], S[2 * sl][3]); Pk[sl].z = pk2(S[2 * sl + 1][0], S[2 * sl + 1][1]); Pk[sl].w = pk2(S[2 * sl + 1][2], S[2 * sl + 1][3]); }
        f32x4 O[4];
#pragma unroll
        for (int dt = 0; dt < 4; ++dt) O[dt] = (f32x4){0.f, 0.f, 0.f, 0.f};
#pragma unroll
        for (int sl = 0; sl < 8; ++sl) {
            if (sl <= 4) asm volatile("s_waitcnt vmcnt(12)" ::: "memory"); else if (sl == 5) asm volatile("s_waitcnt vmcnt(8)" ::: "memory"); else if (sl == 6) asm volatile("s_waitcnt vmcnt(4)" ::: "memory"); else asm volatile("s_waitcnt vmcnt(0)" ::: "memory");
            const unsigned a0 = vb_addr + (sl & 3) * 4096 + (8 * qd + (hd >> 2)) * 128 + (hd & 3) * 8;
            u32x2 tr[4][2];
            asm volatile("ds_read_b64_tr_b16 %0, %8\n\tds_read_b64_tr_b16 %1, %8 offset:512\n\tds_read_b64_tr_b16 %2, %8 offset:32\n\tds_read_b64_tr_b16 %3, %8 offset:544\n\t"
                         "ds_read_b64_tr_b16 %4, %8 offset:64\n\tds_read_b64_tr_b16 %5, %8 offset:576\n\tds_read_b64_tr_b16 %6, %8 offset:96\n\tds_read_b64_tr_b16 %7, %8 offset:608\n\ts_waitcnt lgkmcnt(0)"
                         : "=&v"(tr[0][0]), "=&v"(tr[0][1]), "=&v"(tr[1][0]), "=&v"(tr[1][1]), "=&v"(tr[2][0]), "=&v"(tr[2][1]), "=&v"(tr[3][0]), "=&v"(tr[3][1]) : "v"(a0) : "memory");
            if (sl + 4 < 8) V_DMA(sl + 4);
            const bf16x8 Pf = __builtin_bit_cast(bf16x8, Pk[sl]);
#pragma unroll
            for (int dt = 0; dt < 4; ++dt) { u32x4 vw; vw.x = tr[dt][0].x; vw.y = tr[dt][0].y; vw.z = tr[dt][1].x; vw.w = tr[dt][1].y;
                O[dt] = __builtin_amdgcn_mfma_f32_16x16x32_bf16(__builtin_bit_cast(bf16x8, vw), Pf, O[dt], 0, 0, 0); }
        }
#undef V_DMA
        const float inv = 1.0f / sum;
        if (hd < 8) {
#pragma unroll
            for (int dt = 0; dt < 4; ++dt) { u32x2 w; w.x = pk2(O[dt][0] * inv, O[dt][1] * inv); w.y = pk2(O[dt][2] * inv, O[dt][3] * inv);
                *(u32x2*)(YA + tok * 512 + hd * 64 + dt * 16 + qd * 4) = w; } }
    }
}

#define DPP_F(v, ctrl, rmask) __builtin_bit_cast(float, __builtin_amdgcn_update_dpp(__builtin_bit_cast(int, v), __builtin_bit_cast(int, v), ctrl, rmask, 0xf, false))
__device__ __forceinline__ float wave_max_dpp(float v) {
    asm volatile("s_nop 1\n\tv_max_f32_dpp %0, %0, %0 row_shr:1 row_mask:0xf bank_mask:0xf\n\ts_nop 1\n\tv_max_f32_dpp %0, %0, %0 row_shr:2 row_mask:0xf bank_mask:0xf\n\ts_nop 1\n\t"
                 "v_max_f32_dpp %0, %0, %0 row_shr:3 row_mask:0xf bank_mask:0xf\n\ts_nop 1\n\tv_max_f32_dpp %0, %0, %0 row_shr:4 row_mask:0xf bank_mask:0xf\n\ts_nop 1\n\t"
                 "v_max_f32_dpp %0, %0, %0 row_shr:8 row_mask:0xf bank_mask:0xf\n\ts_nop 1\n\tv_max_f32_dpp %0, %0, %0 row_bcast:15 row_mask:0xa bank_mask:0xf\n\ts_nop 1\n\t"
                 "v_max_f32_dpp %0, %0, %0 row_bcast:31 row_mask:0xc bank_mask:0xf\n\ts_nop 1" : "+v"(v));
    return __builtin_bit_cast(float, __builtin_amdgcn_readlane(__builtin_bit_cast(int, v), 63));
}
#define DPP_Z(v, ctrl, rmask, bmask) __builtin_bit_cast(float, __builtin_amdgcn_update_dpp(0, __builtin_bit_cast(int, v), ctrl, rmask, bmask, false))
__device__ __forceinline__ float wave_sum_dpp(float v0) {
    float v1 = v0 + DPP_Z(v0, 0x111, 0xf, 0xf); v1 += DPP_Z(v0, 0x112, 0xf, 0xf); v1 += DPP_Z(v0, 0x113, 0xf, 0xf);
    v1 += DPP_Z(v1, 0x114, 0xf, 0xe); v1 += DPP_Z(v1, 0x118, 0xf, 0xc);
    v1 += DPP_Z(v1, 0x142, 0xa, 0xf); v1 += DPP_Z(v1, 0x143, 0xc, 0xf);
    return __builtin_bit_cast(float, __builtin_amdgcn_readlane(__builtin_bit_cast(int, v1), 63));
}
constexpr int RT_LG = 0;
constexpr int RT_ENT = 32768;
constexpr int RT_HIST = RT_ENT + 8 * 128 * 12;
constexpr int RT_NV = 49152;
__device__ __forceinline__ void route_tile(const Params& p, LAS unsigned char* lds, int tile, int skip) {
    const int tid = tidx(), lane = tid & 63, wave = __builtin_amdgcn_readfirstlane(tid >> 6), hd = lane & 15, qd = lane >> 4;
    const float* ada = (const float*)(p.ws + WS_ADA); const float* g2 = p.in[19];
    bf16_t* U2 = (bf16_t*)(p.ws + WS_U);
    LAS int* hist = (LAS int*)(lds + RT_HIST);
    LAS float* LGT = (LAS float*)(lds + RT_LG);
    LAS int* ENT = (LAS int*)(lds + RT_ENT) + wave * 384;
    const int b = (tile * 128) >> 12;
    __syncthreads();
    if (tid < 64) hist[tid] = 0;
    if (tid == 64) hist[128] = 0;
    { LAS float* NV = (LAS float*)(lds + RT_NV);
      for (int i = tid; i < 256; i += NTHR) { const f32x4 g = *(const f32x4*)(g2 + 4 * i), sc = *(const f32x4*)(ada + b * 6144 + 4096 + 4 * i), sh = *(const f32x4*)(ada + b * 6144 + 3072 + 4 * i);
          *(LAS f32x4*)(NV + 4 * i) = g * (sc + 1.0f); *(LAS f32x4*)(NV + 1024 + 4 * i) = sh; } }
    __syncthreads();
    if (wave < 4) {
        const int tokw = tile * 128 + wave * 32;
        float rstd[2]; const bf16_t* hrow[2];
#pragma unroll
        for (int rt = 0; rt < 2; ++rt) { const int m = tokw + rt * 16 + hd; hrow[rt] = (const bf16_t*)(p.out + (size_t)m * D) + qd * 8;
            const f32x4 q4 = *(const f32x4*)((const float*)(p.ws + WS_SS) + (size_t)m * 16 + qd * 4); float ss = (q4.x + q4.y) + (q4.z + q4.w);
            ss += __shfl_xor(ss, 16); ss += __shfl_xor(ss, 32); rstd[rt] = 1.0f / sqrtf(ss * (1.f / D) + EPS); }
        const bf16x8* WH = (const bf16x8*)(p.ws + WS_WRF) + lane; const bf16x8* WL = WH + 32 * 4 * 64;
        f32x4 acc[2][4];
#pragma unroll
        for (int rt = 0; rt < 2; ++rt)
#pragma unroll
            for (int nt = 0; nt < 4; ++nt) acc[rt][nt] = (f32x4){0.f, 0.f, 0.f, 0.f};
        bf16x8 wh[4], wl[4], whn[4], wln[4]; u32x4 xa[2], xn[2], xnn[2];
#pragma unroll
        for (int nt = 0; nt < 4; ++nt) { wh[nt] = WH[nt * 64]; wl[nt] = WL[nt * 64]; }
#pragma unroll
        for (int rt = 0; rt < 2; ++rt) { xa[rt] = *(const u32x4*)(hrow[rt]); xn[rt] = *(const u32x4*)(hrow[rt] + 32); }
#pragma unroll 2
        for (int ks = 0; ks < 32; ++ks) {
            const int kn = (ks + 1 < 32) ? ks + 1 : ks;
#pragma unroll
            for (int nt = 0; nt < 4; ++nt) { whn[nt] = WH[(kn * 4 + nt) * 64]; wln[nt] = WL[(kn * 4 + nt) * 64]; }
#pragma unroll
            for (int rt = 0; rt < 2; ++rt) xnn[rt] = *(const u32x4*)(hrow[rt] + ((ks + 2 < 32) ? ks + 2 : ks) * 32);
            const int c0 = ks * 32 + qd * 8;
            const LAS float* NV = (const LAS float*)(lds + RT_NV);
            const f32x4 ma = *(const LAS f32x4*)(NV + c0), mb = *(const LAS f32x4*)(NV + c0 + 4), ha = *(const LAS f32x4*)(NV + 1024 + c0), hb = *(const LAS f32x4*)(NV + 1024 + c0 + 4);
#pragma unroll
            for (int rt = 0; rt < 2; ++rt) {
                const f32x4 x0 = {bflo(xa[rt].x), bfhi(xa[rt].x), bflo(xa[rt].y), bfhi(xa[rt].y)}, x1 = {bflo(xa[rt].z), bfhi(xa[rt].z), bflo(xa[rt].w), bfhi(xa[rt].w)};
                const f32x4 y0 = x0 * rstd[rt] * ma + ha, y1 = x1 * rstd[rt] * mb + hb;
                const u32x4 hi = pack8(y0, y1);
                f32x4 r0, r1; r0.x = y0.x - bflo(hi.x); r0.y = y0.y - bfhi(hi.x); r0.z = y0.z - bflo(hi.y); r0.w = y0.w - bfhi(hi.y);
                r1.x = y1.x - bflo(hi.z); r1.y = y1.y - bfhi(hi.z); r1.z = y1.z - bflo(hi.w); r1.w = y1.w - bfhi(hi.w);
                const bf16x8 uh = __builtin_bit_cast(bf16x8, hi), ul = __builtin_bit_cast(bf16x8, pack8(r0, r1));
#pragma unroll
                for (int nt = 0; nt < 4; ++nt) {
                    acc[rt][nt] = __builtin_amdgcn_mfma_f32_16x16x32_bf16(wh[nt], uh, acc[rt][nt], 0, 0, 0);
                    acc[rt][nt] = __builtin_amdgcn_mfma_f32_16x16x32_bf16(wl[nt], uh, acc[rt][nt], 0, 0, 0);
                    acc[rt][nt] = __builtin_amdgcn_mfma_f32_16x16x32_bf16(wh[nt], ul, acc[rt][nt], 0, 0, 0); } }
#pragma unroll
            for (int nt = 0; nt < 4; ++nt) { wh[nt] = whn[nt]; wl[nt] = wln[nt]; }
#pragma unroll
            for (int rt = 0; rt < 2; ++rt) { xa[rt] = xn[rt]; xn[rt] = xnn[rt]; }
        }
#pragma unroll
        for (int rt = 0; rt < 2; ++rt)
#pragma unroll
            for (int nt = 0; nt < 4; ++nt) *(LAS f32x4*)(LGT + (wave * 32 + rt * 16 + hd) * 64 + nt * 16 + qd * 4) = acc[rt][nt];
    }
    {
        LAS int* rowctr = hist + 128;
        LAS const float* NV = (LAS const float*)(lds + RT_NV);
        auto claim = [&]() -> int { int r = 0; if (lane == 0) r = __hip_atomic_fetch_add(rowctr, 1, __ATOMIC_RELAXED, __HIP_MEMORY_SCOPE_WORKGROUP); return __builtin_amdgcn_readfirstlane(r); };
        const float* SSp = (const float*)(p.ws + WS_SS);
#define RT_ROWLOAD(vv, sv, rr) do { if ((rr) < 128) { const int m_ = tile * 128 + (rr); const u32x4* xr_ = (const u32x4*)(p.out + (size_t)m_ * D) + lane; vv[0] = xr_[0]; vv[1] = xr_[64]; sv = SSp[(size_t)m_ * 16 + (lane & 15)]; } } while (0)
        int r = claim(), rn = claim(); u32x4 v[2] = {}, vn[2] = {}; float ssl = 0.f, ssn = 0.f;
        RT_ROWLOAD(v, ssl, r); RT_ROWLOAD(vn, ssn, rn);
        while (r < 128) {
            const int rnn = (rn < 128) ? claim() : 128; u32x4 vnn[2] = {vn[0], vn[1]}; float ssnn = 0.f;
            RT_ROWLOAD(vnn, ssnn, rnn);
            float ss = ssl; ss += __shfl_xor(ss, 1); ss += __shfl_xor(ss, 2); ss += __shfl_xor(ss, 4); ss += __shfl_xor(ss, 8);
            const float rstd = 1.0f / sqrtf(ss * (1.f / D) + EPS);
            u32x4* o16 = (u32x4*)(U2 + (size_t)(tile * 128 + r) * D) + lane;
#pragma unroll
            for (int j = 0; j < 2; ++j) { const int c0 = 8 * lane + 512 * j;
                const f32x4 ma = *(LAS const f32x4*)(NV + c0), mb = *(LAS const f32x4*)(NV + c0 + 4), sh = *(LAS const f32x4*)(NV + 1024 + c0), sb = *(LAS const f32x4*)(NV + 1024 + c0 + 4);
                const f32x4 x0 = {bflo(v[j].x), bfhi(v[j].x), bflo(v[j].y), bfhi(v[j].y)}, x1 = {bflo(v[j].z), bfhi(v[j].z), bflo(v[j].w), bfhi(v[j].w)};
                o16[64 * j] = pack8(x0 * rstd * ma + sh, x1 * rstd * mb + sb); }
            v[0] = vn[0]; v[1] = vn[1]; vn[0] = vnn[0]; vn[1] = vnn[1];
            ssl = ssn; ssn = ssnn; r = rn; rn = rnn;
        }
#undef RT_ROWLOAD
    }
    __syncthreads();
    const int tok0 = tile * 128 + wave * 16;
    LAS float* LG = LGT + wave * 1024;
    const float rbias = p.in[21][lane];
#pragma unroll 1
    for (int mi = 0; mi < 16; ++mi) {
        const float score = sigmoidf_(LG[mi * 64 + lane]); const float biased = score + rbias;
        float m1 = biased;
        m1 = fmaxf(m1, DPP_F(m1, 0xb1, 0xf)); m1 = fmaxf(m1, DPP_F(m1, 0x4e, 0xf)); m1 = fmaxf(m1, DPP_F(m1, 0x141, 0xf));
        const unsigned long long bal = __ballot(biased == m1); const int grp = lane >> 3;
        const unsigned gm = (unsigned)((bal >> (grp * 8)) & 0xffull); const int first = __ffs((int)gm) - 1;
        float v2 = ((lane & 7) == first) ? -INFINITY : biased;
        v2 = fmaxf(v2, DPP_F(v2, 0xb1, 0xf)); v2 = fmaxf(v2, DPP_F(v2, 0x4e, 0xf)); v2 = fmaxf(v2, DPP_F(v2, 0x141, 0xf));
        const float gscore = m1 + v2;
        int grank = 0;
#pragma unroll
        for (int og = 0; og < 8; ++og) { const float o = __builtin_bit_cast(float, __builtin_amdgcn_readlane(__builtin_bit_cast(int, gscore), og * 8)); grank += (o > gscore || (o == gscore && og < grp)) ? 1 : 0; }
        float mv = (grank < 4) ? biased : -INFINITY;
        unsigned long long chosen_m = 0ull;
#pragma unroll 1
        for (int it = 0; it < 8; ++it) { const float mxv = wave_max_dpp(mv); const unsigned long long e = __ballot(mv == mxv); const int w = (int)__builtin_ctzll(e); chosen_m |= 1ull << w; if (lane == w) mv = -INFINITY; }
        const bool chosen = (chosen_m >> lane) & 1ull;
        const int rank = (int)__builtin_amdgcn_mbcnt_hi((unsigned)(chosen_m >> 32), __builtin_amdgcn_mbcnt_lo((unsigned)chosen_m, 0u));
        const float gsum = wave_sum_dpp(chosen ? score : 0.f);
        if (chosen) { const int lpos = __hip_atomic_fetch_add(hist + lane, 1, __ATOMIC_RELAXED, __HIP_MEMORY_SCOPE_WORKGROUP);   const int e = mi * 8 + rank; ENT[e * 3] = lane; ENT[e * 3 + 1] = lpos; ENT[e * 3 + 2] = __builtin_bit_cast(int, score / gsum * 2.5f); }
    }
    __syncthreads();
    const int ch = (tile * 128) / CHTOK;
    if (skip) return;
    if (tid < 64) { const int c = hist[tid]; int base = 0; if (c > 0) base = (int)atomicAdd((unsigned*)(p.ws + WS_CTL) + CW_CNT + ch * NE + tid, (unsigned)c); hist[64 + tid] = base; }
    __syncthreads();
#pragma unroll
    for (int i = 0; i < 2; ++i) { const int e = lane + 64 * i; const int ex = ENT[e * 3], lpos = ENT[e * 3 + 1]; const float gate = __builtin_bit_cast(float, ENT[e * 3 + 2]);
        const int m = tok0 + (e >> 3), rk = e & 7, pair = ch * NE + ex, ps = hist[64 + ex] + lpos;
        ((int*)(p.ws + WS_DSTL))[(size_t)pair * PAIRCAP + ps] = (m - ch * CHTOK) * NSLOT + rk; ((float*)(p.ws + WS_GATEL))[(size_t)pair * PAIRCAP + ps] = gate; }
}

#define XB_TMO      128
#define XB_XCNT(j)  (256  + 64 * (j))
#define XB_XSUB(j)  (1280 + 64 * (j))
#define XB_XGEN(j)  (2304 + 64 * (j))
#define XB_TOP      3328
#define XB_TOPGEN   3392
#define XCD_BAR_WORDS 3456
#define XB_SPIN_CAP (1u << 22)
__device__ __forceinline__ unsigned xb_ld(unsigned* p)              { return __hip_atomic_load(p, __ATOMIC_RELAXED, __HIP_MEMORY_SCOPE_AGENT); }
__device__ __forceinline__ unsigned xb_add(unsigned* p, unsigned v) { return __hip_atomic_fetch_add(p, v, __ATOMIC_RELAXED, __HIP_MEMORY_SCOPE_AGENT); }
__device__ __forceinline__ unsigned xb_xcc_id() { return (unsigned)__builtin_amdgcn_s_getreg((3 << 11) | 20) & 0xFu; }
#define XB_SPIN(cond, bar) do { unsigned _sp = 0; while (cond) { __builtin_amdgcn_s_sleep(1); \
    if ((++_sp & 255u) == 0u) { if (xb_ld(&(bar)[XB_TMO])) break; if (_sp > XB_SPIN_CAP) { atomicAdd(&(bar)[XB_TMO], 1u); break; } } } } while (0)
struct XcdBarrier { unsigned* bar; unsigned x; volatile LAS unsigned* st; };
__device__ __forceinline__ XcdBarrier xcd_barrier_post(unsigned* bar, volatile LAS unsigned* st) {
    XcdBarrier b; b.bar = bar; b.x = xb_xcc_id(); b.st = st;
    if (tidx() == 0) (void)xb_add(&bar[XB_XCNT(b.x)], 1u);
    return b;
}
__device__ __forceinline__ void xcd_barrier_complete(unsigned* bar, unsigned x, unsigned& nloc, unsigned& nx) {
    const unsigned G = gridDim.x * gridDim.y * gridDim.z;
    unsigned sum, cnt, mine, sp = 0u;
    for (;;) {
        sum = 0u; cnt = 0u; mine = 0u;
#pragma unroll
        for (unsigned j = 0; j < 16; ++j) { const unsigned c = xb_ld(&bar[XB_XCNT(j)]); sum += c; cnt += (c > 0u) ? 1u : 0u; mine = (j == x) ? c : mine; }
        if (sum == G) break;
        __builtin_amdgcn_s_sleep(1);
        if ((++sp & 255u) == 0u) { if (xb_ld(&bar[XB_TMO])) break; if (sp > XB_SPIN_CAP) { atomicAdd(&bar[XB_TMO], 1u); break; } }
    }
    nloc = mine > 0u ? mine : 1u; nx = cnt > 0u ? cnt : 1u;
}
__device__ __forceinline__ void xcd_barrier(const XcdBarrier& b) {
    asm volatile("s_waitcnt vmcnt(0)" ::: "memory");
    __syncthreads();
    if (tidx() == 0) {
        unsigned* bar = b.bar;
        __builtin_amdgcn_s_waitcnt(0);
        unsigned nloc = b.st[0], nx = b.st[1];
        if (nloc == 0u) { xcd_barrier_complete(bar, b.x, nloc, nx); b.st[0] = nloc; b.st[1] = nx; }
        const unsigned old = xb_add(&bar[XB_XSUB(b.x)], 1u);
        const unsigned gen = old / nloc;
        if (old + 1u == (gen + 1u) * nloc) {
            __builtin_amdgcn_fence(__ATOMIC_RELEASE, "agent");
            asm volatile("s_waitcnt vmcnt(0)" ::: "memory");
            const unsigned og = xb_add(&bar[XB_TOP], 1u);
            const unsigned tg = og / nx;
            if (og + 1u == (tg + 1u) * nx) xb_add(&bar[XB_TOPGEN], 1u);
            else XB_SPIN(xb_ld(&bar[XB_TOPGEN]) == tg, bar);
            __builtin_amdgcn_fence(__ATOMIC_ACQUIRE, "agent");
            xb_add(&bar[XB_XGEN(b.x)], 1u);
            asm volatile("s_waitcnt vmcnt(0)" ::: "memory");
        } else {
            XB_SPIN(xb_ld(&bar[XB_XGEN(b.x)]) == gen, bar);
            __builtin_amdgcn_fence(__ATOMIC_ACQUIRE, "agent");
            asm volatile("s_waitcnt vmcnt(0)" ::: "memory");
        }
    }
    __syncthreads();
}

enum { PH_PREP = 0, PH_MOD, PH_INPROJ, PH_MIX  , PH_GLU, PH_MIXAB, PH_OUT, PH_ROUTE  , PH_MOE1, PH_MOE2_0, PH_COMB_0, PH_END };

#ifndef USE_CG_SYNC
#define USE_CG_SYNC 0
#endif
__global__ void __launch_bounds__(NTHR, 2) mega(Params p_arg) {
    extern __shared__ __attribute__((aligned(16))) unsigned char lds_raw[];
    LAS unsigned char* lds = (LAS unsigned char*)lds_raw;
    const int G = gridDim.x, bx = blockIdx.x;
    const int vcu = (G % 8 == 0) ? (bx % 8) * (G / 8) + bx / 8 : bx;
    const int tid = tidx(), lane = tid & 63, wave = __builtin_amdgcn_readfirstlane(tid >> 6);
    unsigned char* const ws_ = p_arg.ws; unsigned char* ws = ws_; (void)ws;
    if (tid < 32) ((LAS unsigned*)(lds + LDS_MISC))[tid] = 0u;
    __syncthreads();
#if USE_CG_SYNC
    cg::grid_group grid = cg::this_grid();
#define GRID_SYNC() grid.sync()
#else
    XcdBarrier xbar = xcd_barrier_post((unsigned*)(ws + WS_CTL) + CW_BAR, (volatile LAS unsigned*)(lds + LDS_MISC) + 8);
#define GRID_SYNC() xcd_barrier(xbar)
#endif
#ifndef ONLY_PH
#define ONLY_PH -1
#endif
#define IN(k) (ONLY_PH < 0 || ONLY_PH == (k))
#define SEAM(k) do { if ((k) + 1 < PH_END) GRID_SYNC(); } while (0)
#ifndef REP_PH
#define REP_PH -1
#endif
#ifndef REP_N
#define REP_N 3
#endif
#ifndef PROBE_NOSTORE
#define PROBE_NOSTORE 0
#endif
#define PHASE(k, ...) do { if (IN(k)) { { const int PROBE_SKIP = 0; unsigned zoff_ = 0u; asm volatile("" : "+s"(zoff_)); unsigned char* ws = ws_ + zoff_; const Params& p = *(const Params*)((const char*)&p_arg + zoff_); __VA_ARGS__ } if ((REP_PH) == (k)) { GRID_SYNC(); { const int PROBE_SKIP = PROBE_NOSTORE; unsigned zoff_ = 0u; asm volatile("" : "+s"(zoff_)); unsigned char* ws = ws_ + zoff_; const Params& p = *(const Params*)((const char*)&p_arg + zoff_); __VA_ARGS__ } GRID_SYNC(); { const int PROBE_SKIP = PROBE_NOSTORE; unsigned zoff_ = 0u; asm volatile("" : "+s"(zoff_)); unsigned char* ws = ws_ + zoff_; const Params& p = *(const Params*)((const char*)&p_arg + zoff_); __VA_ARGS__ } } } SEAM(k); } while (0)
    PHASE(PH_PREP, p0_prep(p, lds, vcu, G););
    PHASE(PH_MOD, p1_modulate(p, vcu, G););
    PHASE(PH_INPROJ, {
        pg8::DenseSched S; S.init(ws + WS_U, ws + WS_W_IN, NTOK, NIN, 1024, G, bx);
        EpiInProj E{(bf16_t*)(ws + WS_PROJ), (bf16_t*)(ws + WS_G), (bf16_t*)(ws + WS_KIF)};
        pg8::gemm_phase<EpiInProj, pg8::DenseSched, false>(lds, 1024, S, E);
        if (G == 256 && bx >= 128) { __syncthreads(); run_transposes(p, ws, lds, T_NITEMS - T_LATE2 - T_LATE, T_NITEMS - T_LATE2, (bx - 128) * NWAVES + wave, 128 * NWAVES); } });
    PHASE(PH_MIX, {
#ifdef GOLD_S5
        for (int it = vcu + G * wave; it < 256; it += G * NWAVES) gold_s5(p, it, lane);
#else
#ifndef REP_S5
#define REP_S5 1
#endif
#ifndef REP_ATTN
#define REP_ATTN 1
#endif
        for (int r_ = 0; r_ < REP_S5; ++r_) for (int it = vcu; it < 256; it += G) s5_item(p, lds, it);
#endif
#ifdef GOLD_ATTN
        for (int pr = vcu; pr < NTOK / 2; pr += G) gold_attn_pair(p, lds, pr);
#else
        for (int r_ = 0; r_ < REP_ATTN; ++r_) {
            for (int k = 0; ; ++k) { int ab, aq;
                if (G == 256) { if (k >= 16) break; ab = vcu >> 5; aq = 511 - ((vcu & 31) + 32 * k); }
                else { const int it = vcu + k * G; if (it >= NTOK / 8) break; ab = it & 7; aq = 511 - (it >> 3); }
                attn_item(p, lds, ab, aq); } }
#endif
        __syncthreads(); });
    PHASE(PH_GLU, {
        pg8::DenseSched S; S.init(ws + WS_YG, ws + WS_W_GLU, NTOK, 512, 512, G, bx);
        EpiGlu E{(const bf16_t*)(ws + WS_YG), p.in[15], (bf16_t*)(ws + WS_U)};
        pg8::gemm_phase<EpiGlu, pg8::DenseSched, false>(lds, 512, S, E); });
    PHASE(PH_MIXAB, {
        MixSched S; S.D0.init(ws + WS_U, ws + WS_W_PS, NTOK, 1024, 512, G, bx); S.D1.init(ws + WS_YATTN, ws + WS_W_PA, NTOK, 1024, 512, G, bx);
        EpiMix E{(const bf16_t*)(ws + WS_G), (bf16_t*)(ws + WS_MERGED)};
        pg8::gemm_phase<EpiMix, MixSched, false, false, true>(lds, 512, S, E); });
    PHASE(PH_OUT, {
        pg8::DenseSched S; S.init(ws + WS_MERGED, ws + WS_W_OUT, NTOK, 1024, 1024, G, bx);
        EpiOut E{p.in[0], (const float*)(ws + WS_ADA), p.out, (float*)(ws + WS_SS)};
        pg8::gemm_phase<EpiOut, pg8::DenseSched, false>(lds, 1024, S, E); });
    PHASE(PH_ROUTE, { for (int tile = vcu; tile < NTOK / 128; tile += G) route_tile(p, lds, tile, PROBE_SKIP); });
    PHASE(PH_MOE1, {
        build_moe_tables(lds, (const unsigned*)(ws + WS_CTL) + CW_CNT);
        Moe1Sched S{lds, G, vcu, (const char*)(ws + WS_U), (const int*)(ws + WS_DSTL), (const int*)(ws + WS_IDENT), (const char*)(ws + WS_W_EGU), (const char*)(ws + WS_W_SGU)};
        EpiMoe1 E{(bf16_t*)(ws + WS_H)};
        pg8::gemm_phase<EpiMoe1, Moe1Sched, true>(lds, 1024, S, E);
        { LAS int* TB_ = (LAS int*)(lds + LDS_TB); const int total = (RFL(TB_[256]) + 128) * 2, rem = total % G, nidle = rem ? G - rem : 0;
          __syncthreads();
          if (nidle == 0) run_transposes(p, ws, lds, T_NITEMS - T_LATE2, T_NITEMS, vcu * NWAVES + wave, G * NWAVES);
          else if (vcu >= rem) run_transposes(p, ws, lds, T_NITEMS - T_LATE2, T_NITEMS, (vcu - rem) * NWAVES + wave, nidle * NWAVES); } });
#pragma unroll
    for (int ch = 0; ch < NCHUNK; ++ch) {
        PHASE(PH_MOE2_0 + 2 * ch, {
            build_moe_tables(lds, (const unsigned*)(ws + WS_CTL) + CW_CNT);
            Moe2Sched S{lds, G, vcu, ch, ws};
            EpiMoe2 E{(unsigned char*)(ws + WS_Y), PROBE_SKIP, lds};
            pg8::gemm_phase<EpiMoe2, Moe2Sched, false, true>(lds, 256, S, E); });
        PHASE(PH_COMB_0 + 2 * ch, { p_combine(p, vcu, G, ch); });
    }
#undef IN
}

extern "C" void kernel_launch(void* const* d_in, const int* in_sizes, int n_in, void* d_out, int out_size, void* d_ws, size_t ws_size, hipStream_t stream) {
    static int grid = 0;
    if (grid == 0) {
        if (n_in != 29 || out_size != NTOK * D || ws_size < WS_NEED) { fprintf(stderr, "kernel_launch: unexpected shapes n_in %d out %d ws %zu\n", n_in, out_size, ws_size); grid = -1; return; }
        int dev = 0, cus = 0, per_cu = 0;
        hipGetDevice(&dev); hipDeviceGetAttribute(&cus, hipDeviceAttributeMultiprocessorCount, dev);
        hipFuncSetAttribute((const void*)mega, hipFuncAttributeMaxDynamicSharedMemorySize, LDS_BYTES);
        hipOccupancyMaxActiveBlocksPerMultiprocessor(&per_cu, (const void*)mega, NTHR, LDS_BYTES);
        (void)hipGetLastError();
        grid = (per_cu >= 1) ? cus : -1;
        if (grid < 0) { fprintf(stderr, "kernel_launch: occupancy query says %d blocks/CU\n", per_cu); return; }
    }
    if (grid < 0) return;
    hipMemsetAsync((char*)d_ws + WS_CTL, 0, CTL_BYTES, stream);
    Params p{};
    for (int i = 0; i < 29; ++i) p.in[i] = (const float*)d_in[i];
    p.out = (float*)d_out; p.ws = (unsigned char*)d_ws;
    p.ph_lo = 0; p.ph_hi = PH_END;
    void* args[] = {&p};
    hipError_t e = hipLaunchCooperativeKernel((const void*)mega, dim3(grid), dim3(NTHR), args, LDS_BYTES, stream);
    if (e != hipSuccess) fprintf(stderr, "kernel_launch: cooperative launch failed: %s (grid %d)\n", hipGetErrorString(e), grid);
}
```

```cpp
#include <hip/hip_runtime.h>
#include <hip/hip_cooperative_groups.h>
#include <cstdio>
#include <cstdint>
#include <cmath>
namespace cg = cooperative_groups;

#define GAS __attribute__((address_space(1)))
#define LAS __attribute__((address_space(3)))
typedef unsigned short bf16_t;
typedef short bf16x8 __attribute__((ext_vector_type(8)));
typedef float f32x4 __attribute__((ext_vector_type(4)));
typedef float f32x2 __attribute__((ext_vector_type(2)));
typedef unsigned u32x4 __attribute__((ext_vector_type(4)));
typedef unsigned u32x2 __attribute__((ext_vector_type(2)));

constexpr int NB = 8, SEQ = 4096, NTOK = NB * SEQ, D = 1024;
constexpr int IN_W = 3784, NIN = 3840, PROJ_W = 1792, G_W = 2048;
constexpr int C_USSM = 0, C_Q = 512, C_K = 1024, C_V = 1088, C_QI = 1152, C_KI = 1664, C_WI = 1728, PROJ_USED = 1736;
constexpr int NE = 64, TOPK = 8, NCHUNK = 1, CHTOK = NTOK / NCHUNK, NPAIR = NCHUNK * NE, PAIRCAP = CHTOK, NSLOT = 9;
constexpr float Y_SCALE = 64.0f;
constexpr int HROWS_ROUTED = NTOK * TOPK, HSH_ROW0 = HROWS_ROUTED + 256;
constexpr float EPS = 1e-6f;
constexpr int NWAVES = 8, NTHR = 512;

constexpr size_t MiB = 1u << 20;
constexpr size_t WS_CTL = 0, CTL_BYTES = 1 * MiB;
constexpr size_t WS_ADA = 1 * MiB;
constexpr size_t WS_ONES = 1 * MiB + 224 * 1024;
constexpr size_t WS_A32 = 1 * MiB + 256 * 1024;
constexpr size_t WS_IDENT = 1 * MiB + 512 * 1024;
constexpr size_t WS_WRF = 1 * MiB + 768 * 1024;
constexpr size_t WS_W_IN = 2 * MiB;
constexpr size_t WS_W_GLU = 10 * MiB;
constexpr size_t WS_W_PS = 11 * MiB;
constexpr size_t WS_W_PA = 12 * MiB;
constexpr size_t WS_W_OUT = 13 * MiB;
constexpr size_t WS_W_SGU = 15 * MiB;
constexpr size_t WS_W_SD = 16 * MiB;
constexpr size_t WS_TZF = 17 * MiB, WS_WINF = 18 * MiB, WS_WOUTF = 22 * MiB;
constexpr size_t WS_W_ED = 26 * MiB;
constexpr size_t WS_W_EGU = 58 * MiB;
constexpr size_t WS_KIF = 122 * MiB;
constexpr size_t WS_U = 128 * MiB;
constexpr size_t WS_PROJ = 192 * MiB;
constexpr size_t WS_G = 304 * MiB;
constexpr size_t WS_YG = 432 * MiB;
constexpr size_t WS_YATTN = 464 * MiB;
constexpr size_t WS_MERGED = 192 * MiB;
constexpr size_t WS_Y = 58 * MiB;
constexpr size_t WS_H = 346 * MiB;
constexpr size_t WS_DSTL = 492 * MiB;
constexpr size_t WS_SS = 4 * MiB;
constexpr size_t WS_GATEL = 500 * MiB;
constexpr size_t WS_NEED = 512 * MiB;
constexpr int CW_CNT = 0;
constexpr int CW_BAR = 4096;
constexpr int CW_Q0 = 1024;

constexpr int STAGE_BYTES = 131072;
constexpr int LDS_RO = STAGE_BYTES;
constexpr int LDS_MISC = LDS_RO + 2048;
constexpr int LDS_CNT = LDS_MISC + 128;
constexpr int LDS_RS = LDS_CNT + 1024;
constexpr int LDS_TB = LDS_RS + 1040;
constexpr int LDS_TD = LDS_TB + 1040;
constexpr int LDS_META = LDS_TD + 1408 * 4;
constexpr int LDS_BYTES = 147456;
static_assert(LDS_META + 4096 <= LDS_BYTES, "LDS map");

__device__ __forceinline__ unsigned f2bf(float f) { unsigned u = __builtin_bit_cast(unsigned, f); return (u + 0x7fffu + ((u >> 16) & 1u)) >> 16; }
typedef __bf16 bf16x2_t __attribute__((ext_vector_type(2)));
__device__ __forceinline__ unsigned pk2(float lo, float hi) { const f32x2 v = {lo, hi}; const bf16x2_t r = __builtin_convertvector(v, bf16x2_t); return __builtin_bit_cast(unsigned, r); }
__device__ __forceinline__ float bf2f(unsigned short b) { return __builtin_bit_cast(float, (unsigned)b << 16); }
__device__ __forceinline__ float bflo(unsigned w) { return __builtin_bit_cast(float, w << 16); }
__device__ __forceinline__ float bfhi(unsigned w) { return __builtin_bit_cast(float, w & 0xffff0000u); }
__device__ __forceinline__ float sigmoidf_(float x) { return __builtin_amdgcn_rcpf(1.0f + __builtin_amdgcn_exp2f(-1.44269504089f * x)); }
__device__ __forceinline__ float wave_sum(float v) {
#pragma unroll
    for (int o = 1; o < 64; o <<= 1) v += __shfl_xor(v, o);
    return v;
}
__device__ __forceinline__ int tidx() { int t = threadIdx.x; asm volatile("" : "+v"(t)); return t; }
#define LDS_WAIT() asm volatile("s_waitcnt lgkmcnt(0)" ::: "memory")

namespace pg8 {
constexpr int BM = 256, BK = 64, HALF = 128, HTB = HALF * BK * 2, NXCD = 8, WGM = 8;
__host__ __device__ __forceinline__ int lds_byte(int r, int c) { const int st = (r >> 4) * 2 + (c >> 5), rr = r & 15, cc = c & 31, ob = rr * 64 + cc * 2; return st * 1024 + (ob ^ (((ob >> 9) & 1) << 5)); }
__host__ __device__ __forceinline__ void stage_rc(int b, int& R, int& C) { const int st = b / 1024, sb = b % 1024, swz = sb ^ (((sb >> 9) & 1) << 5); R = (st >> 1) * 16 + swz / 64; C = (st & 1) * 32 + (swz % 64) / 2; }
__host__ __device__ __forceinline__ int perm32(int rho) { const int n = rho >> 4, i = rho & 15; return 8 * (i >> 2) + 4 * n + (i & 3); }

struct Unit { int pm, pn; const char* A; const char* B; const int* rows; int valid; int x0; int rbase; const float* gp; };

struct DenseSched {
    int nM, nN, nwg, G, c; const char* A; const char* B; size_t tstep;
    __device__ __forceinline__ void init(const void* A_, const void* B_, int M, int N, int K, int G_, int c_) { nM = M / BM; nN = N / BM; nwg = nM * nN; G = G_; c = c_; A = (const char*)A_; B = (const char*)B_; tstep = (size_t)BM * K * 2; }
    __device__ __forceinline__ bool next(int i, Unit& u) const {
        const long L = (long)i * G + c; if (L >= nwg) return false;
        int wgid = (int)L; { const int q = nwg / NXCD, r = nwg % NXCD, xcd = wgid % NXCD, off = wgid / NXCD; wgid = (xcd < r ? xcd * (q + 1) : r * (q + 1) + (xcd - r) * q) + off; }
        const int nig = WGM * nN, gid = wgid / nig, fm = gid * WGM, gsz = (nM - fm) < WGM ? (nM - fm) : WGM;
        u.pm = fm + ((wgid % nig) % gsz); u.pn = (wgid % nig) / gsz;
        u.A = A + (size_t)u.pm * tstep; u.B = B + (size_t)u.pn * tstep; u.rows = nullptr; u.valid = 256; u.x0 = 0; u.rbase = 0; u.gp = nullptr; return true;
    }
};

template <class Epi, class Sched, bool GATHER, bool RMETA = false, bool KEEPACC = false>
__device__ __forceinline__ void gemm_phase(LAS unsigned char* lds, const int K, const Sched& S, const Epi& E) {
    int tid_ = tidx(); asm volatile("" : "+v"(tid_));
    const int tid = tid_, wid = __builtin_amdgcn_readfirstlane(tid >> 6), lane = tid & 63, wr = wid >> 2, wc = wid & 3, fr = lane & 15, fq = lane >> 4;
    const int nt = K / BK;
    unsigned voffA[2], voffB[2]; int roA[2];
#pragma unroll
    for (int i = 0; i < 2; ++i) { int R, C; stage_rc(tid * 16 + i * 8192, R, C); const int Rb = (R & ~31) + perm32(R & 31);
        voffA[i] = GATHER ? (unsigned)(C * 2) : (unsigned)(R * K + C) * 2u; voffB[i] = (unsigned)(Rb * K + C) * 2u; roA[i] = R * 4; }
    const size_t kstep = (size_t)(BK * 2);
    const size_t hstep = (size_t)HALF * K * 2;
    const unsigned ldsw = (unsigned)wid * 1024u;
    const int aoff = lds_byte(wr * 64 + fr, fq * 8), boff = lds_byte(wc * 32 + fr, fq * 8);
    LAS unsigned char* ro = lds + LDS_RO;
#define PG8_SA(b, h) (((b) * 2 + (h)) * HTB)
#define PG8_SB(b, h) ((4 + (b) * 2 + (h)) * HTB)
#define PG8_STAGE_B(bufoff, gbase) do { _Pragma("unroll") for (int _i = 0; _i < 2; ++_i) \
        __builtin_amdgcn_global_load_lds((const unsigned*)((const char*)(gbase) + voffB[_i]), (LAS unsigned*)(lds + (bufoff) + ldsw + _i * 8192), 16, 0, 0); } while (0)
#define PG8_STAGE_A(bufoff, gbase, h, slot) do { _Pragma("unroll") for (int _i = 0; _i < 2; ++_i) { \
        unsigned _vo = voffA[_i]; const char* _gb = (const char*)(gbase); \
        if (GATHER) _vo += *(const LAS unsigned*)(ro + (slot) * 1024 + (h) * 512 + roA[_i]); else _gb += (h) * hstep; \
        __builtin_amdgcn_global_load_lds((const unsigned*)(_gb + _vo), (LAS unsigned*)(lds + (bufoff) + ldsw + _i * 8192), 16, 0, 0); } } while (0)
#define PG8_LDA(dst, b, h) do { _Pragma("unroll") for (int m = 0; m < 4; ++m) _Pragma("unroll") for (int k = 0; k < 2; ++k) dst[m][k] = *(const LAS bf16x8*)(lds + PG8_SA(b, h) + aoff + m * 2048 + k * 1024); } while (0)
#define PG8_LDB(dst, b, h) do { _Pragma("unroll") for (int n = 0; n < 2; ++n) _Pragma("unroll") for (int k = 0; k < 2; ++k) dst[n][k] = *(const LAS bf16x8*)(lds + PG8_SB(b, h) + boff + n * 2048 + k * 1024); } while (0)
#define PG8_MMA(ai, bj, At, Bt) do { __builtin_amdgcn_s_setprio(1); _Pragma("unroll") for (int m = 0; m < 4; ++m) _Pragma("unroll") for (int n = 0; n < 2; ++n) _Pragma("unroll") for (int k = 0; k < 2; ++k) \
        acc[ai][bj][m][n] = __builtin_amdgcn_mfma_f32_16x16x32_bf16(Bt[n][k], At[m][k], acc[ai][bj][m][n], 0, 0, 0); __builtin_amdgcn_s_setprio(0); } while (0)
#define PG8_WAIT_V(n) asm volatile("s_waitcnt vmcnt(" #n ")" ::: "memory")
#define PG8_WAIT_L(n) asm volatile("s_waitcnt lgkmcnt(" #n ")" ::: "memory")
#define PG8_BAR __builtin_amdgcn_s_barrier()
#define PG8_SCHED __builtin_amdgcn_sched_barrier(0)
    Unit cur, nxt; int ui = 0;
    if (!S.next(0, cur)) return;
    f32x4 acc[2][2][4][2];
#pragma unroll
    for (int a = 0; a < 2; ++a)
#pragma unroll
        for (int b = 0; b < 2; ++b)
#pragma unroll
            for (int m = 0; m < 4; ++m)
#pragma unroll
                for (int n = 0; n < 2; ++n) acc[a][b][m][n] = (f32x4){0.f, 0.f, 0.f, 0.f};
    bf16x8 At[4][2], B0[2][2], B1[2][2];
    const char* cA = cur.A; const char* cB = cur.B;
    if (GATHER) {
        if (tid < 256) { const int r = tid < cur.valid ? cur.rbase + cur.rows[tid] / NSLOT : 0; *(LAS unsigned*)(ro + tid * 4) = (unsigned)r * (unsigned)(K * 2); }
        __syncthreads();
    }
    PG8_STAGE_B(PG8_SB(0, 0), cB); PG8_STAGE_B(PG8_SB(0, 1), cB + hstep); PG8_STAGE_A(PG8_SA(0, 0), cA, 0, 0); PG8_STAGE_A(PG8_SA(0, 1), cA, 1, 0);
    if (wr == 1) PG8_BAR;
    PG8_WAIT_V(2); PG8_BAR;
    PG8_STAGE_B(PG8_SB(1, 0), cB + kstep); PG8_STAGE_A(PG8_SA(1, 0), cA + kstep, 0, 0); PG8_STAGE_B(PG8_SB(1, 1), cB + hstep + kstep);
    PG8_WAIT_V(6); PG8_BAR;
    for (;;) {
        const bool has_next = S.next(ui + 1, nxt);
        const int cslot = ui & 1, nslot = has_next ? (cslot ^ 1) : cslot;
        int pre_r = 0;
        if (GATHER) { if (has_next && tid < 256 && tid < nxt.valid) pre_r = nxt.rows[tid]; }
        if (RMETA) { if (wid < 4) {
            __builtin_amdgcn_global_load_lds((const unsigned*)(cur.gp + lane + wid * 64), (LAS unsigned*)(lds + LDS_META + cslot * 1024 + wid * 256), 4, 0, 0);
            __builtin_amdgcn_global_load_lds((const unsigned*)(cur.rows + lane + wid * 64), (LAS unsigned*)(lds + LDS_META + 2048 + cslot * 1024 + wid * 256), 4, 0, 0); } }
        const char* nA = has_next ? nxt.A : cA; const char* nB = has_next ? nxt.B : cB;
#pragma unroll 1
        for (int t = 0; t < nt; t += 2) {
            const bool last = (t == nt - 2);
            const char* a1 = cA + (size_t)(t + 1) * kstep;
            const char* a2 = last ? nA : cA + (size_t)(t + 2) * kstep; const char* b2 = last ? nB : cB + (size_t)(t + 2) * kstep;
            const char* a3 = a2 + kstep; const char* b3 = b2 + kstep;
            const int slot2 = last ? nslot : cslot;
            if (t == 2 || nt == 2) {
                if (GATHER) { if (has_next && tid < 256) { const int r = tid < nxt.valid ? nxt.rbase + pre_r / NSLOT : 0; *(LAS unsigned*)(ro + nslot * 1024 + tid * 4) = (unsigned)r * (unsigned)(K * 2); } }
            }
            PG8_LDB(B0, 0, 0); PG8_LDB(B1, 0, 1); PG8_SCHED; PG8_LDA(At, 0, 0); PG8_STAGE_A(PG8_SA(1, 1), a1, 1, cslot);
            PG8_WAIT_V(8); PG8_WAIT_L(0); PG8_BAR; PG8_MMA(0, 0, At, B0); PG8_MMA(0, 1, At, B1); PG8_BAR; PG8_SCHED;
            PG8_LDA(At, 0, 1); PG8_STAGE_B(PG8_SB(0, 0), b2); PG8_STAGE_B(PG8_SB(0, 1), b2 + hstep); PG8_STAGE_A(PG8_SA(0, 0), a2, 0, slot2);
            PG8_WAIT_V(8); PG8_WAIT_L(0); PG8_BAR; PG8_MMA(1, 0, At, B0); PG8_MMA(1, 1, At, B1); PG8_BAR; PG8_SCHED;
            PG8_LDB(B0, 1, 0); PG8_LDB(B1, 1, 1); PG8_SCHED; PG8_LDA(At, 1, 0); PG8_STAGE_A(PG8_SA(0, 1), a2, 1, slot2);
            PG8_WAIT_V(8); PG8_WAIT_L(0); PG8_BAR; PG8_MMA(0, 0, At, B0); PG8_MMA(0, 1, At, B1); PG8_BAR; PG8_SCHED;
            PG8_LDA(At, 1, 1); PG8_STAGE_B(PG8_SB(1, 0), b3); PG8_STAGE_B(PG8_SB(1, 1), b3 + hstep); PG8_STAGE_A(PG8_SA(1, 0), a3, 0, slot2);
            PG8_WAIT_V(8); PG8_WAIT_L(0); PG8_BAR; PG8_MMA(1, 0, At, B0); PG8_MMA(1, 1, At, B1); PG8_BAR; PG8_SCHED;
        }
        if (wr == 0) PG8_BAR;
        E(acc, cur, wr, wc, fr, fq, lds + LDS_META + (ui & 1) * 1024);
        if (!has_next) break;
        if (!KEEPACC || nxt.x0 == 0) {
#pragma unroll
        for (int a = 0; a < 2; ++a)
#pragma unroll
            for (int b = 0; b < 2; ++b)
#pragma unroll
                for (int m = 0; m < 4; ++m)
#pragma unroll
                    for (int n = 0; n < 2; ++n) acc[a][b][m][n] = (f32x4){0.f, 0.f, 0.f, 0.f};
        }
        cur = nxt; cA = nA; cB = nB; ++ui;
        if (wr == 1) PG8_BAR;
    }
    PG8_WAIT_V(0);
    PG8_BAR;
#undef PG8_SA
#undef PG8_SB
#undef PG8_STAGE_A
#undef PG8_STAGE_B
#undef PG8_LDA
#undef PG8_LDB
#undef PG8_MMA
#undef PG8_WAIT_V
#undef PG8_WAIT_L
#undef PG8_BAR
#undef PG8_SCHED
}
}
using pg8::Unit;

#define EPI_LOOP_BEGIN \
    _Pragma("unroll") for (int ai = 0; ai < 2; ++ai) _Pragma("unroll") for (int m = 0; m < 4; ++m) { const int rl = ai * 128 + wr * 64 + m * 16 + fr; const int row = u.pm * 256 + rl; \
    _Pragma("unroll") for (int bj = 0; bj < 2; ++bj) { const int col = u.pn * 256 + bj * 128 + wc * 32 + 8 * fq; const f32x4 v0 = acc[ai][bj][m][0], v1 = acc[ai][bj][m][1]; (void)row; (void)col; (void)rl;
#define EPI_LOOP_END } if (m == 3) asm volatile("" ::: "memory"); }
__device__ __forceinline__ u32x4 pack8(const f32x4 a, const f32x4 b) { u32x4 w; w.x = pk2(a[0], a[1]); w.y = pk2(a[2], a[3]); w.z = pk2(b[0], b[1]); w.w = pk2(b[2], b[3]); return w; }
__device__ __forceinline__ void unpack8(const u32x4 w, float (&f)[8]) { f[0] = bflo(w.x); f[1] = bfhi(w.x); f[2] = bflo(w.y); f[3] = bfhi(w.y); f[4] = bflo(w.z); f[5] = bfhi(w.z); f[6] = bflo(w.w); f[7] = bfhi(w.w); }

struct EpiInProj {
    bf16_t* PROJ; bf16_t* G; bf16_t* KIF;
    __device__ __forceinline__ void operator()(const f32x4 (&acc)[2][2][4][2], const Unit& u, int wr, int wc, int fr, int fq, LAS unsigned char* meta) const {
        EPI_LOOP_BEGIN
            if (u.pn < 7) { const u32x4 w8 = pack8(v0, v1); *(u32x4*)(PROJ + (size_t)row * PROJ_W + col) = w8;
                if (u.pn == 6 && col >= C_KI && col < C_KI + 64) { const int d0 = col - C_KI, key = row & 4095, bb = row >> 12;
                    *(u32x4*)(KIF + ((size_t)((bb * 128 + (key >> 5)) * 4 + (d0 >> 4)) * 64 + (key & 31) + 32 * ((d0 >> 3) & 1)) * 8) = w8; } }
            else { f32x4 s0, s1;
#pragma unroll
                for (int j = 0; j < 4; ++j) { s0[j] = sigmoidf_(v0[j]); s1[j] = sigmoidf_(v1[j]); }
                *(u32x4*)(G + (size_t)row * G_W + (col - PROJ_W)) = pack8(s0, s1); }
        EPI_LOOP_END
    }
};
struct EpiGlu {
    const bf16_t* YG; const float* bias; bf16_t* O;
    __device__ __forceinline__ void operator()(const f32x4 (&acc)[2][2][4][2], const Unit& u, int wr, int wc, int fr, int fq, LAS unsigned char* meta) const {
        f32x4 bb[2][2];
#pragma unroll
        for (int bj = 0; bj < 2; ++bj) { const int col = u.pn * 256 + bj * 128 + wc * 32 + 8 * fq; bb[bj][0] = *(const f32x4*)(bias + col); bb[bj][1] = *(const f32x4*)(bias + col + 4); }
        EPI_LOOP_BEGIN
            float y[8]; unpack8(*(const u32x4*)(YG + (size_t)row * 512 + col), y);
            const f32x4 b0 = bb[bj][0], b1 = bb[bj][1]; f32x4 o0, o1;
#pragma unroll
            for (int j = 0; j < 4; ++j) { o0[j] = y[j] * sigmoidf_(v0[j] + b0[j]); o1[j] = y[4 + j] * sigmoidf_(v1[j] + b1[j]); }
            *(u32x4*)(O + (size_t)row * 512 + col) = pack8(o0, o1);
        EPI_LOOP_END
    }
};
struct EpiMix {
    const bf16_t* G; bf16_t* O;
    __device__ __forceinline__ void operator()(f32x4 (&acc)[2][2][4][2], const Unit& u, int wr, int wc, int fr, int fq, LAS unsigned char* meta) const {
        const size_t gbase = (size_t)(u.pm * 256 + wr * 64 + fr) * G_W + u.pn * 256 + wc * 32 + 8 * fq;
        if (u.x0 == 0) {
#pragma unroll
            for (int ai = 0; ai < 2; ++ai) {
                u32x4 q1[4][2], q2[4][2];
#pragma unroll
                for (int m = 0; m < 4; ++m)
#pragma unroll
                    for (int bj = 0; bj < 2; ++bj) { const size_t o_ = gbase + (size_t)(ai * 128 + m * 16) * G_W + bj * 128; q1[m][bj] = *(const u32x4*)(G + o_); q2[m][bj] = *(const u32x4*)(G + o_ + 1024); }
#pragma unroll
                for (int m = 0; m < 4; ++m)
#pragma unroll
                    for (int bj = 0; bj < 2; ++bj) { float g1[8], g2[8]; unpack8(q1[m][bj], g1); unpack8(q2[m][bj], g2);
#pragma unroll
                        for (int j = 0; j < 4; ++j) { acc[ai][bj][m][0][j] *= g1[j] * __builtin_amdgcn_rcpf(fmaxf(g2[j], 1e-6f)); acc[ai][bj][m][1][j] *= g1[4 + j] * __builtin_amdgcn_rcpf(fmaxf(g2[4 + j], 1e-6f)); } }
                asm volatile("" ::: "memory"); }
        } else {
            u32x4 q2[2][4][2];
#pragma unroll
            for (int ai = 0; ai < 2; ++ai)
#pragma unroll
                for (int m = 0; m < 4; ++m)
#pragma unroll
                    for (int bj = 0; bj < 2; ++bj) q2[ai][m][bj] = *(const u32x4*)(G + gbase + (size_t)(ai * 128 + m * 16) * G_W + bj * 128 + 1024);
#pragma unroll
            for (int ai = 0; ai < 2; ++ai)
#pragma unroll
                for (int m = 0; m < 4; ++m)
#pragma unroll
                    for (int bj = 0; bj < 2; ++bj) { float g2[8]; unpack8(q2[ai][m][bj], g2); f32x4 o0, o1;
#pragma unroll
                        for (int j = 0; j < 4; ++j) { o0[j] = acc[ai][bj][m][0][j] * fmaxf(g2[j], 1e-6f); o1[j] = acc[ai][bj][m][1][j] * fmaxf(g2[4 + j], 1e-6f); }
                        *(u32x4*)(O + (size_t)(u.pm * 256 + ai * 128 + wr * 64 + m * 16 + fr) * D + u.pn * 256 + bj * 128 + wc * 32 + 8 * fq) = pack8(o0, o1); }
        }
    }
};
struct MixSched {
    pg8::DenseSched D0, D1;
    __device__ __forceinline__ bool next(int i, Unit& u) const { const bool ok = (i & 1) ? D1.next(i >> 1, u) : D0.next(i >> 1, u); u.x0 = i & 1; return ok; }
};
struct EpiOut {
    const float* X; const float* ada; float* O; float* SS;
    __device__ __forceinline__ void operator()(const f32x4 (&acc)[2][2][4][2], const Unit& u, int wr, int wc, int fr, int fq, LAS unsigned char* meta) const {
        f32x4 gg[2][2];
#pragma unroll
        for (int bj = 0; bj < 2; ++bj) { const float* gp = ada + (size_t)((u.pm * 256) >> 12) * 6144 + 2048 + u.pn * 256 + bj * 128 + wc * 32 + 8 * fq; gg[bj][0] = *(const f32x4*)gp; gg[bj][1] = *(const f32x4*)(gp + 4); }
        const size_t base = (size_t)(u.pm * 256 + wr * 64 + fr) * D + u.pn * 256 + wc * 32 + 8 * fq;
        f32x4 xq[3][2][2];
#define EPO_LOAD(slot, rg) do { const size_t o_ = base + (size_t)(((rg) >> 2) * 128 + ((rg) & 3) * 16) * D; _Pragma("unroll") for (int bj = 0; bj < 2; ++bj) { xq[slot][bj][0] = *(const f32x4*)(X + o_ + bj * 128); xq[slot][bj][1] = *(const f32x4*)(X + o_ + bj * 128 + 4); } } while (0)
        EPO_LOAD(0, 0); EPO_LOAD(1, 1);
#pragma unroll
        for (int rg = 0; rg < 8; ++rg) { const int ai = rg >> 2, m = rg & 3;
            if (rg + 2 < 8) EPO_LOAD((rg + 2) % 3, rg + 2);
            const size_t o_ = base + (size_t)(ai * 128 + m * 16) * D; float ss = 0.f;
#pragma unroll
            for (int bj = 0; bj < 2; ++bj) { const f32x4 o0 = xq[rg % 3][bj][0] + gg[bj][0] * acc[ai][bj][m][0], o1 = xq[rg % 3][bj][1] + gg[bj][1] * acc[ai][bj][m][1];
                *(u32x4*)((bf16_t*)O + 2 * (o_ - (size_t)(u.pn * 256 + wc * 32 + 8 * fq)) + (u.pn * 256 + wc * 32 + 8 * fq) + bj * 128) = pack8(o0, o1);
                ss += (o0.x * o0.x + o0.y * o0.y) + (o0.z * o0.z + o0.w * o0.w) + (o1.x * o1.x + o1.y * o1.y) + (o1.z * o1.z + o1.w * o1.w); }
            ss += __shfl_xor(ss, 16); ss += __shfl_xor(ss, 32);
            if (fq == 0) SS[(size_t)(u.pm * 256 + ai * 128 + wr * 64 + m * 16 + fr) * 16 + u.pn * 4 + wc] = ss;
            asm volatile("" ::: "memory"); }
#undef EPO_LOAD
    }
};
struct EpiMoe1 {
    bf16_t* H;
    __device__ __forceinline__ void operator()(const f32x4 (&acc)[2][2][4][2], const Unit& u, int wr, int wc, int fr, int fq, LAS unsigned char* meta) const {
#pragma unroll
        for (int ai = 0; ai < 2; ++ai)
#pragma unroll
            for (int m = 0; m < 4; ++m) { const int rl = ai * 128 + wr * 64 + m * 16 + fr;
                if (rl < u.valid) { f32x4 o0, o1;
#pragma unroll
                    for (int j = 0; j < 4; ++j) { const float g0 = acc[ai][0][m][0][j], g1 = acc[ai][1][m][0][j]; o0[j] = g0 * sigmoidf_(g0) * acc[ai][0][m][1][j]; o1[j] = g1 * sigmoidf_(g1) * acc[ai][1][m][1][j]; }
                    *(u32x4*)(H + (size_t)(u.x0 + rl) * 256 + u.pn * 128 + wc * 32 + 8 * fq) = pack8(o0, o1); } }
    }
};
__device__ __forceinline__ void epi_stage_write(LAS unsigned char* sc, int fr, int fq, const u32x4 w0, const u32x4 w1) {
    LAS unsigned char* rowp = sc + (fr >> 3) * 8192 + (fr & 7) * 128; const int x = fr & 7;
    *(LAS u32x4*)(rowp + ((fq ^ x) * 16)) = w0; *(LAS u32x4*)(rowp + (((4 + fq) ^ x) * 16)) = w1;
}
__device__ __forceinline__ u32x4 epi_stage_read(const LAS unsigned char* sc, int q, int lane) {
    const int r = lane >> 3, c = lane & 7; return *(const LAS u32x4*)(sc + q * 8192 + r * 128 + ((c ^ r) * 16));
}
__device__ __forceinline__ unsigned pk4_fp8(float a, float b, float c, float d) {
    a = __builtin_amdgcn_fmed3f(a, -448.f, 448.f); b = __builtin_amdgcn_fmed3f(b, -448.f, 448.f); c = __builtin_amdgcn_fmed3f(c, -448.f, 448.f); d = __builtin_amdgcn_fmed3f(d, -448.f, 448.f);
    int w = 0; w = __builtin_amdgcn_cvt_pk_fp8_f32(a, b, w, false); w = __builtin_amdgcn_cvt_pk_fp8_f32(c, d, w, true); return (unsigned)w;
}
struct EpiMoe2 {
    unsigned char* Y; int skip; LAS unsigned char* lds0;
    __device__ __forceinline__ void operator()(const f32x4 (&acc)[2][2][4][2], const Unit& u, int wr, int wc, int fr, int fq, LAS unsigned char* meta) const {
        asm volatile("" : "+v"(fr), "+v"(fq));
        const int lane = fr + 16 * fq;
        LAS unsigned char* sc0 = lds0 + 3 * pg8::HTB + (wr * 4 + wc) * 1024;
#pragma unroll
        for (int ai = 0; ai < 2; ++ai)
#pragma unroll
            for (int m = 0; m < 4; ++m) { const int rl0 = ai * 128 + wr * 64 + m * 16; LAS unsigned char* sc = sc0 + (m & 1) * 8192;
                const float g = *(const LAS float*)(meta + (rl0 + fr) * 4) * Y_SCALE;
                u32x2 w0, w1;
                w0.x = pk4_fp8(acc[ai][0][m][0][0] * g, acc[ai][0][m][0][1] * g, acc[ai][0][m][0][2] * g, acc[ai][0][m][0][3] * g); w0.y = pk4_fp8(acc[ai][0][m][1][0] * g, acc[ai][0][m][1][1] * g, acc[ai][0][m][1][2] * g, acc[ai][0][m][1][3] * g);
                w1.x = pk4_fp8(acc[ai][1][m][0][0] * g, acc[ai][1][m][0][1] * g, acc[ai][1][m][0][2] * g, acc[ai][1][m][0][3] * g); w1.y = pk4_fp8(acc[ai][1][m][1][0] * g, acc[ai][1][m][1][1] * g, acc[ai][1][m][1][2] * g, acc[ai][1][m][1][3] * g);
                *(LAS u32x2*)(sc + fr * 64 + fq * 8) = w0; *(LAS u32x2*)(sc + fr * 64 + 32 + fq * 8) = w1;
                { const int r = lane >> 2, c = lane & 3, rl = rl0 + r; const u32x4 v = *(const LAS u32x4*)(sc + r * 64 + c * 16);
                  if (rl < u.valid && !skip) { const int dst = *(const LAS int*)(meta + 2048 + rl * 4); *(u32x4*)(Y + (size_t)dst * D + u.pn * 256 + wc * 64 + c * 16) = v; } } }
    }
};

__device__ __forceinline__ void build_moe_tables(LAS unsigned char* lds, const unsigned* cnt_g) {
    LAS int* CNT = (LAS int*)(lds + LDS_CNT); LAS int* RS = (LAS int*)(lds + LDS_RS); LAS int* TB = (LAS int*)(lds + LDS_TB); LAS unsigned* TD = (LAS unsigned*)(lds + LDS_TD);
    const int tid = tidx();
    __syncthreads();
    if (tid < 256) { int c = tid < NPAIR ? (int)cnt_g[tid] : 0; c = c < 0 ? 0 : (c > PAIRCAP ? PAIRCAP : c); CNT[tid] = c; }
    __syncthreads();
    if (tid < 64) {
        int c[4], rs = 0, tb = 0;
#pragma unroll
        for (int i = 0; i < 4; ++i) { c[i] = CNT[4 * tid + i]; rs += c[i]; tb += (c[i] + 255) >> 8; }
        int srs = rs, stb = tb;
#pragma unroll
        for (int o = 1; o < 64; o <<= 1) { const int a = __shfl_up(srs, o), e = __shfl_up(stb, o); if (tid >= o) { srs += a; stb += e; } }
        int ers = srs - rs, etb = stb - tb;
#pragma unroll
        for (int i = 0; i < 4; ++i) { RS[4 * tid + i] = ers; TB[4 * tid + i] = etb; ers += c[i]; etb += (c[i] + 255) >> 8; }
        if (tid == 63) { RS[256] = srs; TB[256] = stb; }
    }
    __syncthreads();
    if (tid < 256) { const int c = CNT[tid], nt = (c + 255) >> 8, tb = TB[tid]; for (int k = 0; k < nt; ++k) TD[tb + k] = (unsigned)tid | ((unsigned)k << 9); }
    __syncthreads();
}
#define RFL(x) __builtin_amdgcn_readfirstlane(x)
struct Moe1Sched {
    LAS unsigned char* lds; int G, c; const char* U2; const int* dstl; const int* ident; const char* Wegu; const char* Wsgu;
    __device__ __forceinline__ bool next(int i, Unit& u) const {
        LAS int* CNT = (LAS int*)(lds + LDS_CNT); LAS int* RS = (LAS int*)(lds + LDS_RS); LAS int* TB = (LAS int*)(lds + LDS_TB); LAS unsigned* TD = (LAS unsigned*)(lds + LDS_TD);
        const int ntr = RFL(TB[256]); const int L = i * G + c; if (L >= (ntr + 128) * 2) return false;
        const int tau = L >> 1; u.pn = L & 1; u.pm = 0; u.A = U2; u.gp = nullptr;
        if (tau < ntr) { const unsigned d = (unsigned)RFL((int)TD[tau]); const int j = d & 511, k = d >> 9; u.valid = min(256, RFL(CNT[j]) - k * 256); u.rows = dstl + (size_t)(j * PAIRCAP + k * 256); u.x0 = RFL(RS[j]) + k * 256; u.rbase = (j >> 6) * CHTOK;
            u.B = Wegu + (size_t)(j & 63) * (512 * 1024 * 2) + (size_t)u.pn * (256 * 1024 * 2); }
        else { const int k = tau - ntr; u.valid = 256; u.rows = ident + k * 256; u.x0 = HSH_ROW0 + k * 256; u.rbase = (k / (CHTOK / 256)) * CHTOK; u.B = Wsgu + (size_t)u.pn * (256 * 1024 * 2); }
        return true;
    }
};
struct Moe2Sched {
    LAS unsigned char* lds; int G, c, ch; const unsigned char* ws;
    __device__ __forceinline__ bool next(int i, Unit& u) const {
        LAS int* CNT = (LAS int*)(lds + LDS_CNT); LAS int* RS = (LAS int*)(lds + LDS_RS); LAS int* TB = (LAS int*)(lds + LDS_TB); LAS unsigned* TD = (LAS unsigned*)(lds + LDS_TD);
        constexpr int NSH = CHTOK / 256;
        const int t0 = RFL(TB[64 * ch]), ntr = RFL(TB[64 * ch + 64]) - t0; const int L = i * G + c; if (L >= (ntr + NSH) * 4) return false;
        const int tau = L >> 2; u.pn = L & 3; u.pm = 0; u.rbase = 0; u.x0 = 0;
        if (tau < ntr) { const unsigned d = (unsigned)RFL((int)TD[t0 + tau]); const int j = d & 511, k = d >> 9; u.valid = min(256, RFL(CNT[j]) - k * 256);
            u.A = (const char*)(ws + WS_H) + (size_t)(RFL(RS[j]) + k * 256) * 512; u.rows = (const int*)(ws + WS_DSTL) + (size_t)(j * PAIRCAP + k * 256); u.gp = (const float*)(ws + WS_GATEL) + (size_t)(j * PAIRCAP + k * 256);
            u.B = (const char*)(ws + WS_W_ED) + (size_t)(j & 63) * (1024 * 256 * 2) + (size_t)u.pn * (256 * 256 * 2); }
        else { const int k = NSH * ch + (tau - ntr); u.valid = 256; u.A = (const char*)(ws + WS_H) + (size_t)(HSH_ROW0 + k * 256) * 512; u.rows = (const int*)(ws + WS_IDENT) + k * 256; u.gp = (const float*)(ws + WS_ONES); u.B = (const char*)(ws + WS_W_SD) + (size_t)u.pn * (256 * 256 * 2); }
        return true;
    }
};

struct Params { const float* in[29]; float* out; unsigned char* ws; int ph_lo, ph_hi; };

__device__ __forceinline__ void s5_tables_item(const Params& p, LAS unsigned char* lds, int item) {
    const int g = item >> 3, part = item & 7, tid = tidx();
    LAS float* AP = (LAS float*)lds;
    LAS float* BB = AP + 64 * 33 * 2;
    LAS float* CC = BB + 64 * 16 * 2;
    const float dt = expf(p.in[8][g]);
    __syncthreads();
    for (int i = tid; i < 64 * 33; i += NTHR) { const int pp = i / 33, tau = i - pp * 33; const float lr = p.in[6][g * 64 + pp], li = p.in[7][g * 64 + pp];
        const float mag = expf(lr * dt * (float)tau), th = li * dt * (float)tau; AP[i * 2] = mag * cosf(th); AP[i * 2 + 1] = mag * sinf(th); }
    for (int i = tid; i < 64 * 16; i += NTHR) { const int pp = i >> 4; const float lr = p.in[6][g * 64 + pp], li = p.in[7][g * 64 + pp];
        const float mag = expf(lr * dt); const float a_re = mag * cosf(li * dt), a_im = mag * sinf(li * dt);
        const float den = lr * lr + li * li, n_re = a_re - 1.0f; const float f_re = (n_re * lr + a_im * li) / den, f_im = (a_im * lr - n_re * li) / den;
        const float br = p.in[9][(size_t)(g * 64) * 16 + i], bi = p.in[10][(size_t)(g * 64) * 16 + i];
        BB[i * 2] = f_re * br - f_im * bi; BB[i * 2 + 1] = f_re * bi + f_im * br; }
    for (int i = tid; i < 16 * 64; i += NTHR) { CC[i * 2] = p.in[11][(size_t)g * 1024 + i]; CC[i * 2 + 1] = p.in[12][(size_t)g * 1024 + i]; }
    __syncthreads();
    if (part == 0 && tid < 64) { float* a32 = (float*)(p.ws + WS_A32); a32[(g * 64 + tid) * 2] = AP[(tid * 33 + 32) * 2]; a32[(g * 64 + tid) * 2 + 1] = AP[(tid * 33 + 32) * 2 + 1]; }
    {
        const int jh = tid >> 8, t2 = tid & 255;
        const int fr = t2 >> 6, l = t2 & 63, delta = part * 4 + fr, ho = l & 15, q = l >> 4, tau = delta - (q >> 1); float v[4];
#pragma unroll 1
        for (int jj = 0; jj < 4; ++jj) { const int j = jh * 4 + jj; const int hi = (q & 1) * 8 + j; float acc = 0.f;
            if (tau >= 0) { for (int pp = 0; pp < 64; ++pp) { const float ar = AP[(pp * 33 + tau) * 2], ai = AP[(pp * 33 + tau) * 2 + 1], br = BB[(pp * 16 + hi) * 2], bi = BB[(pp * 16 + hi) * 2 + 1], cr = CC[(ho * 64 + pp) * 2], ci = CC[(ho * 64 + pp) * 2 + 1];
                    acc += cr * (ar * br - ai * bi) - ci * (ar * bi + ai * br); }
                if (tau == 0 && ho == hi) acc += p.in[13][g * 16 + ho]; }
            v[jj] = acc; }
        u32x2 o; o.x = pk2(v[0], v[1]); o.y = pk2(v[2], v[3]);
        *(u32x2*)((bf16_t*)(p.ws + WS_TZF) + ((size_t)(g * 32 + delta) * 64 + l) * 8 + jh * 4) = o;
    }
    for (int u = tid; u < 1024; u += NTHR) {
        const int ks = u >> 6, l = u & 63, n = part * 16 + (l & 15), q = l >> 4, ri = n >> 6, pp = n & 63; float v[8];
#pragma unroll
        for (int j = 0; j < 8; ++j) { const int k = ks * 32 + q * 8 + j, sidx = k >> 4, hi = k & 15;
            const float ar = AP[(pp * 33 + 31 - sidx) * 2], ai = AP[(pp * 33 + 31 - sidx) * 2 + 1], br = BB[(pp * 16 + hi) * 2], bi = BB[(pp * 16 + hi) * 2 + 1];
            v[j] = ri ? (ar * bi + ai * br) : (ar * br - ai * bi); }
        u32x4 o; o.x = pk2(v[0], v[1]); o.y = pk2(v[2], v[3]); o.z = pk2(v[4], v[5]); o.w = pk2(v[6], v[7]);
        *(u32x4*)((bf16_t*)(p.ws + WS_WINF) + ((size_t)((g * 8 + part) * 16 + ks) * 64 + l) * 8) = o;
    }
    for (int u = tid; u < 1024; u += NTHR) {
        const int fr = u >> 6, l = u & 63, t = part * 4 + (fr >> 2), ksp = fr & 3, ho = l & 15, q = l >> 4; float v[8];
#pragma unroll
        for (int j = 0; j < 8; ++j) { const int kp = ksp * 32 + q * 8 + j, ri = kp >> 6, pp = kp & 63;
            const float cr = CC[(ho * 64 + pp) * 2], ci = CC[(ho * 64 + pp) * 2 + 1], ar = AP[(pp * 33 + t + 1) * 2], ai = AP[(pp * 33 + t + 1) * 2 + 1];
            v[j] = ri ? -(cr * ai + ci * ar) : (cr * ar - ci * ai); }
        u32x4 o; o.x = pk2(v[0], v[1]); o.y = pk2(v[2], v[3]); o.z = pk2(v[4], v[5]); o.w = pk2(v[6], v[7]);
        *(u32x4*)((bf16_t*)(p.ws + WS_WOUTF) + ((size_t)((g * 32 + t) * 4 + ksp) * 64 + l) * 8) = o;
    }
    __syncthreads();
}

__device__ __forceinline__ float gelu_tanh(float y) { const float z = 0.7978845608028654f * (y + 0.044715f * y * y * y); const float e = __expf(2.0f * z); const float th = 1.0f - 2.0f / (e + 1.0f); return 0.5f * y * (1.0f + th); }

__device__ __forceinline__ void s5_item(const Params& p, LAS unsigned char* lds, int item) {
    const int b = item >> 5, g = item & 31;
    const int tid = tidx(), lane = tid & 63, wave = __builtin_amdgcn_readfirstlane(tid >> 6), hd = lane & 15, qd = lane >> 4;
    const bf16_t* PROJ = (const bf16_t*)(p.ws + WS_PROJ); bf16_t* YG = (bf16_t*)(p.ws + WS_YG);
    LAS float* SL = (LAS float*)lds;
    LAS unsigned char* WO = lds + 65536;
    const char* WoutG = (const char*)(p.ws + WS_WOUTF) + (size_t)g * 32 * 4 * 1024;
#define S5_WO_DMA(h) do { _Pragma("unroll") for (int j_ = 0; j_ < 8; ++j_) \
        __builtin_amdgcn_global_load_lds((const unsigned*)(WoutG + (size_t)(h) * 65536 + (j_ * 512 + tid) * 16), (LAS unsigned*)(WO + j_ * 8192 + wave * 1024), 16, 0, 0); } while (0)
    const int c = 16 * wave + hd;
    __syncthreads();
    S5_WO_DMA(0);
    bf16x8 Uf[16];
#pragma unroll
    for (int ks = 0; ks < 16; ++ks) Uf[ks] = *(const bf16x8*)(PROJ + ((size_t)b * SEQ + c * 32 + 2 * ks + (qd >> 1)) * PROJ_W + C_USSM + g * 16 + (qd & 1) * 8);
    { const bf16x8* WinF = (const bf16x8*)(p.ws + WS_WINF) + (size_t)g * 8 * 16 * 64 + lane;
      bf16x8 wc_[8], wn_[8];
#pragma unroll
      for (int ks = 0; ks < 8; ++ks) wc_[ks] = WinF[ks * 64];
      f32x4 a = (f32x4){0.f, 0.f, 0.f, 0.f};
#pragma unroll 2
      for (int j = 0; j < 16; ++j) { const int jn = (j < 15) ? j + 1 : j;
#pragma unroll
          for (int i = 0; i < 8; ++i) wn_[i] = WinF[(jn * 8 + i) * 64];
          if ((j & 1) == 0) {
#pragma unroll
              for (int i = 0; i < 8; ++i) a = __builtin_amdgcn_mfma_f32_16x16x32_bf16(wc_[i], Uf[i], a, 0, 0, 0); }
          else {
#pragma unroll
              for (int i = 0; i < 8; ++i) a = __builtin_amdgcn_mfma_f32_16x16x32_bf16(wc_[i], Uf[8 + i], a, 0, 0, 0);
              *(LAS f32x4*)(SL + c * 128 + (j >> 1) * 16 + qd * 4) = a; a = (f32x4){0.f, 0.f, 0.f, 0.f}; }
#pragma unroll
          for (int i = 0; i < 8; ++i) wc_[i] = wn_[i]; } }
    __syncthreads();
    if (wave == 0) { const float* a32 = (const float*)(p.ws + WS_A32); const float ar = a32[(g * 64 + lane) * 2], ai = a32[(g * 64 + lane) * 2 + 1]; float hr = 0.f, hi = 0.f;
#pragma unroll 4
        for (int cc = 0; cc < 128; ++cc) { const float sr = SL[cc * 128 + lane], si = SL[cc * 128 + 64 + lane]; const float nr = ar * hr - ai * hi + sr, ni = ar * hi + ai * hr + si; hr = nr; hi = ni; SL[cc * 128 + lane] = hr; SL[cc * 128 + 64 + lane] = hi; } }
    __syncthreads();
    bf16x8 Hf[4];
#pragma unroll
    for (int ks = 0; ks < 4; ++ks) { if (c >= 1) { const f32x4 x0 = *(const LAS f32x4*)(SL + (c - 1) * 128 + ks * 32 + qd * 8), x1 = *(const LAS f32x4*)(SL + (c - 1) * 128 + ks * 32 + qd * 8 + 4); Hf[ks] = __builtin_bit_cast(bf16x8, pack8(x0, x1)); }
        else Hf[ks] = (bf16x8){0, 0, 0, 0, 0, 0, 0, 0}; }
    const bf16x8* TzF = (const bf16x8*)(p.ws + WS_TZF) + (size_t)g * 32 * 64 + lane;
#pragma unroll
    for (int half = 0; half < 2; ++half) {
        f32x4 acc[16];
#pragma unroll
        for (int tt = 0; tt < 16; ++tt) acc[tt] = (f32x4){0.f, 0.f, 0.f, 0.f};
        const int ndelta = half * 16 + 16;
        bf16x8 fr[4];
#pragma unroll
        for (int i = 0; i < 4; ++i) fr[i] = TzF[i * 64];
#pragma unroll
        for (int delta = 0; delta < 32; ++delta) {
            if (delta < ndelta) {
                const bf16x8 f0 = fr[delta & 3];
                if (delta + 4 < ndelta) fr[delta & 3] = TzF[(delta + 4) * 64];
#pragma unroll
                for (int ks = 0; ks < 16; ++ks) { const int t = delta + 2 * ks; if (t >= half * 16 && t < half * 16 + 16) acc[t - half * 16] = __builtin_amdgcn_mfma_f32_16x16x32_bf16(f0, Uf[ks], acc[t - half * 16], 0, 0, 0); }
            }
        }
        asm volatile("s_waitcnt vmcnt(0)" ::: "memory");
        __syncthreads();
#pragma unroll
        for (int tt = 0; tt < 16; ++tt) { const int t = half * 16 + tt;
#pragma unroll
            for (int ks = 0; ks < 4; ++ks) acc[tt] = __builtin_amdgcn_mfma_f32_16x16x32_bf16(*(const LAS bf16x8*)(WO + (tt * 4 + ks) * 1024 + lane * 16), Hf[ks], acc[tt], 0, 0, 0);
            u32x2 w; w.x = pk2(gelu_tanh(acc[tt][0]), gelu_tanh(acc[tt][1])); w.y = pk2(gelu_tanh(acc[tt][2]), gelu_tanh(acc[tt][3]));
            *(u32x2*)(YG + ((size_t)b * SEQ + c * 32 + t) * 512 + g * 16 + qd * 4) = w;
            if ((tt & 1) == 1) asm volatile("" ::: "memory"); }
        if (half == 0) { asm volatile("s_waitcnt lgkmcnt(0)" ::: "memory"); __syncthreads(); S5_WO_DMA(1); }
    }
#undef S5_WO_DMA
    __syncthreads();
}

struct TDesc { const float* W; bf16_t* WT; int K, N, item, kind; };
__device__ __forceinline__ void t_load(const TDesc& d, int lane, f32x4 (&v)[16]) {
    const int nblk = (d.N + 63) >> 6, kb = d.item / nblk, nb = d.item - kb * nblk, k0 = 64 * kb, n0 = 64 * nb;
    const int lr = lane >> 4, lc = (lane & 15) * 4;
#pragma unroll
    for (int i = 0; i < 16; ++i) v[i] = (n0 + lc < d.N) ? *(const f32x4*)(d.W + (size_t)(k0 + 4 * i + lr) * d.N + n0 + lc) : (f32x4){0.f, 0.f, 0.f, 0.f};
}
struct RmId { __device__ int operator()(int n) const { return n; } };
struct RmWave { __device__ int operator()(int n) const { const int L = n & 255; return (n & ~255) + 128 * ((L >> 5) & 1) + 32 * (L >> 6) + (L & 31); } };
struct RmIn { __device__ int operator()(int n) const { return n < PROJ_USED ? n : n + (PROJ_W - PROJ_USED); } };
struct RmGate { __device__ int operator()(int n) const { const int hl = n & 127; return 256 * (n >> 7) + 128 * ((hl >> 2) & 1) + 32 * (hl >> 5) + 8 * ((hl >> 3) & 3) + (hl & 3); } };
struct RmUp { __device__ int operator()(int n) const { const int hl = n & 127; return 256 * (n >> 7) + 128 * ((hl >> 2) & 1) + 32 * (hl >> 5) + 8 * ((hl >> 3) & 3) + 4 + (hl & 3); } };
__device__ __forceinline__ int t_rowmap(int kind, int n) { return kind == 0 ? n : kind == 1 ? RmWave()(n) : kind == 2 ? RmIn()(n) : kind == 3 ? RmGate()(n) : RmUp()(n); }
__device__ __forceinline__ void t_store(const TDesc& d, const f32x4 (&v)[16], LAS float* scr, int lane) {
    const int nblk = (d.N + 63) >> 6, kb = d.item / nblk, nb = d.item - kb * nblk, k0 = 64 * kb, n0 = 64 * nb;
    const int lr = lane >> 4, lc = (lane & 15) * 4;
#pragma unroll
    for (int i = 0; i < 16; ++i) { LAS float* dd = scr + (4 * i + lr) * 65 + lc; dd[0] = v[i].x; dd[1] = v[i].y; dd[2] = v[i].z; dd[3] = v[i].w; }
    LDS_WAIT(); asm volatile("" ::: "memory");
    const int nl = lane >> 3, kc = (lane & 7) * 8;
#pragma unroll
    for (int j = 0; j < 8; ++j) { const int n = nl + 8 * j; const LAS float* sp = scr + kc * 65 + n;
        u32x4 o; o.x = pk2(sp[0 * 65], sp[1 * 65]); o.y = pk2(sp[2 * 65], sp[3 * 65]); o.z = pk2(sp[4 * 65], sp[5 * 65]); o.w = pk2(sp[6 * 65], sp[7 * 65]);
        if (n0 + n < d.N) *(u32x4*)(d.WT + (size_t)t_rowmap(d.kind, n0 + n) * d.K + k0 + kc) = o; }
    LDS_WAIT(); asm volatile("" ::: "memory");
}

constexpr int T_I_IN = 16 * 60, T_I_GLU = 8 * 8, T_I_PS = 8 * 16, T_I_OUT = 16 * 16, T_I_SG = 16 * 4, T_I_SD = 4 * 16, T_I_EG = 64 * 64;
constexpr int T_NITEMS = T_I_IN + T_I_GLU + 2 * T_I_PS + T_I_OUT + 2 * T_I_SG + T_I_SD + 3 * T_I_EG;
constexpr int T_LATE = 5 * 128 * NWAVES;
constexpr int T_LATE2 = T_I_EG;
static_assert(T_LATE + T_LATE2 <= 3 * T_I_EG, "late items are expert matrices");
__device__ __forceinline__ TDesc tdesc_of(const Params& p, unsigned char* ws, int r) { TDesc d;
    if (r < T_I_IN) { d = TDesc{p.in[5], (bf16_t*)(ws + WS_W_IN), 1024, IN_W, r, 2}; return d; } r -= T_I_IN;
    if (r < T_I_GLU) { d = TDesc{p.in[14], (bf16_t*)(ws + WS_W_GLU), 512, 512, r, 0}; return d; } r -= T_I_GLU;
    if (r < T_I_PS) { d = TDesc{p.in[16], (bf16_t*)(ws + WS_W_PS), 512, 1024, r, 0}; return d; } r -= T_I_PS;
    if (r < T_I_PS) { d = TDesc{p.in[17], (bf16_t*)(ws + WS_W_PA), 512, 1024, r, 0}; return d; } r -= T_I_PS;
    if (r < T_I_OUT) { d = TDesc{p.in[18], (bf16_t*)(ws + WS_W_OUT), 1024, 1024, r, 0}; return d; } r -= T_I_OUT;
    if (r < T_I_SG) { d = TDesc{p.in[25], (bf16_t*)(ws + WS_W_SGU), 1024, 256, r, 3}; return d; } r -= T_I_SG;
    if (r < T_I_SG) { d = TDesc{p.in[26], (bf16_t*)(ws + WS_W_SGU), 1024, 256, r, 4}; return d; } r -= T_I_SG;
    if (r < T_I_SD) { d = TDesc{p.in[27], (bf16_t*)(ws + WS_W_SD), 256, 1024, r, 1}; return d; } r -= T_I_SD;
    if (r < T_I_EG) { const int e = r >> 6; d = TDesc{p.in[22] + (size_t)e * 262144, (bf16_t*)(ws + WS_W_EGU) + (size_t)e * 524288, 1024, 256, r & 63, 3}; return d; } r -= T_I_EG;
    if (r < T_I_EG) { const int e = r >> 6; d = TDesc{p.in[23] + (size_t)e * 262144, (bf16_t*)(ws + WS_W_EGU) + (size_t)e * 524288, 1024, 256, r & 63, 4}; return d; } r -= T_I_EG;
    { const int e = r >> 6; d = TDesc{p.in[24] + (size_t)e * 262144, (bf16_t*)(ws + WS_W_ED) + (size_t)e * 262144, 256, 1024, r & 63, 1}; return d; } }
__device__ __forceinline__ void run_transposes(const Params& p, unsigned char* ws, LAS unsigned char* lds, int r0, int r1, int widx, int nw) {
    const int lane = tidx() & 63, wave = __builtin_amdgcn_readfirstlane(tidx() >> 6);
    LAS float* scr = (LAS float*)(lds + wave * 16640);
    int r = r1 - 1 - widx;
    if (r < r0) return;
    TDesc d0 = tdesc_of(p, ws, r), d1 = d0, d2 = d0; f32x4 v0[16], v1[16], v2[16];
    t_load(d0, lane, v0);
    bool h1 = (r - nw >= r0);
    if (h1) { d1 = tdesc_of(p, ws, r - nw); t_load(d1, lane, v1); }
    for (;;) {
        const bool h2 = h1 && (r - 2 * nw >= r0);
        if (h2) { d2 = tdesc_of(p, ws, r - 2 * nw); t_load(d2, lane, v2); }
        t_store(d0, v0, scr, lane);
        if (!h1) break;
        d0 = d1; d1 = d2; r -= nw; h1 = h2;
#pragma unroll
        for (int i = 0; i < 16; ++i) { v0[i] = v1[i]; v1[i] = v2[i]; }
    }
}
__device__ __forceinline__ void p0_prep(const Params& p, LAS unsigned char* lds, int vcu, int G) {
    const int tid = tidx(), lane = tid & 63, wave = __builtin_amdgcn_readfirstlane(tid >> 6);
    unsigned char* ws = p.ws;
    for (int it = vcu; it < 256; it += G) s5_tables_item(p, lds, it);
    {
        LAS float* sc = (LAS float*)lds;
        LAS float* red = (LAS float*)(lds + 32768);
        const float* c = p.in[1]; const float* w = p.in[2]; const float* bb = p.in[3]; float* ada = (float*)(ws + WS_ADA);
        bool loaded = false;
        for (int it = vcu; it < 96; it += G) {
            if (!loaded) { for (int i = tid; i < 8192; i += NTHR) { const float v = c[i]; sc[i] = v * sigmoidf_(v); } loaded = true; }
            __syncthreads();
            const int kq = tid >> 6, col = it * 64 + lane; float a[8];
#pragma unroll
            for (int b = 0; b < 8; ++b) a[b] = 0.f;
#pragma unroll 16
            for (int k = kq * 128; k < kq * 128 + 128; ++k) { const float wv = w[(size_t)k * 6144 + col];
#pragma unroll
                for (int b = 0; b < 8; ++b) a[b] += sc[b * 1024 + k] * wv; }
#pragma unroll
            for (int b = 0; b < 8; ++b) red[(kq * 8 + b) * 64 + lane] = a[b];
            __syncthreads();
            { const int b = tid >> 6; float s = bb[col];
#pragma unroll
              for (int q = 0; q < 8; ++q) s += red[(q * 8 + b) * 64 + lane];
              ada[b * 6144 + col] = s; }
            __syncthreads();
        }
        __syncthreads();
    }
    run_transposes(p, ws, lds, 0, T_NITEMS - T_LATE2 - ((G == 256) ? T_LATE : 0), vcu * NWAVES + wave, G * NWAVES);
    { const int gt = vcu * NTHR + tid, NGT = G * NTHR;
      u32x4* z = (u32x4*)(ws + WS_W_IN + (size_t)PROJ_USED * 1024 * 2);
      for (int i = gt; i < (PROJ_W - PROJ_USED) * 1024 * 2 / 16; i += NGT) z[i] = (u32x4){0u, 0u, 0u, 0u};
      int* id = (int*)(ws + WS_IDENT); for (int i = gt; i < NTOK; i += NGT) id[i] = (i % CHTOK) * NSLOT + 8;
      if (gt < 256) ((float*)(ws + WS_ONES))[gt] = 1.0f;
      for (int u = gt; u < 32 * 4 * 64; u += NGT) { const int l = u & 63, nt = (u >> 6) & 3, ks = u >> 8; const int n = nt * 16 + (l & 15), q = l >> 4; float hi[8], lo[8];
#pragma unroll
          for (int j = 0; j < 8; ++j) { const float w = p.in[20][(size_t)(ks * 32 + q * 8 + j) * 64 + n]; const float h = bf2f((unsigned short)f2bf(w)); hi[j] = h; lo[j] = w - h; }
          u32x4 o; o.x = pk2(hi[0], hi[1]); o.y = pk2(hi[2], hi[3]); o.z = pk2(hi[4], hi[5]); o.w = pk2(hi[6], hi[7]);
          *(u32x4*)((bf16_t*)(ws + WS_WRF) + (size_t)u * 8) = o;
          o.x = pk2(lo[0], lo[1]); o.y = pk2(lo[2], lo[3]); o.z = pk2(lo[4], lo[5]); o.w = pk2(lo[6], lo[7]);
          *(u32x4*)((bf16_t*)(ws + WS_WRF) + (size_t)(32 * 4 * 64 + u) * 8) = o; } }
}

__device__ __forceinline__ void p1_modulate(const Params& p, int vcu, int G) {
    const int tid = tidx(), lane = tid & 63, wave = tid >> 6; const int gw = vcu * NWAVES + wave, NGW = G * NWAVES;
    const float* ada = (const float*)(p.ws + WS_ADA); const float* g1 = p.in[4]; bf16_t* U = (bf16_t*)(p.ws + WS_U);
    for (int m = gw; m < NTOK; m += NGW) {
        const f32x4* xr = (const f32x4*)(p.in[0] + (size_t)m * D) + lane; const int b = m >> 12;
        f32x4 v[4]; float s = 0.f;
#pragma unroll
        for (int j = 0; j < 4; ++j) { v[j] = xr[64 * j]; s += (v[j].x * v[j].x + v[j].y * v[j].y) + (v[j].z * v[j].z + v[j].w * v[j].w); }
        const float rstd = 1.0f / sqrtf(wave_sum(s) * (1.f / D) + EPS);
        unsigned long long* o8 = (unsigned long long*)(U + (size_t)m * D) + lane;
#pragma unroll
        for (int j = 0; j < 4; ++j) { const int c0 = 4 * lane + 256 * j;
            const f32x4 gg = *(const f32x4*)(g1 + c0), sh = *(const f32x4*)(ada + b * 6144 + c0), scl = *(const f32x4*)(ada + b * 6144 + 1024 + c0);
            const f32x4 y = v[j] * rstd * gg * (scl + 1.0f) + sh;
            o8[64 * j] = (unsigned long long)pk2(y.x, y.y) | ((unsigned long long)pk2(y.z, y.w) << 32); }
    }
}

__device__ __forceinline__ void p_combine(const Params& p, int vcu, int G, int ch) {
    const int tid = tidx(), lane = tid & 63, wave = tid >> 6; const int gw = vcu * NWAVES + wave, NGW = G * NWAVES;
    const float* ada = (const float*)(p.ws + WS_ADA); const float* gf = p.in[28];
    const unsigned char* Y = (const unsigned char*)(p.ws + WS_Y);
    u32x4 w[NSLOT];
    { const int mi0 = gw < CHTOK ? gw : 0; const unsigned char* yp = Y + (size_t)mi0 * NSLOT * D + lane * 16;
#pragma unroll
      for (int k = 0; k < NSLOT; ++k) w[k] = *(const u32x4*)(yp + (size_t)k * D); }
    for (int mi = gw; mi < CHTOK; mi += NGW) {
        const int m = ch * CHTOK + mi; const int b = m >> 12;
        float* orow = p.out + (size_t)m * D + lane * 16;
        f32x4 h[4], g2[4];
        { const u32x4* hp = (const u32x4*)((const bf16_t*)(p.out + (size_t)m * D) + lane * 16); const u32x4 h0 = hp[0], h1 = hp[1];
          h[0] = (f32x4){bflo(h0.x), bfhi(h0.x), bflo(h0.y), bfhi(h0.y)}; h[1] = (f32x4){bflo(h0.z), bfhi(h0.z), bflo(h0.w), bfhi(h0.w)};
          h[2] = (f32x4){bflo(h1.x), bfhi(h1.x), bflo(h1.y), bfhi(h1.y)}; h[3] = (f32x4){bflo(h1.z), bfhi(h1.z), bflo(h1.w), bfhi(h1.w)}; }
#pragma unroll
        for (int q = 0; q < 4; ++q) g2[q] = *(const f32x4*)(ada + b * 6144 + 5120 + lane * 16 + 4 * q);
        float a[16];
#pragma unroll
        for (int j = 0; j < 16; ++j) a[j] = 0.f;
#pragma unroll
        for (int k = 0; k < NSLOT; ++k)
#pragma unroll
            for (int q = 0; q < 4; ++q) { const f32x2 lo = __builtin_amdgcn_cvt_pk_f32_fp8((int)w[k][q], false), hi = __builtin_amdgcn_cvt_pk_f32_fp8((int)w[k][q], true);
                a[4 * q] += lo.x; a[4 * q + 1] += lo.y; a[4 * q + 2] += hi.x; a[4 * q + 3] += hi.y; }
        { const int mn = (mi + NGW < CHTOK) ? mi + NGW : mi; const unsigned char* yp = Y + (size_t)mn * NSLOT * D + lane * 16;
#pragma unroll
          for (int k = 0; k < NSLOT; ++k) w[k] = *(const u32x4*)(yp + (size_t)k * D); }
        float r[16]; float s = 0.f;
#pragma unroll
        for (int i = 0; i < 4; ++i)
#pragma unroll
            for (int j = 0; j < 4; ++j) { const float v = h[i][j] + g2[i][j] * (a[i * 4 + j] * (1.0f / Y_SCALE)); r[i * 4 + j] = v; s += v * v; }
        const float rstd = 1.0f / sqrtf(wave_sum(s) * (1.f / D) + EPS);
#pragma unroll
        for (int q = 0; q < 4; ++q) { const f32x4 g = *(const f32x4*)(gf + lane * 16 + 4 * q); f32x4 o;
#pragma unroll
            for (int j = 0; j < 4; ++j) o[j] = r[q * 4 + j] * rstd * g[j];
            *(f32x4*)(orow + 4 * q) = o; }
    }
}

__device__ __forceinline__ unsigned fkey(float x) { const unsigned u = __builtin_bit_cast(unsigned, x); return (u & 0x80000000u) ? ~u : (u | 0x80000000u); }

__device__ __forceinline__ void gold_s5(const Params& p, int item, int lane) {
    const int b = item >> 5, g = item & 31;
    const bf16_t* PROJ = (const bf16_t*)(p.ws + WS_PROJ); bf16_t* YG = (bf16_t*)(p.ws + WS_YG);
    const float dt = expf(p.in[8][g]); const float lr = p.in[6][g * 64 + lane], li = p.in[7][g * 64 + lane];
    const float mag = expf(lr * dt); const float a_re = mag * cosf(li * dt), a_im = mag * sinf(li * dt);
    const float den = lr * lr + li * li, n_re = a_re - 1.0f;
    const float f_re = (n_re * lr + a_im * li) / den, f_im = (a_im * lr - n_re * li) / den;
    float bbr[16], bbi[16], cr[16], ci[16];
#pragma unroll
    for (int h = 0; h < 16; ++h) { const float br = p.in[9][(g * 64 + lane) * 16 + h], bi = p.in[10][(g * 64 + lane) * 16 + h];
        bbr[h] = f_re * br - f_im * bi; bbi[h] = f_re * bi + f_im * br;
        cr[h] = p.in[11][(g * 16 + h) * 64 + lane]; ci[h] = p.in[12][(g * 16 + h) * 64 + lane]; }
    const float dsk = p.in[13][g * 16 + (lane & 15)];
    float hr = 0.f, hi = 0.f;
    for (int t = 0; t < SEQ; ++t) {
        const size_t row = (size_t)b * SEQ + t;
        const u32x4 w0 = *(const u32x4*)(PROJ + row * PROJ_W + C_USSM + g * 16), w1 = *(const u32x4*)(PROJ + row * PROJ_W + C_USSM + g * 16 + 8);
        float u[16]; { float f[8]; unpack8(w0, f);
#pragma unroll
            for (int j = 0; j < 8; ++j) u[j] = f[j];
            unpack8(w1, f);
#pragma unroll
            for (int j = 0; j < 8; ++j) u[8 + j] = f[j]; }
        float bur = 0.f, bui = 0.f;
#pragma unroll
        for (int h = 0; h < 16; ++h) { bur += bbr[h] * u[h]; bui += bbi[h] * u[h]; }
        const float nr = a_re * hr - a_im * hi + bur, ni = a_re * hi + a_im * hr + bui; hr = nr; hi = ni;
        float y = 0.f, um = 0.f;
#pragma unroll
        for (int h = 0; h < 16; ++h) { const float v = wave_sum(cr[h] * hr - ci[h] * hi); if ((lane & 15) == h) { y = v; um = u[h]; } }
        y += dsk * um;
        const float gl = 0.5f * y * (1.0f + tanhf(0.7978845608028654f * (y + 0.044715f * y * y * y)));
        if (lane < 16) YG[row * 512 + g * 16 + lane] = (bf16_t)f2bf(gl);
    }
}

__device__ __forceinline__ void gold_attn_pair(const Params& p, LAS unsigned char* lds, int pairid) {
    const int half = tidx() >> 8, tid = tidx() & 255;
    LAS unsigned char* base = lds + half * 32768;
    LAS float* qi = (LAS float*)base; LAS float* qv = qi + 512; LAS float* sc = qv + 512; LAS float* lg = sc + 4096;
    LAS float* wi = lg + 2048; LAS float* mx = wi + 8; LAS float* sm = mx + 8; LAS int* sel = (LAS int*)(sm + 8); LAS int* red = sel + 256; LAS int* cntp = red + 256;
    const int qid = pairid * 2 + half; const int b = qid >> 12, t = qid & 4095;
    const bf16_t* PROJ = (const bf16_t*)(p.ws + WS_PROJ); bf16_t* YA = (bf16_t*)(p.ws + WS_YATTN);
    const size_t qrow = (size_t)qid * PROJ_W;
    __syncthreads();
    for (int i = tid; i < 512; i += 256) { qi[i] = bf2f(PROJ[qrow + C_QI + i]); qv[i] = bf2f(PROJ[qrow + C_Q + i]); }
    if (tid < 8) wi[tid] = bf2f(PROJ[qrow + C_WI + tid]);
    if (tid == 0) cntp[0] = 0;
    __syncthreads();
    const int n = t + 1;
    for (int s = tid; s < n; s += 256) {
        const bf16_t* kp = PROJ + ((size_t)b * SEQ + s) * PROJ_W + C_KI; float kk[64];
#pragma unroll
        for (int c8 = 0; c8 < 8; ++c8) { float f[8]; unpack8(*(const u32x4*)(kp + c8 * 8), f);
#pragma unroll
            for (int j = 0; j < 8; ++j) kk[c8 * 8 + j] = f[j]; }
        float score = 0.f;
        for (int h = 0; h < 8; ++h) { float d = 0.f;
#pragma unroll
            for (int j = 0; j < 64; ++j) d += qi[h * 64 + j] * kk[j];
            score += wi[h] * fmaxf(d, 0.f); }
        sc[s] = score;
    }
    __syncthreads();
    const bool small = (t | 1) <= 255;
    if (small) { if (tid < n) sel[tid] = tid; if (tid == 0) cntp[0] = n; __syncthreads(); }
    else {
        unsigned thr = 0u;
        for (int bit = 31; bit >= 0; --bit) {
            const unsigned cand = thr | (1u << bit); int c = 0;
            for (int s = tid; s < n; s += 256) c += (fkey(sc[s]) >= cand) ? 1 : 0;
            red[tid] = c; __syncthreads();
            for (int o = 128; o > 0; o >>= 1) { if (tid < o) red[tid] += red[tid + o]; __syncthreads(); }
            if (red[0] >= 256) thr = cand;
            __syncthreads();
        }
        for (int s = tid; s < n; s += 256) if (fkey(sc[s]) > thr) { const int ps = atomicAdd((int*)cntp, 1); sel[ps] = s; }
        __syncthreads();
        if (tid == 0) { int c = cntp[0]; for (int s = 0; s < n && c < 256; ++s) if (fkey(sc[s]) == thr) sel[c++] = s; cntp[0] = c; }
        __syncthreads();
    }
    const int ns = cntp[0];
    { const int j = tid; const int s = (j < ns) ? sel[j] : 0;
      const bf16_t* kp = PROJ + ((size_t)b * SEQ + s) * PROJ_W + C_K; float kk[64];
#pragma unroll
      for (int c8 = 0; c8 < 8; ++c8) { float f[8]; unpack8(*(const u32x4*)(kp + c8 * 8), f);
#pragma unroll
          for (int jj = 0; jj < 8; ++jj) kk[c8 * 8 + jj] = f[jj]; }
      for (int h = 0; h < 8; ++h) { float d = 0.f;
#pragma unroll
          for (int jj = 0; jj < 64; ++jj) d += qv[h * 64 + jj] * kk[jj];
          const float slope = exp2f(-(float)(h + 1));
          lg[h * 256 + j] = (j < ns) ? d * 0.125f - slope * (float)(t - s) : -INFINITY; } }
    __syncthreads();
    if (tid < 8) { float m = -INFINITY; for (int j = 0; j < 256; ++j) m = fmaxf(m, lg[tid * 256 + j]); float sum = 0.f; for (int j = 0; j < 256; ++j) sum += __expf(lg[tid * 256 + j] - m); mx[tid] = m; sm[tid] = sum; }
    __syncthreads();
    for (int i = tid; i < 2048; i += 256) { const int h = i >> 8; lg[i] = __expf(lg[i] - mx[h]) / sm[h]; }
    __syncthreads();
    { const int h = tid >> 5, d0 = (tid & 31) * 2; float o0 = 0.f, o1 = 0.f;
      for (int j = 0; j < ns; ++j) { const unsigned w = *(const unsigned*)(PROJ + ((size_t)b * SEQ + sel[j]) * PROJ_W + C_V + d0); const float pj = lg[h * 256 + j]; o0 += pj * bflo(w); o1 += pj * bfhi(w); }
      *(unsigned*)(YA + (size_t)qid * 512 + h * 64 + d0) = pk2(o0, o1); }
}

typedef float f32x16 __attribute__((ext_vector_type(16)));
typedef _Float16 f16_t;
constexpr int AT_SC = 0;
constexpr int AT_V = 65536;
constexpr int AT_SEL = LDS_CNT;
static_assert(AT_V + 8 * 2 * 4096 <= STAGE_BYTES && AT_SEL + 8 * 1152 <= LDS_BYTES, "attention LDS map");

#define DPP_ZI(v, ctrl, rmask, bmask) __builtin_amdgcn_update_dpp(0, (int)(v), ctrl, rmask, bmask, false)
__device__ __forceinline__ int wave_scan_i(int v0) {
    int v1 = v0 + DPP_ZI(v0, 0x111, 0xf, 0xf); v1 += DPP_ZI(v0, 0x112, 0xf, 0xf); v1 += DPP_ZI(v0, 0x113, 0xf, 0xf);
    v1 += DPP_ZI(v1, 0x114, 0xf, 0xe); v1 += DPP_ZI(v1, 0x118, 0xf, 0xc);
    v1 += DPP_ZI(v1, 0x142, 0xa, 0xf); v1 += DPP_ZI(v1, 0x143, 0xc, 0xf);
    return v1;
}
__device__ __forceinline__ float relu_i(float x) { const int xi = __builtin_bit_cast(int, x); return __builtin_bit_cast(float, xi > 0 ? xi : 0); }
__device__ __forceinline__ u32x2 tr_read16(unsigned addr) { u32x2 r; asm volatile("ds_read_b64_tr_b16 %0, %1" : "=v"(r) : "v"(addr) : "memory"); return r; }

__device__ __forceinline__ void attn_item(const Params& p, LAS unsigned char* lds, int b, int qblk) {
    const int tid = tidx(), lane = tid & 63, wave = __builtin_amdgcn_readfirstlane(tid >> 6);
    const int q0 = qblk * 8;
    const bf16_t* PROJ = (const bf16_t*)(p.ws + WS_PROJ); bf16_t* YA = (bf16_t*)(p.ws + WS_YATTN);
    const size_t tok0 = (size_t)b * SEQ + q0;
    LAS unsigned short* SC = (LAS unsigned short*)(lds + AT_SC);
    LAS unsigned short* SELq = (LAS unsigned short*)(lds + AT_SEL) + wave * 576;
    const int nkt = (q0 + 8 + 31) >> 5;
    const int nchmax = (q0 + 8 + 511) >> 9;
    __syncthreads();
    for (int i = nkt * 32 + lane; i < nchmax * 512; i += 64) SC[wave * 4096 + i] = 0xFC00u;
    __syncthreads();
#ifndef AT_REP_A
#define AT_REP_A 1
#endif
#ifndef AT_REP_B
#define AT_REP_B 1
#endif
#ifndef AT_REP_C
#define AT_REP_C 1
#endif
#ifndef AT_SKIP_A
    for (int ra_ = 0; ra_ < AT_REP_A; ++ra_) {
        const int hf = lane >> 5, l32 = lane & 31;
        const int rq = 2 * ((l32 >> 2) & 1) + ((l32 >> 4) & 1), rh = (l32 & 3) + 4 * ((l32 >> 3) & 1);
        bf16x8 Af[2][4]; float wgt[2][16];
#pragma unroll
        for (int qg = 0; qg < 2; ++qg) { const bf16_t* qp = PROJ + (tok0 + 4 * qg + rq) * PROJ_W + C_QI + rh * 64 + hf * 8;
#pragma unroll
            for (int s = 0; s < 4; ++s) Af[qg][s] = *(const bf16x8*)(qp + s * 16);
#pragma unroll
            for (int qq = 0; qq < 2; ++qq) { const u32x4 w = *(const u32x4*)(PROJ + (tok0 + 4 * qg + 2 * hf + qq) * PROJ_W + C_WI); float f[8]; unpack8(w, f);
#pragma unroll
                for (int h = 0; h < 8; ++h) wgt[qg][qq * 8 + h] = f[h]; } }
        const bf16x8* KIF = (const bf16x8*)(p.ws + WS_KIF) + (size_t)b * 128 * 4 * 64 + lane;
        bf16x8 B0[4], B1[4];
        { const int kt0 = wave < nkt ? wave : 0, kt1 = wave + 8 < nkt ? wave + 8 : kt0;
#pragma unroll
          for (int s = 0; s < 4; ++s) { B0[s] = KIF[(kt0 * 4 + s) * 64]; B1[s] = KIF[(kt1 * 4 + s) * 64]; } }
#define STEP_A_TILE(BF, KT) do { const int key = (KT) * 32 + l32; \
            _Pragma("unroll") for (int qg = 0; qg < 2; ++qg) { \
                f32x16 c; _Pragma("unroll") for (int j = 0; j < 16; ++j) c[j] = 0.f; \
                _Pragma("unroll") for (int s = 0; s < 4; ++s) c = __builtin_amdgcn_mfma_f32_32x32x16_bf16(Af[qg][s], BF[s], c, 0, 0, 0); \
                float sa = 0.f, sb = 0.f; \
                _Pragma("unroll") for (int h = 0; h < 8; ++h) { sa += wgt[qg][h] * relu_i(c[h]); sb += wgt[qg][8 + h] * relu_i(c[8 + h]); } \
                const int qa = 4 * qg + 2 * hf; \
                sa = fminf(fmaxf(sa * 0.0441941738f, -60000.f), 60000.f); sb = fminf(fmaxf(sb * 0.0441941738f, -60000.f), 60000.f); \
                if (key > q0 + qa) sa = -INFINITY; \
                if (key > q0 + qa + 1) sb = -INFINITY; \
                const f16_t ha = (f16_t)sa, hb = (f16_t)sb; \
                SC[qa * 4096 + key] = __builtin_bit_cast(unsigned short, ha); SC[(qa + 1) * 4096 + key] = __builtin_bit_cast(unsigned short, hb); } } while (0)
        for (int kt = wave; kt < nkt; kt += 16) {
            STEP_A_TILE(B0, kt);
            { const int ktn = (kt + 16 < nkt) ? kt + 16 : kt;
#pragma unroll
              for (int s = 0; s < 4; ++s) B0[s] = KIF[(ktn * 4 + s) * 64]; }
            if (kt + 8 < nkt) {
                STEP_A_TILE(B1, kt + 8);
                { const int ktn = (kt + 24 < nkt) ? kt + 24 : kt;
#pragma unroll
                  for (int s = 0; s < 4; ++s) B1[s] = KIF[(ktn * 4 + s) * 64]; } }
        }
#undef STEP_A_TILE
    }
#endif
    __syncthreads();
    const int t = q0 + wave, n = t + 1;
    int ns;
    for (int rb_ = 0; rb_ < AT_REP_B; ++rb_) {
#ifdef AT_SKIP_B
    if (true) {
#else
    if (n <= 256) {
#endif
#pragma unroll
        for (int i = 0; i < 4; ++i) { const int pos = lane + 64 * i; SELq[pos] = (unsigned short)(pos < n ? pos : 0); }
        ns = n;
    } else {
        const int nch = (n + 511) >> 9;
        unsigned XH[32], XL[32];
        LAS unsigned char* row = lds + AT_SC + wave * 8192;
#pragma unroll
        for (int i = 0; i < 8; ++i) {
            if (i < nch) { const u32x4 w = *(const LAS u32x4*)(row + i * 1024 + lane * 16);
#pragma unroll
                for (int e2 = 0; e2 < 4; ++e2) { const unsigned x = w[e2]; const unsigned sg = (x & 0x80008000u) >> 15; const unsigned k2 = x ^ ((sg * 0xffffu) | 0x80008000u);
                    XH[i * 4 + e2] = k2; XL[i * 4 + e2] = k2 << 16; } }
            else {
#pragma unroll
                for (int e2 = 0; e2 < 4; ++e2) { XH[i * 4 + e2] = 0u; XL[i * 4 + e2] = 0u; } }
        }
        LAS unsigned* H1 = (LAS unsigned*)(lds + 65536 + wave * 8192);
        LAS unsigned* H2 = (LAS unsigned*)((LAS unsigned char*)SELq + 640);
        LAS unsigned* H1p = H1 + (lane & 1) * 1024;
#pragma unroll
        for (int i = 0; i < 8; ++i) *(LAS u32x4*)(H1 + (i * 64 + lane) * 4) = (u32x4){0u, 0u, 0u, 0u};
        H2[lane] = 0u;
        LDS_WAIT(); __builtin_amdgcn_wave_barrier();
#pragma unroll
        for (int i = 0; i < 8; ++i) if (i < nch) {
#pragma unroll
            for (int e2 = 0; e2 < 4; ++e2) { const unsigned x = XH[i * 4 + e2];
                __hip_atomic_fetch_add(H1p + (x >> 22), 1u, __ATOMIC_RELAXED, __HIP_MEMORY_SCOPE_WORKGROUP);
                __hip_atomic_fetch_add(H1p + ((x >> 6) & 1023u), 1u, __ATOMIC_RELAXED, __HIP_MEMORY_SCOPE_WORKGROUP); } }
        LDS_WAIT(); __builtin_amdgcn_wave_barrier();
        unsigned B1, cabove; const unsigned dummy = 64u + (unsigned)lane;
        {
            unsigned hb[16];
#pragma unroll
            for (int i = 0; i < 4; ++i) { const u32x4 w = *(const LAS u32x4*)(H1 + lane * 16 + i * 4), w2 = *(const LAS u32x4*)(H1 + 1024 + lane * 16 + i * 4); hb[4 * i] = w.x + w2.x; hb[4 * i + 1] = w.y + w2.y; hb[4 * i + 2] = w.z + w2.z; hb[4 * i + 3] = w.w + w2.w; }
            unsigned sl_ = 0u;
#pragma unroll
            for (int i = 0; i < 16; ++i) sl_ += hb[i];
            const int inc_ = wave_scan_i((int)sl_);
            const unsigned above = (unsigned)(__builtin_amdgcn_readlane(inc_, 63) - inc_), suf = above + sl_;
            const bool mine = above < 256u && suf >= 256u;
            unsigned bsel = 0u, cab = 0u;
            if (mine) { unsigned run = above; bool done = false;
#pragma unroll
                for (int i = 15; i >= 0; --i) { if (!done && run + hb[i] >= 256u) { bsel = (unsigned)(lane * 16 + i); cab = run; done = true; } run += hb[i]; } }
            const unsigned long long mk = __ballot(mine); const int src = (int)__builtin_ctzll(mk);
            B1 = (unsigned)__builtin_amdgcn_readlane((int)bsel, src); cabove = (unsigned)__builtin_amdgcn_readlane((int)cab, src);
        }
#pragma unroll
        for (int i = 0; i < 8; ++i) if (i < nch) {
#pragma unroll
            for (int e2 = 0; e2 < 4; ++e2) { const unsigned x = XH[i * 4 + e2];
                const unsigned ah = ((x >> 22) == B1) ? ((x >> 16) & 63u) : dummy, al = (((x >> 6) & 1023u) == B1) ? (x & 63u) : dummy;
                __hip_atomic_fetch_add(H2 + ah, 1u, __ATOMIC_RELAXED, __HIP_MEMORY_SCOPE_WORKGROUP);
                __hip_atomic_fetch_add(H2 + al, 1u, __ATOMIC_RELAXED, __HIP_MEMORY_SCOPE_WORKGROUP); } }
        LDS_WAIT(); __builtin_amdgcn_wave_barrier();
        unsigned thr;
        {   const unsigned h2 = H2[lane]; const int inc_ = wave_scan_i((int)h2); const unsigned ab2 = (unsigned)(__builtin_amdgcn_readlane(inc_, 63) - inc_), suf = ab2 + h2;
            const unsigned need = 256u - cabove;
            const bool mine = ab2 < need && suf >= need;
            const unsigned long long mk = __ballot(mine); const unsigned B2 = (unsigned)__builtin_ctzll(mk);
            thr = (B1 << 6) | B2; }
        const unsigned c32 = thr << 16, c32h = c32 | 0xffffu;
#define TIE2(a, b) asm volatile("" : "+v"(a), "+v"(b))
        int cgt = 0, ceq = 0;
#pragma unroll
        for (int j = 0; j < 32; ++j) { unsigned xh = XH[j], xl = XL[j]; TIE2(xh, cgt); TIE2(xl, ceq);
            cgt += (xh > c32h) ? 1 : 0; cgt += (xl > c32) ? 1 : 0; ceq += ((xh >> 16) == thr) ? 1 : 0; ceq += (xl == c32) ? 1 : 0; }
        const int sgt = wave_scan_i(cgt), seq = wave_scan_i(ceq);
        const int tot_gt = __builtin_amdgcn_readlane(sgt, 63);
        int o1 = sgt - cgt, o2 = tot_gt + seq - ceq;
        const int trash = 256 + lane;
#pragma unroll
        for (int i = 0; i < 8; ++i) if (i < nch) {
#pragma unroll
            for (int e2 = 0; e2 < 4; ++e2) { const int j = i * 4 + e2; const int idx = i * 512 + lane * 8 + 2 * e2;
                unsigned xl = XL[j], xh = XH[j]; TIE2(xl, o1); TIE2(xh, o2);
                { const bool gt = xl > c32, eq = xl == c32; const int a2 = (eq && o2 < 256) ? o2 : trash, a1 = gt ? o1 : a2; SELq[a1] = (unsigned short)idx; o1 += gt ? 1 : 0; o2 += eq ? 1 : 0; }
                TIE2(xh, o1);
                { const bool gt = xh > c32h, eq = (xh >> 16) == thr; const int a2 = (eq && o2 < 256) ? o2 : trash, a1 = gt ? o1 : a2; SELq[a1] = (unsigned short)(idx + 1); o1 += gt ? 1 : 0; o2 += eq ? 1 : 0; } } }
        ns = 256;
    }
    LDS_WAIT(); __builtin_amdgcn_wave_barrier(); }
    __syncthreads();
    {
        const int hd = lane & 15, qd = lane >> 4;
        const size_t tok = tok0 + wave;
        LAS unsigned char* vb = lds + wave * 16384;
        const unsigned vb_addr = (unsigned)(size_t)vb;
        const int vrow = lane >> 3, vch = lane & 7;
        const char* bbase = (const char*)(PROJ + (size_t)b * SEQ * PROJ_W);
        const unsigned voff0 = (unsigned)(C_V * 2 + vch * 16), koff0 = (unsigned)(C_K * 2 + qd * 16);
        unsigned roff[32];
#pragma unroll
        for (int j_ = 0; j_ < 32; ++j_) roff[j_] = (unsigned)SELq[(j_ >> 2) * 32 + vrow + 8 * (j_ & 3)] * (unsigned)(PROJ_W * 2);
#define V_DMA(sl) do { _Pragma("unroll") for (int i_ = 0; i_ < 4; ++i_) { \
            __builtin_amdgcn_global_load_lds((const unsigned*)(bbase + (roff[(sl) * 4 + i_] + voff0)), (LAS unsigned*)(vb + ((sl) & 3) * 4096 + i_ * 1024), 16, 0, 0); } } while (0)
        bf16x8 Qf[2];
#pragma unroll
        for (int ks = 0; ks < 2; ++ks) { if (hd < 8) Qf[ks] = *(const bf16x8*)(PROJ + tok * PROJ_W + C_Q + hd * 64 + ks * 32 + qd * 8); else Qf[ks] = (bf16x8){0, 0, 0, 0, 0, 0, 0, 0}; }
#define KSWZ(row) ((unsigned)(((row) & 3) | ((((row) >> 3) & 1) << 2)))
#define K_DMA(sl) do { _Pragma("unroll") for (int i_ = 0; i_ < 4; ++i_) { const int row_ = i_ * 8 + vrow; \
            __builtin_amdgcn_global_load_lds((const unsigned*)(bbase + (roff[(sl) * 4 + i_] + (unsigned)(C_K * 2) + (((unsigned)vch ^ KSWZ(row_)) * 16u))), (LAS unsigned*)(vb + ((sl) & 3) * 4096 + i_ * 1024), 16, 0, 0); } } while (0)
        (void)koff0;
        K_DMA(0); K_DMA(1); K_DMA(2); K_DMA(3);
        f32x4 S[16];
#pragma unroll
        for (int sl = 0; sl < 8; ++sl) {
            asm volatile("s_waitcnt vmcnt(12)" ::: "memory");
#pragma unroll
            for (int Th = 0; Th < 2; ++Th) { const int prow = (hd >> 2) * 8 + Th * 4 + (hd & 3); const unsigned fp = KSWZ(prow);
                const LAS unsigned char* ka = vb + (sl & 3) * 4096 + prow * 128;
                const bf16x8 K0 = *(const LAS bf16x8*)(ka + (((unsigned)qd ^ fp) * 16u)), K1 = *(const LAS bf16x8*)(ka + (((unsigned)(4 + qd) ^ fp) * 16u));
                f32x4 a = (f32x4){0.f, 0.f, 0.f, 0.f};
                a = __builtin_amdgcn_mfma_f32_16x16x32_bf16(K0, Qf[0], a, 0, 0, 0); a = __builtin_amdgcn_mfma_f32_16x16x32_bf16(K1, Qf[1], a, 0, 0, 0); S[2 * sl + Th] = a; }
            asm volatile("s_waitcnt lgkmcnt(0)" ::: "memory");
            if (sl + 4 < 8) K_DMA(sl + 4); else V_DMA(sl - 4);
        }
        const float slope = exp2f(-(float)((hd & 7) + 1)), abase = -slope * (float)t;
        float mx = -INFINITY;
#pragma unroll
        for (int sl = 0; sl < 8; ++sl) { const u32x4 w = *(const LAS u32x4*)((LAS unsigned char*)SELq + (sl * 32 + qd * 8) * 2);
#pragma unroll
            for (int e = 0; e < 8; ++e) { const int T = sl * 2 + (e >> 2), r = e & 3; const unsigned ww = w[e >> 1]; const float sf = (float)((e & 1) ? (ww >> 16) : (ww & 0xffffu));
                const float lgv = __builtin_fmaf(S[T][r], 0.125f, __builtin_fmaf(slope, sf, abase)); S[T][r] = lgv; } }
        if (ns < 256) {
#pragma unroll
            for (int sl = 0; sl < 8; ++sl)
#pragma unroll
                for (int e = 0; e < 8; ++e) { if (sl * 32 + qd * 8 + e >= ns) S[sl * 2 + (e >> 2)][e & 3] = -INFINITY; } }
#pragma unroll
        for (int T = 0; T < 16; ++T) { asm("v_max3_f32 %0, %0, %1, %2" : "+v"(mx) : "v"(S[T][0]), "v"(S[T][1])); asm("v_max3_f32 %0, %0, %1, %2" : "+v"(mx) : "v"(S[T][2]), "v"(S[T][3])); }
        mx = fmaxf(mx, __shfl_xor(mx, 16)); mx = fmaxf(mx, __shfl_xor(mx, 32));
        float sum = 0.f;
        const float mxl = mx * 1.44269504089f;
#pragma unroll
        for (int T = 0; T < 16; ++T)
#pragma unroll
            for (int r = 0; r < 4; ++r) { const float e = __builtin_amdgcn_exp2f(S[T][r] * 1.44269504089f - mxl); S[T][r] = e; sum += e; }
        sum += __shfl_xor(sum, 16); sum += __shfl_xor(sum, 32);
        u32x4 Pk[8];
#pragma unroll
        for (int sl = 0; sl < 8; ++sl) { Pk[sl].x = pk2(S[2 * sl][0], S[2 * sl][1]); Pk[sl].y = pk2(S[2 * sl][2], S[2 * sl][3]); Pk[sl].z = pk2(S[2 * sl + 1][0], S[2 * sl + 1][1]); Pk[sl].w = pk2(S[2 * sl + 1][2], S[2 * sl + 1][3]); }
        f32x4 O[4];
#pragma unroll
        for (int dt = 0; dt < 4; ++dt) O[dt] = (f32x4){0.f, 0.f, 0.f, 0.f};
#pragma unroll
        for (int sl = 0; sl < 8; ++sl) {
            if (sl <= 4) asm volatile("s_waitcnt vmcnt(12)" ::: "memory"); else if (sl == 5) asm volatile("s_waitcnt vmcnt(8)" ::: "memory"); else if (sl == 6) asm volatile("s_waitcnt vmcnt(4)" ::: "memory"); else asm volatile("s_waitcnt vmcnt(0)" ::: "memory");
            const unsigned a0 = vb_addr + (sl & 3) * 4096 + (8 * qd + (hd >> 2)) * 128 + (hd & 3) * 8;
            u32x2 tr[4][2];
            asm volatile("ds_read_b64_tr_b16 %0, %8\n\tds_read_b64_tr_b16 %1, %8 offset:512\n\tds_read_b64_tr_b16 %2, %8 offset:32\n\tds_read_b64_tr_b16 %3, %8 offset:544\n\t"
                         "ds_read_b64_tr_b16 %4, %8 offset:64\n\tds_read_b64_tr_b16 %5, %8 offset:576\n\tds_read_b64_tr_b16 %6, %8 offset:96\n\tds_read_b64_tr_b16 %7, %8 offset:608\n\ts_waitcnt lgkmcnt(0)"
                         : "=&v"(tr[0][0]), "=&v"(tr[0][1]), "=&v"(tr[1][0]), "=&v"(tr[1][1]), "=&v"(tr[2][0]), "=&v"(tr[2][1]), "=&v"(tr[3][0]), "=&v"(tr[3][1]) : "v"(a0) : "memory");
            if (sl + 4 < 8) V_DMA(sl + 4);
            const bf16x8 Pf = __builtin_bit_cast(bf16x8, Pk[sl]);
#pragma unroll
            for (int dt = 0; dt < 4; ++dt) { u32x4 vw; vw.x = tr[dt][0].x; vw.y = tr[dt][0].y; vw.z = tr[dt][1].x; vw.w = tr[dt][1].y;
                O[dt] = __builtin_amdgcn_mfma_f32_16x16x32_bf16(__builtin_bit_cast(bf16x8, vw), Pf, O[dt], 0, 0, 0); }
        }
#undef V_DMA
        const float inv = 1.0f / sum;
        if (hd < 8) {
#pragma unroll
            for (int dt = 0; dt < 4; ++dt) { u32x2 w; w.x = pk2(O[dt][0] * inv, O[dt][1] * inv); w.y = pk2(O[dt][2] * inv, O[dt][3] * inv);
                *(u32x2*)(YA + tok * 512 + hd * 64 + dt * 16 + qd * 4) = w; } }
    }
}

#define DPP_F(v, ctrl, rmask) __builtin_bit_cast(float, __builtin_amdgcn_update_dpp(__builtin_bit_cast(int, v), __builtin_bit_cast(int, v), ctrl, rmask, 0xf, false))
__device__ __forceinline__ float wave_max_dpp(float v) {
    asm volatile("s_nop 1\n\tv_max_f32_dpp %0, %0, %0 row_shr:1 row_mask:0xf bank_mask:0xf\n\ts_nop 1\n\tv_max_f32_dpp %0, %0, %0 row_shr:2 row_mask:0xf bank_mask:0xf\n\ts_nop 1\n\t"
                 "v_max_f32_dpp %0, %0, %0 row_shr:3 row_mask:0xf bank_mask:0xf\n\ts_nop 1\n\tv_max_f32_dpp %0, %0, %0 row_shr:4 row_mask:0xf bank_mask:0xf\n\ts_nop 1\n\t"
                 "v_max_f32_dpp %0, %0, %0 row_shr:8 row_mask:0xf bank_mask:0xf\n\ts_nop 1\n\tv_max_f32_dpp %0, %0, %0 row_bcast:15 row_mask:0xa bank_mask:0xf\n\ts_nop 1\n\t"
                 "v_max_f32_dpp %0, %0, %0 row_bcast:31 row_mask:0xc bank_mask:0xf\n\ts_nop 1" : "+v"(v));
    return __builtin_bit_cast(float, __builtin_amdgcn_readlane(__builtin_bit_cast(int, v), 63));
}
#define DPP_Z(v, ctrl, rmask, bmask) __builtin_bit_cast(float, __builtin_amdgcn_update_dpp(0, __builtin_bit_cast(int, v), ctrl, rmask, bmask, false))
__device__ __forceinline__ float wave_sum_dpp(float v0) {
    float v1 = v0 + DPP_Z(v0, 0x111, 0xf, 0xf); v1 += DPP_Z(v0, 0x112, 0xf, 0xf); v1 += DPP_Z(v0, 0x113, 0xf, 0xf);
    v1 += DPP_Z(v1, 0x114, 0xf, 0xe); v1 += DPP_Z(v1, 0x118, 0xf, 0xc);
    v1 += DPP_Z(v1, 0x142, 0xa, 0xf); v1 += DPP_Z(v1, 0x143, 0xc, 0xf);
    return __builtin_bit_cast(float, __builtin_amdgcn_readlane(__builtin_bit_cast(int, v1), 63));
}
constexpr int RT_LG = 0;
constexpr int RT_ENT = 32768;
constexpr int RT_HIST = RT_ENT + 8 * 128 * 12;
constexpr int RT_NV = 49152;
__device__ __forceinline__ void route_tile(const Params& p, LAS unsigned char* lds, int tile, int skip) {
    const int tid = tidx(), lane = tid & 63, wave = __builtin_amdgcn_readfirstlane(tid >> 6), hd = lane & 15, qd = lane >> 4;
    const float* ada = (const float*)(p.ws + WS_ADA); const float* g2 = p.in[19];
    bf16_t* U2 = (bf16_t*)(p.ws + WS_U);
    LAS int* hist = (LAS int*)(lds + RT_HIST);
    LAS float* LGT = (LAS float*)(lds + RT_LG);
    LAS int* ENT = (LAS int*)(lds + RT_ENT) + wave * 384;
    const int b = (tile * 128) >> 12;
    __syncthreads();
    if (tid < 64) hist[tid] = 0;
    if (tid == 64) hist[128] = 0;
    { LAS float* NV = (LAS float*)(lds + RT_NV);
      for (int i = tid; i < 256; i += NTHR) { const f32x4 g = *(const f32x4*)(g2 + 4 * i), sc = *(const f32x4*)(ada + b * 6144 + 4096 + 4 * i), sh = *(const f32x4*)(ada + b * 6144 + 3072 + 4 * i);
          *(LAS f32x4*)(NV + 4 * i) = g * (sc + 1.0f); *(LAS f32x4*)(NV + 1024 + 4 * i) = sh; } }
    __syncthreads();
    if (wave < 4) {
        const int tokw = tile * 128 + wave * 32;
        float rstd[2]; const bf16_t* hrow[2];
#pragma unroll
        for (int rt = 0; rt < 2; ++rt) { const int m = tokw + rt * 16 + hd; hrow[rt] = (const bf16_t*)(p.out + (size_t)m * D) + qd * 8;
            const f32x4 q4 = *(const f32x4*)((const float*)(p.ws + WS_SS) + (size_t)m * 16 + qd * 4); float ss = (q4.x + q4.y) + (q4.z + q4.w);
            ss += __shfl_xor(ss, 16); ss += __shfl_xor(ss, 32); rstd[rt] = 1.0f / sqrtf(ss * (1.f / D) + EPS); }
        const bf16x8* WH = (const bf16x8*)(p.ws + WS_WRF) + lane; const bf16x8* WL = WH + 32 * 4 * 64;
        f32x4 acc[2][4];
#pragma unroll
        for (int rt = 0; rt < 2; ++rt)
#pragma unroll
            for (int nt = 0; nt < 4; ++nt) acc[rt][nt] = (f32x4){0.f, 0.f, 0.f, 0.f};
        bf16x8 wh[4], wl[4], whn[4], wln[4]; u32x4 xa[2], xn[2], xnn[2];
#pragma unroll
        for (int nt = 0; nt < 4; ++nt) { wh[nt] = WH[nt * 64]; wl[nt] = WL[nt * 64]; }
#pragma unroll
        for (int rt = 0; rt < 2; ++rt) { xa[rt] = *(const u32x4*)(hrow[rt]); xn[rt] = *(const u32x4*)(hrow[rt] + 32); }
#pragma unroll 2
        for (int ks = 0; ks < 32; ++ks) {
            const int kn = (ks + 1 < 32) ? ks + 1 : ks;
#pragma unroll
            for (int nt = 0; nt < 4; ++nt) { whn[nt] = WH[(kn * 4 + nt) * 64]; wln[nt] = WL[(kn * 4 + nt) * 64]; }
#pragma unroll
            for (int rt = 0; rt < 2; ++rt) xnn[rt] = *(const u32x4*)(hrow[rt] + ((ks + 2 < 32) ? ks + 2 : ks) * 32);
            const int c0 = ks * 32 + qd * 8;
            const LAS float* NV = (const LAS float*)(lds + RT_NV);
            const f32x4 ma = *(const LAS f32x4*)(NV + c0), mb = *(const LAS f32x4*)(NV + c0 + 4), ha = *(const LAS f32x4*)(NV + 1024 + c0), hb = *(const LAS f32x4*)(NV + 1024 + c0 + 4);
#pragma unroll
            for (int rt = 0; rt < 2; ++rt) {
                const f32x4 x0 = {bflo(xa[rt].x), bfhi(xa[rt].x), bflo(xa[rt].y), bfhi(xa[rt].y)}, x1 = {bflo(xa[rt].z), bfhi(xa[rt].z), bflo(xa[rt].w), bfhi(xa[rt].w)};
                const f32x4 y0 = x0 * rstd[rt] * ma + ha, y1 = x1 * rstd[rt] * mb + hb;
                const u32x4 hi = pack8(y0, y1);
                f32x4 r0, r1; r0.x = y0.x - bflo(hi.x); r0.y = y0.y - bfhi(hi.x); r0.z = y0.z - bflo(hi.y); r0.w = y0.w - bfhi(hi.y);
                r1.x = y1.x - bflo(hi.z); r1.y = y1.y - bfhi(hi.z); r1.z = y1.z - bflo(hi.w); r1.w = y1.w - bfhi(hi.w);
                const bf16x8 uh = __builtin_bit_cast(bf16x8, hi), ul = __builtin_bit_cast(bf16x8, pack8(r0, r1));
#pragma unroll
                for (int nt = 0; nt < 4; ++nt) {
                    acc[rt][nt] = __builtin_amdgcn_mfma_f32_16x16x32_bf16(wh[nt], uh, acc[rt][nt], 0, 0, 0);
                    acc[rt][nt] = __builtin_amdgcn_mfma_f32_16x16x32_bf16(wl[nt], uh, acc[rt][nt], 0, 0, 0);
                    acc[rt][nt] = __builtin_amdgcn_mfma_f32_16x16x32_bf16(wh[nt], ul, acc[rt][nt], 0, 0, 0); } }
#pragma unroll
            for (int nt = 0; nt < 4; ++nt) { wh[nt] = whn[nt]; wl[nt] = wln[nt]; }
#pragma unroll
            for (int rt = 0; rt < 2; ++rt) { xa[rt] = xn[rt]; xn[rt] = xnn[rt]; }
        }
#pragma unroll
        for (int rt = 0; rt < 2; ++rt)
#pragma unroll
            for (int nt = 0; nt < 4; ++nt) *(LAS f32x4*)(LGT + (wave * 32 + rt * 16 + hd) * 64 + nt * 16 + qd * 4) = acc[rt][nt];
    }
    {
        LAS int* rowctr = hist + 128;
        LAS const float* NV = (LAS const float*)(lds + RT_NV);
        auto claim = [&]() -> int { int r = 0; if (lane == 0) r = __hip_atomic_fetch_add(rowctr, 1, __ATOMIC_RELAXED, __HIP_MEMORY_SCOPE_WORKGROUP); return __builtin_amdgcn_readfirstlane(r); };
        const float* SSp = (const float*)(p.ws + WS_SS);
#define RT_ROWLOAD(vv, sv, rr) do { if ((rr) < 128) { const int m_ = tile * 128 + (rr); const u32x4* xr_ = (const u32x4*)(p.out + (size_t)m_ * D) + lane; vv[0] = xr_[0]; vv[1] = xr_[64]; sv = SSp[(size_t)m_ * 16 + (lane & 15)]; } } while (0)
        int r = claim(), rn = claim(); u32x4 v[2] = {}, vn[2] = {}; float ssl = 0.f, ssn = 0.f;
        RT_ROWLOAD(v, ssl, r); RT_ROWLOAD(vn, ssn, rn);
        while (r < 128) {
            const int rnn = (rn < 128) ? claim() : 128; u32x4 vnn[2] = {vn[0], vn[1]}; float ssnn = 0.f;
            RT_ROWLOAD(vnn, ssnn, rnn);
            float ss = ssl; ss += __shfl_xor(ss, 1); ss += __shfl_xor(ss, 2); ss += __shfl_xor(ss, 4); ss += __shfl_xor(ss, 8);
            const float rstd = 1.0f / sqrtf(ss * (1.f / D) + EPS);
            u32x4* o16 = (u32x4*)(U2 + (size_t)(tile * 128 + r) * D) + lane;
#pragma unroll
            for (int j = 0; j < 2; ++j) { const int c0 = 8 * lane + 512 * j;
                const f32x4 ma = *(LAS const f32x4*)(NV + c0), mb = *(LAS const f32x4*)(NV + c0 + 4), sh = *(LAS const f32x4*)(NV + 1024 + c0), sb = *(LAS const f32x4*)(NV + 1024 + c0 + 4);
                const f32x4 x0 = {bflo(v[j].x), bfhi(v[j].x), bflo(v[j].y), bfhi(v[j].y)}, x1 = {bflo(v[j].z), bfhi(v[j].z), bflo(v[j].w), bfhi(v[j].w)};
                o16[64 * j] = pack8(x0 * rstd * ma + sh, x1 * rstd * mb + sb); }
            v[0] = vn[0]; v[1] = vn[1]; vn[0] = vnn[0]; vn[1] = vnn[1];
            ssl = ssn; ssn = ssnn; r = rn; rn = rnn;
        }
#undef RT_ROWLOAD
    }
    __syncthreads();
    const int tok0 = tile * 128 + wave * 16;
    LAS float* LG = LGT + wave * 1024;
    const float rbias = p.in[21][lane];
#pragma unroll 1
    for (int mi = 0; mi < 16; ++mi) {
        const float score = sigmoidf_(LG[mi * 64 + lane]); const float biased = score + rbias;
        float m1 = biased;
        m1 = fmaxf(m1, DPP_F(m1, 0xb1, 0xf)); m1 = fmaxf(m1, DPP_F(m1, 0x4e, 0xf)); m1 = fmaxf(m1, DPP_F(m1, 0x141, 0xf));
        const unsigned long long bal = __ballot(biased == m1); const int grp = lane >> 3;
        const unsigned gm = (unsigned)((bal >> (grp * 8)) & 0xffull); const int first = __ffs((int)gm) - 1;
        float v2 = ((lane & 7) == first) ? -INFINITY : biased;
        v2 = fmaxf(v2, DPP_F(v2, 0xb1, 0xf)); v2 = fmaxf(v2, DPP_F(v2, 0x4e, 0xf)); v2 = fmaxf(v2, DPP_F(v2, 0x141, 0xf));
        const float gscore = m1 + v2;
        int grank = 0;
#pragma unroll
        for (int og = 0; og < 8; ++og) { const float o = __builtin_bit_cast(float, __builtin_amdgcn_readlane(__builtin_bit_cast(int, gscore), og * 8)); grank += (o > gscore || (o == gscore && og < grp)) ? 1 : 0; }
        float mv = (grank < 4) ? biased : -INFINITY;
        unsigned long long chosen_m = 0ull;
#pragma unroll 1
        for (int it = 0; it < 8; ++it) { const float mxv = wave_max_dpp(mv); const unsigned long long e = __ballot(mv == mxv); const int w = (int)__builtin_ctzll(e); chosen_m |= 1ull << w; if (lane == w) mv = -INFINITY; }
        const bool chosen = (chosen_m >> lane) & 1ull;
        const int rank = (int)__builtin_amdgcn_mbcnt_hi((unsigned)(chosen_m >> 32), __builtin_amdgcn_mbcnt_lo((unsigned)chosen_m, 0u));
        const float gsum = wave_sum_dpp(chosen ? score : 0.f);
        if (chosen) { const int lpos = __hip_atomic_fetch_add(hist + lane, 1, __ATOMIC_RELAXED, __HIP_MEMORY_SCOPE_WORKGROUP);   const int e = mi * 8 + rank; ENT[e * 3] = lane; ENT[e * 3 + 1] = lpos; ENT[e * 3 + 2] = __builtin_bit_cast(int, score / gsum * 2.5f); }
    }
    __syncthreads();
    const int ch = (tile * 128) / CHTOK;
    if (skip) return;
    if (tid < 64) { const int c = hist[tid]; int base = 0; if (c > 0) base = (int)atomicAdd((unsigned*)(p.ws + WS_CTL) + CW_CNT + ch * NE + tid, (unsigned)c); hist[64 + tid] = base; }
    __syncthreads();
#pragma unroll
    for (int i = 0; i < 2; ++i) { const int e = lane + 64 * i; const int ex = ENT[e * 3], lpos = ENT[e * 3 + 1]; const float gate = __builtin_bit_cast(float, ENT[e * 3 + 2]);
        const int m = tok0 + (e >> 3), rk = e & 7, pair = ch * NE + ex, ps = hist[64 + ex] + lpos;
        ((int*)(p.ws + WS_DSTL))[(size_t)pair * PAIRCAP + ps] = (m - ch * CHTOK) * NSLOT + rk; ((float*)(p.ws + WS_GATEL))[(size_t)pair * PAIRCAP + ps] = gate; }
}

#define XB_TMO      128
#define XB_XCNT(j)  (256  + 64 * (j))
#define XB_XSUB(j)  (1280 + 64 * (j))
#define XB_XGEN(j)  (2304 + 64 * (j))
#define XB_TOP      3328
#define XB_TOPGEN   3392
#define XCD_BAR_WORDS 3456
#define XB_SPIN_CAP (1u << 22)
__device__ __forceinline__ unsigned xb_ld(unsigned* p)              { return __hip_atomic_load(p, __ATOMIC_RELAXED, __HIP_MEMORY_SCOPE_AGENT); }
__device__ __forceinline__ unsigned xb_add(unsigned* p, unsigned v) { return __hip_atomic_fetch_add(p, v, __ATOMIC_RELAXED, __HIP_MEMORY_SCOPE_AGENT); }
__device__ __forceinline__ unsigned xb_xcc_id() { return (unsigned)__builtin_amdgcn_s_getreg((3 << 11) | 20) & 0xFu; }
#define XB_SPIN(cond, bar) do { unsigned _sp = 0; while (cond) { __builtin_amdgcn_s_sleep(1); \
    if ((++_sp & 255u) == 0u) { if (xb_ld(&(bar)[XB_TMO])) break; if (_sp > XB_SPIN_CAP) { atomicAdd(&(bar)[XB_TMO], 1u); break; } } } } while (0)
struct XcdBarrier { unsigned* bar; unsigned x; volatile LAS unsigned* st; };
__device__ __forceinline__ XcdBarrier xcd_barrier_post(unsigned* bar, volatile LAS unsigned* st) {
    XcdBarrier b; b.bar = bar; b.x = xb_xcc_id(); b.st = st;
    if (tidx() == 0) (void)xb_add(&bar[XB_XCNT(b.x)], 1u);
    return b;
}
__device__ __forceinline__ void xcd_barrier_complete(unsigned* bar, unsigned x, unsigned& nloc, unsigned& nx) {
    const unsigned G = gridDim.x * gridDim.y * gridDim.z;
    unsigned sum, cnt, mine, sp = 0u;
    for (;;) {
        sum = 0u; cnt = 0u; mine = 0u;
#pragma unroll
        for (unsigned j = 0; j < 16; ++j) { const unsigned c = xb_ld(&bar[XB_XCNT(j)]); sum += c; cnt += (c > 0u) ? 1u : 0u; mine = (j == x) ? c : mine; }
        if (sum == G) break;
        __builtin_amdgcn_s_sleep(1);
        if ((++sp & 255u) == 0u) { if (xb_ld(&bar[XB_TMO])) break; if (sp > XB_SPIN_CAP) { atomicAdd(&bar[XB_TMO], 1u); break; } }
    }
    nloc = mine > 0u ? mine : 1u; nx = cnt > 0u ? cnt : 1u;
}
__device__ __forceinline__ void xcd_barrier(const XcdBarrier& b) {
    asm volatile("s_waitcnt vmcnt(0)" ::: "memory");
    __syncthreads();
    if (tidx() == 0) {
        unsigned* bar = b.bar;
        __builtin_amdgcn_s_waitcnt(0);
        unsigned nloc = b.st[0], nx = b.st[1];
        if (nloc == 0u) { xcd_barrier_complete(bar, b.x, nloc, nx); b.st[0] = nloc; b.st[1] = nx; }
        const unsigned old = xb_add(&bar[XB_XSUB(b.x)], 1u);
        const unsigned gen = old / nloc;
        if (old + 1u == (gen + 1u) * nloc) {
            __builtin_amdgcn_fence(__ATOMIC_RELEASE, "agent");
            asm volatile("s_waitcnt vmcnt(0)" ::: "memory");
            const unsigned og = xb_add(&bar[XB_TOP], 1u);
            const unsigned tg = og / nx;
            if (og + 1u == (tg + 1u) * nx) xb_add(&bar[XB_TOPGEN], 1u);
            else XB_SPIN(xb_ld(&bar[XB_TOPGEN]) == tg, bar);
            __builtin_amdgcn_fence(__ATOMIC_ACQUIRE, "agent");
            xb_add(&bar[XB_XGEN(b.x)], 1u);
            asm volatile("s_waitcnt vmcnt(0)" ::: "memory");
        } else {
            XB_SPIN(xb_ld(&bar[XB_XGEN(b.x)]) == gen, bar);
            __builtin_amdgcn_fence(__ATOMIC_ACQUIRE, "agent");
            asm volatile("s_waitcnt vmcnt(0)" ::: "memory");
        }
    }
    __syncthreads();
}

enum { PH_PREP = 0, PH_MOD, PH_INPROJ, PH_MIX  , PH_GLU, PH_MIXAB, PH_OUT, PH_ROUTE  , PH_MOE1, PH_MOE2_0, PH_COMB_0, PH_END };

#ifndef USE_CG_SYNC
#define USE_CG_SYNC 0
#endif
__global__ void __launch_bounds__(NTHR, 2) mega(Params p_arg) {
    extern __shared__ __attribute__((aligned(16))) unsigned char lds_raw[];
    LAS unsigned char* lds = (LAS unsigned char*)lds_raw;
    const int G = gridDim.x, bx = blockIdx.x;
    const int vcu = (G % 8 == 0) ? (bx % 8) * (G / 8) + bx / 8 : bx;
    const int tid = tidx(), lane = tid & 63, wave = __builtin_amdgcn_readfirstlane(tid >> 6);
    unsigned char* const ws_ = p_arg.ws; unsigned char* ws = ws_; (void)ws;
    if (tid < 32) ((LAS unsigned*)(lds + LDS_MISC))[tid] = 0u;
    __syncthreads();
#if USE_CG_SYNC
    cg::grid_group grid = cg::this_grid();
#define GRID_SYNC() grid.sync()
#else
    XcdBarrier xbar = xcd_barrier_post((unsigned*)(ws + WS_CTL) + CW_BAR, (volatile LAS unsigned*)(lds + LDS_MISC) + 8);
#define GRID_SYNC() xcd_barrier(xbar)
#endif
#ifndef ONLY_PH
#define ONLY_PH -1
#endif
#define IN(k) (ONLY_PH < 0 || ONLY_PH == (k))
#define SEAM(k) do { if ((k) + 1 < PH_END) GRID_SYNC(); } while (0)
#ifndef REP_PH
#define REP_PH -1
#endif
#ifndef REP_N
#define REP_N 3
#endif
#ifndef PROBE_NOSTORE
#define PROBE_NOSTORE 0
#endif
#define PHASE(k, ...) do { if (IN(k)) { { const int PROBE_SKIP = 0; unsigned zoff_ = 0u; asm volatile("" : "+s"(zoff_)); unsigned char* ws = ws_ + zoff_; const Params& p = *(const Params*)((const char*)&p_arg + zoff_); __VA_ARGS__ } if ((REP_PH) == (k)) { GRID_SYNC(); { const int PROBE_SKIP = PROBE_NOSTORE; unsigned zoff_ = 0u; asm volatile("" : "+s"(zoff_)); unsigned char* ws = ws_ + zoff_; const Params& p = *(const Params*)((const char*)&p_arg + zoff_); __VA_ARGS__ } GRID_SYNC(); { const int PROBE_SKIP = PROBE_NOSTORE; unsigned zoff_ = 0u; asm volatile("" : "+s"(zoff_)); unsigned char* ws = ws_ + zoff_; const Params& p = *(const Params*)((const char*)&p_arg + zoff_); __VA_ARGS__ } } } SEAM(k); } while (0)
    PHASE(PH_PREP, p0_prep(p, lds, vcu, G););
    PHASE(PH_MOD, p1_modulate(p, vcu, G););
    PHASE(PH_INPROJ, {
        pg8::DenseSched S; S.init(ws + WS_U, ws + WS_W_IN, NTOK, NIN, 1024, G, bx);
        EpiInProj E{(bf16_t*)(ws + WS_PROJ), (bf16_t*)(ws + WS_G), (bf16_t*)(ws + WS_KIF)};
        pg8::gemm_phase<EpiInProj, pg8::DenseSched, false>(lds, 1024, S, E);
        if (G == 256 && bx >= 128) { __syncthreads(); run_transposes(p, ws, lds, T_NITEMS - T_LATE2 - T_LATE, T_NITEMS - T_LATE2, (bx - 128) * NWAVES + wave, 128 * NWAVES); } });
    PHASE(PH_MIX, {
#ifdef GOLD_S5
        for (int it = vcu + G * wave; it < 256; it += G * NWAVES) gold_s5(p, it, lane);
#else
#ifndef REP_S5
#define REP_S5 1
#endif
#ifndef REP_ATTN
#define REP_ATTN 1
#endif
        for (int r_ = 0; r_ < REP_S5; ++r_) for (int it = vcu; it < 256; it += G) s5_item(p, lds, it);
#endif
#ifdef GOLD_ATTN
        for (int pr = vcu; pr < NTOK / 2; pr += G) gold_attn_pair(p, lds, pr);
#else
        for (int r_ = 0; r_ < REP_ATTN; ++r_) {
            for (int k = 0; ; ++k) { int ab, aq;
                if (G == 256) { if (k >= 16) break; ab = vcu >> 5; aq = 511 - ((vcu & 31) + 32 * k); }
                else { const int it = vcu + k * G; if (it >= NTOK / 8) break; ab = it & 7; aq = 511 - (it >> 3); }
                attn_item(p, lds, ab, aq); } }
#endif
        __syncthreads(); });
    PHASE(PH_GLU, {
        pg8::DenseSched S; S.init(ws + WS_YG, ws + WS_W_GLU, NTOK, 512, 512, G, bx);
        EpiGlu E{(const bf16_t*)(ws + WS_YG), p.in[15], (bf16_t*)(ws + WS_U)};
        pg8::gemm_phase<EpiGlu, pg8::DenseSched, false>(lds, 512, S, E); });
    PHASE(PH_MIXAB, {
        MixSched S; S.D0.init(ws + WS_U, ws + WS_W_PS, NTOK, 1024, 512, G, bx); S.D1.init(ws + WS_YATTN, ws + WS_W_PA, NTOK, 1024, 512, G, bx);
        EpiMix E{(const bf16_t*)(ws + WS_G), (bf16_t*)(ws + WS_MERGED)};
        pg8::gemm_phase<EpiMix, MixSched, false, false, true>(lds, 512, S, E); });
    PHASE(PH_OUT, {
        pg8::DenseSched S; S.init(ws + WS_MERGED, ws + WS_W_OUT, NTOK, 1024, 1024, G, bx);
        EpiOut E{p.in[0], (const float*)(ws + WS_ADA), p.out, (float*)(ws + WS_SS)};
        pg8::gemm_phase<EpiOut, pg8::DenseSched, false>(lds, 1024, S, E); });
    PHASE(PH_ROUTE, { for (int tile = vcu; tile < NTOK / 128; tile += G) route_tile(p, lds, tile, PROBE_SKIP); });
    PHASE(PH_MOE1, {
        build_moe_tables(lds, (const unsigned*)(ws + WS_CTL) + CW_CNT);
        Moe1Sched S{lds, G, vcu, (const char*)(ws + WS_U), (const int*)(ws + WS_DSTL), (const int*)(ws + WS_IDENT), (const char*)(ws + WS_W_EGU), (const char*)(ws + WS_W_SGU)};
        EpiMoe1 E{(bf16_t*)(ws + WS_H)};
        pg8::gemm_phase<EpiMoe1, Moe1Sched, true>(lds, 1024, S, E);
        { LAS int* TB_ = (LAS int*)(lds + LDS_TB); const int total = (RFL(TB_[256]) + 128) * 2, rem = total % G, nidle = rem ? G - rem : 0;
          __syncthreads();
          if (nidle == 0) run_transposes(p, ws, lds, T_NITEMS - T_LATE2, T_NITEMS, vcu * NWAVES + wave, G * NWAVES);
          else if (vcu >= rem) run_transposes(p, ws, lds, T_NITEMS - T_LATE2, T_NITEMS, (vcu - rem) * NWAVES + wave, nidle * NWAVES); } });
#pragma unroll
    for (int ch = 0; ch < NCHUNK; ++ch) {
        PHASE(PH_MOE2_0 + 2 * ch, {
            build_moe_tables(lds, (const unsigned*)(ws + WS_CTL) + CW_CNT);
            Moe2Sched S{lds, G, vcu, ch, ws};
            EpiMoe2 E{(unsigned char*)(ws + WS_Y), PROBE_SKIP, lds};
            pg8::gemm_phase<EpiMoe2, Moe2Sched, false, true>(lds, 256, S, E); });
        PHASE(PH_COMB_0 + 2 * ch, { p_combine(p, vcu, G, ch); });
    }
#undef IN
}

extern "C" void kernel_launch(void* const* d_in, const int* in_sizes, int n_in, void* d_out, int out_size, void* d_ws, size_t ws_size, hipStream_t stream) {
    static int grid = 0;
    if (grid == 0) {
        if (n_in != 29 || out_size != NTOK * D || ws_size < WS_NEED) { fprintf(stderr, "kernel_launch: unexpected shapes n_in %d out %d ws %zu\n", n_in, out_size, ws_size); grid = -1; return; }
        int dev = 0, cus = 0, per_cu = 0;
        hipGetDevice(&dev); hipDeviceGetAttribute(&cus, hipDeviceAttributeMultiprocessorCount, dev);
        hipFuncSetAttribute((const void*)mega, hipFuncAttributeMaxDynamicSharedMemorySize, LDS_BYTES);
        hipOccupancyMaxActiveBlocksPerMultiprocessor(&per_cu, (const void*)mega, NTHR, LDS_BYTES);
        (void)hipGetLastError();
        grid = (per_cu >= 1) ? cus : -1;
        if (grid < 0) { fprintf(stderr, "kernel_launch: occupancy query says %d blocks/CU\n", per_cu); return; }
    }
    if (grid < 0) return;
    hipMemsetAsync((char*)d_ws + WS_CTL, 0, CTL_BYTES, stream);
    Params p{};
    for (int i = 0; i < 29; ++i) p.in[i] = (const float*)d_in[i];
    p.out = (float*)d_out; p.ws = (unsigned char*)d_ws;
    p.ph_lo = 0; p.ph_hi = PH_END;
    void* args[] = {&p};
    hipError_t e = hipLaunchCooperativeKernel((const void*)mega, dim3(grid), dim3(NTHR), args, LDS_BYTES, stream);
    if (e != hipSuccess) fprintf(stderr, "kernel_launch: cooperative launch failed: %s (grid %d)\n", hipGetErrorString(e), grid);
}
```

```cpp
#include <hip/hip_runtime.h>
#include <hip/hip_cooperative_groups.h>
#include <cstdio>
#include <cstdint>
#include <cmath>
namespace cg = cooperative_groups;

#define GAS __attribute__((address_space(1)))
#define LAS __attribute__((address_space(3)))
typedef unsigned short bf16_t;
typedef short bf16x8 __attribute__((ext_vector_type(8)));
typedef float f32x4 __attribute__((ext_vector_type(4)));
typedef float f32x2 __attribute__((ext_vector_type(2)));
typedef unsigned u32x4 __attribute__((ext_vector_type(4)));
typedef unsigned u32x2 __attribute__((ext_vector_type(2)));

constexpr int NB = 8, SEQ = 4096, NTOK = NB * SEQ, D = 1024;
constexpr int IN_W = 3784, NIN = 3840, PROJ_W = 1792, G_W = 2048;
constexpr int C_USSM = 0, C_Q = 512, C_K = 1024, C_V = 1088, C_QI = 1152, C_KI = 1664, C_WI = 1728, PROJ_USED = 1736;
constexpr int NE = 64, TOPK = 8, NCHUNK = 1, CHTOK = NTOK / NCHUNK, NPAIR = NCHUNK * NE, PAIRCAP = CHTOK, NSLOT = 9;
constexpr float Y_SCALE = 64.0f;
constexpr int HROWS_ROUTED = NTOK * TOPK, HSH_ROW0 = HROWS_ROUTED + 256;
constexpr float EPS = 1e-6f;
constexpr int NWAVES = 8, NTHR = 512;

constexpr size_t MiB = 1u << 20;
constexpr size_t WS_CTL = 0, CTL_BYTES = 1 * MiB;
constexpr size_t WS_ADA = 1 * MiB;
constexpr size_t WS_ONES = 1 * MiB + 224 * 1024;
constexpr size_t WS_A32 = 1 * MiB + 256 * 1024;
constexpr size_t WS_IDENT = 1 * MiB + 512 * 1024;
constexpr size_t WS_WRF = 1 * MiB + 768 * 1024;
constexpr size_t WS_W_IN = 2 * MiB;
constexpr size_t WS_W_GLU = 10 * MiB;
constexpr size_t WS_W_PS = 11 * MiB;
constexpr size_t WS_W_PA = 12 * MiB;
constexpr size_t WS_W_OUT = 13 * MiB;
constexpr size_t WS_W_SGU = 15 * MiB;
constexpr size_t WS_W_SD = 16 * MiB;
constexpr size_t WS_TZF = 17 * MiB, WS_WINF = 18 * MiB, WS_WOUTF = 22 * MiB;
constexpr size_t WS_W_ED = 26 * MiB;
constexpr size_t WS_W_EGU = 58 * MiB;
constexpr size_t WS_KIF = 122 * MiB;
constexpr size_t WS_U = 128 * MiB;
constexpr size_t WS_PROJ = 192 * MiB;
constexpr size_t WS_G = 304 * MiB;
constexpr size_t WS_YG = 432 * MiB;
constexpr size_t WS_YATTN = 464 * MiB;
constexpr size_t WS_MERGED = 192 * MiB;
constexpr size_t WS_Y = 58 * MiB;
constexpr size_t WS_H = 346 * MiB;
constexpr size_t WS_DSTL = 492 * MiB;
constexpr size_t WS_SS = 4 * MiB;
constexpr size_t WS_GATEL = 500 * MiB;
constexpr size_t WS_NEED = 512 * MiB;
constexpr int CW_CNT = 0;
constexpr int CW_BAR = 4096;
constexpr int CW_Q0 = 1024;

constexpr int STAGE_BYTES = 131072;
constexpr int LDS_RO = STAGE_BYTES;
constexpr int LDS_MISC = LDS_RO + 2048;
constexpr int LDS_CNT = LDS_MISC + 128;
constexpr int LDS_RS = LDS_CNT + 1024;
constexpr int LDS_TB = LDS_RS + 1040;
constexpr int LDS_TD = LDS_TB + 1040;
constexpr int LDS_META = LDS_TD + 1408 * 4;
constexpr int LDS_BYTES = 147456;
static_assert(LDS_META + 4096 <= LDS_BYTES, "LDS map");

__device__ __forceinline__ unsigned f2bf(float f) { unsigned u = __builtin_bit_cast(unsigned, f); return (u + 0x7fffu + ((u >> 16) & 1u)) >> 16; }
typedef __bf16 bf16x2_t __attribute__((ext_vector_type(2)));
__device__ __forceinline__ unsigned pk2(float lo, float hi) { const f32x2 v = {lo, hi}; const bf16x2_t r = __builtin_convertvector(v, bf16x2_t); return __builtin_bit_cast(unsigned, r); }
__device__ __forceinline__ float bf2f(unsigned short b) { return __builtin_bit_cast(float, (unsigned)b << 16); }
__device__ __forceinline__ float bflo(unsigned w) { return __builtin_bit_cast(float, w << 16); }
__device__ __forceinline__ float bfhi(unsigned w) { return __builtin_bit_cast(float, w & 0xffff0000u); }
__device__ __forceinline__ float sigmoidf_(float x) { return __builtin_amdgcn_rcpf(1.0f + __builtin_amdgcn_exp2f(-1.44269504089f * x)); }
__device__ __forceinline__ float wave_sum(float v) {
#pragma unroll
    for (int o = 1; o < 64; o <<= 1) v += __shfl_xor(v, o);
    return v;
}
__device__ __forceinline__ int tidx() { int t = threadIdx.x; asm volatile("" : "+v"(t)); return t; }
#define LDS_WAIT() asm volatile("s_waitcnt lgkmcnt(0)" ::: "memory")

namespace pg8 {
constexpr int BM = 256, BK = 64, HALF = 128, HTB = HALF * BK * 2, NXCD = 8, WGM = 8;
__host__ __device__ __forceinline__ int lds_byte(int r, int c) { const int st = (r >> 4) * 2 + (c >> 5), rr = r & 15, cc = c & 31, ob = rr * 64 + cc * 2; return st * 1024 + (ob ^ (((ob >> 9) & 1) << 5)); }
__host__ __device__ __forceinline__ void stage_rc(int b, int& R, int& C) { const int st = b / 1024, sb = b % 1024, swz = sb ^ (((sb >> 9) & 1) << 5); R = (st >> 1) * 16 + swz / 64; C = (st & 1) * 32 + (swz % 64) / 2; }
__host__ __device__ __forceinline__ int perm32(int rho) { const int n = rho >> 4, i = rho & 15; return 8 * (i >> 2) + 4 * n + (i & 3); }

struct Unit { int pm, pn; const char* A; const char* B; const int* rows; int valid; int x0; int rbase; const float* gp; };

struct DenseSched {
    int nM, nN, nwg, G, c; const char* A; const char* B; size_t tstep;
    __device__ __forceinline__ void init(const void* A_, const void* B_, int M, int N, int K, int G_, int c_) { nM = M / BM; nN = N / BM; nwg = nM * nN; G = G_; c = c_; A = (const char*)A_; B = (const char*)B_; tstep = (size_t)BM * K * 2; }
    __device__ __forceinline__ bool next(int i, Unit& u) const {
        const long L = (long)i * G + c; if (L >= nwg) return false;
        int wgid = (int)L; { const int q = nwg / NXCD, r = nwg % NXCD, xcd = wgid % NXCD, off = wgid / NXCD; wgid = (xcd < r ? xcd * (q + 1) : r * (q + 1) + (xcd - r) * q) + off; }
        const int nig = WGM * nN, gid = wgid / nig, fm = gid * WGM, gsz = (nM - fm) < WGM ? (nM - fm) : WGM;
        u.pm = fm + ((wgid % nig) % gsz); u.pn = (wgid % nig) / gsz;
        u.A = A + (size_t)u.pm * tstep; u.B = B + (size_t)u.pn * tstep; u.rows = nullptr; u.valid = 256; u.x0 = 0; u.rbase = 0; u.gp = nullptr; return true;
    }
};

template <class Epi, class Sched, bool GATHER, bool RMETA = false, bool KEEPACC = false>
__device__ __forceinline__ void gemm_phase(LAS unsigned char* lds, const int K, const Sched& S, const Epi& E) {
    int tid_ = tidx(); asm volatile("" : "+v"(tid_));
    const int tid = tid_, wid = __builtin_amdgcn_readfirstlane(tid >> 6), lane = tid & 63, wr = wid >> 2, wc = wid & 3, fr = lane & 15, fq = lane >> 4;
    const int nt = K / BK;
    unsigned voffA[2], voffB[2]; int roA[2];
#pragma unroll
    for (int i = 0; i < 2; ++i) { int R, C; stage_rc(tid * 16 + i * 8192, R, C); const int Rb = (R & ~31) + perm32(R & 31);
        voffA[i] = GATHER ? (unsigned)(C * 2) : (unsigned)(R * K + C) * 2u; voffB[i] = (unsigned)(Rb * K + C) * 2u; roA[i] = R * 4; }
    const size_t kstep = (size_t)(BK * 2);
    const size_t hstep = (size_t)HALF * K * 2;
    const unsigned ldsw = (unsigned)wid * 1024u;
    const int aoff = lds_byte(wr * 64 + fr, fq * 8), boff = lds_byte(wc * 32 + fr, fq * 8);
    LAS unsigned char* ro = lds + LDS_RO;
#define PG8_SA(b, h) (((b) * 2 + (h)) * HTB)
#define PG8_SB(b, h) ((4 + (b) * 2 + (h)) * HTB)
#define PG8_STAGE_B(bufoff, gbase) do { _Pragma("unroll") for (int _i = 0; _i < 2; ++_i) \
        __builtin_amdgcn_global_load_lds((const unsigned*)((const char*)(gbase) + voffB[_i]), (LAS unsigned*)(lds + (bufoff) + ldsw + _i * 8192), 16, 0, 0); } while (0)
#define PG8_STAGE_A(bufoff, gbase, h, slot) do { _Pragma("unroll") for (int _i = 0; _i < 2; ++_i) { \
        unsigned _vo = voffA[_i]; const char* _gb = (const char*)(gbase); \
        if (GATHER) _vo += *(const LAS unsigned*)(ro + (slot) * 1024 + (h) * 512 + roA[_i]); else _gb += (h) * hstep; \
        __builtin_amdgcn_global_load_lds((const unsigned*)(_gb + _vo), (LAS unsigned*)(lds + (bufoff) + ldsw + _i * 8192), 16, 0, 0); } } while (0)
#define PG8_LDA(dst, b, h) do { _Pragma("unroll") for (int m = 0; m < 4; ++m) _Pragma("unroll") for (int k = 0; k < 2; ++k) dst[m][k] = *(const LAS bf16x8*)(lds + PG8_SA(b, h) + aoff + m * 2048 + k * 1024); } while (0)
#define PG8_LDB(dst, b, h) do { _Pragma("unroll") for (int n = 0; n < 2; ++n) _Pragma("unroll") for (int k = 0; k < 2; ++k) dst[n][k] = *(const LAS bf16x8*)(lds + PG8_SB(b, h) + boff + n * 2048 + k * 1024); } while (0)
#define PG8_MMA(ai, bj, At, Bt) do { __builtin_amdgcn_s_setprio(1); _Pragma("unroll") for (int m = 0; m < 4; ++m) _Pragma("unroll") for (int n = 0; n < 2; ++n) _Pragma("unroll") for (int k = 0; k < 2; ++k) \
        acc[ai][bj][m][n] = __builtin_amdgcn_mfma_f32_16x16x32_bf16(Bt[n][k], At[m][k], acc[ai][bj][m][n], 0, 0, 0); __builtin_amdgcn_s_setprio(0); } while (0)
#define PG8_WAIT_V(n) asm volatile("s_waitcnt vmcnt(" #n ")" ::: "memory")
#define PG8_WAIT_L(n) asm volatile("s_waitcnt lgkmcnt(" #n ")" ::: "memory")
#define PG8_BAR __builtin_amdgcn_s_barrier()
#define PG8_SCHED __builtin_amdgcn_sched_barrier(0)
    Unit cur, nxt; int ui = 0;
    if (!S.next(0, cur)) return;
    f32x4 acc[2][2][4][2];
#pragma unroll
    for (int a = 0; a < 2; ++a)
#pragma unroll
        for (int b = 0; b < 2; ++b)
#pragma unroll
            for (int m = 0; m < 4; ++m)
#pragma unroll
                for (int n = 0; n < 2; ++n) acc[a][b][m][n] = (f32x4){0.f, 0.f, 0.f, 0.f};
    bf16x8 At[4][2], B0[2][2], B1[2][2];
    const char* cA = cur.A; const char* cB = cur.B;
    if (GATHER) {
        if (tid < 256) { const int r = tid < cur.valid ? cur.rbase + cur.rows[tid] / NSLOT : 0; *(LAS unsigned*)(ro + tid * 4) = (unsigned)r * (unsigned)(K * 2); }
        __syncthreads();
    }
    PG8_STAGE_B(PG8_SB(0, 0), cB); PG8_STAGE_B(PG8_SB(0, 1), cB + hstep); PG8_STAGE_A(PG8_SA(0, 0), cA, 0, 0); PG8_STAGE_A(PG8_SA(0, 1), cA, 1, 0);
    if (wr == 1) PG8_BAR;
    PG8_WAIT_V(2); PG8_BAR;
    PG8_STAGE_B(PG8_SB(1, 0), cB + kstep); PG8_STAGE_A(PG8_SA(1, 0), cA + kstep, 0, 0); PG8_STAGE_B(PG8_SB(1, 1), cB + hstep + kstep);
    PG8_WAIT_V(6); PG8_BAR;
    for (;;) {
        const bool has_next = S.next(ui + 1, nxt);
        const int cslot = ui & 1, nslot = has_next ? (cslot ^ 1) : cslot;
        int pre_r = 0;
        if (GATHER) { if (has_next && tid < 256 && tid < nxt.valid) pre_r = nxt.rows[tid]; }
        if (RMETA) { if (wid < 4) {
            __builtin_amdgcn_global_load_lds((const unsigned*)(cur.gp + lane + wid * 64), (LAS unsigned*)(lds + LDS_META + cslot * 1024 + wid * 256), 4, 0, 0);
            __builtin_amdgcn_global_load_lds((const unsigned*)(cur.rows + lane + wid * 64), (LAS unsigned*)(lds + LDS_META + 2048 + cslot * 1024 + wid * 256), 4, 0, 0); } }
        const char* nA = has_next ? nxt.A : cA; const char* nB = has_next ? nxt.B : cB;
#pragma unroll 1
        for (int t = 0; t < nt; t += 2) {
            const bool last = (t == nt - 2);
            const char* a1 = cA + (size_t)(t + 1) * kstep;
            const char* a2 = last ? nA : cA + (size_t)(t + 2) * kstep; const char* b2 = last ? nB : cB + (size_t)(t + 2) * kstep;
            const char* a3 = a2 + kstep; const char* b3 = b2 + kstep;
            const int slot2 = last ? nslot : cslot;
            if (t == 2 || nt == 2) {
                if (GATHER) { if (has_next && tid < 256) { const int r = tid < nxt.valid ? nxt.rbase + pre_r / NSLOT : 0; *(LAS unsigned*)(ro + nslot * 1024 + tid * 4) = (unsigned)r * (unsigned)(K * 2); } }
            }
            PG8_LDB(B0, 0, 0); PG8_LDB(B1, 0, 1); PG8_SCHED; PG8_LDA(At, 0, 0); PG8_STAGE_A(PG8_SA(1, 1), a1, 1, cslot);
            PG8_WAIT_V(8); PG8_WAIT_L(0); PG8_BAR; PG8_MMA(0, 0, At, B0); PG8_MMA(0, 1, At, B1); PG8_BAR; PG8_SCHED;
            PG8_LDA(At, 0, 1); PG8_STAGE_B(PG8_SB(0, 0), b2); PG8_STAGE_B(PG8_SB(0, 1), b2 + hstep); PG8_STAGE_A(PG8_SA(0, 0), a2, 0, slot2);
            PG8_WAIT_V(8); PG8_WAIT_L(0); PG8_BAR; PG8_MMA(1, 0, At, B0); PG8_MMA(1, 1, At, B1); PG8_BAR; PG8_SCHED;
            PG8_LDB(B0, 1, 0); PG8_LDB(B1, 1, 1); PG8_SCHED; PG8_LDA(At, 1, 0); PG8_STAGE_A(PG8_SA(0, 1), a2, 1, slot2);
            PG8_WAIT_V(8); PG8_WAIT_L(0); PG8_BAR; PG8_MMA(0, 0, At, B0); PG8_MMA(0, 1, At, B1); PG8_BAR; PG8_SCHED;
            PG8_LDA(At, 1, 1); PG8_STAGE_B(PG8_SB(1, 0), b3); PG8_STAGE_B(PG8_SB(1, 1), b3 + hstep); PG8_STAGE_A(PG8_SA(1, 0), a3, 0, slot2);
            PG8_WAIT_V(8); PG8_WAIT_L(0); PG8_BAR; PG8_MMA(1, 0, At, B0); PG8_MMA(1, 1, At, B1); PG8_BAR; PG8_SCHED;
        }
        if (wr == 0) PG8_BAR;
        E(acc, cur, wr, wc, fr, fq, lds + LDS_META + (ui & 1) * 1024);
        if (!has_next) break;
        if (!KEEPACC || nxt.x0 == 0) {
#pragma unroll
        for (int a = 0; a < 2; ++a)
#pragma unroll
            for (int b = 0; b < 2; ++b)
#pragma unroll
                for (int m = 0; m < 4; ++m)
#pragma unroll
                    for (int n = 0; n < 2; ++n) acc[a][b][m][n] = (f32x4){0.f, 0.f, 0.f, 0.f};
        }
        cur = nxt; cA = nA; cB = nB; ++ui;
        if (wr == 1) PG8_BAR;
    }
    PG8_WAIT_V(0);
    PG8_BAR;
#undef PG8_SA
#undef PG8_SB
#undef PG8_STAGE_A
#undef PG8_STAGE_B
#undef PG8_LDA
#undef PG8_LDB
#undef PG8_MMA
#undef PG8_WAIT_V
#undef PG8_WAIT_L
#undef PG8_BAR
#undef PG8_SCHED
}
}
using pg8::Unit;

#define EPI_LOOP_BEGIN \
    _Pragma("unroll") for (int ai = 0; ai < 2; ++ai) _Pragma("unroll") for (int m = 0; m < 4; ++m) { const int rl = ai * 128 + wr * 64 + m * 16 + fr; const int row = u.pm * 256 + rl; \
    _Pragma("unroll") for (int bj = 0; bj < 2; ++bj) { const int col = u.pn * 256 + bj * 128 + wc * 32 + 8 * fq; const f32x4 v0 = acc[ai][bj][m][0], v1 = acc[ai][bj][m][1]; (void)row; (void)col; (void)rl;
#define EPI_LOOP_END } if (m == 3) asm volatile("" ::: "memory"); }
__device__ __forceinline__ u32x4 pack8(const f32x4 a, const f32x4 b) { u32x4 w; w.x = pk2(a[0], a[1]); w.y = pk2(a[2], a[3]); w.z = pk2(b[0], b[1]); w.w = pk2(b[2], b[3]); return w; }
__device__ __forceinline__ void unpack8(const u32x4 w, float (&f)[8]) { f[0] = bflo(w.x); f[1] = bfhi(w.x); f[2] = bflo(w.y); f[3] = bfhi(w.y); f[4] = bflo(w.z); f[5] = bfhi(w.z); f[6] = bflo(w.w); f[7] = bfhi(w.w); }

struct EpiInProj {
    bf16_t* PROJ; bf16_t* G; bf16_t* KIF;
    __device__ __forceinline__ void operator()(const f32x4 (&acc)[2][2][4][2], const Unit& u, int wr, int wc, int fr, int fq, LAS unsigned char* meta) const {
        if (u.pn < 7) {
        EPI_LOOP_BEGIN
            { const u32x4 w8 = pack8(v0, v1); *(u32x4*)(PROJ + (size_t)row * PROJ_W + col) = w8;
                if (u.pn == 6 && col >= C_KI && col < C_KI + 64) { const int d0 = col - C_KI, key = row & 4095, bb = row >> 12;
                    *(u32x4*)(KIF + ((size_t)((bb * 128 + (key >> 5)) * 4 + (d0 >> 4)) * 64 + (key & 31) + 32 * ((d0 >> 3) & 1)) * 8) = w8; } }
        EPI_LOOP_END
        } else {
            const int ch0 = (u.pn - 7) * 128 + wc * 32 + 8 * fq;
#pragma unroll
            for (int ai = 0; ai < 2; ++ai)
#pragma unroll
                for (int m = 0; m < 4; ++m) { const int row = u.pm * 256 + ai * 128 + wr * 64 + m * 16 + fr;
                    f32x4 s2a, s2b;
#pragma unroll
                    for (int j = 0; j < 4; ++j) { s2a[j] = fmaxf(sigmoidf_(acc[ai][1][m][0][j]), 1e-6f); s2b[j] = fmaxf(sigmoidf_(acc[ai][1][m][1][j]), 1e-6f); }
                    const u32x4 w2 = pack8(s2a, s2b); float s2r[8]; unpack8(w2, s2r); f32x4 r0, r1;
#pragma unroll
                    for (int j = 0; j < 4; ++j) { r0[j] = sigmoidf_(acc[ai][0][m][0][j]) * __builtin_amdgcn_rcpf(s2r[j]); r1[j] = sigmoidf_(acc[ai][0][m][1][j]) * __builtin_amdgcn_rcpf(s2r[4 + j]); }
                    *(u32x4*)(G + (size_t)row * G_W + ch0) = pack8(r0, r1); *(u32x4*)(G + (size_t)row * G_W + 1024 + ch0) = w2;
                    asm volatile("" ::: "memory"); __builtin_amdgcn_sched_barrier(0); }
        }
    }
};
struct EpiGlu {
    const bf16_t* YG; const float* bias; bf16_t* O;
    __device__ __forceinline__ void operator()(const f32x4 (&acc)[2][2][4][2], const Unit& u, int wr, int wc, int fr, int fq, LAS unsigned char* meta) const {
        f32x4 bb[2][2];
#pragma unroll
        for (int bj = 0; bj < 2; ++bj) { const int col = u.pn * 256 + bj * 128 + wc * 32 + 8 * fq; bb[bj][0] = *(const f32x4*)(bias + col); bb[bj][1] = *(const f32x4*)(bias + col + 4); }
        EPI_LOOP_BEGIN
            float y[8]; unpack8(*(const u32x4*)(YG + (size_t)row * 512 + col), y);
            const f32x4 b0 = bb[bj][0], b1 = bb[bj][1]; f32x4 o0, o1;
#pragma unroll
            for (int j = 0; j < 4; ++j) { o0[j] = y[j] * sigmoidf_(v0[j] + b0[j]); o1[j] = y[4 + j] * sigmoidf_(v1[j] + b1[j]); }
            *(u32x4*)(O + (size_t)row * 512 + col) = pack8(o0, o1);
        EPI_LOOP_END
    }
};
struct EpiMix {
    const bf16_t* G; bf16_t* O;
    __device__ __forceinline__ void operator()(f32x4 (&acc)[2][2][4][2], const Unit& u, int wr, int wc, int fr, int fq, LAS unsigned char* meta) const {
        unsigned rowl = (unsigned)(wr * 64 + fr); asm volatile("" : "+v"(rowl));
        const size_t gbase = (size_t)(u.pm * 256 + rowl) * G_W + u.pn * 256 + wc * 32 + 8 * fq + (u.x0 ? 1024 : 0);
#define EPM_LOADS u32x4 q[2][4][2]; _Pragma("unroll") for (int ai = 0; ai < 2; ++ai) _Pragma("unroll") for (int m = 0; m < 4; ++m) _Pragma("unroll") for (int bj = 0; bj < 2; ++bj) q[ai][m][bj] = *(const u32x4*)(G + gbase + (size_t)(ai * 128 + m * 16) * G_W + bj * 128)
        if (u.x0 == 0) { EPM_LOADS;
#pragma unroll
            for (int ai = 0; ai < 2; ++ai)
#pragma unroll
                for (int m = 0; m < 4; ++m)
#pragma unroll
                    for (int bj = 0; bj < 2; ++bj) { float g[8]; unpack8(q[ai][m][bj], g);
#pragma unroll
                        for (int j = 0; j < 4; ++j) { acc[ai][bj][m][0][j] *= g[j]; acc[ai][bj][m][1][j] *= g[4 + j]; } }
        } else { asm volatile("" : "+v"(rowl)); const size_t gbase = (size_t)(u.pm * 256 + rowl) * G_W + u.pn * 256 + wc * 32 + 8 * fq + 1024; EPM_LOADS;
#pragma unroll
            for (int ai = 0; ai < 2; ++ai)
#pragma unroll
                for (int m = 0; m < 4; ++m)
#pragma unroll
                    for (int bj = 0; bj < 2; ++bj) { float g2[8]; unpack8(q[ai][m][bj], g2); f32x4 o0, o1;
#pragma unroll
                        for (int j = 0; j < 4; ++j) { o0[j] = acc[ai][bj][m][0][j] * g2[j]; o1[j] = acc[ai][bj][m][1][j] * g2[4 + j]; }
                        *(u32x4*)(O + (size_t)(u.pm * 256 + ai * 128 + wr * 64 + m * 16 + fr) * D + u.pn * 256 + bj * 128 + wc * 32 + 8 * fq) = pack8(o0, o1); }
        }
#undef EPM_LOADS
    }
};
struct MixSched {
    pg8::DenseSched D0, D1;
    __device__ __forceinline__ bool next(int i, Unit& u) const { const bool ok = (i & 1) ? D1.next(i >> 1, u) : D0.next(i >> 1, u); u.x0 = i & 1; return ok; }
};
struct EpiOut {
    const float* X; const float* ada; float* O; float* SS;
    __device__ __forceinline__ void operator()(const f32x4 (&acc)[2][2][4][2], const Unit& u, int wr, int wc, int fr, int fq, LAS unsigned char* meta) const {
        f32x4 gg[2][2];
#pragma unroll
        for (int bj = 0; bj < 2; ++bj) { const float* gp = ada + (size_t)((u.pm * 256) >> 12) * 6144 + 2048 + u.pn * 256 + bj * 128 + wc * 32 + 8 * fq; gg[bj][0] = *(const f32x4*)gp; gg[bj][1] = *(const f32x4*)(gp + 4); }
        const size_t base = (size_t)(u.pm * 256 + wr * 64 + fr) * D + u.pn * 256 + wc * 32 + 8 * fq;
        f32x4 xq[3][2][2];
#define EPO_LOAD(slot, rg) do { const size_t o_ = base + (size_t)(((rg) >> 2) * 128 + ((rg) & 3) * 16) * D; _Pragma("unroll") for (int bj = 0; bj < 2; ++bj) { xq[slot][bj][0] = *(const f32x4*)(X + o_ + bj * 128); xq[slot][bj][1] = *(const f32x4*)(X + o_ + bj * 128 + 4); } } while (0)
        EPO_LOAD(0, 0); EPO_LOAD(1, 1);
#pragma unroll
        for (int rg = 0; rg < 8; ++rg) { const int ai = rg >> 2, m = rg & 3;
            if (rg + 2 < 8) EPO_LOAD((rg + 2) % 3, rg + 2);
            const size_t o_ = base + (size_t)(ai * 128 + m * 16) * D; float ss = 0.f;
#pragma unroll
            for (int bj = 0; bj < 2; ++bj) { const f32x4 o0 = xq[rg % 3][bj][0] + gg[bj][0] * acc[ai][bj][m][0], o1 = xq[rg % 3][bj][1] + gg[bj][1] * acc[ai][bj][m][1];
                *(u32x4*)((bf16_t*)O + 2 * (o_ - (size_t)(u.pn * 256 + wc * 32 + 8 * fq)) + (u.pn * 256 + wc * 32 + 8 * fq) + bj * 128) = pack8(o0, o1);
                ss += (o0.x * o0.x + o0.y * o0.y) + (o0.z * o0.z + o0.w * o0.w) + (o1.x * o1.x + o1.y * o1.y) + (o1.z * o1.z + o1.w * o1.w); }
            ss += __shfl_xor(ss, 16); ss += __shfl_xor(ss, 32);
            if (fq == 0) SS[(size_t)(u.pm * 256 + ai * 128 + wr * 64 + m * 16 + fr) * 16 + u.pn * 4 + wc] = ss;
            asm volatile("" ::: "memory"); }
#undef EPO_LOAD
    }
};
struct EpiMoe1 {
    bf16_t* H;
    __device__ __forceinline__ void operator()(const f32x4 (&acc)[2][2][4][2], const Unit& u, int wr, int wc, int fr, int fq, LAS unsigned char* meta) const {
#pragma unroll
        for (int ai = 0; ai < 2; ++ai)
#pragma unroll
            for (int m = 0; m < 4; ++m) { const int rl = ai * 128 + wr * 64 + m * 16 + fr;
                if (rl < u.valid) { f32x4 o0, o1;
#pragma unroll
                    for (int j = 0; j < 4; ++j) { const float g0 = acc[ai][0][m][0][j], g1 = acc[ai][1][m][0][j]; o0[j] = g0 * sigmoidf_(g0) * acc[ai][0][m][1][j]; o1[j] = g1 * sigmoidf_(g1) * acc[ai][1][m][1][j]; }
                    *(u32x4*)(H + (size_t)(u.x0 + rl) * 256 + u.pn * 128 + wc * 32 + 8 * fq) = pack8(o0, o1); } }
    }
};
__device__ __forceinline__ void epi_stage_write(LAS unsigned char* sc, int fr, int fq, const u32x4 w0, const u32x4 w1) {
    LAS unsigned char* rowp = sc + (fr >> 3) * 8192 + (fr & 7) * 128; const int x = fr & 7;
    *(LAS u32x4*)(rowp + ((fq ^ x) * 16)) = w0; *(LAS u32x4*)(rowp + (((4 + fq) ^ x) * 16)) = w1;
}
__device__ __forceinline__ u32x4 epi_stage_read(const LAS unsigned char* sc, int q, int lane) {
    const int r = lane >> 3, c = lane & 7; return *(const LAS u32x4*)(sc + q * 8192 + r * 128 + ((c ^ r) * 16));
}
__device__ __forceinline__ unsigned pk4_fp8(float a, float b, float c, float d) {
    a = __builtin_amdgcn_fmed3f(a, -448.f, 448.f); b = __builtin_amdgcn_fmed3f(b, -448.f, 448.f); c = __builtin_amdgcn_fmed3f(c, -448.f, 448.f); d = __builtin_amdgcn_fmed3f(d, -448.f, 448.f);
    int w = 0; w = __builtin_amdgcn_cvt_pk_fp8_f32(a, b, w, false); w = __builtin_amdgcn_cvt_pk_fp8_f32(c, d, w, true); return (unsigned)w;
}
struct EpiMoe2 {
    unsigned char* Y; int skip; LAS unsigned char* lds0;
    __device__ __forceinline__ void operator()(const f32x4 (&acc)[2][2][4][2], const Unit& u, int wr, int wc, int fr, int fq, LAS unsigned char* meta) const {
        asm volatile("" : "+v"(fr), "+v"(fq));
        const int lane = fr + 16 * fq;
        LAS unsigned char* sc0 = lds0 + 3 * pg8::HTB + (wr * 4 + wc) * 1024;
#pragma unroll
        for (int ai = 0; ai < 2; ++ai)
#pragma unroll
            for (int m = 0; m < 4; ++m) { const int rl0 = ai * 128 + wr * 64 + m * 16; LAS unsigned char* sc = sc0 + (m & 1) * 8192;
                const float g = *(const LAS float*)(meta + (rl0 + fr) * 4) * Y_SCALE;
                u32x2 w0, w1;
                w0.x = pk4_fp8(acc[ai][0][m][0][0] * g, acc[ai][0][m][0][1] * g, acc[ai][0][m][0][2] * g, acc[ai][0][m][0][3] * g); w0.y = pk4_fp8(acc[ai][0][m][1][0] * g, acc[ai][0][m][1][1] * g, acc[ai][0][m][1][2] * g, acc[ai][0][m][1][3] * g);
                w1.x = pk4_fp8(acc[ai][1][m][0][0] * g, acc[ai][1][m][0][1] * g, acc[ai][1][m][0][2] * g, acc[ai][1][m][0][3] * g); w1.y = pk4_fp8(acc[ai][1][m][1][0] * g, acc[ai][1][m][1][1] * g, acc[ai][1][m][1][2] * g, acc[ai][1][m][1][3] * g);
                *(LAS u32x2*)(sc + fr * 64 + fq * 8) = w0; *(LAS u32x2*)(sc + fr * 64 + 32 + fq * 8) = w1;
                { const int r = lane >> 2, c = lane & 3, rl = rl0 + r; const u32x4 v = *(const LAS u32x4*)(sc + r * 64 + c * 16);
                  if (rl < u.valid && !skip) { const int dst = *(const LAS int*)(meta + 2048 + rl * 4); *(u32x4*)(Y + (size_t)dst * D + u.pn * 256 + wc * 64 + c * 16) = v; } } }
    }
};

__device__ __forceinline__ void build_moe_tables(LAS unsigned char* lds, const unsigned* cnt_g) {
    LAS int* CNT = (LAS int*)(lds + LDS_CNT); LAS int* RS = (LAS int*)(lds + LDS_RS); LAS int* TB = (LAS int*)(lds + LDS_TB); LAS unsigned* TD = (LAS unsigned*)(lds + LDS_TD);
    const int tid = tidx();
    __syncthreads();
    if (tid < 256) { int c = tid < NPAIR ? (int)cnt_g[tid] : 0; c = c < 0 ? 0 : (c > PAIRCAP ? PAIRCAP : c); CNT[tid] = c; }
    __syncthreads();
    if (tid < 64) {
        int c[4], rs = 0, tb = 0;
#pragma unroll
        for (int i = 0; i < 4; ++i) { c[i] = CNT[4 * tid + i]; rs += c[i]; tb += (c[i] + 255) >> 8; }
        int srs = rs, stb = tb;
#pragma unroll
        for (int o = 1; o < 64; o <<= 1) { const int a = __shfl_up(srs, o), e = __shfl_up(stb, o); if (tid >= o) { srs += a; stb += e; } }
        int ers = srs - rs, etb = stb - tb;
#pragma unroll
        for (int i = 0; i < 4; ++i) { RS[4 * tid + i] = ers; TB[4 * tid + i] = etb; ers += c[i]; etb += (c[i] + 255) >> 8; }
        if (tid == 63) { RS[256] = srs; TB[256] = stb; }
    }
    __syncthreads();
    if (tid < 256) { const int c = CNT[tid], nt = (c + 255) >> 8, tb = TB[tid]; for (int k = 0; k < nt; ++k) TD[tb + k] = (unsigned)tid | ((unsigned)k << 9); }
    __syncthreads();
}
#define RFL(x) __builtin_amdgcn_readfirstlane(x)
struct Moe1Sched {
    LAS unsigned char* lds; int G, c; const char* U2; const int* dstl; const int* ident; const char* Wegu; const char* Wsgu;
    __device__ __forceinline__ bool next(int i, Unit& u) const {
        LAS int* CNT = (LAS int*)(lds + LDS_CNT); LAS int* RS = (LAS int*)(lds + LDS_RS); LAS int* TB = (LAS int*)(lds + LDS_TB); LAS unsigned* TD = (LAS unsigned*)(lds + LDS_TD);
        const int ntr = RFL(TB[256]); const int L = i * G + c; if (L >= (ntr + 128) * 2) return false;
        const int tau = L >> 1; u.pn = L & 1; u.pm = 0; u.A = U2; u.gp = nullptr;
        if (tau < ntr) { const unsigned d = (unsigned)RFL((int)TD[tau]); const int j = d & 511, k = d >> 9; u.valid = min(256, RFL(CNT[j]) - k * 256); u.rows = dstl + (size_t)(j * PAIRCAP + k * 256); u.x0 = RFL(RS[j]) + k * 256; u.rbase = (j >> 6) * CHTOK;
            u.B = Wegu + (size_t)(j & 63) * (512 * 1024 * 2) + (size_t)u.pn * (256 * 1024 * 2); }
        else { const int k = tau - ntr; u.valid = 256; u.rows = ident + k * 256; u.x0 = HSH_ROW0 + k * 256; u.rbase = (k / (CHTOK / 256)) * CHTOK; u.B = Wsgu + (size_t)u.pn * (256 * 1024 * 2); }
        return true;
    }
};
struct Moe2Sched {
    LAS unsigned char* lds; int G, c, ch; const unsigned char* ws;
    __device__ __forceinline__ bool next(int i, Unit& u) const {
        LAS int* CNT = (LAS int*)(lds + LDS_CNT); LAS int* RS = (LAS int*)(lds + LDS_RS); LAS int* TB = (LAS int*)(lds + LDS_TB); LAS unsigned* TD = (LAS unsigned*)(lds + LDS_TD);
        constexpr int NSH = CHTOK / 256;
        const int t0 = RFL(TB[64 * ch]), ntr = RFL(TB[64 * ch + 64]) - t0; const int L = i * G + c; if (L >= (ntr + NSH) * 4) return false;
        const int tau = L >> 2; u.pn = L & 3; u.pm = 0; u.rbase = 0; u.x0 = 0;
        if (tau < ntr) { const unsigned d = (unsigned)RFL((int)TD[t0 + tau]); const int j = d & 511, k = d >> 9; u.valid = min(256, RFL(CNT[j]) - k * 256);
            u.A = (const char*)(ws + WS_H) + (size_t)(RFL(RS[j]) + k * 256) * 512; u.rows = (const int*)(ws + WS_DSTL) + (size_t)(j * PAIRCAP + k * 256); u.gp = (const float*)(ws + WS_GATEL) + (size_t)(j * PAIRCAP + k * 256);
            u.B = (const char*)(ws + WS_W_ED) + (size_t)(j & 63) * (1024 * 256 * 2) + (size_t)u.pn * (256 * 256 * 2); }
        else { const int k = NSH * ch + (tau - ntr); u.valid = 256; u.A = (const char*)(ws + WS_H) + (size_t)(HSH_ROW0 + k * 256) * 512; u.rows = (const int*)(ws + WS_IDENT) + k * 256; u.gp = (const float*)(ws + WS_ONES); u.B = (const char*)(ws + WS_W_SD) + (size_t)u.pn * (256 * 256 * 2); }
        return true;
    }
};

struct Params { const float* in[29]; float* out; unsigned char* ws; int ph_lo, ph_hi; };

__device__ __forceinline__ void s5_tables_item(const Params& p, LAS unsigned char* lds, int item) {
    const int g = item >> 3, part = item & 7, tid = tidx();
    LAS float* AP = (LAS float*)lds;
    LAS float* BB = AP + 64 * 33 * 2;
    LAS float* CC = BB + 64 * 16 * 2;
    const float dt = expf(p.in[8][g]);
    __syncthreads();
    for (int i = tid; i < 64 * 33; i += NTHR) { const int pp = i / 33, tau = i - pp * 33; const float lr = p.in[6][g * 64 + pp], li = p.in[7][g * 64 + pp];
        const float mag = expf(lr * dt * (float)tau), th = li * dt * (float)tau; AP[i * 2] = mag * cosf(th); AP[i * 2 + 1] = mag * sinf(th); }
    for (int i = tid; i < 64 * 16; i += NTHR) { const int pp = i >> 4; const float lr = p.in[6][g * 64 + pp], li = p.in[7][g * 64 + pp];
        const float mag = expf(lr * dt); const float a_re = mag * cosf(li * dt), a_im = mag * sinf(li * dt);
        const float den = lr * lr + li * li, n_re = a_re - 1.0f; const float f_re = (n_re * lr + a_im * li) / den, f_im = (a_im * lr - n_re * li) / den;
        const float br = p.in[9][(size_t)(g * 64) * 16 + i], bi = p.in[10][(size_t)(g * 64) * 16 + i];
        BB[i * 2] = f_re * br - f_im * bi; BB[i * 2 + 1] = f_re * bi + f_im * br; }
    for (int i = tid; i < 16 * 64; i += NTHR) { CC[i * 2] = p.in[11][(size_t)g * 1024 + i]; CC[i * 2 + 1] = p.in[12][(size_t)g * 1024 + i]; }
    __syncthreads();
    if (part == 0 && tid < 64) { float* a32 = (float*)(p.ws + WS_A32); a32[(g * 64 + tid) * 2] = AP[(tid * 33 + 32) * 2]; a32[(g * 64 + tid) * 2 + 1] = AP[(tid * 33 + 32) * 2 + 1]; }
    {
        const int jh = tid >> 8, t2 = tid & 255;
        const int fr = t2 >> 6, l = t2 & 63, delta = part * 4 + fr, ho = l & 15, q = l >> 4, tau = delta - (q >> 1); float v[4];
#pragma unroll 1
        for (int jj = 0; jj < 4; ++jj) { const int j = jh * 4 + jj; const int hi = (q & 1) * 8 + j; float acc = 0.f;
            if (tau >= 0) { for (int pp = 0; pp < 64; ++pp) { const float ar = AP[(pp * 33 + tau) * 2], ai = AP[(pp * 33 + tau) * 2 + 1], br = BB[(pp * 16 + hi) * 2], bi = BB[(pp * 16 + hi) * 2 + 1], cr = CC[(ho * 64 + pp) * 2], ci = CC[(ho * 64 + pp) * 2 + 1];
                    acc += cr * (ar * br - ai * bi) - ci * (ar * bi + ai * br); }
                if (tau == 0 && ho == hi) acc += p.in[13][g * 16 + ho]; }
            v[jj] = acc; }
        u32x2 o; o.x = pk2(v[0], v[1]); o.y = pk2(v[2], v[3]);
        *(u32x2*)((bf16_t*)(p.ws + WS_TZF) + ((size_t)(g * 32 + delta) * 64 + l) * 8 + jh * 4) = o;
    }
    for (int u = tid; u < 1024; u += NTHR) {
        const int ks = u >> 6, l = u & 63, n = part * 16 + (l & 15), q = l >> 4, ri = n >> 6, pp = n & 63; float v[8];
#pragma unroll
        for (int j = 0; j < 8; ++j) { const int k = ks * 32 + q * 8 + j, sidx = k >> 4, hi = k & 15;
            const float ar = AP[(pp * 33 + 31 - sidx) * 2], ai = AP[(pp * 33 + 31 - sidx) * 2 + 1], br = BB[(pp * 16 + hi) * 2], bi = BB[(pp * 16 + hi) * 2 + 1];
            v[j] = ri ? (ar * bi + ai * br) : (ar * br - ai * bi); }
        u32x4 o; o.x = pk2(v[0], v[1]); o.y = pk2(v[2], v[3]); o.z = pk2(v[4], v[5]); o.w = pk2(v[6], v[7]);
        *(u32x4*)((bf16_t*)(p.ws + WS_WINF) + ((size_t)((g * 8 + part) * 16 + ks) * 64 + l) * 8) = o;
    }
    for (int u = tid; u < 1024; u += NTHR) {
        const int fr = u >> 6, l = u & 63, t = part * 4 + (fr >> 2), ksp = fr & 3, ho = l & 15, q = l >> 4; float v[8];
#pragma unroll
        for (int j = 0; j < 8; ++j) { const int kp = ksp * 32 + q * 8 + j, ri = kp >> 6, pp = kp & 63;
            const float cr = CC[(ho * 64 + pp) * 2], ci = CC[(ho * 64 + pp) * 2 + 1], ar = AP[(pp * 33 + t + 1) * 2], ai = AP[(pp * 33 + t + 1) * 2 + 1];
            v[j] = ri ? -(cr * ai + ci * ar) : (cr * ar - ci * ai); }
        u32x4 o; o.x = pk2(v[0], v[1]); o.y = pk2(v[2], v[3]); o.z = pk2(v[4], v[5]); o.w = pk2(v[6], v[7]);
        *(u32x4*)((bf16_t*)(p.ws + WS_WOUTF) + ((size_t)((g * 32 + t) * 4 + ksp) * 64 + l) * 8) = o;
    }
    __syncthreads();
}

__device__ __forceinline__ float gelu_tanh(float y) { const float z = 0.7978845608028654f * (y + 0.044715f * y * y * y); const float e = __expf(2.0f * z); const float th = 1.0f - 2.0f / (e + 1.0f); return 0.5f * y * (1.0f + th); }

__device__ __forceinline__ void s5_item(const Params& p, LAS unsigned char* lds, int item) {
    const int b = item >> 5, g = item & 31;
    const int tid = tidx(), lane = tid & 63, wave = __builtin_amdgcn_readfirstlane(tid >> 6), hd = lane & 15, qd = lane >> 4;
    const bf16_t* PROJ = (const bf16_t*)(p.ws + WS_PROJ); bf16_t* YG = (bf16_t*)(p.ws + WS_YG);
    LAS float* SL = (LAS float*)lds;
    LAS unsigned char* WO = lds + 65536;
    const char* WoutG = (const char*)(p.ws + WS_WOUTF) + (size_t)g * 32 * 4 * 1024;
#define S5_WO_DMA(h) do { _Pragma("unroll") for (int j_ = 0; j_ < 8; ++j_) \
        __builtin_amdgcn_global_load_lds((const unsigned*)(WoutG + (size_t)(h) * 65536 + (j_ * 512 + tid) * 16), (LAS unsigned*)(WO + j_ * 8192 + wave * 1024), 16, 0, 0); } while (0)
    const int c = 16 * wave + hd;
    __syncthreads();
    S5_WO_DMA(0);
    bf16x8 Uf[16];
#pragma unroll
    for (int ks = 0; ks < 16; ++ks) Uf[ks] = *(const bf16x8*)(PROJ + ((size_t)b * SEQ + c * 32 + 2 * ks + (qd >> 1)) * PROJ_W + C_USSM + g * 16 + (qd & 1) * 8);
    { const bf16x8* WinF = (const bf16x8*)(p.ws + WS_WINF) + (size_t)g * 8 * 16 * 64 + lane;
      bf16x8 wc_[8], wn_[8];
#pragma unroll
      for (int ks = 0; ks < 8; ++ks) wc_[ks] = WinF[ks * 64];
      f32x4 a = (f32x4){0.f, 0.f, 0.f, 0.f};
#pragma unroll 2
      for (int j = 0; j < 16; ++j) { const int jn = (j < 15) ? j + 1 : j;
#pragma unroll
          for (int i = 0; i < 8; ++i) wn_[i] = WinF[(jn * 8 + i) * 64];
          if ((j & 1) == 0) {
#pragma unroll
              for (int i = 0; i < 8; ++i) a = __builtin_amdgcn_mfma_f32_16x16x32_bf16(wc_[i], Uf[i], a, 0, 0, 0); }
          else {
#pragma unroll
              for (int i = 0; i < 8; ++i) a = __builtin_amdgcn_mfma_f32_16x16x32_bf16(wc_[i], Uf[8 + i], a, 0, 0, 0);
              *(LAS f32x4*)(SL + c * 128 + (j >> 1) * 16 + qd * 4) = a; a = (f32x4){0.f, 0.f, 0.f, 0.f}; }
#pragma unroll
          for (int i = 0; i < 8; ++i) wc_[i] = wn_[i]; } }
    __syncthreads();
    if (wave == 0) { const float* a32 = (const float*)(p.ws + WS_A32); const float ar = a32[(g * 64 + lane) * 2], ai = a32[(g * 64 + lane) * 2 + 1]; float hr = 0.f, hi = 0.f;
#pragma unroll 4
        for (int cc = 0; cc < 128; ++cc) { const float sr = SL[cc * 128 + lane], si = SL[cc * 128 + 64 + lane]; const float nr = ar * hr - ai * hi + sr, ni = ar * hi + ai * hr + si; hr = nr; hi = ni; SL[cc * 128 + lane] = hr; SL[cc * 128 + 64 + lane] = hi; } }
    __syncthreads();
    bf16x8 Hf[4];
#pragma unroll
    for (int ks = 0; ks < 4; ++ks) { if (c >= 1) { const f32x4 x0 = *(const LAS f32x4*)(SL + (c - 1) * 128 + ks * 32 + qd * 8), x1 = *(const LAS f32x4*)(SL + (c - 1) * 128 + ks * 32 + qd * 8 + 4); Hf[ks] = __builtin_bit_cast(bf16x8, pack8(x0, x1)); }
        else Hf[ks] = (bf16x8){0, 0, 0, 0, 0, 0, 0, 0}; }
    const bf16x8* TzF = (const bf16x8*)(p.ws + WS_TZF) + (size_t)g * 32 * 64 + lane;
#pragma unroll
    for (int half = 0; half < 2; ++half) {
        f32x4 acc[16];
#pragma unroll
        for (int tt = 0; tt < 16; ++tt) acc[tt] = (f32x4){0.f, 0.f, 0.f, 0.f};
        const int ndelta = half * 16 + 16;
        bf16x8 fr[4];
#pragma unroll
        for (int i = 0; i < 4; ++i) fr[i] = TzF[i * 64];
#pragma unroll
        for (int delta = 0; delta < 32; ++delta) {
            if (delta < ndelta) {
                const bf16x8 f0 = fr[delta & 3];
                if (delta + 4 < ndelta) fr[delta & 3] = TzF[(delta + 4) * 64];
#pragma unroll
                for (int ks = 0; ks < 16; ++ks) { const int t = delta + 2 * ks; if (t >= half * 16 && t < half * 16 + 16) acc[t - half * 16] = __builtin_amdgcn_mfma_f32_16x16x32_bf16(f0, Uf[ks], acc[t - half * 16], 0, 0, 0); }
            }
        }
        asm volatile("s_waitcnt vmcnt(0)" ::: "memory");
        __syncthreads();
#pragma unroll
        for (int tt = 0; tt < 16; ++tt) { const int t = half * 16 + tt;
#pragma unroll
            for (int ks = 0; ks < 4; ++ks) acc[tt] = __builtin_amdgcn_mfma_f32_16x16x32_bf16(*(const LAS bf16x8*)(WO + (tt * 4 + ks) * 1024 + lane * 16), Hf[ks], acc[tt], 0, 0, 0);
            u32x2 w; w.x = pk2(gelu_tanh(acc[tt][0]), gelu_tanh(acc[tt][1])); w.y = pk2(gelu_tanh(acc[tt][2]), gelu_tanh(acc[tt][3]));
            *(u32x2*)(YG + ((size_t)b * SEQ + c * 32 + t) * 512 + g * 16 + qd * 4) = w;
            if ((tt & 1) == 1) asm volatile("" ::: "memory"); }
        if (half == 0) { asm volatile("s_waitcnt lgkmcnt(0)" ::: "memory"); __syncthreads(); S5_WO_DMA(1); }
    }
#undef S5_WO_DMA
    __syncthreads();
}

struct TDesc { const float* W; bf16_t* WT; int K, N, item, kind; };
__device__ __forceinline__ void t_load(const TDesc& d, int lane, f32x4 (&v)[16]) {
    const int nblk = (d.N + 63) >> 6, kb = d.item / nblk, nb = d.item - kb * nblk, k0 = 64 * kb, n0 = 64 * nb;
    const int lr = lane >> 4, lc = (lane & 15) * 4;
#pragma unroll
    for (int i = 0; i < 16; ++i) v[i] = (n0 + lc < d.N) ? *(const f32x4*)(d.W + (size_t)(k0 + 4 * i + lr) * d.N + n0 + lc) : (f32x4){0.f, 0.f, 0.f, 0.f};
}
struct RmId { __device__ int operator()(int n) const { return n; } };
struct RmWave { __device__ int operator()(int n) const { const int L = n & 255; return (n & ~255) + 128 * ((L >> 5) & 1) + 32 * (L >> 6) + (L & 31); } };
struct RmIn { __device__ int operator()(int n) const { if (n < PROJ_USED) return n; const int g = n - PROJ_USED, c = g & 1023; return PROJ_W + 256 * (c >> 7) + 128 * (g >> 10) + (c & 127); } };
struct RmGate { __device__ int operator()(int n) const { const int hl = n & 127; return 256 * (n >> 7) + 128 * ((hl >> 2) & 1) + 32 * (hl >> 5) + 8 * ((hl >> 3) & 3) + (hl & 3); } };
struct RmUp { __device__ int operator()(int n) const { const int hl = n & 127; return 256 * (n >> 7) + 128 * ((hl >> 2) & 1) + 32 * (hl >> 5) + 8 * ((hl >> 3) & 3) + 4 + (hl & 3); } };
__device__ __forceinline__ int t_rowmap(int kind, int n) { return kind == 0 ? n : kind == 1 ? RmWave()(n) : kind == 2 ? RmIn()(n) : kind == 3 ? RmGate()(n) : RmUp()(n); }
__device__ __forceinline__ void t_store(const TDesc& d, const f32x4 (&v)[16], LAS float* scr, int lane) {
    const int nblk = (d.N + 63) >> 6, kb = d.item / nblk, nb = d.item - kb * nblk, k0 = 64 * kb, n0 = 64 * nb;
    const int lr = lane >> 4, lc = (lane & 15) * 4;
#pragma unroll
    for (int i = 0; i < 16; ++i) { LAS float* dd = scr + (4 * i + lr) * 65 + lc; dd[0] = v[i].x; dd[1] = v[i].y; dd[2] = v[i].z; dd[3] = v[i].w; }
    LDS_WAIT(); asm volatile("" ::: "memory");
    const int nl = lane >> 3, kc = (lane & 7) * 8;
#pragma unroll
    for (int j = 0; j < 8; ++j) { const int n = nl + 8 * j; const LAS float* sp = scr + kc * 65 + n;
        u32x4 o; o.x = pk2(sp[0 * 65], sp[1 * 65]); o.y = pk2(sp[2 * 65], sp[3 * 65]); o.z = pk2(sp[4 * 65], sp[5 * 65]); o.w = pk2(sp[6 * 65], sp[7 * 65]);
        if (n0 + n < d.N) *(u32x4*)(d.WT + (size_t)t_rowmap(d.kind, n0 + n) * d.K + k0 + kc) = o; }
    LDS_WAIT(); asm volatile("" ::: "memory");
}

constexpr int T_I_IN = 16 * 60, T_I_GLU = 8 * 8, T_I_PS = 8 * 16, T_I_OUT = 16 * 16, T_I_SG = 16 * 4, T_I_SD = 4 * 16, T_I_EG = 64 * 64;
constexpr int T_NITEMS = T_I_IN + T_I_GLU + 2 * T_I_PS + T_I_OUT + 2 * T_I_SG + T_I_SD + 3 * T_I_EG;
constexpr int T_LATE = 5 * 128 * NWAVES;
constexpr int T_LATE2 = T_I_EG;
static_assert(T_LATE + T_LATE2 <= 3 * T_I_EG, "late items are expert matrices");
__device__ __forceinline__ TDesc tdesc_of(const Params& p, unsigned char* ws, int r) { TDesc d;
    if (r < T_I_IN) { d = TDesc{p.in[5], (bf16_t*)(ws + WS_W_IN), 1024, IN_W, r, 2}; return d; } r -= T_I_IN;
    if (r < T_I_GLU) { d = TDesc{p.in[14], (bf16_t*)(ws + WS_W_GLU), 512, 512, r, 0}; return d; } r -= T_I_GLU;
    if (r < T_I_PS) { d = TDesc{p.in[16], (bf16_t*)(ws + WS_W_PS), 512, 1024, r, 0}; return d; } r -= T_I_PS;
    if (r < T_I_PS) { d = TDesc{p.in[17], (bf16_t*)(ws + WS_W_PA), 512, 1024, r, 0}; return d; } r -= T_I_PS;
    if (r < T_I_OUT) { d = TDesc{p.in[18], (bf16_t*)(ws + WS_W_OUT), 1024, 1024, r, 0}; return d; } r -= T_I_OUT;
    if (r < T_I_SG) { d = TDesc{p.in[25], (bf16_t*)(ws + WS_W_SGU), 1024, 256, r, 3}; return d; } r -= T_I_SG;
    if (r < T_I_SG) { d = TDesc{p.in[26], (bf16_t*)(ws + WS_W_SGU), 1024, 256, r, 4}; return d; } r -= T_I_SG;
    if (r < T_I_SD) { d = TDesc{p.in[27], (bf16_t*)(ws + WS_W_SD), 256, 1024, r, 1}; return d; } r -= T_I_SD;
    if (r < T_I_EG) { const int e = r >> 6; d = TDesc{p.in[22] + (size_t)e * 262144, (bf16_t*)(ws + WS_W_EGU) + (size_t)e * 524288, 1024, 256, r & 63, 3}; return d; } r -= T_I_EG;
    if (r < T_I_EG) { const int e = r >> 6; d = TDesc{p.in[23] + (size_t)e * 262144, (bf16_t*)(ws + WS_W_EGU) + (size_t)e * 524288, 1024, 256, r & 63, 4}; return d; } r -= T_I_EG;
    { const int e = r >> 6; d = TDesc{p.in[24] + (size_t)e * 262144, (bf16_t*)(ws + WS_W_ED) + (size_t)e * 262144, 256, 1024, r & 63, 1}; return d; } }
__device__ __forceinline__ void run_transposes(const Params& p, unsigned char* ws, LAS unsigned char* lds, int r0, int r1, int widx, int nw) {
    const int lane = tidx() & 63, wave = __builtin_amdgcn_readfirstlane(tidx() >> 6);
    LAS float* scr = (LAS float*)(lds + wave * 16640);
    int r = r1 - 1 - widx;
    if (r < r0) return;
    TDesc d0 = tdesc_of(p, ws, r), d1 = d0, d2 = d0; f32x4 v0[16], v1[16], v2[16];
    t_load(d0, lane, v0);
    bool h1 = (r - nw >= r0);
    if (h1) { d1 = tdesc_of(p, ws, r - nw); t_load(d1, lane, v1); }
    for (;;) {
        const bool h2 = h1 && (r - 2 * nw >= r0);
        if (h2) { d2 = tdesc_of(p, ws, r - 2 * nw); t_load(d2, lane, v2); }
        t_store(d0, v0, scr, lane);
        if (!h1) break;
        d0 = d1; d1 = d2; r -= nw; h1 = h2;
#pragma unroll
        for (int i = 0; i < 16; ++i) { v0[i] = v1[i]; v1[i] = v2[i]; }
    }
}
__device__ __forceinline__ void p0_prep(const Params& p, LAS unsigned char* lds, int vcu, int G) {
    const int tid = tidx(), lane = tid & 63, wave = __builtin_amdgcn_readfirstlane(tid >> 6);
    unsigned char* ws = p.ws;
    for (int it = vcu; it < 256; it += G) s5_tables_item(p, lds, it);
    {
        LAS float* sc = (LAS float*)lds;
        LAS float* red = (LAS float*)(lds + 32768);
        const float* c = p.in[1]; const float* w = p.in[2]; const float* bb = p.in[3]; float* ada = (float*)(ws + WS_ADA);
        bool loaded = false;
        for (int it = vcu; it < 96; it += G) {
            if (!loaded) { for (int i = tid; i < 8192; i += NTHR) { const float v = c[i]; sc[i] = v * sigmoidf_(v); } loaded = true; }
            __syncthreads();
            const int kq = tid >> 6, col = it * 64 + lane; float a[8];
#pragma unroll
            for (int b = 0; b < 8; ++b) a[b] = 0.f;
#pragma unroll 16
            for (int k = kq * 128; k < kq * 128 + 128; ++k) { const float wv = w[(size_t)k * 6144 + col];
#pragma unroll
                for (int b = 0; b < 8; ++b) a[b] += sc[b * 1024 + k] * wv; }
#pragma unroll
            for (int b = 0; b < 8; ++b) red[(kq * 8 + b) * 64 + lane] = a[b];
            __syncthreads();
            { const int b = tid >> 6; float s = bb[col];
#pragma unroll
              for (int q = 0; q < 8; ++q) s += red[(q * 8 + b) * 64 + lane];
              ada[b * 6144 + col] = s; }
            __syncthreads();
        }
        __syncthreads();
    }
    run_transposes(p, ws, lds, 0, T_NITEMS - T_LATE2 - ((G == 256) ? T_LATE : 0), vcu * NWAVES + wave, G * NWAVES);
    { const int gt = vcu * NTHR + tid, NGT = G * NTHR;
      u32x4* z = (u32x4*)(ws + WS_W_IN + (size_t)PROJ_USED * 1024 * 2);
      for (int i = gt; i < (PROJ_W - PROJ_USED) * 1024 * 2 / 16; i += NGT) z[i] = (u32x4){0u, 0u, 0u, 0u};
      int* id = (int*)(ws + WS_IDENT); for (int i = gt; i < NTOK; i += NGT) id[i] = (i % CHTOK) * NSLOT + 8;
      if (gt < 256) ((float*)(ws + WS_ONES))[gt] = 1.0f;
      for (int u = gt; u < 32 * 4 * 64; u += NGT) { const int l = u & 63, nt = (u >> 6) & 3, ks = u >> 8; const int n = nt * 16 + (l & 15), q = l >> 4; float hi[8], lo[8];
#pragma unroll
          for (int j = 0; j < 8; ++j) { const float w = p.in[20][(size_t)(ks * 32 + q * 8 + j) * 64 + n]; const float h = bf2f((unsigned short)f2bf(w)); hi[j] = h; lo[j] = w - h; }
          u32x4 o; o.x = pk2(hi[0], hi[1]); o.y = pk2(hi[2], hi[3]); o.z = pk2(hi[4], hi[5]); o.w = pk2(hi[6], hi[7]);
          *(u32x4*)((bf16_t*)(ws + WS_WRF) + (size_t)u * 8) = o;
          o.x = pk2(lo[0], lo[1]); o.y = pk2(lo[2], lo[3]); o.z = pk2(lo[4], lo[5]); o.w = pk2(lo[6], lo[7]);
          *(u32x4*)((bf16_t*)(ws + WS_WRF) + (size_t)(32 * 4 * 64 + u) * 8) = o; } }
}

__device__ __forceinline__ void p1_modulate(const Params& p, int vcu, int G) {
    const int tid = tidx(), lane = tid & 63, wave = tid >> 6; const int gw = vcu * NWAVES + wave, NGW = G * NWAVES;
    const float* ada = (const float*)(p.ws + WS_ADA); const float* g1 = p.in[4]; bf16_t* U = (bf16_t*)(p.ws + WS_U);
    for (int m = gw; m < NTOK; m += NGW) {
        const f32x4* xr = (const f32x4*)(p.in[0] + (size_t)m * D) + lane; const int b = m >> 12;
        f32x4 v[4]; float s = 0.f;
#pragma unroll
        for (int j = 0; j < 4; ++j) { v[j] = xr[64 * j]; s += (v[j].x * v[j].x + v[j].y * v[j].y) + (v[j].z * v[j].z + v[j].w * v[j].w); }
        const float rstd = 1.0f / sqrtf(wave_sum(s) * (1.f / D) + EPS);
        unsigned long long* o8 = (unsigned long long*)(U + (size_t)m * D) + lane;
#pragma unroll
        for (int j = 0; j < 4; ++j) { const int c0 = 4 * lane + 256 * j;
            const f32x4 gg = *(const f32x4*)(g1 + c0), sh = *(const f32x4*)(ada + b * 6144 + c0), scl = *(const f32x4*)(ada + b * 6144 + 1024 + c0);
            const f32x4 y = v[j] * rstd * gg * (scl + 1.0f) + sh;
            o8[64 * j] = (unsigned long long)pk2(y.x, y.y) | ((unsigned long long)pk2(y.z, y.w) << 32); }
    }
}

__device__ __forceinline__ void p_combine(const Params& p, int vcu, int G, int ch) {
    const int tid = tidx(), lane = tid & 63, wave = tid >> 6; const int gw = vcu * NWAVES + wave, NGW = G * NWAVES;
    const float* ada = (const float*)(p.ws + WS_ADA); const float* gf = p.in[28];
    const unsigned char* Y = (const unsigned char*)(p.ws + WS_Y);
    u32x4 w[NSLOT];
    { const int mi0 = gw < CHTOK ? gw : 0; const unsigned char* yp = Y + (size_t)mi0 * NSLOT * D + lane * 16;
#pragma unroll
      for (int k = 0; k < NSLOT; ++k) w[k] = *(const u32x4*)(yp + (size_t)k * D); }
    for (int mi = gw; mi < CHTOK; mi += NGW) {
        const int m = ch * CHTOK + mi; const int b = m >> 12;
        float* orow = p.out + (size_t)m * D + lane * 16;
        f32x4 h[4], g2[4];
        { const u32x4* hp = (const u32x4*)((const bf16_t*)(p.out + (size_t)m * D) + lane * 16); const u32x4 h0 = hp[0], h1 = hp[1];
          h[0] = (f32x4){bflo(h0.x), bfhi(h0.x), bflo(h0.y), bfhi(h0.y)}; h[1] = (f32x4){bflo(h0.z), bfhi(h0.z), bflo(h0.w), bfhi(h0.w)};
          h[2] = (f32x4){bflo(h1.x), bfhi(h1.x), bflo(h1.y), bfhi(h1.y)}; h[3] = (f32x4){bflo(h1.z), bfhi(h1.z), bflo(h1.w), bfhi(h1.w)}; }
#pragma unroll
        for (int q = 0; q < 4; ++q) g2[q] = *(const f32x4*)(ada + b * 6144 + 5120 + lane * 16 + 4 * q);
        float a[16];
#pragma unroll
        for (int j = 0; j < 16; ++j) a[j] = 0.f;
#pragma unroll
        for (int k = 0; k < NSLOT; ++k)
#pragma unroll
            for (int q = 0; q < 4; ++q) { const f32x2 lo = __builtin_amdgcn_cvt_pk_f32_fp8((int)w[k][q], false), hi = __builtin_amdgcn_cvt_pk_f32_fp8((int)w[k][q], true);
                a[4 * q] += lo.x; a[4 * q + 1] += lo.y; a[4 * q + 2] += hi.x; a[4 * q + 3] += hi.y; }
        { const int mn = (mi + NGW < CHTOK) ? mi + NGW : mi; const unsigned char* yp = Y + (size_t)mn * NSLOT * D + lane * 16;
#pragma unroll
          for (int k = 0; k < NSLOT; ++k) w[k] = *(const u32x4*)(yp + (size_t)k * D); }
        float r[16]; float s = 0.f;
#pragma unroll
        for (int i = 0; i < 4; ++i)
#pragma unroll
            for (int j = 0; j < 4; ++j) { const float v = h[i][j] + g2[i][j] * (a[i * 4 + j] * (1.0f / Y_SCALE)); r[i * 4 + j] = v; s += v * v; }
        const float rstd = 1.0f / sqrtf(wave_sum(s) * (1.f / D) + EPS);
#pragma unroll
        for (int q = 0; q < 4; ++q) { const f32x4 g = *(const f32x4*)(gf + lane * 16 + 4 * q); f32x4 o;
#pragma unroll
            for (int j = 0; j < 4; ++j) o[j] = r[q * 4 + j] * rstd * g[j];
            *(f32x4*)(orow + 4 * q) = o; }
    }
}

__device__ __forceinline__ unsigned fkey(float x) { const unsigned u = __builtin_bit_cast(unsigned, x); return (u & 0x80000000u) ? ~u : (u | 0x80000000u); }

__device__ __forceinline__ void gold_s5(const Params& p, int item, int lane) {
    const int b = item >> 5, g = item & 31;
    const bf16_t* PROJ = (const bf16_t*)(p.ws + WS_PROJ); bf16_t* YG = (bf16_t*)(p.ws + WS_YG);
    const float dt = expf(p.in[8][g]); const float lr = p.in[6][g * 64 + lane], li = p.in[7][g * 64 + lane];
    const float mag = expf(lr * dt); const float a_re = mag * cosf(li * dt), a_im = mag * sinf(li * dt);
    const float den = lr * lr + li * li, n_re = a_re - 1.0f;
    const float f_re = (n_re * lr + a_im * li) / den, f_im = (a_im * lr - n_re * li) / den;
    float bbr[16], bbi[16], cr[16], ci[16];
#pragma unroll
    for (int h = 0; h < 16; ++h) { const float br = p.in[9][(g * 64 + lane) * 16 + h], bi = p.in[10][(g * 64 + lane) * 16 + h];
        bbr[h] = f_re * br - f_im * bi; bbi[h] = f_re * bi + f_im * br;
        cr[h] = p.in[11][(g * 16 + h) * 64 + lane]; ci[h] = p.in[12][(g * 16 + h) * 64 + lane]; }
    const float dsk = p.in[13][g * 16 + (lane & 15)];
    float hr = 0.f, hi = 0.f;
    for (int t = 0; t < SEQ; ++t) {
        const size_t row = (size_t)b * SEQ + t;
        const u32x4 w0 = *(const u32x4*)(PROJ + row * PROJ_W + C_USSM + g * 16), w1 = *(const u32x4*)(PROJ + row * PROJ_W + C_USSM + g * 16 + 8);
        float u[16]; { float f[8]; unpack8(w0, f);
#pragma unroll
            for (int j = 0; j < 8; ++j) u[j] = f[j];
            unpack8(w1, f);
#pragma unroll
            for (int j = 0; j < 8; ++j) u[8 + j] = f[j]; }
        float bur = 0.f, bui = 0.f;
#pragma unroll
        for (int h = 0; h < 16; ++h) { bur += bbr[h] * u[h]; bui += bbi[h] * u[h]; }
        const float nr = a_re * hr - a_im * hi + bur, ni = a_re * hi + a_im * hr + bui; hr = nr; hi = ni;
        float y = 0.f, um = 0.f;
#pragma unroll
        for (int h = 0; h < 16; ++h) { const float v = wave_sum(cr[h] * hr - ci[h] * hi); if ((lane & 15) == h) { y = v; um = u[h]; } }
        y += dsk * um;
        const float gl = 0.5f * y * (1.0f + tanhf(0.7978845608028654f * (y + 0.044715f * y * y * y)));
        if (lane < 16) YG[row * 512 + g * 16 + lane] = (bf16_t)f2bf(gl);
    }
}

__device__ __forceinline__ void gold_attn_pair(const Params& p, LAS unsigned char* lds, int pairid) {
    const int half = tidx() >> 8, tid = tidx() & 255;
    LAS unsigned char* base = lds + half * 32768;
    LAS float* qi = (LAS float*)base; LAS float* qv = qi + 512; LAS float* sc = qv + 512; LAS float* lg = sc + 4096;
    LAS float* wi = lg + 2048; LAS float* mx = wi + 8; LAS float* sm = mx + 8; LAS int* sel = (LAS int*)(sm + 8); LAS int* red = sel + 256; LAS int* cntp = red + 256;
    const int qid = pairid * 2 + half; const int b = qid >> 12, t = qid & 4095;
    const bf16_t* PROJ = (const bf16_t*)(p.ws + WS_PROJ); bf16_t* YA = (bf16_t*)(p.ws + WS_YATTN);
    const size_t qrow = (size_t)qid * PROJ_W;
    __syncthreads();
    for (int i = tid; i < 512; i += 256) { qi[i] = bf2f(PROJ[qrow + C_QI + i]); qv[i] = bf2f(PROJ[qrow + C_Q + i]); }
    if (tid < 8) wi[tid] = bf2f(PROJ[qrow + C_WI + tid]);
    if (tid == 0) cntp[0] = 0;
    __syncthreads();
    const int n = t + 1;
    for (int s = tid; s < n; s += 256) {
        const bf16_t* kp = PROJ + ((size_t)b * SEQ + s) * PROJ_W + C_KI; float kk[64];
#pragma unroll
        for (int c8 = 0; c8 < 8; ++c8) { float f[8]; unpack8(*(const u32x4*)(kp + c8 * 8), f);
#pragma unroll
            for (int j = 0; j < 8; ++j) kk[c8 * 8 + j] = f[j]; }
        float score = 0.f;
        for (int h = 0; h < 8; ++h) { float d = 0.f;
#pragma unroll
            for (int j = 0; j < 64; ++j) d += qi[h * 64 + j] * kk[j];
            score += wi[h] * fmaxf(d, 0.f); }
        sc[s] = score;
    }
    __syncthreads();
    const bool small = (t | 1) <= 255;
    if (small) { if (tid < n) sel[tid] = tid; if (tid == 0) cntp[0] = n; __syncthreads(); }
    else {
        unsigned thr = 0u;
        for (int bit = 31; bit >= 0; --bit) {
            const unsigned cand = thr | (1u << bit); int c = 0;
            for (int s = tid; s < n; s += 256) c += (fkey(sc[s]) >= cand) ? 1 : 0;
            red[tid] = c; __syncthreads();
            for (int o = 128; o > 0; o >>= 1) { if (tid < o) red[tid] += red[tid + o]; __syncthreads(); }
            if (red[0] >= 256) thr = cand;
            __syncthreads();
        }
        for (int s = tid; s < n; s += 256) if (fkey(sc[s]) > thr) { const int ps = atomicAdd((int*)cntp, 1); sel[ps] = s; }
        __syncthreads();
        if (tid == 0) { int c = cntp[0]; for (int s = 0; s < n && c < 256; ++s) if (fkey(sc[s]) == thr) sel[c++] = s; cntp[0] = c; }
        __syncthreads();
    }
    const int ns = cntp[0];
    { const int j = tid; const int s = (j < ns) ? sel[j] : 0;
      const bf16_t* kp = PROJ + ((size_t)b * SEQ + s) * PROJ_W + C_K; float kk[64];
#pragma unroll
      for (int c8 = 0; c8 < 8; ++c8) { float f[8]; unpack8(*(const u32x4*)(kp + c8 * 8), f);
#pragma unroll
          for (int jj = 0; jj < 8; ++jj) kk[c8 * 8 + jj] = f[jj]; }
      for (int h = 0; h < 8; ++h) { float d = 0.f;
#pragma unroll
          for (int jj = 0; jj < 64; ++jj) d += qv[h * 64 + jj] * kk[jj];
          const float slope = exp2f(-(float)(h + 1));
          lg[h * 256 + j] = (j < ns) ? d * 0.125f - slope * (float)(t - s) : -INFINITY; } }
    __syncthreads();
    if (tid < 8) { float m = -INFINITY; for (int j = 0; j < 256; ++j) m = fmaxf(m, lg[tid * 256 + j]); float sum = 0.f; for (int j = 0; j < 256; ++j) sum += __expf(lg[tid * 256 + j] - m); mx[tid] = m; sm[tid] = sum; }
    __syncthreads();
    for (int i = tid; i < 2048; i += 256) { const int h = i >> 8; lg[i] = __expf(lg[i] - mx[h]) / sm[h]; }
    __syncthreads();
    { const int h = tid >> 5, d0 = (tid & 31) * 2; float o0 = 0.f, o1 = 0.f;
      for (int j = 0; j < ns; ++j) { const unsigned w = *(const unsigned*)(PROJ + ((size_t)b * SEQ + sel[j]) * PROJ_W + C_V + d0); const float pj = lg[h * 256 + j]; o0 += pj * bflo(w); o1 += pj * bfhi(w); }
      *(unsigned*)(YA + (size_t)qid * 512 + h * 64 + d0) = pk2(o0, o1); }
}

typedef float f32x16 __attribute__((ext_vector_type(16)));
typedef _Float16 f16_t;
constexpr int AT_SC = 0;
constexpr int AT_V = 65536;
constexpr int AT_SEL = LDS_CNT;
static_assert(AT_V + 8 * 2 * 4096 <= STAGE_BYTES && AT_SEL + 8 * 1152 <= LDS_BYTES, "attention LDS map");

#define DPP_ZI(v, ctrl, rmask, bmask) __builtin_amdgcn_update_dpp(0, (int)(v), ctrl, rmask, bmask, false)
__device__ __forceinline__ int wave_scan_i(int v0) {
    int v1 = v0 + DPP_ZI(v0, 0x111, 0xf, 0xf); v1 += DPP_ZI(v0, 0x112, 0xf, 0xf); v1 += DPP_ZI(v0, 0x113, 0xf, 0xf);
    v1 += DPP_ZI(v1, 0x114, 0xf, 0xe); v1 += DPP_ZI(v1, 0x118, 0xf, 0xc);
    v1 += DPP_ZI(v1, 0x142, 0xa, 0xf); v1 += DPP_ZI(v1, 0x143, 0xc, 0xf);
    return v1;
}
__device__ __forceinline__ float relu_i(float x) { const int xi = __builtin_bit_cast(int, x); return __builtin_bit_cast(float, xi > 0 ? xi : 0); }
__device__ __forceinline__ u32x2 tr_read16(unsigned addr) { u32x2 r; asm volatile("ds_read_b64_tr_b16 %0, %1" : "=v"(r) : "v"(addr) : "memory"); return r; }

__device__ __forceinline__ void attn_item(const Params& p, LAS unsigned char* lds, int b, int qblk) {
    const int tid = tidx(), lane = tid & 63, wave = __builtin_amdgcn_readfirstlane(tid >> 6);
    const int q0 = qblk * 8;
    const bf16_t* PROJ = (const bf16_t*)(p.ws + WS_PROJ); bf16_t* YA = (bf16_t*)(p.ws + WS_YATTN);
    const size_t tok0 = (size_t)b * SEQ + q0;
    LAS unsigned short* SC = (LAS unsigned short*)(lds + AT_SC);
    LAS unsigned short* SELq = (LAS unsigned short*)(lds + AT_SEL) + wave * 576;
    const int nkt = (q0 + 8 + 31) >> 5;
    const int nchmax = (q0 + 8 + 511) >> 9;
    __syncthreads();
    for (int i = nkt * 32 + lane; i < nchmax * 512; i += 64) SC[wave * 4096 + i] = 0xFC00u;
    __syncthreads();
#ifndef AT_REP_A
#define AT_REP_A 1
#endif
#ifndef AT_REP_B
#define AT_REP_B 1
#endif
#ifndef AT_REP_C
#define AT_REP_C 1
#endif
#ifndef AT_SKIP_A
    for (int ra_ = 0; ra_ < AT_REP_A; ++ra_) {
        const int hf = lane >> 5, l32 = lane & 31;
        const int rq = 2 * ((l32 >> 2) & 1) + ((l32 >> 4) & 1), rh = (l32 & 3) + 4 * ((l32 >> 3) & 1);
        bf16x8 Af[2][4]; float wgt[2][16];
#pragma unroll
        for (int qg = 0; qg < 2; ++qg) { const bf16_t* qp = PROJ + (tok0 + 4 * qg + rq) * PROJ_W + C_QI + rh * 64 + hf * 8;
#pragma unroll
            for (int s = 0; s < 4; ++s) Af[qg][s] = *(const bf16x8*)(qp + s * 16);
#pragma unroll
            for (int qq = 0; qq < 2; ++qq) { const u32x4 w = *(const u32x4*)(PROJ + (tok0 + 4 * qg + 2 * hf + qq) * PROJ_W + C_WI); float f[8]; unpack8(w, f);
#pragma unroll
                for (int h = 0; h < 8; ++h) wgt[qg][qq * 8 + h] = f[h]; } }
        const bf16x8* KIF = (const bf16x8*)(p.ws + WS_KIF) + (size_t)b * 128 * 4 * 64 + lane;
        bf16x8 B0[4], B1[4];
        { const int kt0 = wave < nkt ? wave : 0, kt1 = wave + 8 < nkt ? wave + 8 : kt0;
#pragma unroll
          for (int s = 0; s < 4; ++s) { B0[s] = KIF[(kt0 * 4 + s) * 64]; B1[s] = KIF[(kt1 * 4 + s) * 64]; } }
#define STEP_A_TILE(BF, KT) do { const int key = (KT) * 32 + l32; \
            _Pragma("unroll") for (int qg = 0; qg < 2; ++qg) { \
                f32x16 c; _Pragma("unroll") for (int j = 0; j < 16; ++j) c[j] = 0.f; \
                _Pragma("unroll") for (int s = 0; s < 4; ++s) c = __builtin_amdgcn_mfma_f32_32x32x16_bf16(Af[qg][s], BF[s], c, 0, 0, 0); \
                float sa = 0.f, sb = 0.f; \
                _Pragma("unroll") for (int h = 0; h < 8; ++h) { sa += wgt[qg][h] * relu_i(c[h]); sb += wgt[qg][8 + h] * relu_i(c[8 + h]); } \
                const int qa = 4 * qg + 2 * hf; \
                sa = fminf(fmaxf(sa * 0.0441941738f, -60000.f), 60000.f); sb = fminf(fmaxf(sb * 0.0441941738f, -60000.f), 60000.f); \
                if (key > q0 + qa) sa = -INFINITY; \
                if (key > q0 + qa + 1) sb = -INFINITY; \
                const f16_t ha = (f16_t)sa, hb = (f16_t)sb; \
                SC[qa * 4096 + key] = __builtin_bit_cast(unsigned short, ha); SC[(qa + 1) * 4096 + key] = __builtin_bit_cast(unsigned short, hb); } } while (0)
        for (int kt = wave; kt < nkt; kt += 16) {
            STEP_A_TILE(B0, kt);
            { const int ktn = (kt + 16 < nkt) ? kt + 16 : kt;
#pragma unroll
              for (int s = 0; s < 4; ++s) B0[s] = KIF[(ktn * 4 + s) * 64]; }
            if (kt + 8 < nkt) {
                STEP_A_TILE(B1, kt + 8);
                { const int ktn = (kt + 24 < nkt) ? kt + 24 : kt;
#pragma unroll
                  for (int s = 0; s < 4; ++s) B1[s] = KIF[(ktn * 4 + s) * 64]; } }
        }
#undef STEP_A_TILE
    }
#endif
    __syncthreads();
    const int t = q0 + wave, n = t + 1;
    int ns;
    for (int rb_ = 0; rb_ < AT_REP_B; ++rb_) {
#ifdef AT_SKIP_B
    if (true) {
#else
    if (n <= 256) {
#endif
#pragma unroll
        for (int i = 0; i < 4; ++i) { const int pos = lane + 64 * i; SELq[pos] = (unsigned short)(pos < n ? pos : 0); }
        ns = n;
    } else {
        const int nch = (n + 511) >> 9;
        unsigned XH[32], XL[32];
        LAS unsigned char* row = lds + AT_SC + wave * 8192;
#pragma unroll
        for (int i = 0; i < 8; ++i) {
            if (i < nch) { const u32x4 w = *(const LAS u32x4*)(row + i * 1024 + lane * 16);
#pragma unroll
                for (int e2 = 0; e2 < 4; ++e2) { const unsigned x = w[e2]; const unsigned sg = (x & 0x80008000u) >> 15; const unsigned k2 = x ^ ((sg * 0xffffu) | 0x80008000u);
                    XH[i * 4 + e2] = k2; XL[i * 4 + e2] = k2 << 16; } }
            else {
#pragma unroll
                for (int e2 = 0; e2 < 4; ++e2) { XH[i * 4 + e2] = 0u; XL[i * 4 + e2] = 0u; } }
        }
        LAS unsigned* H1 = (LAS unsigned*)(lds + 65536 + wave * 8192);
        LAS unsigned* H2 = (LAS unsigned*)((LAS unsigned char*)SELq + 640);
        LAS unsigned* H1p = H1 + (lane & 1) * 1024;
#pragma unroll
        for (int i = 0; i < 8; ++i) *(LAS u32x4*)(H1 + (i * 64 + lane) * 4) = (u32x4){0u, 0u, 0u, 0u};
        H2[lane] = 0u;
        LDS_WAIT(); __builtin_amdgcn_wave_barrier();
#pragma unroll
        for (int i = 0; i < 8; ++i) if (i < nch) {
#pragma unroll
            for (int e2 = 0; e2 < 4; ++e2) { const unsigned x = XH[i * 4 + e2];
                __hip_atomic_fetch_add(H1p + (x >> 22), 1u, __ATOMIC_RELAXED, __HIP_MEMORY_SCOPE_WORKGROUP);
                __hip_atomic_fetch_add(H1p + ((x >> 6) & 1023u), 1u, __ATOMIC_RELAXED, __HIP_MEMORY_SCOPE_WORKGROUP); } }
        LDS_WAIT(); __builtin_amdgcn_wave_barrier();
        unsigned B1, cabove; const unsigned dummy = 64u + (unsigned)lane;
        {
            unsigned hb[16];
#pragma unroll
            for (int i = 0; i < 4; ++i) { const u32x4 w = *(const LAS u32x4*)(H1 + lane * 16 + i * 4), w2 = *(const LAS u32x4*)(H1 + 1024 + lane * 16 + i * 4); hb[4 * i] = w.x + w2.x; hb[4 * i + 1] = w.y + w2.y; hb[4 * i + 2] = w.z + w2.z; hb[4 * i + 3] = w.w + w2.w; }
            unsigned sl_ = 0u;
#pragma unroll
            for (int i = 0; i < 16; ++i) sl_ += hb[i];
            const int inc_ = wave_scan_i((int)sl_);
            const unsigned above = (unsigned)(__builtin_amdgcn_readlane(inc_, 63) - inc_), suf = above + sl_;
            const bool mine = above < 256u && suf >= 256u;
            unsigned bsel = 0u, cab = 0u;
            if (mine) { unsigned run = above; bool done = false;
#pragma unroll
                for (int i = 15; i >= 0; --i) { if (!done && run + hb[i] >= 256u) { bsel = (unsigned)(lane * 16 + i); cab = run; done = true; } run += hb[i]; } }
            const unsigned long long mk = __ballot(mine); const int src = (int)__builtin_ctzll(mk);
            B1 = (unsigned)__builtin_amdgcn_readlane((int)bsel, src); cabove = (unsigned)__builtin_amdgcn_readlane((int)cab, src);
        }
#pragma unroll
        for (int i = 0; i < 8; ++i) if (i < nch) {
#pragma unroll
            for (int e2 = 0; e2 < 4; ++e2) { const unsigned x = XH[i * 4 + e2];
                const unsigned ah = ((x >> 22) == B1) ? ((x >> 16) & 63u) : dummy, al = (((x >> 6) & 1023u) == B1) ? (x & 63u) : dummy;
                __hip_atomic_fetch_add(H2 + ah, 1u, __ATOMIC_RELAXED, __HIP_MEMORY_SCOPE_WORKGROUP);
                __hip_atomic_fetch_add(H2 + al, 1u, __ATOMIC_RELAXED, __HIP_MEMORY_SCOPE_WORKGROUP); } }
        LDS_WAIT(); __builtin_amdgcn_wave_barrier();
        unsigned thr;
        {   const unsigned h2 = H2[lane]; const int inc_ = wave_scan_i((int)h2); const unsigned ab2 = (unsigned)(__builtin_amdgcn_readlane(inc_, 63) - inc_), suf = ab2 + h2;
            const unsigned need = 256u - cabove;
            const bool mine = ab2 < need && suf >= need;
            const unsigned long long mk = __ballot(mine); const unsigned B2 = (unsigned)__builtin_ctzll(mk);
            thr = (B1 << 6) | B2; }
        const unsigned c32 = thr << 16, c32h = c32 | 0xffffu;
#define TIE2(a, b) asm volatile("" : "+v"(a), "+v"(b))
        int cgt = 0, ceq = 0;
#pragma unroll
        for (int j = 0; j < 32; ++j) { unsigned xh = XH[j], xl = XL[j]; TIE2(xh, cgt); TIE2(xl, ceq);
            cgt += (xh > c32h) ? 1 : 0; cgt += (xl > c32) ? 1 : 0; ceq += ((xh >> 16) == thr) ? 1 : 0; ceq += (xl == c32) ? 1 : 0; }
        const int sgt = wave_scan_i(cgt), seq = wave_scan_i(ceq);
        const int tot_gt = __builtin_amdgcn_readlane(sgt, 63);
        int o1 = sgt - cgt, o2 = tot_gt + seq - ceq;
        const int trash = 256 + lane;
#pragma unroll
        for (int i = 0; i < 8; ++i) if (i < nch) {
#pragma unroll
            for (int e2 = 0; e2 < 4; ++e2) { const int j = i * 4 + e2; const int idx = i * 512 + lane * 8 + 2 * e2;
                unsigned xl = XL[j], xh = XH[j]; TIE2(xl, o1); TIE2(xh, o2);
                { const bool gt = xl > c32, eq = xl == c32; const int a2 = (eq && o2 < 256) ? o2 : trash, a1 = gt ? o1 : a2; SELq[a1] = (unsigned short)idx; o1 += gt ? 1 : 0; o2 += eq ? 1 : 0; }
                TIE2(xh, o1);
                { const bool gt = xh > c32h, eq = (xh >> 16) == thr; const int a2 = (eq && o2 < 256) ? o2 : trash, a1 = gt ? o1 : a2; SELq[a1] = (unsigned short)(idx + 1); o1 += gt ? 1 : 0; o2 += eq ? 1 : 0; } } }
        ns = 256;
    }
    LDS_WAIT(); __builtin_amdgcn_wave_barrier(); }
    __syncthreads();
    {
        const int hd = lane & 15, qd = lane >> 4;
        const size_t tok = tok0 + wave;
        LAS unsigned char* vb = lds + wave * 16384;
        const unsigned vb_addr = (unsigned)(size_t)vb;
        const int vrow = lane >> 3, vch = lane & 7;
        const char* bbase = (const char*)(PROJ + (size_t)b * SEQ * PROJ_W);
        const unsigned voff0 = (unsigned)(C_V * 2 + vch * 16), koff0 = (unsigned)(C_K * 2 + qd * 16);
        unsigned roff[32];
#pragma unroll
        for (int j_ = 0; j_ < 32; ++j_) roff[j_] = (unsigned)SELq[(j_ >> 2) * 32 + vrow + 8 * (j_ & 3)] * (unsigned)(PROJ_W * 2);
#define V_DMA(sl) do { _Pragma("unroll") for (int i_ = 0; i_ < 4; ++i_) { \
            __builtin_amdgcn_global_load_lds((const unsigned*)(bbase + (roff[(sl) * 4 + i_] + voff0)), (LAS unsigned*)(vb + ((sl) & 3) * 4096 + i_ * 1024), 16, 0, 0); } } while (0)
        bf16x8 Qf[2];
#pragma unroll
        for (int ks = 0; ks < 2; ++ks) { if (hd < 8) Qf[ks] = *(const bf16x8*)(PROJ + tok * PROJ_W + C_Q + hd * 64 + ks * 32 + qd * 8); else Qf[ks] = (bf16x8){0, 0, 0, 0, 0, 0, 0, 0}; }
#define KSWZ(row) ((unsigned)(((row) & 3) | ((((row) >> 3) & 1) << 2)))
#define K_DMA(sl) do { _Pragma("unroll") for (int i_ = 0; i_ < 4; ++i_) { const int row_ = i_ * 8 + vrow; \
            __builtin_amdgcn_global_load_lds((const unsigned*)(bbase + (roff[(sl) * 4 + i_] + (unsigned)(C_K * 2) + (((unsigned)vch ^ KSWZ(row_)) * 16u))), (LAS unsigned*)(vb + ((sl) & 3) * 4096 + i_ * 1024), 16, 0, 0); } } while (0)
        (void)koff0;
        K_DMA(0); K_DMA(1); K_DMA(2); K_DMA(3);
        f32x4 S[16];
#pragma unroll
        for (int sl = 0; sl < 8; ++sl) {
            asm volatile("s_waitcnt vmcnt(12)" ::: "memory");
#pragma unroll
            for (int Th = 0; Th < 2; ++Th) { const int prow = (hd >> 2) * 8 + Th * 4 + (hd & 3); const unsigned fp = KSWZ(prow);
                const LAS unsigned char* ka = vb + (sl & 3) * 4096 + prow * 128;
                const bf16x8 K0 = *(const LAS bf16x8*)(ka + (((unsigned)qd ^ fp) * 16u)), K1 = *(const LAS bf16x8*)(ka + (((unsigned)(4 + qd) ^ fp) * 16u));
                f32x4 a = (f32x4){0.f, 0.f, 0.f, 0.f};
                a = __builtin_amdgcn_mfma_f32_16x16x32_bf16(K0, Qf[0], a, 0, 0, 0); a = __builtin_amdgcn_mfma_f32_16x16x32_bf16(K1, Qf[1], a, 0, 0, 0); S[2 * sl + Th] = a; }
            asm volatile("s_waitcnt lgkmcnt(0)" ::: "memory");
            if (sl + 4 < 8) K_DMA(sl + 4); else V_DMA(sl - 4);
        }
        const float slope = exp2f(-(float)((hd & 7) + 1)), abase = -slope * (float)t;
        float mx = -INFINITY;
#pragma unroll
        for (int sl = 0; sl < 8; ++sl) { const u32x4 w = *(const LAS u32x4*)((LAS unsigned char*)SELq + (sl * 32 + qd * 8) * 2);
#pragma unroll
            for (int e = 0; e < 8; ++e) { const int T = sl * 2 + (e >> 2), r = e & 3; const unsigned ww = w[e >> 1]; const float sf = (float)((e & 1) ? (ww >> 16) : (ww & 0xffffu));
                const float lgv = __builtin_fmaf(S[T][r], 0.125f, __builtin_fmaf(slope, sf, abase)); S[T][r] = lgv; } }
        if (ns < 256) {
#pragma unroll
            for (int sl = 0; sl < 8; ++sl)
#pragma unroll
                for (int e = 0; e < 8; ++e) { if (sl * 32 + qd * 8 + e >= ns) S[sl * 2 + (e >> 2)][e & 3] = -INFINITY; } }
#pragma unroll
        for (int T = 0; T < 16; ++T) { asm("v_max3_f32 %0, %0, %1, %2" : "+v"(mx) : "v"(S[T][0]), "v"(S[T][1])); asm("v_max3_f32 %0, %0, %1, %2" : "+v"(mx) : "v"(S[T][2]), "v"(S[T][3])); }
        mx = fmaxf(mx, __shfl_xor(mx, 16)); mx = fmaxf(mx, __shfl_xor(mx, 32));
        float sum = 0.f;
        const float mxl = mx * 1.44269504089f;
#pragma unroll
        for (int T = 0; T < 16; ++T)
#pragma unroll
            for (int r = 0; r < 4; ++r) { const float e = __builtin_amdgcn_exp2f(S[T][r] * 1.44269504089f - mxl); S[T][r] = e; sum += e; }
        sum += __shfl_xor(sum, 16); sum += __shfl_xor(sum, 32);
        u32x4 Pk[8];
#pragma unroll
        for (int sl = 0; sl < 8; ++sl) { Pk[sl].x = pk2(S[2 * sl][0], S[2 * sl][1]); Pk[sl].y = pk2(S[2 * sl][2], S[2 * sl][3]); Pk[sl].z = pk2(S[2 * sl + 1][0], S[2 * sl + 1][1]); Pk[sl].w = pk2(S[2 * sl + 1][2], S[2 * sl + 1][3]); }
        f32x4 O[4];
#pragma unroll
        for (int dt = 0; dt < 4; ++dt) O[dt] = (f32x4){0.f, 0.f, 0.f, 0.f};
#pragma unroll
        for (int sl = 0; sl < 8; ++sl) {
            if (sl <= 4) asm volatile("s_waitcnt vmcnt(12)" ::: "memory"); else if (sl == 5) asm volatile("s_waitcnt vmcnt(8)" ::: "memory"); else if (sl == 6) asm volatile("s_waitcnt vmcnt(4)" ::: "memory"); else asm volatile("s_waitcnt vmcnt(0)" ::: "memory");
            const unsigned a0 = vb_addr + (sl & 3) * 4096 + (8 * qd + (hd >> 2)) * 128 + (hd & 3) * 8;
            u32x2 tr[4][2];
            asm volatile("ds_read_b64_tr_b16 %0, %8\n\tds_read_b64_tr_b16 %1, %8 offset:512\n\tds_read_b64_tr_b16 %2, %8 offset:32\n\tds_read_b64_tr_b16 %3, %8 offset:544\n\t"
                         "ds_read_b64_tr_b16 %4, %8 offset:64\n\tds_read_b64_tr_b16 %5, %8 offset:576\n\tds_read_b64_tr_b16 %6, %8 offset:96\n\tds_read_b64_tr_b16 %7, %8 offset:608\n\ts_waitcnt lgkmcnt(0)"
                         : "=&v"(tr[0][0]), "=&v"(tr[0][1]), "=&v"(tr[1][0]), "=&v"(tr[1][1]), "=&v"(tr[2][0]), "=&v"(tr[2][1]), "=&v"(tr[3][0]), "=&v"(tr[3][1]) : "v"(a0) : "memory");
            if (sl + 4 < 8) V_DMA(sl + 4);
            const bf16x8 Pf = __builtin_bit_cast(bf16x8, Pk[sl]);
#pragma unroll
            for (int dt = 0; dt < 4; ++dt) { u32x4 vw; vw.x = tr[dt][0].x; vw.y = tr[dt][0].y; vw.z = tr[dt][1].x; vw.w = tr[dt][1].y;
                O[dt] = __builtin_amdgcn_mfma_f32_16x16x32_bf16(__builtin_bit_cast(bf16x8, vw), Pf, O[dt], 0, 0, 0); }
        }
#undef V_DMA
        const float inv = 1.0f / sum;
        if (hd < 8) {
#pragma unroll
            for (int dt = 0; dt < 4; ++dt) { u32x2 w; w.x = pk2(O[dt][0] * inv, O[dt][1] * inv); w.y = pk2(O[dt][2] * inv, O[dt][3] * inv);
                *(u32x2*)(YA + tok * 512 + hd * 64 + dt * 16 + qd * 4) = w; } }
    }
}

#define DPP_F(v, ctrl, rmask) __builtin_bit_cast(float, __builtin_amdgcn_update_dpp(__builtin_bit_cast(int, v), __builtin_bit_cast(int, v), ctrl, rmask, 0xf, false))
__device__ __forceinline__ float wave_max_dpp(float v) {
    asm volatile("s_nop 1\n\tv_max_f32_dpp %0, %0, %0 row_shr:1 row_mask:0xf bank_mask:0xf\n\ts_nop 1\n\tv_max_f32_dpp %0, %0, %0 row_shr:2 row_mask:0xf bank_mask:0xf\n\ts_nop 1\n\t"
                 "v_max_f32_dpp %0, %0, %0 row_shr:3 row_mask:0xf bank_mask:0xf\n\ts_nop 1\n\tv_max_f32_dpp %0, %0, %0 row_shr:4 row_mask:0xf bank_mask:0xf\n\ts_nop 1\n\t"
                 "v_max_f32_dpp %0, %0, %0 row_shr:8 row_mask:0xf bank_mask:0xf\n\ts_nop 1\n\tv_max_f32_dpp %0, %0, %0 row_bcast:15 row_mask:0xa bank_mask:0xf\n\ts_nop 1\n\t"
                 "v_max_f32_dpp %0, %0, %0 row_bcast:31 row_mask:0xc bank_mask:0xf\n\ts_nop 1" : "+v"(v));
    return __builtin_bit_cast(float, __builtin_amdgcn_readlane(__builtin_bit_cast(int, v), 63));
}
#define DPP_Z(v, ctrl, rmask, bmask) __builtin_bit_cast(float, __builtin_amdgcn_update_dpp(0, __builtin_bit_cast(int, v), ctrl, rmask, bmask, false))
__device__ __forceinline__ float wave_sum_dpp(float v0) {
    float v1 = v0 + DPP_Z(v0, 0x111, 0xf, 0xf); v1 += DPP_Z(v0, 0x112, 0xf, 0xf); v1 += DPP_Z(v0, 0x113, 0xf, 0xf);
    v1 += DPP_Z(v1, 0x114, 0xf, 0xe); v1 += DPP_Z(v1, 0x118, 0xf, 0xc);
    v1 += DPP_Z(v1, 0x142, 0xa, 0xf); v1 += DPP_Z(v1, 0x143, 0xc, 0xf);
    return __builtin_bit_cast(float, __builtin_amdgcn_readlane(__builtin_bit_cast(int, v1), 63));
}
constexpr int RT_LG = 0;
constexpr int RT_ENT = 32768;
constexpr int RT_HIST = RT_ENT + 8 * 128 * 12;
constexpr int RT_NV = 49152;
__device__ __forceinline__ void route_tile(const Params& p, LAS unsigned char* lds, int tile, int skip) {
    const int tid = tidx(), lane = tid & 63, wave = __builtin_amdgcn_readfirstlane(tid >> 6), hd = lane & 15, qd = lane >> 4;
    const float* ada = (const float*)(p.ws + WS_ADA); const float* g2 = p.in[19];
    bf16_t* U2 = (bf16_t*)(p.ws + WS_U);
    LAS int* hist = (LAS int*)(lds + RT_HIST);
    LAS float* LGT = (LAS float*)(lds + RT_LG);
    LAS int* ENT = (LAS int*)(lds + RT_ENT) + wave * 384;
    const int b = (tile * 128) >> 12;
    __syncthreads();
    if (tid < 64) hist[tid] = 0;
    if (tid == 64) hist[128] = 0;
    { LAS float* NV = (LAS float*)(lds + RT_NV);
      for (int i = tid; i < 256; i += NTHR) { const f32x4 g = *(const f32x4*)(g2 + 4 * i), sc = *(const f32x4*)(ada + b * 6144 + 4096 + 4 * i), sh = *(const f32x4*)(ada + b * 6144 + 3072 + 4 * i);
          *(LAS f32x4*)(NV + 4 * i) = g * (sc + 1.0f); *(LAS f32x4*)(NV + 1024 + 4 * i) = sh; } }
    __syncthreads();
    if (wave < 4) {
        const int tokw = tile * 128 + wave * 32;
        float rstd[2]; const bf16_t* hrow[2];
#pragma unroll
        for (int rt = 0; rt < 2; ++rt) { const int m = tokw + rt * 16 + hd; hrow[rt] = (const bf16_t*)(p.out + (size_t)m * D) + qd * 8;
            const f32x4 q4 = *(const f32x4*)((const float*)(p.ws + WS_SS) + (size_t)m * 16 + qd * 4); float ss = (q4.x + q4.y) + (q4.z + q4.w);
            ss += __shfl_xor(ss, 16); ss += __shfl_xor(ss, 32); rstd[rt] = 1.0f / sqrtf(ss * (1.f / D) + EPS); }
        const bf16x8* WH = (const bf16x8*)(p.ws + WS_WRF) + lane; const bf16x8* WL = WH + 32 * 4 * 64;
        f32x4 acc[2][4];
#pragma unroll
        for (int rt = 0; rt < 2; ++rt)
#pragma unroll
            for (int nt = 0; nt < 4; ++nt) acc[rt][nt] = (f32x4){0.f, 0.f, 0.f, 0.f};
        bf16x8 wh[4], wl[4], whn[4], wln[4]; u32x4 xa[2], xn[2], xnn[2];
#pragma unroll
        for (int nt = 0; nt < 4; ++nt) { wh[nt] = WH[nt * 64]; wl[nt] = WL[nt * 64]; }
#pragma unroll
        for (int rt = 0; rt < 2; ++rt) { xa[rt] = *(const u32x4*)(hrow[rt]); xn[rt] = *(const u32x4*)(hrow[rt] + 32); }
#pragma unroll 2
        for (int ks = 0; ks < 32; ++ks) {
            const int kn = (ks + 1 < 32) ? ks + 1 : ks;
#pragma unroll
            for (int nt = 0; nt < 4; ++nt) { whn[nt] = WH[(kn * 4 + nt) * 64]; wln[nt] = WL[(kn * 4 + nt) * 64]; }
#pragma unroll
            for (int rt = 0; rt < 2; ++rt) xnn[rt] = *(const u32x4*)(hrow[rt] + ((ks + 2 < 32) ? ks + 2 : ks) * 32);
            const int c0 = ks * 32 + qd * 8;
            const LAS float* NV = (const LAS float*)(lds + RT_NV);
            const f32x4 ma = *(const LAS f32x4*)(NV + c0), mb = *(const LAS f32x4*)(NV + c0 + 4), ha = *(const LAS f32x4*)(NV + 1024 + c0), hb = *(const LAS f32x4*)(NV + 1024 + c0 + 4);
#pragma unroll
            for (int rt = 0; rt < 2; ++rt) {
                const f32x4 x0 = {bflo(xa[rt].x), bfhi(xa[rt].x), bflo(xa[rt].y), bfhi(xa[rt].y)}, x1 = {bflo(xa[rt].z), bfhi(xa[rt].z), bflo(xa[rt].w), bfhi(xa[rt].w)};
                const f32x4 y0 = x0 * rstd[rt] * ma + ha, y1 = x1 * rstd[rt] * mb + hb;
                const u32x4 hi = pack8(y0, y1);
                f32x4 r0, r1; r0.x = y0.x - bflo(hi.x); r0.y = y0.y - bfhi(hi.x); r0.z = y0.z - bflo(hi.y); r0.w = y0.w - bfhi(hi.y);
                r1.x = y1.x - bflo(hi.z); r1.y = y1.y - bfhi(hi.z); r1.z = y1.z - bflo(hi.w); r1.w = y1.w - bfhi(hi.w);
                const bf16x8 uh = __builtin_bit_cast(bf16x8, hi), ul = __builtin_bit_cast(bf16x8, pack8(r0, r1));
#pragma unroll
                for (int nt = 0; nt < 4; ++nt) {
                    acc[rt][nt] = __builtin_amdgcn_mfma_f32_16x16x32_bf16(wh[nt], uh, acc[rt][nt], 0, 0, 0);
                    acc[rt][nt] = __builtin_amdgcn_mfma_f32_16x16x32_bf16(wl[nt], uh, acc[rt][nt], 0, 0, 0);
                    acc[rt][nt] = __builtin_amdgcn_mfma_f32_16x16x32_bf16(wh[nt], ul, acc[rt][nt], 0, 0, 0); } }
#pragma unroll
            for (int nt = 0; nt < 4; ++nt) { wh[nt] = whn[nt]; wl[nt] = wln[nt]; }
#pragma unroll
            for (int rt = 0; rt < 2; ++rt) { xa[rt] = xn[rt]; xn[rt] = xnn[rt]; }
        }
#pragma unroll
        for (int rt = 0; rt < 2; ++rt)
#pragma unroll
            for (int nt = 0; nt < 4; ++nt) *(LAS f32x4*)(LGT + (wave * 32 + rt * 16 + hd) * 64 + nt * 16 + qd * 4) = acc[rt][nt];
    }
    {
        LAS int* rowctr = hist + 128;
        LAS const float* NV = (LAS const float*)(lds + RT_NV);
        auto claim = [&]() -> int { int r = 0; if (lane == 0) r = __hip_atomic_fetch_add(rowctr, 1, __ATOMIC_RELAXED, __HIP_MEMORY_SCOPE_WORKGROUP); return __builtin_amdgcn_readfirstlane(r); };
        const float* SSp = (const float*)(p.ws + WS_SS);
#define RT_ROWLOAD(vv, sv, rr) do { if ((rr) < 128) { const int m_ = tile * 128 + (rr); const u32x4* xr_ = (const u32x4*)(p.out + (size_t)m_ * D) + lane; vv[0] = xr_[0]; vv[1] = xr_[64]; sv = SSp[(size_t)m_ * 16 + (lane & 15)]; } } while (0)
        int r = claim(), rn = claim(); u32x4 v[2] = {}, vn[2] = {}; float ssl = 0.f, ssn = 0.f;
        RT_ROWLOAD(v, ssl, r); RT_ROWLOAD(vn, ssn, rn);
        while (r < 128) {
            const int rnn = (rn < 128) ? claim() : 128; u32x4 vnn[2] = {vn[0], vn[1]}; float ssnn = 0.f;
            RT_ROWLOAD(vnn, ssnn, rnn);
            float ss = ssl; ss += __shfl_xor(ss, 1); ss += __shfl_xor(ss, 2); ss += __shfl_xor(ss, 4); ss += __shfl_xor(ss, 8);
            const float rstd = 1.0f / sqrtf(ss * (1.f / D) + EPS);
            u32x4* o16 = (u32x4*)(U2 + (size_t)(tile * 128 + r) * D) + lane;
#pragma unroll
            for (int j = 0; j < 2; ++j) { const int c0 = 8 * lane + 512 * j;
                const f32x4 ma = *(LAS const f32x4*)(NV + c0), mb = *(LAS const f32x4*)(NV + c0 + 4), sh = *(LAS const f32x4*)(NV + 1024 + c0), sb = *(LAS const f32x4*)(NV + 1024 + c0 + 4);
                const f32x4 x0 = {bflo(v[j].x), bfhi(v[j].x), bflo(v[j].y), bfhi(v[j].y)}, x1 = {bflo(v[j].z), bfhi(v[j].z), bflo(v[j].w), bfhi(v[j].w)};
                o16[64 * j] = pack8(x0 * rstd * ma + sh, x1 * rstd * mb + sb); }
            v[0] = vn[0]; v[1] = vn[1]; vn[0] = vnn[0]; vn[1] = vnn[1];
            ssl = ssn; ssn = ssnn; r = rn; rn = rnn;
        }
#undef RT_ROWLOAD
    }
    __syncthreads();
    const int tok0 = tile * 128 + wave * 16;
    LAS float* LG = LGT + wave * 1024;
    const float rbias = p.in[21][lane];
#pragma unroll 1
    for (int mi = 0; mi < 16; ++mi) {
        const float score = sigmoidf_(LG[mi * 64 + lane]); const float biased = score + rbias;
        float m1 = biased;
        m1 = fmaxf(m1, DPP_F(m1, 0xb1, 0xf)); m1 = fmaxf(m1, DPP_F(m1, 0x4e, 0xf)); m1 = fmaxf(m1, DPP_F(m1, 0x141, 0xf));
        const unsigned long long bal = __ballot(biased == m1); const int grp = lane >> 3;
        const unsigned gm = (unsigned)((bal >> (grp * 8)) & 0xffull); const int first = __ffs((int)gm) - 1;
        float v2 = ((lane & 7) == first) ? -INFINITY : biased;
        v2 = fmaxf(v2, DPP_F(v2, 0xb1, 0xf)); v2 = fmaxf(v2, DPP_F(v2, 0x4e, 0xf)); v2 = fmaxf(v2, DPP_F(v2, 0x141, 0xf));
        const float gscore = m1 + v2;
        int grank = 0;
#pragma unroll
        for (int og = 0; og < 8; ++og) { const float o = __builtin_bit_cast(float, __builtin_amdgcn_readlane(__builtin_bit_cast(int, gscore), og * 8)); grank += (o > gscore || (o == gscore && og < grp)) ? 1 : 0; }
        float mv = (grank < 4) ? biased : -INFINITY;
        unsigned long long chosen_m = 0ull;
#pragma unroll 1
        for (int it = 0; it < 8; ++it) { const float mxv = wave_max_dpp(mv); const unsigned long long e = __ballot(mv == mxv); const int w = (int)__builtin_ctzll(e); chosen_m |= 1ull << w; if (lane == w) mv = -INFINITY; }
        const bool chosen = (chosen_m >> lane) & 1ull;
        const int rank = (int)__builtin_amdgcn_mbcnt_hi((unsigned)(chosen_m >> 32), __builtin_amdgcn_mbcnt_lo((unsigned)chosen_m, 0u));
        const float gsum = wave_sum_dpp(chosen ? score : 0.f);
        if (chosen) { const int lpos = __hip_atomic_fetch_add(hist + lane, 1, __ATOMIC_RELAXED, __HIP_MEMORY_SCOPE_WORKGROUP);   const int e = mi * 8 + rank; ENT[e * 3] = lane; ENT[e * 3 + 1] = lpos; ENT[e * 3 + 2] = __builtin_bit_cast(int, score / gsum * 2.5f); }
    }
    __syncthreads();
    const int ch = (tile * 128) / CHTOK;
    if (skip) return;
    if (tid < 64) { const int c = hist[tid]; int base = 0; if (c > 0) base = (int)atomicAdd((unsigned*)(p.ws + WS_CTL) + CW_CNT + ch * NE + tid, (unsigned)c); hist[64 + tid] = base; }
    __syncthreads();
#pragma unroll
    for (int i = 0; i < 2; ++i) { const int e = lane + 64 * i; const int ex = ENT[e * 3], lpos = ENT[e * 3 + 1]; const float gate = __builtin_bit_cast(float, ENT[e * 3 + 2]);
        const int m = tok0 + (e >> 3), rk = e & 7, pair = ch * NE + ex, ps = hist[64 + ex] + lpos;
        ((int*)(p.ws + WS_DSTL))[(size_t)pair * PAIRCAP + ps] = (m - ch * CHTOK) * NSLOT + rk; ((float*)(p.ws + WS_GATEL))[(size_t)pair * PAIRCAP + ps] = gate; }
}

#define XB_TMO      128
#define XB_XCNT(j)  (256  + 64 * (j))
#define XB_XSUB(j)  (1280 + 64 * (j))
#define XB_XGEN(j)  (2304 + 64 * (j))
#define XB_TOP      3328
#define XB_TOPGEN   3392
#define XCD_BAR_WORDS 3456
#define XB_SPIN_CAP (1u << 22)
__device__ __forceinline__ unsigned xb_ld(unsigned* p)              { return __hip_atomic_load(p, __ATOMIC_RELAXED, __HIP_MEMORY_SCOPE_AGENT); }
__device__ __forceinline__ unsigned xb_add(unsigned* p, unsigned v) { return __hip_atomic_fetch_add(p, v, __ATOMIC_RELAXED, __HIP_MEMORY_SCOPE_AGENT); }
__device__ __forceinline__ unsigned xb_xcc_id() { return (unsigned)__builtin_amdgcn_s_getreg((3 << 11) | 20) & 0xFu; }
#define XB_SPIN(cond, bar) do { unsigned _sp = 0; while (cond) { __builtin_amdgcn_s_sleep(1); \
    if ((++_sp & 255u) == 0u) { if (xb_ld(&(bar)[XB_TMO])) break; if (_sp > XB_SPIN_CAP) { atomicAdd(&(bar)[XB_TMO], 1u); break; } } } } while (0)
struct XcdBarrier { unsigned* bar; unsigned x; volatile LAS unsigned* st; };
__device__ __forceinline__ XcdBarrier xcd_barrier_post(unsigned* bar, volatile LAS unsigned* st) {
    XcdBarrier b; b.bar = bar; b.x = xb_xcc_id(); b.st = st;
    if (tidx() == 0) (void)xb_add(&bar[XB_XCNT(b.x)], 1u);
    return b;
}
__device__ __forceinline__ void xcd_barrier_complete(unsigned* bar, unsigned x, unsigned& nloc, unsigned& nx) {
    const unsigned G = gridDim.x * gridDim.y * gridDim.z;
    unsigned sum, cnt, mine, sp = 0u;
    for (;;) {
        sum = 0u; cnt = 0u; mine = 0u;
#pragma unroll
        for (unsigned j = 0; j < 16; ++j) { const unsigned c = xb_ld(&bar[XB_XCNT(j)]); sum += c; cnt += (c > 0u) ? 1u : 0u; mine = (j == x) ? c : mine; }
        if (sum == G) break;
        __builtin_amdgcn_s_sleep(1);
        if ((++sp & 255u) == 0u) { if (xb_ld(&bar[XB_TMO])) break; if (sp > XB_SPIN_CAP) { atomicAdd(&bar[XB_TMO], 1u); break; } }
    }
    nloc = mine > 0u ? mine : 1u; nx = cnt > 0u ? cnt : 1u;
}
__device__ __forceinline__ void xcd_barrier(const XcdBarrier& b) {
    asm volatile("s_waitcnt vmcnt(0)" ::: "memory");
    __syncthreads();
    if (tidx() == 0) {
        unsigned* bar = b.bar;
        __builtin_amdgcn_s_waitcnt(0);
        unsigned nloc = b.st[0], nx = b.st[1];
        if (nloc == 0u) { xcd_barrier_complete(bar, b.x, nloc, nx); b.st[0] = nloc; b.st[1] = nx; }
        const unsigned old = xb_add(&bar[XB_XSUB(b.x)], 1u);
        const unsigned gen = old / nloc;
        if (old + 1u == (gen + 1u) * nloc) {
            __builtin_amdgcn_fence(__ATOMIC_RELEASE, "agent");
            asm volatile("s_waitcnt vmcnt(0)" ::: "memory");
            const unsigned og = xb_add(&bar[XB_TOP], 1u);
            const unsigned tg = og / nx;
            if (og + 1u == (tg + 1u) * nx) xb_add(&bar[XB_TOPGEN], 1u);
            else XB_SPIN(xb_ld(&bar[XB_TOPGEN]) == tg, bar);
            __builtin_amdgcn_fence(__ATOMIC_ACQUIRE, "agent");
            xb_add(&bar[XB_XGEN(b.x)], 1u);
            asm volatile("s_waitcnt vmcnt(0)" ::: "memory");
        } else {
            XB_SPIN(xb_ld(&bar[XB_XGEN(b.x)]) == gen, bar);
            __builtin_amdgcn_fence(__ATOMIC_ACQUIRE, "agent");
            asm volatile("s_waitcnt vmcnt(0)" ::: "memory");
        }
    }
    __syncthreads();
}

enum { PH_PREP = 0, PH_MOD, PH_INPROJ, PH_MIX  , PH_GLU, PH_MIXAB, PH_OUT, PH_ROUTE  , PH_MOE1, PH_MOE2_0, PH_COMB_0, PH_END };

#ifndef USE_CG_SYNC
#define USE_CG_SYNC 0
#endif
__global__ void __launch_bounds__(NTHR, 2) mega(Params p_arg) {
    extern __shared__ __attribute__((aligned(16))) unsigned char lds_raw[];
    LAS unsigned char* lds = (LAS unsigned char*)lds_raw;
    const int G = gridDim.x, bx = blockIdx.x;
    const int vcu = (G % 8 == 0) ? (bx % 8) * (G / 8) + bx / 8 : bx;
    const int tid = tidx(), lane = tid & 63, wave = __builtin_amdgcn_readfirstlane(tid >> 6);
    unsigned char* const ws_ = p_arg.ws; unsigned char* ws = ws_; (void)ws;
    if (tid < 32) ((LAS unsigned*)(lds + LDS_MISC))[tid] = 0u;
    __syncthreads();
#if USE_CG_SYNC
    cg::grid_group grid = cg::this_grid();
#define GRID_SYNC() grid.sync()
#else
    XcdBarrier xbar = xcd_barrier_post((unsigned*)(ws + WS_CTL) + CW_BAR, (volatile LAS unsigned*)(lds + LDS_MISC) + 8);
#define GRID_SYNC() xcd_barrier(xbar)
#endif
#ifndef ONLY_PH
#define ONLY_PH -1
#endif
#define IN(k) (ONLY_PH < 0 || ONLY_PH == (k))
#define SEAM(k) do { if ((k) + 1 < PH_END) GRID_SYNC(); } while (0)
#ifndef REP_PH
#define REP_PH -1
#endif
#ifndef REP_N
#define REP_N 3
#endif
#ifndef PROBE_NOSTORE
#define PROBE_NOSTORE 0
#endif
#define PHASE(k, ...) do { if (IN(k)) { { const int PROBE_SKIP = 0; unsigned zoff_ = 0u; asm volatile("" : "+s"(zoff_)); unsigned char* ws = ws_ + zoff_; const Params& p = *(const Params*)((const char*)&p_arg + zoff_); __VA_ARGS__ } if ((REP_PH) == (k)) { GRID_SYNC(); { const int PROBE_SKIP = PROBE_NOSTORE; unsigned zoff_ = 0u; asm volatile("" : "+s"(zoff_)); unsigned char* ws = ws_ + zoff_; const Params& p = *(const Params*)((const char*)&p_arg + zoff_); __VA_ARGS__ } GRID_SYNC(); { const int PROBE_SKIP = PROBE_NOSTORE; unsigned zoff_ = 0u; asm volatile("" : "+s"(zoff_)); unsigned char* ws = ws_ + zoff_; const Params& p = *(const Params*)((const char*)&p_arg + zoff_); __VA_ARGS__ } } } SEAM(k); } while (0)
    PHASE(PH_PREP, p0_prep(p, lds, vcu, G););
    PHASE(PH_MOD, p1_modulate(p, vcu, G););
    PHASE(PH_INPROJ, {
        pg8::DenseSched S; S.init(ws + WS_U, ws + WS_W_IN, NTOK, NIN, 1024, G, bx);
        EpiInProj E{(bf16_t*)(ws + WS_PROJ), (bf16_t*)(ws + WS_G), (bf16_t*)(ws + WS_KIF)};
        pg8::gemm_phase<EpiInProj, pg8::DenseSched, false>(lds, 1024, S, E);
        if (G == 256 && bx >= 128) { __syncthreads(); run_transposes(p, ws, lds, T_NITEMS - T_LATE2 - T_LATE, T_NITEMS - T_LATE2, (bx - 128) * NWAVES + wave, 128 * NWAVES); } });
    PHASE(PH_MIX, {
#ifdef GOLD_S5
        for (int it = vcu + G * wave; it < 256; it += G * NWAVES) gold_s5(p, it, lane);
#else
#ifndef REP_S5
#define REP_S5 1
#endif
#ifndef REP_ATTN
#define REP_ATTN 1
#endif
        for (int r_ = 0; r_ < REP_S5; ++r_) for (int it = vcu; it < 256; it += G) s5_item(p, lds, it);
#endif
#ifdef GOLD_ATTN
        for (int pr = vcu; pr < NTOK / 2; pr += G) gold_attn_pair(p, lds, pr);
#else
        for (int r_ = 0; r_ < REP_ATTN; ++r_) {
            for (int k = 0; ; ++k) { int ab, aq;
                if (G == 256) { if (k >= 16) break; ab = vcu >> 5; aq = 511 - ((vcu & 31) + 32 * k); }
                else { const int it = vcu + k * G; if (it >= NTOK / 8) break; ab = it & 7; aq = 511 - (it >> 3); }
                attn_item(p, lds, ab, aq); } }
#endif
        __syncthreads(); });
    PHASE(PH_GLU, {
        pg8::DenseSched S; S.init(ws + WS_YG, ws + WS_W_GLU, NTOK, 512, 512, G, bx);
        EpiGlu E{(const bf16_t*)(ws + WS_YG), p.in[15], (bf16_t*)(ws + WS_U)};
        pg8::gemm_phase<EpiGlu, pg8::DenseSched, false>(lds, 512, S, E); });
    PHASE(PH_MIXAB, {
        MixSched S; S.D0.init(ws + WS_U, ws + WS_W_PS, NTOK, 1024, 512, G, bx); S.D1.init(ws + WS_YATTN, ws + WS_W_PA, NTOK, 1024, 512, G, bx);
        EpiMix E{(const bf16_t*)(ws + WS_G), (bf16_t*)(ws + WS_MERGED)};
        pg8::gemm_phase<EpiMix, MixSched, false, false, true>(lds, 512, S, E); });
    PHASE(PH_OUT, {
        pg8::DenseSched S; S.init(ws + WS_MERGED, ws + WS_W_OUT, NTOK, 1024, 1024, G, bx);
        EpiOut E{p.in[0], (const float*)(ws + WS_ADA), p.out, (float*)(ws + WS_SS)};
        pg8::gemm_phase<EpiOut, pg8::DenseSched, false>(lds, 1024, S, E); });
    PHASE(PH_ROUTE, { for (int tile = vcu; tile < NTOK / 128; tile += G) route_tile(p, lds, tile, PROBE_SKIP); });
    PHASE(PH_MOE1, {
        build_moe_tables(lds, (const unsigned*)(ws + WS_CTL) + CW_CNT);
        Moe1Sched S{lds, G, vcu, (const char*)(ws + WS_U), (const int*)(ws + WS_DSTL), (const int*)(ws + WS_IDENT), (const char*)(ws + WS_W_EGU), (const char*)(ws + WS_W_SGU)};
        EpiMoe1 E{(bf16_t*)(ws + WS_H)};
        pg8::gemm_phase<EpiMoe1, Moe1Sched, true>(lds, 1024, S, E);
        { LAS int* TB_ = (LAS int*)(lds + LDS_TB); const int total = (RFL(TB_[256]) + 128) * 2, rem = total % G, nidle = rem ? G - rem : 0;
          __syncthreads();
          if (nidle == 0) run_transposes(p, ws, lds, T_NITEMS - T_LATE2, T_NITEMS, vcu * NWAVES + wave, G * NWAVES);
          else if (vcu >= rem) run_transposes(p, ws, lds, T_NITEMS - T_LATE2, T_NITEMS, (vcu - rem) * NWAVES + wave, nidle * NWAVES); } });
#pragma unroll
    for (int ch = 0; ch < NCHUNK; ++ch) {
        PHASE(PH_MOE2_0 + 2 * ch, {
            build_moe_tables(lds, (const unsigned*)(ws + WS_CTL) + CW_CNT);
            Moe2Sched S{lds, G, vcu, ch, ws};
            EpiMoe2 E{(unsigned char*)(ws + WS_Y), PROBE_SKIP, lds};
            pg8::gemm_phase<EpiMoe2, Moe2Sched, false, true>(lds, 256, S, E); });
        PHASE(PH_COMB_0 + 2 * ch, { p_combine(p, vcu, G, ch); });
    }
#undef IN
}

extern "C" void kernel_launch(void* const* d_in, const int* in_sizes, int n_in, void* d_out, int out_size, void* d_ws, size_t ws_size, hipStream_t stream) {
    static int grid = 0;
    if (grid == 0) {
        if (n_in != 29 || out_size != NTOK * D || ws_size < WS_NEED) { fprintf(stderr, "kernel_launch: unexpected shapes n_in %d out %d ws %zu\n", n_in, out_size, ws_size); grid = -1; return; }
        int dev = 0, cus = 0, per_cu = 0;
        hipGetDevice(&dev); hipDeviceGetAttribute(&cus, hipDeviceAttributeMultiprocessorCount, dev);
        hipFuncSetAttribute((const void*)mega, hipFuncAttributeMaxDynamicSharedMemorySize, LDS_BYTES);
        hipOccupancyMaxActiveBlocksPerMultiprocessor(&per_cu, (const void*)mega, NTHR, LDS_BYTES);
        (void)hipGetLastError();
        grid = (per_cu >= 1) ? cus : -1;
        if (grid < 0) { fprintf(stderr, "kernel_launch: occupancy query says %d blocks/CU\n", per_cu); return; }
    }
    if (grid < 0) return;
    hipMemsetAsync((char*)d_ws + WS_CTL, 0, CTL_BYTES, stream);
    Params p{};
    for (int i = 0; i < 29; ++i) p.in[i] = (const float*)d_in[i];
    p.out = (float*)d_out; p.ws = (unsigned char*)d_ws;
    p.ph_lo = 0; p.ph_hi = PH_END;
    void* args[] = {&p};
    hipError_t e = hipLaunchCooperativeKernel((const void*)mega, dim3(grid), dim3(NTHR), args, LDS_BYTES, stream);
    if (e != hipSuccess) fprintf(stderr, "kernel_launch: cooperative launch failed: %s (grid %d)\n", hipGetErrorString(e), grid);
}
```

```cpp
#include <hip/hip_runtime.h>
#include <hip/hip_cooperative_groups.h>
#include <cstdio>
#include <cstdint>
#include <cmath>
namespace cg = cooperative_groups;

#define GAS __attribute__((address_space(1)))
#define LAS __attribute__((address_space(3)))
typedef unsigned short bf16_t;
typedef short bf16x8 __attribute__((ext_vector_type(8)));
typedef float f32x4 __attribute__((ext_vector_type(4)));
typedef float f32x2 __attribute__((ext_vector_type(2)));
typedef unsigned u32x4 __attribute__((ext_vector_type(4)));
typedef unsigned u32x2 __attribute__((ext_vector_type(2)));

constexpr int NB = 8, SEQ = 4096, NTOK = NB * SEQ, D = 1024;
constexpr int IN_W = 3784, NIN = 3840, PROJ_W = 1792, G_W = 2048;
constexpr int C_USSM = 0, C_Q = 512, C_K = 1024, C_V = 1088, C_QI = 1152, C_KI = 1664, C_WI = 1728, PROJ_USED = 1736;
constexpr int NE = 64, TOPK = 8, NCHUNK = 1, CHTOK = NTOK / NCHUNK, NPAIR = NCHUNK * NE, PAIRCAP = CHTOK, NSLOT = 9;
constexpr float Y_SCALE = 64.0f;
constexpr int HROWS_ROUTED = NTOK * TOPK, HSH_ROW0 = HROWS_ROUTED + 256;
constexpr float EPS = 1e-6f;
constexpr int NWAVES = 8, NTHR = 512;

constexpr size_t MiB = 1u << 20;
constexpr size_t WS_CTL = 0, CTL_BYTES = 1 * MiB;
constexpr size_t WS_ADA = 1 * MiB;
constexpr size_t WS_ONES = 1 * MiB + 224 * 1024;
constexpr size_t WS_A32 = 1 * MiB + 256 * 1024;
constexpr size_t WS_IDENT = 1 * MiB + 512 * 1024;
constexpr size_t WS_WRF = 1 * MiB + 768 * 1024;
constexpr size_t WS_W_IN = 2 * MiB;
constexpr size_t WS_W_GLU = 10 * MiB;
constexpr size_t WS_W_PS = 11 * MiB;
constexpr size_t WS_W_PA = 12 * MiB;
constexpr size_t WS_W_OUT = 13 * MiB;
constexpr size_t WS_W_SGU = 15 * MiB;
constexpr size_t WS_W_SD = 16 * MiB;
constexpr size_t WS_TZF = 17 * MiB, WS_WINF = 18 * MiB, WS_WOUTF = 22 * MiB;
constexpr size_t WS_W_ED = 26 * MiB;
constexpr size_t WS_W_EGU = 58 * MiB;
constexpr size_t WS_KIF = 122 * MiB;
constexpr size_t WS_U = 128 * MiB;
constexpr size_t WS_PROJ = 192 * MiB;
constexpr size_t WS_G = 304 * MiB;
constexpr size_t WS_YG = 432 * MiB;
constexpr size_t WS_YATTN = 464 * MiB;
constexpr size_t WS_MERGED = 192 * MiB;
constexpr size_t WS_Y = 58 * MiB;
constexpr size_t WS_H = 346 * MiB;
constexpr size_t WS_DSTL = 492 * MiB;
constexpr size_t WS_SS = 4 * MiB;
constexpr size_t WS_GATEL = 500 * MiB;
constexpr size_t WS_NEED = 512 * MiB;
constexpr int CW_CNT = 0;
constexpr int CW_BAR = 4096;
constexpr int CW_Q0 = 1024;

constexpr int STAGE_BYTES = 131072;
constexpr int LDS_RO = STAGE_BYTES;
constexpr int LDS_MISC = LDS_RO + 2048;
constexpr int LDS_CNT = LDS_MISC + 128;
constexpr int LDS_RS = LDS_CNT + 1024;
constexpr int LDS_TB = LDS_RS + 1040;
constexpr int LDS_TD = LDS_TB + 1040;
constexpr int LDS_META = LDS_TD + 1408 * 4;
constexpr int LDS_BYTES = 147456;
static_assert(LDS_META + 4096 <= LDS_BYTES, "LDS map");

__device__ __forceinline__ unsigned f2bf(float f) { unsigned u = __builtin_bit_cast(unsigned, f); return (u + 0x7fffu + ((u >> 16) & 1u)) >> 16; }
typedef __bf16 bf16x2_t __attribute__((ext_vector_type(2)));
__device__ __forceinline__ unsigned pk2(float lo, float hi) { const f32x2 v = {lo, hi}; const bf16x2_t r = __builtin_convertvector(v, bf16x2_t); return __builtin_bit_cast(unsigned, r); }
__device__ __forceinline__ float bf2f(unsigned short b) { return __builtin_bit_cast(float, (unsigned)b << 16); }
__device__ __forceinline__ float bflo(unsigned w) { return __builtin_bit_cast(float, w << 16); }
__device__ __forceinline__ float bfhi(unsigned w) { return __builtin_bit_cast(float, w & 0xffff0000u); }
__device__ __forceinline__ float sigmoidf_(float x) { return __builtin_amdgcn_rcpf(1.0f + __builtin_amdgcn_exp2f(-1.44269504089f * x)); }
__device__ __forceinline__ float wave_sum(float v) {
#pragma unroll
    for (int o = 1; o < 64; o <<= 1) v += __shfl_xor(v, o);
    return v;
}
__device__ __forceinline__ int tidx() { int t = threadIdx.x; asm volatile("" : "+v"(t)); return t; }
#define LDS_WAIT() asm volatile("s_waitcnt lgkmcnt(0)" ::: "memory")

namespace pg8 {
constexpr int BM = 256, BK = 64, HALF = 128, HTB = HALF * BK * 2, NXCD = 8, WGM = 8;
__host__ __device__ __forceinline__ int lds_byte(int r, int c) { const int st = (r >> 4) * 2 + (c >> 5), rr = r & 15, cc = c & 31, ob = rr * 64 + cc * 2; return st * 1024 + (ob ^ (((ob >> 9) & 1) << 5)); }
__host__ __device__ __forceinline__ void stage_rc(int b, int& R, int& C) { const int st = b / 1024, sb = b % 1024, swz = sb ^ (((sb >> 9) & 1) << 5); R = (st >> 1) * 16 + swz / 64; C = (st & 1) * 32 + (swz % 64) / 2; }
__host__ __device__ __forceinline__ int perm32(int rho) { const int n = rho >> 4, i = rho & 15; return 8 * (i >> 2) + 4 * n + (i & 3); }

struct Unit { int pm, pn; const char* A; const char* B; const int* rows; int valid; int x0; int rbase; const float* gp; };

struct DenseSched {
    int nM, nN, nwg, G, c; const char* A; const char* B; size_t tstep;
    __device__ __forceinline__ void init(const void* A_, const void* B_, int M, int N, int K, int G_, int c_) { nM = M / BM; nN = N / BM; nwg = nM * nN; G = G_; c = c_; A = (const char*)A_; B = (const char*)B_; tstep = (size_t)BM * K * 2; }
    __device__ __forceinline__ bool next(int i, Unit& u) const {
        const long L = (long)i * G + c; if (L >= nwg) return false;
        int wgid = (int)L; { const int q = nwg / NXCD, r = nwg % NXCD, xcd = wgid % NXCD, off = wgid / NXCD; wgid = (xcd < r ? xcd * (q + 1) : r * (q + 1) + (xcd - r) * q) + off; }
        const int nig = WGM * nN, gid = wgid / nig, fm = gid * WGM, gsz = (nM - fm) < WGM ? (nM - fm) : WGM;
        u.pm = fm + ((wgid % nig) % gsz); u.pn = (wgid % nig) / gsz;
        u.A = A + (size_t)u.pm * tstep; u.B = B + (size_t)u.pn * tstep; u.rows = nullptr; u.valid = 256; u.x0 = 0; u.rbase = 0; u.gp = nullptr; return true;
    }
};

template <class Epi, class Sched, bool GATHER, bool RMETA = false, bool KEEPACC = false>
__device__ __forceinline__ void gemm_phase(LAS unsigned char* lds, const int K, const Sched& S, const Epi& E) {
    int tid_ = tidx(); asm volatile("" : "+v"(tid_));
    const int tid = tid_, wid = __builtin_amdgcn_readfirstlane(tid >> 6), lane = tid & 63, wr = wid >> 2, wc = wid & 3, fr = lane & 15, fq = lane >> 4;
    const int nt = K / BK;
    unsigned voffA[2], voffB[2]; int roA[2];
#pragma unroll
    for (int i = 0; i < 2; ++i) { int R, C; stage_rc(tid * 16 + i * 8192, R, C); const int Rb = (R & ~31) + perm32(R & 31);
        voffA[i] = GATHER ? (unsigned)(C * 2) : (unsigned)(R * K + C) * 2u; voffB[i] = (unsigned)(Rb * K + C) * 2u; roA[i] = R * 4; }
    const size_t kstep = (size_t)(BK * 2);
    const size_t hstep = (size_t)HALF * K * 2;
    const unsigned ldsw = (unsigned)wid * 1024u;
    const int aoff = lds_byte(wr * 64 + fr, fq * 8), boff = lds_byte(wc * 32 + fr, fq * 8);
    LAS unsigned char* ro = lds + LDS_RO;
#define PG8_SA(b, h) (((b) * 2 + (h)) * HTB)
#define PG8_SB(b, h) ((4 + (b) * 2 + (h)) * HTB)
#define PG8_STAGE_B(bufoff, gbase) do { _Pragma("unroll") for (int _i = 0; _i < 2; ++_i) \
        __builtin_amdgcn_global_load_lds((const unsigned*)((const char*)(gbase) + voffB[_i]), (LAS unsigned*)(lds + (bufoff) + ldsw + _i * 8192), 16, 0, 0); } while (0)
#define PG8_STAGE_A(bufoff, gbase, h, slot) do { _Pragma("unroll") for (int _i = 0; _i < 2; ++_i) { \
        unsigned _vo = voffA[_i]; const char* _gb = (const char*)(gbase); \
        if (GATHER) _vo += *(const LAS unsigned*)(ro + (slot) * 1024 + (h) * 512 + roA[_i]); else _gb += (h) * hstep; \
        __builtin_amdgcn_global_load_lds((const unsigned*)(_gb + _vo), (LAS unsigned*)(lds + (bufoff) + ldsw + _i * 8192), 16, 0, 0); } } while (0)
#define PG8_LDA(dst, b, h) do { _Pragma("unroll") for (int m = 0; m < 4; ++m) _Pragma("unroll") for (int k = 0; k < 2; ++k) dst[m][k] = *(const LAS bf16x8*)(lds + PG8_SA(b, h) + aoff + m * 2048 + k * 1024); } while (0)
#define PG8_LDB(dst, b, h) do { _Pragma("unroll") for (int n = 0; n < 2; ++n) _Pragma("unroll") for (int k = 0; k < 2; ++k) dst[n][k] = *(const LAS bf16x8*)(lds + PG8_SB(b, h) + boff + n * 2048 + k * 1024); } while (0)
#define PG8_MMA(ai, bj, At, Bt) do { __builtin_amdgcn_s_setprio(1); _Pragma("unroll") for (int m = 0; m < 4; ++m) _Pragma("unroll") for (int n = 0; n < 2; ++n) _Pragma("unroll") for (int k = 0; k < 2; ++k) \
        acc[ai][bj][m][n] = __builtin_amdgcn_mfma_f32_16x16x32_bf16(Bt[n][k], At[m][k], acc[ai][bj][m][n], 0, 0, 0); __builtin_amdgcn_s_setprio(0); } while (0)
#define PG8_WAIT_V(n) asm volatile("s_waitcnt vmcnt(" #n ")" ::: "memory")
#define PG8_WAIT_L(n) asm volatile("s_waitcnt lgkmcnt(" #n ")" ::: "memory")
#define PG8_BAR __builtin_amdgcn_s_barrier()
#define PG8_SCHED __builtin_amdgcn_sched_barrier(0)
    Unit cur, nxt; int ui = 0;
    if (!S.next(0, cur)) return;
    f32x4 acc[2][2][4][2];
#pragma unroll
    for (int a = 0; a < 2; ++a)
#pragma unroll
        for (int b = 0; b < 2; ++b)
#pragma unroll
            for (int m = 0; m < 4; ++m)
#pragma unroll
                for (int n = 0; n < 2; ++n) acc[a][b][m][n] = (f32x4){0.f, 0.f, 0.f, 0.f};
    bf16x8 At[4][2], B0[2][2], B1[2][2];
    const char* cA = cur.A; const char* cB = cur.B;
    if (GATHER) {
        if (tid < 256) { const int r = tid < cur.valid ? cur.rbase + cur.rows[tid] / NSLOT : 0; *(LAS unsigned*)(ro + tid * 4) = (unsigned)r * (unsigned)(K * 2); }
        __syncthreads();
    }
    PG8_STAGE_B(PG8_SB(0, 0), cB); PG8_STAGE_B(PG8_SB(0, 1), cB + hstep); PG8_STAGE_A(PG8_SA(0, 0), cA, 0, 0); PG8_STAGE_A(PG8_SA(0, 1), cA, 1, 0);
    if (wr == 1) PG8_BAR;
    PG8_WAIT_V(2); PG8_BAR;
    PG8_STAGE_B(PG8_SB(1, 0), cB + kstep); PG8_STAGE_A(PG8_SA(1, 0), cA + kstep, 0, 0); PG8_STAGE_B(PG8_SB(1, 1), cB + hstep + kstep);
    PG8_WAIT_V(6); PG8_BAR;
    for (;;) {
        const bool has_next = S.next(ui + 1, nxt);
        const int cslot = ui & 1, nslot = has_next ? (cslot ^ 1) : cslot;
        int pre_r = 0;
        if (GATHER) { if (has_next && tid < 256 && tid < nxt.valid) pre_r = nxt.rows[tid]; }
        if (RMETA) { if (wid < 4) {
            __builtin_amdgcn_global_load_lds((const unsigned*)(cur.gp + lane + wid * 64), (LAS unsigned*)(lds + LDS_META + cslot * 1024 + wid * 256), 4, 0, 0);
            __builtin_amdgcn_global_load_lds((const unsigned*)(cur.rows + lane + wid * 64), (LAS unsigned*)(lds + LDS_META + 2048 + cslot * 1024 + wid * 256), 4, 0, 0); } }
        const char* nA = has_next ? nxt.A : cA; const char* nB = has_next ? nxt.B : cB;
#pragma unroll 1
        for (int t = 0; t < nt; t += 2) {
            const bool last = (t == nt - 2);
            const char* a1 = cA + (size_t)(t + 1) * kstep;
            const char* a2 = last ? nA : cA + (size_t)(t + 2) * kstep; const char* b2 = last ? nB : cB + (size_t)(t + 2) * kstep;
            const char* a3 = a2 + kstep; const char* b3 = b2 + kstep;
            const int slot2 = last ? nslot : cslot;
            if (t == 2 || nt == 2) {
                if (GATHER) { if (has_next && tid < 256) { const int r = tid < nxt.valid ? nxt.rbase + pre_r / NSLOT : 0; *(LAS unsigned*)(ro + nslot * 1024 + tid * 4) = (unsigned)r * (unsigned)(K * 2); } }
            }
            PG8_LDB(B0, 0, 0); PG8_LDB(B1, 0, 1); PG8_SCHED; PG8_LDA(At, 0, 0); PG8_STAGE_A(PG8_SA(1, 1), a1, 1, cslot);
            PG8_WAIT_V(8); PG8_WAIT_L(0); PG8_BAR; PG8_MMA(0, 0, At, B0); PG8_MMA(0, 1, At, B1); PG8_BAR; PG8_SCHED;
            PG8_LDA(At, 0, 1); PG8_STAGE_B(PG8_SB(0, 0), b2); PG8_STAGE_B(PG8_SB(0, 1), b2 + hstep); PG8_STAGE_A(PG8_SA(0, 0), a2, 0, slot2);
            PG8_WAIT_V(8); PG8_WAIT_L(0); PG8_BAR; PG8_MMA(1, 0, At, B0); PG8_MMA(1, 1, At, B1); PG8_BAR; PG8_SCHED;
            PG8_LDB(B0, 1, 0); PG8_LDB(B1, 1, 1); PG8_SCHED; PG8_LDA(At, 1, 0); PG8_STAGE_A(PG8_SA(0, 1), a2, 1, slot2);
            PG8_WAIT_V(8); PG8_WAIT_L(0); PG8_BAR; PG8_MMA(0, 0, At, B0); PG8_MMA(0, 1, At, B1); PG8_BAR; PG8_SCHED;
            PG8_LDA(At, 1, 1); PG8_STAGE_B(PG8_SB(1, 0), b3); PG8_STAGE_B(PG8_SB(1, 1), b3 + hstep); PG8_STAGE_A(PG8_SA(1, 0), a3, 0, slot2);
            PG8_WAIT_V(8); PG8_WAIT_L(0); PG8_BAR; PG8_MMA(1, 0, At, B0); PG8_MMA(1, 1, At, B1); PG8_BAR; PG8_SCHED;
        }
        if (wr == 0) PG8_BAR;
        E(acc, cur, wr, wc, fr, fq, lds + LDS_META + (ui & 1) * 1024);
        if (!has_next) break;
        if (!KEEPACC || nxt.x0 == 0) {
#pragma unroll
        for (int a = 0; a < 2; ++a)
#pragma unroll
            for (int b = 0; b < 2; ++b)
#pragma unroll
                for (int m = 0; m < 4; ++m)
#pragma unroll
                    for (int n = 0; n < 2; ++n) acc[a][b][m][n] = (f32x4){0.f, 0.f, 0.f, 0.f};
        }
        cur = nxt; cA = nA; cB = nB; ++ui;
        if (wr == 1) PG8_BAR;
    }
    PG8_WAIT_V(0);
    PG8_BAR;
#undef PG8_SA
#undef PG8_SB
#undef PG8_STAGE_A
#undef PG8_STAGE_B
#undef PG8_LDA
#undef PG8_LDB
#undef PG8_MMA
#undef PG8_WAIT_V
#undef PG8_WAIT_L
#undef PG8_BAR
#undef PG8_SCHED
}
}
using pg8::Unit;

#define EPI_LOOP_BEGIN \
    _Pragma("unroll") for (int ai = 0; ai < 2; ++ai) _Pragma("unroll") for (int m = 0; m < 4; ++m) { const int rl = ai * 128 + wr * 64 + m * 16 + fr; const int row = u.pm * 256 + rl; \
    _Pragma("unroll") for (int bj = 0; bj < 2; ++bj) { const int col = u.pn * 256 + bj * 128 + wc * 32 + 8 * fq; const f32x4 v0 = acc[ai][bj][m][0], v1 = acc[ai][bj][m][1]; (void)row; (void)col; (void)rl;
#define EPI_LOOP_END } if (m == 3) asm volatile("" ::: "memory"); }
__device__ __forceinline__ u32x4 pack8(const f32x4 a, const f32x4 b) { u32x4 w; w.x = pk2(a[0], a[1]); w.y = pk2(a[2], a[3]); w.z = pk2(b[0], b[1]); w.w = pk2(b[2], b[3]); return w; }
__device__ __forceinline__ void unpack8(const u32x4 w, float (&f)[8]) { f[0] = bflo(w.x); f[1] = bfhi(w.x); f[2] = bflo(w.y); f[3] = bfhi(w.y); f[4] = bflo(w.z); f[5] = bfhi(w.z); f[6] = bflo(w.w); f[7] = bfhi(w.w); }

struct EpiInProj {
    bf16_t* PROJ; bf16_t* G; bf16_t* KIF;
    __device__ __forceinline__ void operator()(const f32x4 (&acc)[2][2][4][2], const Unit& u, int wr, int wc, int fr, int fq, LAS unsigned char* meta) const {
        if (u.pn < 7) {
        EPI_LOOP_BEGIN
            { const u32x4 w8 = pack8(v0, v1); *(u32x4*)(PROJ + (size_t)row * PROJ_W + col) = w8;
                if (u.pn == 6 && col >= C_KI && col < C_KI + 64) { const int d0 = col - C_KI, key = row & 4095, bb = row >> 12;
                    *(u32x4*)(KIF + ((size_t)((bb * 128 + (key >> 5)) * 4 + (d0 >> 4)) * 64 + (key & 31) + 32 * ((d0 >> 3) & 1)) * 8) = w8; } }
        EPI_LOOP_END
        } else {
            const int ch0 = (u.pn - 7) * 128 + wc * 32 + 8 * fq;
#pragma unroll
            for (int ai = 0; ai < 2; ++ai)
#pragma unroll
                for (int m = 0; m < 4; ++m) { const int row = u.pm * 256 + ai * 128 + wr * 64 + m * 16 + fr;
                    f32x4 s2a, s2b;
#pragma unroll
                    for (int j = 0; j < 4; ++j) { s2a[j] = fmaxf(sigmoidf_(acc[ai][1][m][0][j]), 1e-6f); s2b[j] = fmaxf(sigmoidf_(acc[ai][1][m][1][j]), 1e-6f); }
                    const u32x4 w2 = pack8(s2a, s2b); float s2r[8]; unpack8(w2, s2r); f32x4 r0, r1;
#pragma unroll
                    for (int j = 0; j < 4; ++j) { r0[j] = sigmoidf_(acc[ai][0][m][0][j]) * __builtin_amdgcn_rcpf(s2r[j]); r1[j] = sigmoidf_(acc[ai][0][m][1][j]) * __builtin_amdgcn_rcpf(s2r[4 + j]); }
                    *(u32x4*)(G + (size_t)row * G_W + ch0) = pack8(r0, r1); *(u32x4*)(G + (size_t)row * G_W + 1024 + ch0) = w2;
                    asm volatile("" ::: "memory"); __builtin_amdgcn_sched_barrier(0); }
        }
    }
};
struct EpiGlu {
    const bf16_t* YG; const float* bias; bf16_t* O;
    __device__ __forceinline__ void operator()(const f32x4 (&acc)[2][2][4][2], const Unit& u, int wr, int wc, int fr, int fq, LAS unsigned char* meta) const {
        f32x4 bb[2][2];
#pragma unroll
        for (int bj = 0; bj < 2; ++bj) { const int col = u.pn * 256 + bj * 128 + wc * 32 + 8 * fq; bb[bj][0] = *(const f32x4*)(bias + col); bb[bj][1] = *(const f32x4*)(bias + col + 4); }
        EPI_LOOP_BEGIN
            float y[8]; unpack8(*(const u32x4*)(YG + (size_t)row * 512 + col), y);
            const f32x4 b0 = bb[bj][0], b1 = bb[bj][1]; f32x4 o0, o1;
#pragma unroll
            for (int j = 0; j < 4; ++j) { o0[j] = y[j] * sigmoidf_(v0[j] + b0[j]); o1[j] = y[4 + j] * sigmoidf_(v1[j] + b1[j]); }
            *(u32x4*)(O + (size_t)row * 512 + col) = pack8(o0, o1);
        EPI_LOOP_END
    }
};
struct EpiMix {
    const bf16_t* G; bf16_t* O;
    __device__ __forceinline__ void operator()(f32x4 (&acc)[2][2][4][2], const Unit& u, int wr, int wc, int fr, int fq, LAS unsigned char* meta) const {
        unsigned rowl = (unsigned)(wr * 64 + fr); asm volatile("" : "+v"(rowl));
        const size_t gbase = (size_t)(u.pm * 256 + rowl) * G_W + u.pn * 256 + wc * 32 + 8 * fq + (u.x0 ? 1024 : 0);
#define EPM_LOADS u32x4 q[2][4][2]; _Pragma("unroll") for (int ai = 0; ai < 2; ++ai) _Pragma("unroll") for (int m = 0; m < 4; ++m) _Pragma("unroll") for (int bj = 0; bj < 2; ++bj) q[ai][m][bj] = *(const u32x4*)(G + gbase + (size_t)(ai * 128 + m * 16) * G_W + bj * 128)
        if (u.x0 == 0) { EPM_LOADS;
#pragma unroll
            for (int ai = 0; ai < 2; ++ai)
#pragma unroll
                for (int m = 0; m < 4; ++m)
#pragma unroll
                    for (int bj = 0; bj < 2; ++bj) { float g[8]; unpack8(q[ai][m][bj], g);
#pragma unroll
                        for (int j = 0; j < 4; ++j) { acc[ai][bj][m][0][j] *= g[j]; acc[ai][bj][m][1][j] *= g[4 + j]; } }
        } else { asm volatile("" : "+v"(rowl)); const size_t gbase = (size_t)(u.pm * 256 + rowl) * G_W + u.pn * 256 + wc * 32 + 8 * fq + 1024; EPM_LOADS;
#pragma unroll
            for (int ai = 0; ai < 2; ++ai)
#pragma unroll
                for (int m = 0; m < 4; ++m)
#pragma unroll
                    for (int bj = 0; bj < 2; ++bj) { float g2[8]; unpack8(q[ai][m][bj], g2); f32x4 o0, o1;
#pragma unroll
                        for (int j = 0; j < 4; ++j) { o0[j] = acc[ai][bj][m][0][j] * g2[j]; o1[j] = acc[ai][bj][m][1][j] * g2[4 + j]; }
                        *(u32x4*)(O + (size_t)(u.pm * 256 + ai * 128 + wr * 64 + m * 16 + fr) * D + u.pn * 256 + bj * 128 + wc * 32 + 8 * fq) = pack8(o0, o1); }
        }
#undef EPM_LOADS
    }
};
struct MixSched {
    pg8::DenseSched D0, D1;
    __device__ __forceinline__ bool next(int i, Unit& u) const { const bool ok = (i & 1) ? D1.next(i >> 1, u) : D0.next(i >> 1, u); u.x0 = i & 1; return ok; }
};
struct EpiOut {
    const float* X; const float* ada; float* O; float* SS;
    __device__ __forceinline__ void operator()(const f32x4 (&acc)[2][2][4][2], const Unit& u, int wr, int wc, int fr, int fq, LAS unsigned char* meta) const {
        f32x4 gg[2][2];
#pragma unroll
        for (int bj = 0; bj < 2; ++bj) { const float* gp = ada + (size_t)((u.pm * 256) >> 12) * 6144 + 2048 + u.pn * 256 + bj * 128 + wc * 32 + 8 * fq; gg[bj][0] = *(const f32x4*)gp; gg[bj][1] = *(const f32x4*)(gp + 4); }
        const size_t base = (size_t)(u.pm * 256 + wr * 64 + fr) * D + u.pn * 256 + wc * 32 + 8 * fq;
        f32x4 xq[3][2][2];
#define EPO_LOAD(slot, rg) do { const size_t o_ = base + (size_t)(((rg) >> 2) * 128 + ((rg) & 3) * 16) * D; _Pragma("unroll") for (int bj = 0; bj < 2; ++bj) { xq[slot][bj][0] = *(const f32x4*)(X + o_ + bj * 128); xq[slot][bj][1] = *(const f32x4*)(X + o_ + bj * 128 + 4); } } while (0)
        EPO_LOAD(0, 0); EPO_LOAD(1, 1);
#pragma unroll
        for (int rg = 0; rg < 8; ++rg) { const int ai = rg >> 2, m = rg & 3;
            if (rg + 2 < 8) EPO_LOAD((rg + 2) % 3, rg + 2);
            const size_t o_ = base + (size_t)(ai * 128 + m * 16) * D; float ss = 0.f;
#pragma unroll
            for (int bj = 0; bj < 2; ++bj) { const f32x4 o0 = xq[rg % 3][bj][0] + gg[bj][0] * acc[ai][bj][m][0], o1 = xq[rg % 3][bj][1] + gg[bj][1] * acc[ai][bj][m][1];
                *(u32x4*)((bf16_t*)O + 2 * (o_ - (size_t)(u.pn * 256 + wc * 32 + 8 * fq)) + (u.pn * 256 + wc * 32 + 8 * fq) + bj * 128) = pack8(o0, o1);
                ss += (o0.x * o0.x + o0.y * o0.y) + (o0.z * o0.z + o0.w * o0.w) + (o1.x * o1.x + o1.y * o1.y) + (o1.z * o1.z + o1.w * o1.w); }
            ss += __shfl_xor(ss, 16); ss += __shfl_xor(ss, 32);
            if (fq == 0) SS[(size_t)(u.pm * 256 + ai * 128 + wr * 64 + m * 16 + fr) * 16 + u.pn * 4 + wc] = ss;
            asm volatile("" ::: "memory"); }
#undef EPO_LOAD
    }
};
struct EpiMoe1 {
    bf16_t* H;
    __device__ __forceinline__ void operator()(const f32x4 (&acc)[2][2][4][2], const Unit& u, int wr, int wc, int fr, int fq, LAS unsigned char* meta) const {
#pragma unroll
        for (int ai = 0; ai < 2; ++ai)
#pragma unroll
            for (int m = 0; m < 4; ++m) { const int rl = ai * 128 + wr * 64 + m * 16 + fr;
                if (rl < u.valid) { f32x4 o0, o1;
#pragma unroll
                    for (int j = 0; j < 4; ++j) { const float g0 = acc[ai][0][m][0][j], g1 = acc[ai][1][m][0][j]; o0[j] = g0 * sigmoidf_(g0) * acc[ai][0][m][1][j]; o1[j] = g1 * sigmoidf_(g1) * acc[ai][1][m][1][j]; }
                    *(u32x4*)(H + (size_t)(u.x0 + rl) * 256 + u.pn * 128 + wc * 32 + 8 * fq) = pack8(o0, o1); } }
    }
};
__device__ __forceinline__ void epi_stage_write(LAS unsigned char* sc, int fr, int fq, const u32x4 w0, const u32x4 w1) {
    LAS unsigned char* rowp = sc + (fr >> 3) * 8192 + (fr & 7) * 128; const int x = fr & 7;
    *(LAS u32x4*)(rowp + ((fq ^ x) * 16)) = w0; *(LAS u32x4*)(rowp + (((4 + fq) ^ x) * 16)) = w1;
}
__device__ __forceinline__ u32x4 epi_stage_read(const LAS unsigned char* sc, int q, int lane) {
    const int r = lane >> 3, c = lane & 7; return *(const LAS u32x4*)(sc + q * 8192 + r * 128 + ((c ^ r) * 16));
}
__device__ __forceinline__ unsigned pk4_fp8(float a, float b, float c, float d) {
    a = __builtin_amdgcn_fmed3f(a, -448.f, 448.f); b = __builtin_amdgcn_fmed3f(b, -448.f, 448.f); c = __builtin_amdgcn_fmed3f(c, -448.f, 448.f); d = __builtin_amdgcn_fmed3f(d, -448.f, 448.f);
    int w = 0; w = __builtin_amdgcn_cvt_pk_fp8_f32(a, b, w, false); w = __builtin_amdgcn_cvt_pk_fp8_f32(c, d, w, true); return (unsigned)w;
}
struct EpiMoe2 {
    unsigned char* Y; int skip; LAS unsigned char* lds0;
    __device__ __forceinline__ void operator()(const f32x4 (&acc)[2][2][4][2], const Unit& u, int wr, int wc, int fr, int fq, LAS unsigned char* meta) const {
        asm volatile("" : "+v"(fr), "+v"(fq));
        const int lane = fr + 16 * fq;
        LAS unsigned char* sc0 = lds0 + 3 * pg8::HTB + (wr * 4 + wc) * 1024;
#pragma unroll
        for (int ai = 0; ai < 2; ++ai)
#pragma unroll
            for (int m = 0; m < 4; ++m) { const int rl0 = ai * 128 + wr * 64 + m * 16; LAS unsigned char* sc = sc0 + (m & 1) * 8192;
                const float g = *(const LAS float*)(meta + (rl0 + fr) * 4) * Y_SCALE;
                u32x2 w0, w1;
                w0.x = pk4_fp8(acc[ai][0][m][0][0] * g, acc[ai][0][m][0][1] * g, acc[ai][0][m][0][2] * g, acc[ai][0][m][0][3] * g); w0.y = pk4_fp8(acc[ai][0][m][1][0] * g, acc[ai][0][m][1][1] * g, acc[ai][0][m][1][2] * g, acc[ai][0][m][1][3] * g);
                w1.x = pk4_fp8(acc[ai][1][m][0][0] * g, acc[ai][1][m][0][1] * g, acc[ai][1][m][0][2] * g, acc[ai][1][m][0][3] * g); w1.y = pk4_fp8(acc[ai][1][m][1][0] * g, acc[ai][1][m][1][1] * g, acc[ai][1][m][1][2] * g, acc[ai][1][m][1][3] * g);
                *(LAS u32x2*)(sc + fr * 64 + fq * 8) = w0; *(LAS u32x2*)(sc + fr * 64 + 32 + fq * 8) = w1;
                { const int r = lane >> 2, c = lane & 3, rl = rl0 + r; const u32x4 v = *(const LAS u32x4*)(sc + r * 64 + c * 16);
                  if (rl < u.valid && !skip) { const int dst = *(const LAS int*)(meta + 2048 + rl * 4); *(u32x4*)(Y + (size_t)dst * D + u.pn * 256 + wc * 64 + c * 16) = v; } } }
    }
};

__device__ __forceinline__ void build_moe_tables(LAS unsigned char* lds, const unsigned* cnt_g) {
    LAS int* CNT = (LAS int*)(lds + LDS_CNT); LAS int* RS = (LAS int*)(lds + LDS_RS); LAS int* TB = (LAS int*)(lds + LDS_TB); LAS unsigned* TD = (LAS unsigned*)(lds + LDS_TD);
    const int tid = tidx();
    __syncthreads();
    if (tid < 256) { int c = tid < NPAIR ? (int)cnt_g[tid] : 0; c = c < 0 ? 0 : (c > PAIRCAP ? PAIRCAP : c); CNT[tid] = c; }
    __syncthreads();
    if (tid < 64) {
        int c[4], rs = 0, tb = 0;
#pragma unroll
        for (int i = 0; i < 4; ++i) { c[i] = CNT[4 * tid + i]; rs += c[i]; tb += (c[i] + 255) >> 8; }
        int srs = rs, stb = tb;
#pragma unroll
        for (int o = 1; o < 64; o <<= 1) { const int a = __shfl_up(srs, o), e = __shfl_up(stb, o); if (tid >= o) { srs += a; stb += e; } }
        int ers = srs - rs, etb = stb - tb;
#pragma unroll
        for (int i = 0; i < 4; ++i) { RS[4 * tid + i] = ers; TB[4 * tid + i] = etb; ers += c[i]; etb += (c[i] + 255) >> 8; }
        if (tid == 63) { RS[256] = srs; TB[256] = stb; }
    }
    __syncthreads();
    if (tid < 256) { const int c = CNT[tid], nt = (c + 255) >> 8, tb = TB[tid]; for (int k = 0; k < nt; ++k) TD[tb + k] = (unsigned)tid | ((unsigned)k << 9); }
    __syncthreads();
}
#define RFL(x) __builtin_amdgcn_readfirstlane(x)
struct Moe1Sched {
    LAS unsigned char* lds; int G, c; const char* U2; const int* dstl; const int* ident; const char* Wegu; const char* Wsgu;
    __device__ __forceinline__ bool next(int i, Unit& u) const {
        LAS int* CNT = (LAS int*)(lds + LDS_CNT); LAS int* RS = (LAS int*)(lds + LDS_RS); LAS int* TB = (LAS int*)(lds + LDS_TB); LAS unsigned* TD = (LAS unsigned*)(lds + LDS_TD);
        const int ntr = RFL(TB[256]); const int L = i * G + c; if (L >= (ntr + 128) * 2) return false;
        const int tau = L >> 1; u.pn = L & 1; u.pm = 0; u.A = U2; u.gp = nullptr;
        if (tau < ntr) { const unsigned d = (unsigned)RFL((int)TD[tau]); const int j = d & 511, k = d >> 9; u.valid = min(256, RFL(CNT[j]) - k * 256); u.rows = dstl + (size_t)(j * PAIRCAP + k * 256); u.x0 = RFL(RS[j]) + k * 256; u.rbase = (j >> 6) * CHTOK;
            u.B = Wegu + (size_t)(j & 63) * (512 * 1024 * 2) + (size_t)u.pn * (256 * 1024 * 2); }
        else { const int k = tau - ntr; u.valid = 256; u.rows = ident + k * 256; u.x0 = HSH_ROW0 + k * 256; u.rbase = (k / (CHTOK / 256)) * CHTOK; u.B = Wsgu + (size_t)u.pn * (256 * 1024 * 2); }
        return true;
    }
};
struct Moe2Sched {
    LAS unsigned char* lds; int G, c, ch; const unsigned char* ws;
    __device__ __forceinline__ bool next(int i, Unit& u) const {
        LAS int* CNT = (LAS int*)(lds + LDS_CNT); LAS int* RS = (LAS int*)(lds + LDS_RS); LAS int* TB = (LAS int*)(lds + LDS_TB); LAS unsigned* TD = (LAS unsigned*)(lds + LDS_TD);
        constexpr int NSH = CHTOK / 256;
        const int t0 = RFL(TB[64 * ch]), ntr = RFL(TB[64 * ch + 64]) - t0; const int L = i * G + c; if (L >= (ntr + NSH) * 4) return false;
        const int tau = L >> 2; u.pn = L & 3; u.pm = 0; u.rbase = 0; u.x0 = 0;
        if (tau < ntr) { const unsigned d = (unsigned)RFL((int)TD[t0 + tau]); const int j = d & 511, k = d >> 9; u.valid = min(256, RFL(CNT[j]) - k * 256);
            u.A = (const char*)(ws + WS_H) + (size_t)(RFL(RS[j]) + k * 256) * 512; u.rows = (const int*)(ws + WS_DSTL) + (size_t)(j * PAIRCAP + k * 256); u.gp = (const float*)(ws + WS_GATEL) + (size_t)(j * PAIRCAP + k * 256);
            u.B = (const char*)(ws + WS_W_ED) + (size_t)(j & 63) * (1024 * 256 * 2) + (size_t)u.pn * (256 * 256 * 2); }
        else { const int k = NSH * ch + (tau - ntr); u.valid = 256; u.A = (const char*)(ws + WS_H) + (size_t)(HSH_ROW0 + k * 256) * 512; u.rows = (const int*)(ws + WS_IDENT) + k * 256; u.gp = (const float*)(ws + WS_ONES); u.B = (const char*)(ws + WS_W_SD) + (size_t)u.pn * (256 * 256 * 2); }
        return true;
    }
};

struct Params { const float* in[29]; float* out; unsigned char* ws; int ph_lo, ph_hi; };

__device__ __forceinline__ void s5_tables_item(const Params& p, LAS unsigned char* lds, int item) {
    const int g = item >> 3, part = item & 7, tid = tidx();
    LAS float* AP = (LAS float*)lds;
    LAS float* BB = AP + 64 * 33 * 2;
    LAS float* CC = BB + 64 * 16 * 2;
    const float dt = expf(p.in[8][g]);
    __syncthreads();
    for (int i = tid; i < 64 * 33; i += NTHR) { const int pp = i / 33, tau = i - pp * 33; const float lr = p.in[6][g * 64 + pp], li = p.in[7][g * 64 + pp];
        const float mag = expf(lr * dt * (float)tau), th = li * dt * (float)tau; AP[i * 2] = mag * cosf(th); AP[i * 2 + 1] = mag * sinf(th); }
    for (int i = tid; i < 64 * 16; i += NTHR) { const int pp = i >> 4; const float lr = p.in[6][g * 64 + pp], li = p.in[7][g * 64 + pp];
        const float mag = expf(lr * dt); const float a_re = mag * cosf(li * dt), a_im = mag * sinf(li * dt);
        const float den = lr * lr + li * li, n_re = a_re - 1.0f; const float f_re = (n_re * lr + a_im * li) / den, f_im = (a_im * lr - n_re * li) / den;
        const float br = p.in[9][(size_t)(g * 64) * 16 + i], bi = p.in[10][(size_t)(g * 64) * 16 + i];
        BB[i * 2] = f_re * br - f_im * bi; BB[i * 2 + 1] = f_re * bi + f_im * br; }
    for (int i = tid; i < 16 * 64; i += NTHR) { CC[i * 2] = p.in[11][(size_t)g * 1024 + i]; CC[i * 2 + 1] = p.in[12][(size_t)g * 1024 + i]; }
    __syncthreads();
    if (part == 0 && tid < 64) { float* a32 = (float*)(p.ws + WS_A32); a32[(g * 64 + tid) * 2] = AP[(tid * 33 + 32) * 2]; a32[(g * 64 + tid) * 2 + 1] = AP[(tid * 33 + 32) * 2 + 1]; }
    {
        const int jh = tid >> 8, t2 = tid & 255;
        const int fr = t2 >> 6, l = t2 & 63, delta = part * 4 + fr, ho = l & 15, q = l >> 4, tau = delta - (q >> 1); float v[4];
#pragma unroll 1
        for (int jj = 0; jj < 4; ++jj) { const int j = jh * 4 + jj; const int hi = (q & 1) * 8 + j; float acc = 0.f;
            if (tau >= 0) { for (int pp = 0; pp < 64; ++pp) { const float ar = AP[(pp * 33 + tau) * 2], ai = AP[(pp * 33 + tau) * 2 + 1], br = BB[(pp * 16 + hi) * 2], bi = BB[(pp * 16 + hi) * 2 + 1], cr = CC[(ho * 64 + pp) * 2], ci = CC[(ho * 64 + pp) * 2 + 1];
                    acc += cr * (ar * br - ai * bi) - ci * (ar * bi + ai * br); }
                if (tau == 0 && ho == hi) acc += p.in[13][g * 16 + ho]; }
            v[jj] = acc; }
        u32x2 o; o.x = pk2(v[0], v[1]); o.y = pk2(v[2], v[3]);
        *(u32x2*)((bf16_t*)(p.ws + WS_TZF) + ((size_t)(g * 32 + delta) * 64 + l) * 8 + jh * 4) = o;
    }
    for (int u = tid; u < 1024; u += NTHR) {
        const int ks = u >> 6, l = u & 63, n = part * 16 + (l & 15), q = l >> 4, ri = n >> 6, pp = n & 63; float v[8];
#pragma unroll
        for (int j = 0; j < 8; ++j) { const int k = ks * 32 + q * 8 + j, sidx = k >> 4, hi = k & 15;
            const float ar = AP[(pp * 33 + 31 - sidx) * 2], ai = AP[(pp * 33 + 31 - sidx) * 2 + 1], br = BB[(pp * 16 + hi) * 2], bi = BB[(pp * 16 + hi) * 2 + 1];
            v[j] = ri ? (ar * bi + ai * br) : (ar * br - ai * bi); }
        u32x4 o; o.x = pk2(v[0], v[1]); o.y = pk2(v[2], v[3]); o.z = pk2(v[4], v[5]); o.w = pk2(v[6], v[7]);
        *(u32x4*)((bf16_t*)(p.ws + WS_WINF) + ((size_t)((g * 8 + part) * 16 + ks) * 64 + l) * 8) = o;
    }
    for (int u = tid; u < 1024; u += NTHR) {
        const int fr = u >> 6, l = u & 63, t = part * 4 + (fr >> 2), ksp = fr & 3, ho = l & 15, q = l >> 4; float v[8];
#pragma unroll
        for (int j = 0; j < 8; ++j) { const int kp = ksp * 32 + q * 8 + j, ri = kp >> 6, pp = kp & 63;
            const float cr = CC[(ho * 64 + pp) * 2], ci = CC[(ho * 64 + pp) * 2 + 1], ar = AP[(pp * 33 + t + 1) * 2], ai = AP[(pp * 33 + t + 1) * 2 + 1];
            v[j] = ri ? -(cr * ai + ci * ar) : (cr * ar - ci * ai); }
        u32x4 o; o.x = pk2(v[0], v[1]); o.y = pk2(v[2], v[3]); o.z = pk2(v[4], v[5]); o.w = pk2(v[6], v[7]);
        *(u32x4*)((bf16_t*)(p.ws + WS_WOUTF) + ((size_t)((g * 32 + t) * 4 + ksp) * 64 + l) * 8) = o;
    }
    __syncthreads();
}

__device__ __forceinline__ float gelu_tanh(float y) { const float z = 0.7978845608028654f * (y + 0.044715f * y * y * y); const float e = __expf(2.0f * z); const float th = 1.0f - 2.0f / (e + 1.0f); return 0.5f * y * (1.0f + th); }

__device__ __forceinline__ void s5_item(const Params& p, LAS unsigned char* lds, int item) {
    const int b = item >> 5, g = item & 31;
    const int tid = tidx(), lane = tid & 63, wave = __builtin_amdgcn_readfirstlane(tid >> 6), hd = lane & 15, qd = lane >> 4;
    const bf16_t* PROJ = (const bf16_t*)(p.ws + WS_PROJ); bf16_t* YG = (bf16_t*)(p.ws + WS_YG);
    LAS float* SL = (LAS float*)lds;
    LAS unsigned char* WO = lds + 65536;
    const char* WoutG = (const char*)(p.ws + WS_WOUTF) + (size_t)g * 32 * 4 * 1024;
#define S5_WO_DMA(h) do { _Pragma("unroll") for (int j_ = 0; j_ < 8; ++j_) \
        __builtin_amdgcn_global_load_lds((const unsigned*)(WoutG + (size_t)(h) * 65536 + (j_ * 512 + tid) * 16), (LAS unsigned*)(WO + j_ * 8192 + wave * 1024), 16, 0, 0); } while (0)
    const int c = 16 * wave + hd;
    __syncthreads();
    S5_WO_DMA(0);
    bf16x8 Uf[16];
#pragma unroll
    for (int ks = 0; ks < 16; ++ks) Uf[ks] = *(const bf16x8*)(PROJ + ((size_t)b * SEQ + c * 32 + 2 * ks + (qd >> 1)) * PROJ_W + C_USSM + g * 16 + (qd & 1) * 8);
    { const bf16x8* WinF = (const bf16x8*)(p.ws + WS_WINF) + (size_t)g * 8 * 16 * 64 + lane;
      bf16x8 wc_[8], wn_[8];
#pragma unroll
      for (int ks = 0; ks < 8; ++ks) wc_[ks] = WinF[ks * 64];
      f32x4 a = (f32x4){0.f, 0.f, 0.f, 0.f};
#pragma unroll 2
      for (int j = 0; j < 16; ++j) { const int jn = (j < 15) ? j + 1 : j;
#pragma unroll
          for (int i = 0; i < 8; ++i) wn_[i] = WinF[(jn * 8 + i) * 64];
          if ((j & 1) == 0) {
#pragma unroll
              for (int i = 0; i < 8; ++i) a = __builtin_amdgcn_mfma_f32_16x16x32_bf16(wc_[i], Uf[i], a, 0, 0, 0); }
          else {
#pragma unroll
              for (int i = 0; i < 8; ++i) a = __builtin_amdgcn_mfma_f32_16x16x32_bf16(wc_[i], Uf[8 + i], a, 0, 0, 0);
              *(LAS f32x4*)(SL + c * 128 + (j >> 1) * 16 + qd * 4) = a; a = (f32x4){0.f, 0.f, 0.f, 0.f}; }
#pragma unroll
          for (int i = 0; i < 8; ++i) wc_[i] = wn_[i]; } }
    __syncthreads();
    if (wave == 0) { const float* a32 = (const float*)(p.ws + WS_A32); const float ar = a32[(g * 64 + lane) * 2], ai = a32[(g * 64 + lane) * 2 + 1]; float hr = 0.f, hi = 0.f;
#pragma unroll 4
        for (int cc = 0; cc < 128; ++cc) { const float sr = SL[cc * 128 + lane], si = SL[cc * 128 + 64 + lane]; const float nr = ar * hr - ai * hi + sr, ni = ar * hi + ai * hr + si; hr = nr; hi = ni; SL[cc * 128 + lane] = hr; SL[cc * 128 + 64 + lane] = hi; } }
    __syncthreads();
    bf16x8 Hf[4];
#pragma unroll
    for (int ks = 0; ks < 4; ++ks) { if (c >= 1) { const f32x4 x0 = *(const LAS f32x4*)(SL + (c - 1) * 128 + ks * 32 + qd * 8), x1 = *(const LAS f32x4*)(SL + (c - 1) * 128 + ks * 32 + qd * 8 + 4); Hf[ks] = __builtin_bit_cast(bf16x8, pack8(x0, x1)); }
        else Hf[ks] = (bf16x8){0, 0, 0, 0, 0, 0, 0, 0}; }
    const bf16x8* TzF = (const bf16x8*)(p.ws + WS_TZF) + (size_t)g * 32 * 64 + lane;
#pragma unroll
    for (int half = 0; half < 2; ++half) {
        f32x4 acc[16];
#pragma unroll
        for (int tt = 0; tt < 16; ++tt) acc[tt] = (f32x4){0.f, 0.f, 0.f, 0.f};
        const int ndelta = half * 16 + 16;
        bf16x8 fr[4];
#pragma unroll
        for (int i = 0; i < 4; ++i) fr[i] = TzF[i * 64];
#pragma unroll
        for (int delta = 0; delta < 32; ++delta) {
            if (delta < ndelta) {
                const bf16x8 f0 = fr[delta & 3];
                if (delta + 4 < ndelta) fr[delta & 3] = TzF[(delta + 4) * 64];
#pragma unroll
                for (int ks = 0; ks < 16; ++ks) { const int t = delta + 2 * ks; if (t >= half * 16 && t < half * 16 + 16) acc[t - half * 16] = __builtin_amdgcn_mfma_f32_16x16x32_bf16(f0, Uf[ks], acc[t - half * 16], 0, 0, 0); }
            }
        }
        asm volatile("s_waitcnt vmcnt(0)" ::: "memory");
        __syncthreads();
#pragma unroll
        for (int tt = 0; tt < 16; ++tt) { const int t = half * 16 + tt;
#pragma unroll
            for (int ks = 0; ks < 4; ++ks) acc[tt] = __builtin_amdgcn_mfma_f32_16x16x32_bf16(*(const LAS bf16x8*)(WO + (tt * 4 + ks) * 1024 + lane * 16), Hf[ks], acc[tt], 0, 0, 0);
            u32x2 w; w.x = pk2(gelu_tanh(acc[tt][0]), gelu_tanh(acc[tt][1])); w.y = pk2(gelu_tanh(acc[tt][2]), gelu_tanh(acc[tt][3]));
            *(u32x2*)(YG + ((size_t)b * SEQ + c * 32 + t) * 512 + g * 16 + qd * 4) = w;
            if ((tt & 1) == 1) asm volatile("" ::: "memory"); }
        if (half == 0) { asm volatile("s_waitcnt lgkmcnt(0)" ::: "memory"); __syncthreads(); S5_WO_DMA(1); }
    }
#undef S5_WO_DMA
    __syncthreads();
}

struct TDesc { const float* W; bf16_t* WT; int K, N, item, kind; };
__device__ __forceinline__ void t_load(const TDesc& d, int lane, f32x4 (&v)[16]) {
    const int nblk = (d.N + 63) >> 6, kb = d.item / nblk, nb = d.item - kb * nblk, k0 = 64 * kb, n0 = 64 * nb;
    const int lr = lane >> 4, lc = (lane & 15) * 4;
#pragma unroll
    for (int i = 0; i < 16; ++i) v[i] = (n0 + lc < d.N) ? *(const f32x4*)(d.W + (size_t)(k0 + 4 * i + lr) * d.N + n0 + lc) : (f32x4){0.f, 0.f, 0.f, 0.f};
}
struct RmId { __device__ int operator()(int n) const { return n; } };
struct RmWave { __device__ int operator()(int n) const { const int L = n & 255; return (n & ~255) + 128 * ((L >> 5) & 1) + 32 * (L >> 6) + (L & 31); } };
struct RmIn { __device__ int operator()(int n) const { if (n < PROJ_USED) return n; const int g = n - PROJ_USED, c = g & 1023; return PROJ_W + 256 * (c >> 7) + 128 * (g >> 10) + (c & 127); } };
struct RmGate { __device__ int operator()(int n) const { const int hl = n & 127; return 256 * (n >> 7) + 128 * ((hl >> 2) & 1) + 32 * (hl >> 5) + 8 * ((hl >> 3) & 3) + (hl & 3); } };
struct RmUp { __device__ int operator()(int n) const { const int hl = n & 127; return 256 * (n >> 7) + 128 * ((hl >> 2) & 1) + 32 * (hl >> 5) + 8 * ((hl >> 3) & 3) + 4 + (hl & 3); } };
__device__ __forceinline__ int t_rowmap(int kind, int n) { return kind == 0 ? n : kind == 1 ? RmWave()(n) : kind == 2 ? RmIn()(n) : kind == 3 ? RmGate()(n) : RmUp()(n); }
__device__ __forceinline__ void t_store(const TDesc& d, const f32x4 (&v)[16], LAS float* scr, int lane) {
    const int nblk = (d.N + 63) >> 6, kb = d.item / nblk, nb = d.item - kb * nblk, k0 = 64 * kb, n0 = 64 * nb;
    const int lr = lane >> 4, lc = (lane & 15) * 4;
#pragma unroll
    for (int i = 0; i < 16; ++i) { LAS float* dd = scr + (4 * i + lr) * 65 + lc; dd[0] = v[i].x; dd[1] = v[i].y; dd[2] = v[i].z; dd[3] = v[i].w; }
    LDS_WAIT(); asm volatile("" ::: "memory");
    const int nl = lane >> 3, kc = (lane & 7) * 8;
#pragma unroll
    for (int j = 0; j < 8; ++j) { const int n = nl + 8 * j; const LAS float* sp = scr + kc * 65 + n;
        u32x4 o; o.x = pk2(sp[0 * 65], sp[1 * 65]); o.y = pk2(sp[2 * 65], sp[3 * 65]); o.z = pk2(sp[4 * 65], sp[5 * 65]); o.w = pk2(sp[6 * 65], sp[7 * 65]);
        if (n0 + n < d.N) *(u32x4*)(d.WT + (size_t)t_rowmap(d.kind, n0 + n) * d.K + k0 + kc) = o; }
    LDS_WAIT(); asm volatile("" ::: "memory");
}

constexpr int T_I_IN = 16 * 60, T_I_GLU = 8 * 8, T_I_PS = 8 * 16, T_I_OUT = 16 * 16, T_I_SG = 16 * 4, T_I_SD = 4 * 16, T_I_EG = 64 * 64;
constexpr int T_NITEMS = T_I_IN + T_I_GLU + 2 * T_I_PS + T_I_OUT + 2 * T_I_SG + T_I_SD + 3 * T_I_EG;
constexpr int T_LATE = 5 * 128 * NWAVES;
constexpr int T_LATE2 = T_I_EG;
static_assert(T_LATE + T_LATE2 <= 3 * T_I_EG, "late items are expert matrices");
__device__ __forceinline__ TDesc tdesc_of(const Params& p, unsigned char* ws, int r) { TDesc d;
    if (r < T_I_IN) { d = TDesc{p.in[5], (bf16_t*)(ws + WS_W_IN), 1024, IN_W, r, 2}; return d; } r -= T_I_IN;
    if (r < T_I_GLU) { d = TDesc{p.in[14], (bf16_t*)(ws + WS_W_GLU), 512, 512, r, 0}; return d; } r -= T_I_GLU;
    if (r < T_I_PS) { d = TDesc{p.in[16], (bf16_t*)(ws + WS_W_PS), 512, 1024, r, 0}; return d; } r -= T_I_PS;
    if (r < T_I_PS) { d = TDesc{p.in[17], (bf16_t*)(ws + WS_W_PA), 512, 1024, r, 0}; return d; } r -= T_I_PS;
    if (r < T_I_OUT) { d = TDesc{p.in[18], (bf16_t*)(ws + WS_W_OUT), 1024, 1024, r, 0}; return d; } r -= T_I_OUT;
    if (r < T_I_SG) { d = TDesc{p.in[25], (bf16_t*)(ws + WS_W_SGU), 1024, 256, r, 3}; return d; } r -= T_I_SG;
    if (r < T_I_SG) { d = TDesc{p.in[26], (bf16_t*)(ws + WS_W_SGU), 1024, 256, r, 4}; return d; } r -= T_I_SG;
    if (r < T_I_SD) { d = TDesc{p.in[27], (bf16_t*)(ws + WS_W_SD), 256, 1024, r, 1}; return d; } r -= T_I_SD;
    if (r < T_I_EG) { const int e = r >> 6; d = TDesc{p.in[22] + (size_t)e * 262144, (bf16_t*)(ws + WS_W_EGU) + (size_t)e * 524288, 1024, 256, r & 63, 3}; return d; } r -= T_I_EG;
    if (r < T_I_EG) { const int e = r >> 6; d = TDesc{p.in[23] + (size_t)e * 262144, (bf16_t*)(ws + WS_W_EGU) + (size_t)e * 524288, 1024, 256, r & 63, 4}; return d; } r -= T_I_EG;
    { const int e = r >> 6; d = TDesc{p.in[24] + (size_t)e * 262144, (bf16_t*)(ws + WS_W_ED) + (size_t)e * 262144, 256, 1024, r & 63, 1}; return d; } }
__device__ __forceinline__ void run_transposes(const Params& p, unsigned char* ws, LAS unsigned char* lds, int r0, int r1, int widx, int nw) {
    const int lane = tidx() & 63, wave = __builtin_amdgcn_readfirstlane(tidx() >> 6);
    LAS float* scr = (LAS float*)(lds + wave * 16640);
    int r = r1 - 1 - widx;
    if (r < r0) return;
    TDesc d0 = tdesc_of(p, ws, r), d1 = d0, d2 = d0; f32x4 v0[16], v1[16], v2[16];
    t_load(d0, lane, v0);
    bool h1 = (r - nw >= r0);
    if (h1) { d1 = tdesc_of(p, ws, r - nw); t_load(d1, lane, v1); }
    for (;;) {
        const bool h2 = h1 && (r - 2 * nw >= r0);
        if (h2) { d2 = tdesc_of(p, ws, r - 2 * nw); t_load(d2, lane, v2); }
        t_store(d0, v0, scr, lane);
        if (!h1) break;
        d0 = d1; d1 = d2; r -= nw; h1 = h2;
#pragma unroll
        for (int i = 0; i < 16; ++i) { v0[i] = v1[i]; v1[i] = v2[i]; }
    }
}
__device__ __forceinline__ void p0_prep(const Params& p, LAS unsigned char* lds, int vcu, int G) {
    const int tid = tidx(), lane = tid & 63, wave = __builtin_amdgcn_readfirstlane(tid >> 6);
    unsigned char* ws = p.ws;
    for (int it = vcu; it < 256; it += G) s5_tables_item(p, lds, it);
    {
        LAS float* sc = (LAS float*)lds;
        LAS float* red = (LAS float*)(lds + 32768);
        const float* c = p.in[1]; const float* w = p.in[2]; const float* bb = p.in[3]; float* ada = (float*)(ws + WS_ADA);
        bool loaded = false;
        for (int it = vcu; it < 96; it += G) {
            if (!loaded) { for (int i = tid; i < 8192; i += NTHR) { const float v = c[i]; sc[i] = v * sigmoidf_(v); } loaded = true; }
            __syncthreads();
            const int kq = tid >> 6, col = it * 64 + lane; float a[8];
#pragma unroll
            for (int b = 0; b < 8; ++b) a[b] = 0.f;
#pragma unroll 16
            for (int k = kq * 128; k < kq * 128 + 128; ++k) { const float wv = w[(size_t)k * 6144 + col];
#pragma unroll
                for (int b = 0; b < 8; ++b) a[b] += sc[b * 1024 + k] * wv; }
#pragma unroll
            for (int b = 0; b < 8; ++b) red[(kq * 8 + b) * 64 + lane] = a[b];
            __syncthreads();
            { const int b = tid >> 6; float s = bb[col];
#pragma unroll
              for (int q = 0; q < 8; ++q) s += red[(q * 8 + b) * 64 + lane];
              ada[b * 6144 + col] = s; }
            __syncthreads();
        }
        __syncthreads();
    }
    run_transposes(p, ws, lds, 0, T_NITEMS - T_LATE2 - ((G == 256) ? T_LATE : 0), vcu * NWAVES + wave, G * NWAVES);
    { const int gt = vcu * NTHR + tid, NGT = G * NTHR;
      u32x4* z = (u32x4*)(ws + WS_W_IN + (size_t)PROJ_USED * 1024 * 2);
      for (int i = gt; i < (PROJ_W - PROJ_USED) * 1024 * 2 / 16; i += NGT) z[i] = (u32x4){0u, 0u, 0u, 0u};
      int* id = (int*)(ws + WS_IDENT); for (int i = gt; i < NTOK; i += NGT) id[i] = (i % CHTOK) * NSLOT + 8;
      if (gt < 256) ((float*)(ws + WS_ONES))[gt] = 1.0f;
      for (int u = gt; u < 32 * 4 * 64; u += NGT) { const int l = u & 63, nt = (u >> 6) & 3, ks = u >> 8; const int n = nt * 16 + (l & 15), q = l >> 4; float hi[8], lo[8];
#pragma unroll
          for (int j = 0; j < 8; ++j) { const float w = p.in[20][(size_t)(ks * 32 + q * 8 + j) * 64 + n]; const float h = bf2f((unsigned short)f2bf(w)); hi[j] = h; lo[j] = w - h; }
          u32x4 o; o.x = pk2(hi[0], hi[1]); o.y = pk2(hi[2], hi[3]); o.z = pk2(hi[4], hi[5]); o.w = pk2(hi[6], hi[7]);
          *(u32x4*)((bf16_t*)(ws + WS_WRF) + (size_t)u * 8) = o;
          o.x = pk2(lo[0], lo[1]); o.y = pk2(lo[2], lo[3]); o.z = pk2(lo[4], lo[5]); o.w = pk2(lo[6], lo[7]);
          *(u32x4*)((bf16_t*)(ws + WS_WRF) + (size_t)(32 * 4 * 64 + u) * 8) = o; } }
}

__device__ __forceinline__ void p1_modulate(const Params& p, int vcu, int G) {
    const int tid = tidx(), lane = tid & 63, wave = tid >> 6; const int gw = vcu * NWAVES + wave, NGW = G * NWAVES;
    const float* ada = (const float*)(p.ws + WS_ADA); const float* g1 = p.in[4]; bf16_t* U = (bf16_t*)(p.ws + WS_U);
    for (int m = gw; m < NTOK; m += NGW) {
        const f32x4* xr = (const f32x4*)(p.in[0] + (size_t)m * D) + lane; const int b = m >> 12;
        f32x4 v[4]; float s = 0.f;
#pragma unroll
        for (int j = 0; j < 4; ++j) { v[j] = xr[64 * j]; s += (v[j].x * v[j].x + v[j].y * v[j].y) + (v[j].z * v[j].z + v[j].w * v[j].w); }
        const float rstd = 1.0f / sqrtf(wave_sum(s) * (1.f / D) + EPS);
        unsigned long long* o8 = (unsigned long long*)(U + (size_t)m * D) + lane;
#pragma unroll
        for (int j = 0; j < 4; ++j) { const int c0 = 4 * lane + 256 * j;
            const f32x4 gg = *(const f32x4*)(g1 + c0), sh = *(const f32x4*)(ada + b * 6144 + c0), scl = *(const f32x4*)(ada + b * 6144 + 1024 + c0);
            const f32x4 y = v[j] * rstd * gg * (scl + 1.0f) + sh;
            o8[64 * j] = (unsigned long long)pk2(y.x, y.y) | ((unsigned long long)pk2(y.z, y.w) << 32); }
    }
}

__device__ __forceinline__ void p_combine(const Params& p, int vcu, int G, int ch) {
    const int tid = tidx(), lane = tid & 63, wave = tid >> 6; const int gw = vcu * NWAVES + wave, NGW = G * NWAVES;
    const float* ada = (const float*)(p.ws + WS_ADA); const float* gf = p.in[28];
    const unsigned char* Y = (const unsigned char*)(p.ws + WS_Y);
    u32x4 w[NSLOT];
    { const int mi0 = gw < CHTOK ? gw : 0; const unsigned char* yp = Y + (size_t)mi0 * NSLOT * D + lane * 16;
#pragma unroll
      for (int k = 0; k < NSLOT; ++k) w[k] = *(const u32x4*)(yp + (size_t)k * D); }
    for (int mi = gw; mi < CHTOK; mi += NGW) {
        const int m = ch * CHTOK + mi; const int b = m >> 12;
        float* orow = p.out + (size_t)m * D + lane * 16;
        f32x4 h[4], g2[4];
        { const u32x4* hp = (const u32x4*)((const bf16_t*)(p.out + (size_t)m * D) + lane * 16); const u32x4 h0 = hp[0], h1 = hp[1];
          h[0] = (f32x4){bflo(h0.x), bfhi(h0.x), bflo(h0.y), bfhi(h0.y)}; h[1] = (f32x4){bflo(h0.z), bfhi(h0.z), bflo(h0.w), bfhi(h0.w)};
          h[2] = (f32x4){bflo(h1.x), bfhi(h1.x), bflo(h1.y), bfhi(h1.y)}; h[3] = (f32x4){bflo(h1.z), bfhi(h1.z), bflo(h1.w), bfhi(h1.w)}; }
#pragma unroll
        for (int q = 0; q < 4; ++q) g2[q] = *(const f32x4*)(ada + b * 6144 + 5120 + lane * 16 + 4 * q);
        float a[16];
#pragma unroll
        for (int j = 0; j < 16; ++j) a[j] = 0.f;
#pragma unroll
        for (int k = 0; k < NSLOT; ++k)
#pragma unroll
            for (int q = 0; q < 4; ++q) { const f32x2 lo = __builtin_amdgcn_cvt_pk_f32_fp8((int)w[k][q], false), hi = __builtin_amdgcn_cvt_pk_f32_fp8((int)w[k][q], true);
                a[4 * q] += lo.x; a[4 * q + 1] += lo.y; a[4 * q + 2] += hi.x; a[4 * q + 3] += hi.y; }
        { const int mn = (mi + NGW < CHTOK) ? mi + NGW : mi; const unsigned char* yp = Y + (size_t)mn * NSLOT * D + lane * 16;
#pragma unroll
          for (int k = 0; k < NSLOT; ++k) w[k] = *(const u32x4*)(yp + (size_t)k * D); }
        float r[16]; float s = 0.f;
#pragma unroll
        for (int i = 0; i < 4; ++i)
#pragma unroll
            for (int j = 0; j < 4; ++j) { const float v = h[i][j] + g2[i][j] * (a[i * 4 + j] * (1.0f / Y_SCALE)); r[i * 4 + j] = v; s += v * v; }
        const float rstd = 1.0f / sqrtf(wave_sum(s) * (1.f / D) + EPS);
#pragma unroll
        for (int q = 0; q < 4; ++q) { const f32x4 g = *(const f32x4*)(gf + lane * 16 + 4 * q); f32x4 o;
#pragma unroll
            for (int j = 0; j < 4; ++j) o[j] = r[q * 4 + j] * rstd * g[j];
            *(f32x4*)(orow + 4 * q) = o; }
    }
}

__device__ __forceinline__ unsigned fkey(float x) { const unsigned u = __builtin_bit_cast(unsigned, x); return (u & 0x80000000u) ? ~u : (u | 0x80000000u); }

__device__ __forceinline__ void gold_s5(const Params& p, int item, int lane) {
    const int b = item >> 5, g = item & 31;
    const bf16_t* PROJ = (const bf16_t*)(p.ws + WS_PROJ); bf16_t* YG = (bf16_t*)(p.ws + WS_YG);
    const float dt = expf(p.in[8][g]); const float lr = p.in[6][g * 64 + lane], li = p.in[7][g * 64 + lane];
    const float mag = expf(lr * dt); const float a_re = mag * cosf(li * dt), a_im = mag * sinf(li * dt);
    const float den = lr * lr + li * li, n_re = a_re - 1.0f;
    const float f_re = (n_re * lr + a_im * li) / den, f_im = (a_im * lr - n_re * li) / den;
    float bbr[16], bbi[16], cr[16], ci[16];
#pragma unroll
    for (int h = 0; h < 16; ++h) { const float br = p.in[9][(g * 64 + lane) * 16 + h], bi = p.in[10][(g * 64 + lane) * 16 + h];
        bbr[h] = f_re * br - f_im * bi; bbi[h] = f_re * bi + f_im * br;
        cr[h] = p.in[11][(g * 16 + h) * 64 + lane]; ci[h] = p.in[12][(g * 16 + h) * 64 + lane]; }
    const float dsk = p.in[13][g * 16 + (lane & 15)];
    float hr = 0.f, hi = 0.f;
    for (int t = 0; t < SEQ; ++t) {
        const size_t row = (size_t)b * SEQ + t;
        const u32x4 w0 = *(const u32x4*)(PROJ + row * PROJ_W + C_USSM + g * 16), w1 = *(const u32x4*)(PROJ + row * PROJ_W + C_USSM + g * 16 + 8);
        float u[16]; { float f[8]; unpack8(w0, f);
#pragma unroll
            for (int j = 0; j < 8; ++j) u[j] = f[j];
            unpack8(w1, f);
#pragma unroll
            for (int j = 0; j < 8; ++j) u[8 + j] = f[j]; }
        float bur = 0.f, bui = 0.f;
#pragma unroll
        for (int h = 0; h < 16; ++h) { bur += bbr[h] * u[h]; bui += bbi[h] * u[h]; }
        const float nr = a_re * hr - a_im * hi + bur, ni = a_re * hi + a_im * hr + bui; hr = nr; hi = ni;
        float y = 0.f, um = 0.f;
#pragma unroll
        for (int h = 0; h < 16; ++h) { const float v = wave_sum(cr[h] * hr - ci[h] * hi); if ((lane & 15) == h) { y = v; um = u[h]; } }
        y += dsk * um;
        const float gl = 0.5f * y * (1.0f + tanhf(0.7978845608028654f * (y + 0.044715f * y * y * y)));
        if (lane < 16) YG[row * 512 + g * 16 + lane] = (bf16_t)f2bf(gl);
    }
}

__device__ __forceinline__ void gold_attn_pair(const Params& p, LAS unsigned char* lds, int pairid) {
    const int half = tidx() >> 8, tid = tidx() & 255;
    LAS unsigned char* base = lds + half * 32768;
    LAS float* qi = (LAS float*)base; LAS float* qv = qi + 512; LAS float* sc = qv + 512; LAS float* lg = sc + 4096;
    LAS float* wi = lg + 2048; LAS float* mx = wi + 8; LAS float* sm = mx + 8; LAS int* sel = (LAS int*)(sm + 8); LAS int* red = sel + 256; LAS int* cntp = red + 256;
    const int qid = pairid * 2 + half; const int b = qid >> 12, t = qid & 4095;
    const bf16_t* PROJ = (const bf16_t*)(p.ws + WS_PROJ); bf16_t* YA = (bf16_t*)(p.ws + WS_YATTN);
    const size_t qrow = (size_t)qid * PROJ_W;
    __syncthreads();
    for (int i = tid; i < 512; i += 256) { qi[i] = bf2f(PROJ[qrow + C_QI + i]); qv[i] = bf2f(PROJ[qrow + C_Q + i]); }
    if (tid < 8) wi[tid] = bf2f(PROJ[qrow + C_WI + tid]);
    if (tid == 0) cntp[0] = 0;
    __syncthreads();
    const int n = t + 1;
    for (int s = tid; s < n; s += 256) {
        const bf16_t* kp = PROJ + ((size_t)b * SEQ + s) * PROJ_W + C_KI; float kk[64];
#pragma unroll
        for (int c8 = 0; c8 < 8; ++c8) { float f[8]; unpack8(*(const u32x4*)(kp + c8 * 8), f);
#pragma unroll
            for (int j = 0; j < 8; ++j) kk[c8 * 8 + j] = f[j]; }
        float score = 0.f;
        for (int h = 0; h < 8; ++h) { float d = 0.f;
#pragma unroll
            for (int j = 0; j < 64; ++j) d += qi[h * 64 + j] * kk[j];
            score += wi[h] * fmaxf(d, 0.f); }
        sc[s] = score;
    }
    __syncthreads();
    const bool small = (t | 1) <= 255;
    if (small) { if (tid < n) sel[tid] = tid; if (tid == 0) cntp[0] = n; __syncthreads(); }
    else {
        unsigned thr = 0u;
        for (int bit = 31; bit >= 0; --bit) {
            const unsigned cand = thr | (1u << bit); int c = 0;
            for (int s = tid; s < n; s += 256) c += (fkey(sc[s]) >= cand) ? 1 : 0;
            red[tid] = c; __syncthreads();
            for (int o = 128; o > 0; o >>= 1) { if (tid < o) red[tid] += red[tid + o]; __syncthreads(); }
            if (red[0] >= 256) thr = cand;
            __syncthreads();
        }
        for (int s = tid; s < n; s += 256) if (fkey(sc[s]) > thr) { const int ps = atomicAdd((int*)cntp, 1); sel[ps] = s; }
        __syncthreads();
        if (tid == 0) { int c = cntp[0]; for (int s = 0; s < n && c < 256; ++s) if (fkey(sc[s]) == thr) sel[c++] = s; cntp[0] = c; }
        __syncthreads();
    }
    const int ns = cntp[0];
    { const int j = tid; const int s = (j < ns) ? sel[j] : 0;
      const bf16_t* kp = PROJ + ((size_t)b * SEQ + s) * PROJ_W + C_K; float kk[64];
#pragma unroll
      for (int c8 = 0; c8 < 8; ++c8) { float f[8]; unpack8(*(const u32x4*)(kp + c8 * 8), f);
#pragma unroll
          for (int jj = 0; jj < 8; ++jj) kk[c8 * 8 + jj] = f[jj]; }
      for (int h = 0; h < 8; ++h) { float d = 0.f;
#pragma unroll
          for (int jj = 0; jj < 64; ++jj) d += qv[h * 64 + jj] * kk[jj];
          const float slope = exp2f(-(float)(h + 1));
          lg[h * 256 + j] = (j < ns) ? d * 0.125f - slope * (float)(t - s) : -INFINITY; } }
    __syncthreads();
    if (tid < 8) { float m = -INFINITY; for (int j = 0; j < 256; ++j) m = fmaxf(m, lg[tid * 256 + j]); float sum = 0.f; for (int j = 0; j < 256; ++j) sum += __expf(lg[tid * 256 + j] - m); mx[tid] = m; sm[tid] = sum; }
    __syncthreads();
    for (int i = tid; i < 2048; i += 256) { const int h = i >> 8; lg[i] = __expf(lg[i] - mx[h]) / sm[h]; }
    __syncthreads();
    { const int h = tid >> 5, d0 = (tid & 31) * 2; float o0 = 0.f, o1 = 0.f;
      for (int j = 0; j < ns; ++j) { const unsigned w = *(const unsigned*)(PROJ + ((size_t)b * SEQ + sel[j]) * PROJ_W + C_V + d0); const float pj = lg[h * 256 + j]; o0 += pj * bflo(w); o1 += pj * bfhi(w); }
      *(unsigned*)(YA + (size_t)qid * 512 + h * 64 + d0) = pk2(o0, o1); }
}

typedef float f32x16 __attribute__((ext_vector_type(16)));
typedef _Float16 f16_t;
constexpr int AT_SC = 0;
constexpr int AT_V = 65536;
constexpr int AT_SEL = LDS_CNT;
static_assert(AT_V + 8 * 2 * 4096 <= STAGE_BYTES && AT_SEL + 8 * 1152 <= LDS_BYTES, "attention LDS map");

#define DPP_ZI(v, ctrl, rmask, bmask) __builtin_amdgcn_update_dpp(0, (int)(v), ctrl, rmask, bmask, false)
__device__ __forceinline__ int wave_scan_i(int v0) {
    int v1 = v0 + DPP_ZI(v0, 0x111, 0xf, 0xf); v1 += DPP_ZI(v0, 0x112, 0xf, 0xf); v1 += DPP_ZI(v0, 0x113, 0xf, 0xf);
    v1 += DPP_ZI(v1, 0x114, 0xf, 0xe); v1 += DPP_ZI(v1, 0x118, 0xf, 0xc);
    v1 += DPP_ZI(v1, 0x142, 0xa, 0xf); v1 += DPP_ZI(v1, 0x143, 0xc, 0xf);
    return v1;
}
__device__ __forceinline__ float relu_i(float x) { const int xi = __builtin_bit_cast(int, x); return __builtin_bit_cast(float, xi > 0 ? xi : 0); }
__device__ __forceinline__ u32x2 tr_read16(unsigned addr) { u32x2 r; asm volatile("ds_read_b64_tr_b16 %0, %1" : "=v"(r) : "v"(addr) : "memory"); return r; }

__device__ __forceinline__ void attn_item(const Params& p, LAS unsigned char* lds, int b, int qblk) {
    const int tid = tidx(), lane = tid & 63, wave = __builtin_amdgcn_readfirstlane(tid >> 6);
    const int q0 = qblk * 8;
    const bf16_t* PROJ = (const bf16_t*)(p.ws + WS_PROJ); bf16_t* YA = (bf16_t*)(p.ws + WS_YATTN);
    const size_t tok0 = (size_t)b * SEQ + q0;
    LAS unsigned short* SC = (LAS unsigned short*)(lds + AT_SC);
    LAS unsigned short* SELq = (LAS unsigned short*)(lds + AT_SEL) + wave * 576;
    const int nkt = (q0 + 8 + 31) >> 5;
    const int nchmax = (q0 + 8 + 511) >> 9;
    __syncthreads();
    for (int i = nkt * 32 + lane; i < nchmax * 512; i += 64) SC[wave * 4096 + i] = 0xFC00u;
    __syncthreads();
#ifndef AT_REP_A
#define AT_REP_A 1
#endif
#ifndef AT_REP_B
#define AT_REP_B 1
#endif
#ifndef AT_REP_C
#define AT_REP_C 1
#endif
#ifndef AT_SKIP_A
    for (int ra_ = 0; ra_ < AT_REP_A; ++ra_) {
        const int hf = lane >> 5, l32 = lane & 31;
        const int rq = 2 * ((l32 >> 2) & 1) + ((l32 >> 4) & 1), rh = (l32 & 3) + 4 * ((l32 >> 3) & 1);
        bf16x8 Af[2][4]; float wgt[2][16];
#pragma unroll
        for (int qg = 0; qg < 2; ++qg) { const bf16_t* qp = PROJ + (tok0 + 4 * qg + rq) * PROJ_W + C_QI + rh * 64 + hf * 8;
#pragma unroll
            for (int s = 0; s < 4; ++s) Af[qg][s] = *(const bf16x8*)(qp + s * 16);
#pragma unroll
            for (int qq = 0; qq < 2; ++qq) { const u32x4 w = *(const u32x4*)(PROJ + (tok0 + 4 * qg + 2 * hf + qq) * PROJ_W + C_WI); float f[8]; unpack8(w, f);
#pragma unroll
                for (int h = 0; h < 8; ++h) wgt[qg][qq * 8 + h] = f[h] * 0.0441941738f; } }
        const bf16x8* KIF = (const bf16x8*)(p.ws + WS_KIF) + (size_t)b * 128 * 4 * 64 + lane;
        bf16x8 B0[4], B1[4];
        { const int kt0 = wave < nkt ? wave : 0, kt1 = wave + 8 < nkt ? wave + 8 : kt0;
#pragma unroll
          for (int s = 0; s < 4; ++s) { B0[s] = KIF[(kt0 * 4 + s) * 64]; B1[s] = KIF[(kt1 * 4 + s) * 64]; } }
#define STEP_A_TILE(BF, KT) do { const int key = (KT) * 32 + l32; \
            _Pragma("unroll") for (int qg = 0; qg < 2; ++qg) { \
                f32x16 c; _Pragma("unroll") for (int j = 0; j < 16; ++j) c[j] = 0.f; \
                _Pragma("unroll") for (int s = 0; s < 4; ++s) c = __builtin_amdgcn_mfma_f32_32x32x16_bf16(Af[qg][s], BF[s], c, 0, 0, 0); \
                float sa = 0.f, sb = 0.f; \
                _Pragma("unroll") for (int h = 0; h < 8; ++h) { sa += wgt[qg][h] * relu_i(c[h]); sb += wgt[qg][8 + h] * relu_i(c[8 + h]); } \
                const int qa = 4 * qg + 2 * hf; \
                sa = __builtin_amdgcn_fmed3f(sa, -60000.f, 60000.f); sb = __builtin_amdgcn_fmed3f(sb, -60000.f, 60000.f); \
                if ((KT) == nkt - 1) {                       \
                    if (key > q0 + qa) sa = -INFINITY; \
                    if (key > q0 + qa + 1) sb = -INFINITY; } \
                const f16_t ha = (f16_t)sa, hb = (f16_t)sb; \
                SC[qa * 4096 + key] = __builtin_bit_cast(unsigned short, ha); SC[(qa + 1) * 4096 + key] = __builtin_bit_cast(unsigned short, hb); } } while (0)
        for (int kt = wave; kt < nkt; kt += 16) {
            STEP_A_TILE(B0, kt);
            { const int ktn = (kt + 16 < nkt) ? kt + 16 : kt;
#pragma unroll
              for (int s = 0; s < 4; ++s) B0[s] = KIF[(ktn * 4 + s) * 64]; }
            if (kt + 8 < nkt) {
                STEP_A_TILE(B1, kt + 8);
                { const int ktn = (kt + 24 < nkt) ? kt + 24 : kt;
#pragma unroll
                  for (int s = 0; s < 4; ++s) B1[s] = KIF[(ktn * 4 + s) * 64]; } }
        }
#undef STEP_A_TILE
    }
#endif
    __syncthreads();
    const int t = q0 + wave, n = t + 1;
    int ns;
    for (int rb_ = 0; rb_ < AT_REP_B; ++rb_) {
#ifdef AT_SKIP_B
    if (true) {
#else
    if (n <= 256) {
#endif
#pragma unroll
        for (int i = 0; i < 4; ++i) { const int pos = lane + 64 * i; SELq[pos] = (unsigned short)(pos < n ? pos : 0); }
        ns = n;
    } else {
        const int nch = (n + 511) >> 9;
        unsigned XH[32], XL[32];
        LAS unsigned char* row = lds + AT_SC + wave * 8192;
#pragma unroll
        for (int i = 0; i < 8; ++i) {
            if (i < nch) { const u32x4 w = *(const LAS u32x4*)(row + i * 1024 + lane * 16);
#pragma unroll
                for (int e2 = 0; e2 < 4; ++e2) { const unsigned x = w[e2]; const unsigned sg = (x & 0x80008000u) >> 15; const unsigned k2 = x ^ ((sg * 0xffffu) | 0x80008000u);
                    XH[i * 4 + e2] = k2; XL[i * 4 + e2] = k2 << 16; } }
            else {
#pragma unroll
                for (int e2 = 0; e2 < 4; ++e2) { XH[i * 4 + e2] = 0u; XL[i * 4 + e2] = 0u; } }
        }
        LAS unsigned* H1 = (LAS unsigned*)(lds + 65536 + wave * 8192);
        LAS unsigned* H2 = (LAS unsigned*)((LAS unsigned char*)SELq + 640);
        LAS unsigned* H1p = H1 + (lane & 1) * 1024;
#pragma unroll
        for (int i = 0; i < 8; ++i) *(LAS u32x4*)(H1 + (i * 64 + lane) * 4) = (u32x4){0u, 0u, 0u, 0u};
        H2[lane] = 0u;
        LDS_WAIT(); __builtin_amdgcn_wave_barrier();
#pragma unroll
        for (int i = 0; i < 8; ++i) if (i < nch) {
#pragma unroll
            for (int e2 = 0; e2 < 4; ++e2) { const unsigned x = XH[i * 4 + e2];
                __hip_atomic_fetch_add(H1p + (x >> 22), 1u, __ATOMIC_RELAXED, __HIP_MEMORY_SCOPE_WORKGROUP);
                __hip_atomic_fetch_add(H1p + ((x >> 6) & 1023u), 1u, __ATOMIC_RELAXED, __HIP_MEMORY_SCOPE_WORKGROUP); } }
        LDS_WAIT(); __builtin_amdgcn_wave_barrier();
        unsigned B1, cabove; const unsigned dummy = 64u + (unsigned)lane;
        {
            unsigned hb[16];
#pragma unroll
            for (int i = 0; i < 4; ++i) { const u32x4 w = *(const LAS u32x4*)(H1 + lane * 16 + i * 4), w2 = *(const LAS u32x4*)(H1 + 1024 + lane * 16 + i * 4); hb[4 * i] = w.x + w2.x; hb[4 * i + 1] = w.y + w2.y; hb[4 * i + 2] = w.z + w2.z; hb[4 * i + 3] = w.w + w2.w; }
            unsigned sl_ = 0u;
#pragma unroll
            for (int i = 0; i < 16; ++i) sl_ += hb[i];
            const int inc_ = wave_scan_i((int)sl_);
            const unsigned above = (unsigned)(__builtin_amdgcn_readlane(inc_, 63) - inc_), suf = above + sl_;
            const bool mine = above < 256u && suf >= 256u;
            unsigned bsel = 0u, cab = 0u;
            if (mine) { unsigned run = above; bool done = false;
#pragma unroll
                for (int i = 15; i >= 0; --i) { if (!done && run + hb[i] >= 256u) { bsel = (unsigned)(lane * 16 + i); cab = run; done = true; } run += hb[i]; } }
            const unsigned long long mk = __ballot(mine); const int src = (int)__builtin_ctzll(mk);
            B1 = (unsigned)__builtin_amdgcn_readlane((int)bsel, src); cabove = (unsigned)__builtin_amdgcn_readlane((int)cab, src);
        }
#pragma unroll
        for (int i = 0; i < 8; ++i) if (i < nch) {
#pragma unroll
            for (int e2 = 0; e2 < 4; ++e2) { const unsigned x = XH[i * 4 + e2];
                const unsigned ah = ((x >> 22) == B1) ? ((x >> 16) & 63u) : dummy, al = (((x >> 6) & 1023u) == B1) ? (x & 63u) : dummy;
                __hip_atomic_fetch_add(H2 + ah, 1u, __ATOMIC_RELAXED, __HIP_MEMORY_SCOPE_WORKGROUP);
                __hip_atomic_fetch_add(H2 + al, 1u, __ATOMIC_RELAXED, __HIP_MEMORY_SCOPE_WORKGROUP); } }
        LDS_WAIT(); __builtin_amdgcn_wave_barrier();
        unsigned thr;
        {   const unsigned h2 = H2[lane]; const int inc_ = wave_scan_i((int)h2); const unsigned ab2 = (unsigned)(__builtin_amdgcn_readlane(inc_, 63) - inc_), suf = ab2 + h2;
            const unsigned need = 256u - cabove;
            const bool mine = ab2 < need && suf >= need;
            const unsigned long long mk = __ballot(mine); const unsigned B2 = (unsigned)__builtin_ctzll(mk);
            thr = (B1 << 6) | B2; }
        const unsigned c32 = thr << 16, c32h = c32 | 0xffffu;
#define TIE2(a, b) asm volatile("" : "+v"(a), "+v"(b))
        int cgt = 0, ceq = 0;
#pragma unroll
        for (int j = 0; j < 32; ++j) { unsigned xh = XH[j], xl = XL[j]; TIE2(xh, cgt); TIE2(xl, ceq);
            cgt += (xh > c32h) ? 1 : 0; cgt += (xl > c32) ? 1 : 0; ceq += ((xh >> 16) == thr) ? 1 : 0; ceq += (xl == c32) ? 1 : 0; }
        const int sgt = wave_scan_i(cgt), seq = wave_scan_i(ceq);
        const int tot_gt = __builtin_amdgcn_readlane(sgt, 63);
        int o1 = sgt - cgt, o2 = tot_gt + seq - ceq;
        const int trash = 256 + lane;
#pragma unroll
        for (int i = 0; i < 8; ++i) if (i < nch) {
#pragma unroll
            for (int e2 = 0; e2 < 4; ++e2) { const int j = i * 4 + e2; const int idx = i * 512 + lane * 8 + 2 * e2;
                unsigned xl = XL[j], xh = XH[j]; TIE2(xl, o1); TIE2(xh, o2);
                { const bool gt = xl > c32, eq = xl == c32; const int a2 = (eq && o2 < 256) ? o2 : trash, a1 = gt ? o1 : a2; SELq[a1] = (unsigned short)idx; o1 += gt ? 1 : 0; o2 += eq ? 1 : 0; }
                TIE2(xh, o1);
                { const bool gt = xh > c32h, eq = (xh >> 16) == thr; const int a2 = (eq && o2 < 256) ? o2 : trash, a1 = gt ? o1 : a2; SELq[a1] = (unsigned short)(idx + 1); o1 += gt ? 1 : 0; o2 += eq ? 1 : 0; } } }
        ns = 256;
    }
    LDS_WAIT(); __builtin_amdgcn_wave_barrier(); }
    __syncthreads();
    {
        const int hd = lane & 15, qd = lane >> 4;
        const size_t tok = tok0 + wave;
        LAS unsigned char* vb = lds + wave * 16384;
        const unsigned vb_addr = (unsigned)(size_t)vb;
        const int vrow = lane >> 3, vch = lane & 7;
        const char* bbase = (const char*)(PROJ + (size_t)b * SEQ * PROJ_W);
        const unsigned voff0 = (unsigned)(C_V * 2 + vch * 16), koff0 = (unsigned)(C_K * 2 + qd * 16);
        unsigned roff[32];
#pragma unroll
        for (int j_ = 0; j_ < 32; ++j_) roff[j_] = (unsigned)SELq[(j_ >> 2) * 32 + vrow + 8 * (j_ & 3)] * (unsigned)(PROJ_W * 2);
#define V_DMA(sl) do { _Pragma("unroll") for (int i_ = 0; i_ < 4; ++i_) { \
            __builtin_amdgcn_global_load_lds((const unsigned*)(bbase + (roff[(sl) * 4 + i_] + voff0)), (LAS unsigned*)(vb + ((sl) & 3) * 4096 + i_ * 1024), 16, 0, 0); } } while (0)
        bf16x8 Qf[2];
#pragma unroll
        for (int ks = 0; ks < 2; ++ks) { if (hd < 8) Qf[ks] = *(const bf16x8*)(PROJ + tok * PROJ_W + C_Q + hd * 64 + ks * 32 + qd * 8); else Qf[ks] = (bf16x8){0, 0, 0, 0, 0, 0, 0, 0}; }
#define KSWZ(row) ((unsigned)(((row) & 3) | ((((row) >> 3) & 1) << 2)))
#define K_DMA(sl) do { _Pragma("unroll") for (int i_ = 0; i_ < 4; ++i_) { const int row_ = i_ * 8 + vrow; \
            __builtin_amdgcn_global_load_lds((const unsigned*)(bbase + (roff[(sl) * 4 + i_] + (unsigned)(C_K * 2) + (((unsigned)vch ^ KSWZ(row_)) * 16u))), (LAS unsigned*)(vb + ((sl) & 3) * 4096 + i_ * 1024), 16, 0, 0); } } while (0)
        (void)koff0;
        K_DMA(0); K_DMA(1); K_DMA(2); K_DMA(3);
        f32x4 S[16];
#pragma unroll
        for (int sl = 0; sl < 8; ++sl) {
            asm volatile("s_waitcnt vmcnt(12)" ::: "memory");
#pragma unroll
            for (int Th = 0; Th < 2; ++Th) { const int prow = (hd >> 2) * 8 + Th * 4 + (hd & 3); const unsigned fp = KSWZ(prow);
                const LAS unsigned char* ka = vb + (sl & 3) * 4096 + prow * 128;
                const bf16x8 K0 = *(const LAS bf16x8*)(ka + (((unsigned)qd ^ fp) * 16u)), K1 = *(const LAS bf16x8*)(ka + (((unsigned)(4 + qd) ^ fp) * 16u));
                f32x4 a = (f32x4){0.f, 0.f, 0.f, 0.f};
                a = __builtin_amdgcn_mfma_f32_16x16x32_bf16(K0, Qf[0], a, 0, 0, 0); a = __builtin_amdgcn_mfma_f32_16x16x32_bf16(K1, Qf[1], a, 0, 0, 0); S[2 * sl + Th] = a; }
            asm volatile("s_waitcnt lgkmcnt(0)" ::: "memory");
            if (sl + 4 < 8) K_DMA(sl + 4); else V_DMA(sl - 4);
        }
        const float slope = exp2f(-(float)((hd & 7) + 1)), abase = -slope * (float)t;
        float mx = -INFINITY;
#pragma unroll
        for (int sl = 0; sl < 8; ++sl) { const u32x4 w = *(const LAS u32x4*)((LAS unsigned char*)SELq + (sl * 32 + qd * 8) * 2);
#pragma unroll
            for (int e = 0; e < 8; ++e) { const int T = sl * 2 + (e >> 2), r = e & 3; const unsigned ww = w[e >> 1]; const float sf = (float)((e & 1) ? (ww >> 16) : (ww & 0xffffu));
                const float lgv = __builtin_fmaf(S[T][r], 0.125f, __builtin_fmaf(slope, sf, abase)); S[T][r] = lgv; } }
        if (ns < 256) {
#pragma unroll
            for (int sl = 0; sl < 8; ++sl)
#pragma unroll
                for (int e = 0; e < 8; ++e) { if (sl * 32 + qd * 8 + e >= ns) S[sl * 2 + (e >> 2)][e & 3] = -INFINITY; } }
#pragma unroll
        for (int T = 0; T < 16; ++T) { asm("v_max3_f32 %0, %0, %1, %2" : "+v"(mx) : "v"(S[T][0]), "v"(S[T][1])); asm("v_max3_f32 %0, %0, %1, %2" : "+v"(mx) : "v"(S[T][2]), "v"(S[T][3])); }
        mx = fmaxf(mx, __shfl_xor(mx, 16)); mx = fmaxf(mx, __shfl_xor(mx, 32));
        float sum = 0.f;
        const float mxl = mx * 1.44269504089f;
#pragma unroll
        for (int T = 0; T < 16; ++T)
#pragma unroll
            for (int r = 0; r < 4; ++r) { const float e = __builtin_amdgcn_exp2f(S[T][r] * 1.44269504089f - mxl); S[T][r] = e; sum += e; }
        sum += __shfl_xor(sum, 16); sum += __shfl_xor(sum, 32);
        u32x4 Pk[8];
#pragma unroll
        for (int sl = 0; sl < 8; ++sl) { Pk[sl].x = pk2(S[2 * sl][0], S[2 * sl][1]); Pk[sl].y = pk2(S[2 * sl][2], S[2 * sl][3]); Pk[sl].z = pk2(S[2 * sl + 1][0], S[2 * sl + 1][1]); Pk[sl].w = pk2(S[2 * sl + 1][2], S[2 * sl + 1][3]); }
        f32x4 O[4];
#pragma unroll
        for (int dt = 0; dt < 4; ++dt) O[dt] = (f32x4){0.f, 0.f, 0.f, 0.f};
#pragma unroll
        for (int sl = 0; sl < 8; ++sl) {
            if (sl <= 4) asm volatile("s_waitcnt vmcnt(12)" ::: "memory"); else if (sl == 5) asm volatile("s_waitcnt vmcnt(8)" ::: "memory"); else if (sl == 6) asm volatile("s_waitcnt vmcnt(4)" ::: "memory"); else asm volatile("s_waitcnt vmcnt(0)" ::: "memory");
            const unsigned a0 = vb_addr + (sl & 3) * 4096 + (8 * qd + (hd >> 2)) * 128 + (hd & 3) * 8;
            u32x2 tr[4][2];
            asm volatile("ds_read_b64_tr_b16 %0, %8\n\tds_read_b64_tr_b16 %1, %8 offset:512\n\tds_read_b64_tr_b16 %2, %8 offset:32\n\tds_read_b64_tr_b16 %3, %8 offset:544\n\t"
                         "ds_read_b64_tr_b16 %4, %8 offset:64\n\tds_read_b64_tr_b16 %5, %8 offset:576\n\tds_read_b64_tr_b16 %6, %8 offset:96\n\tds_read_b64_tr_b16 %7, %8 offset:608\n\ts_waitcnt lgkmcnt(0)"
                         : "=&v"(tr[0][0]), "=&v"(tr[0][1]), "=&v"(tr[1][0]), "=&v"(tr[1][1]), "=&v"(tr[2][0]), "=&v"(tr[2][1]), "=&v"(tr[3][0]), "=&v"(tr[3][1]) : "v"(a0) : "memory");
            if (sl + 4 < 8) V_DMA(sl + 4);
            const bf16x8 Pf = __builtin_bit_cast(bf16x8, Pk[sl]);
#pragma unroll
            for (int dt = 0; dt < 4; ++dt) { u32x4 vw; vw.x = tr[dt][0].x; vw.y = tr[dt][0].y; vw.z = tr[dt][1].x; vw.w = tr[dt][1].y;
                O[dt] = __builtin_amdgcn_mfma_f32_16x16x32_bf16(__builtin_bit_cast(bf16x8, vw), Pf, O[dt], 0, 0, 0); }
        }
#undef V_DMA
        const float inv = 1.0f / sum;
        if (hd < 8) {
#pragma unroll
            for (int dt = 0; dt < 4; ++dt) { u32x2 w; w.x = pk2(O[dt][0] * inv, O[dt][1] * inv); w.y = pk2(O[dt][2] * inv, O[dt][3] * inv);
                *(u32x2*)(YA + tok * 512 + hd * 64 + dt * 16 + qd * 4) = w; } }
    }
}

#define DPP_F(v, ctrl, rmask) __builtin_bit_cast(float, __builtin_amdgcn_update_dpp(__builtin_bit_cast(int, v), __builtin_bit_cast(int, v), ctrl, rmask, 0xf, false))
__device__ __forceinline__ float wave_max_dpp(float v) {
    asm volatile("s_nop 1\n\tv_max_f32_dpp %0, %0, %0 row_shr:1 row_mask:0xf bank_mask:0xf\n\ts_nop 1\n\tv_max_f32_dpp %0, %0, %0 row_shr:2 row_mask:0xf bank_mask:0xf\n\ts_nop 1\n\t"
                 "v_max_f32_dpp %0, %0, %0 row_shr:3 row_mask:0xf bank_mask:0xf\n\ts_nop 1\n\tv_max_f32_dpp %0, %0, %0 row_shr:4 row_mask:0xf bank_mask:0xf\n\ts_nop 1\n\t"
                 "v_max_f32_dpp %0, %0, %0 row_shr:8 row_mask:0xf bank_mask:0xf\n\ts_nop 1\n\tv_max_f32_dpp %0, %0, %0 row_bcast:15 row_mask:0xa bank_mask:0xf\n\ts_nop 1\n\t"
                 "v_max_f32_dpp %0, %0, %0 row_bcast:31 row_mask:0xc bank_mask:0xf\n\ts_nop 1" : "+v"(v));
    return __builtin_bit_cast(float, __builtin_amdgcn_readlane(__builtin_bit_cast(int, v), 63));
}
#define DPP_Z(v, ctrl, rmask, bmask) __builtin_bit_cast(float, __builtin_amdgcn_update_dpp(0, __builtin_bit_cast(int, v), ctrl, rmask, bmask, false))
__device__ __forceinline__ float wave_sum_dpp(float v0) {
    float v1 = v0 + DPP_Z(v0, 0x111, 0xf, 0xf); v1 += DPP_Z(v0, 0x112, 0xf, 0xf); v1 += DPP_Z(v0, 0x113, 0xf, 0xf);
    v1 += DPP_Z(v1, 0x114, 0xf, 0xe); v1 += DPP_Z(v1, 0x118, 0xf, 0xc);
    v1 += DPP_Z(v1, 0x142, 0xa, 0xf); v1 += DPP_Z(v1, 0x143, 0xc, 0xf);
    return __builtin_bit_cast(float, __builtin_amdgcn_readlane(__builtin_bit_cast(int, v1), 63));
}
constexpr int RT_LG = 0;
constexpr int RT_ENT = 32768;
constexpr int RT_HIST = RT_ENT + 8 * 128 * 12;
constexpr int RT_NV = 49152;
__device__ __forceinline__ void route_tile(const Params& p, LAS unsigned char* lds, int tile, int skip) {
    const int tid = tidx(), lane = tid & 63, wave = __builtin_amdgcn_readfirstlane(tid >> 6), hd = lane & 15, qd = lane >> 4;
    const float* ada = (const float*)(p.ws + WS_ADA); const float* g2 = p.in[19];
    bf16_t* U2 = (bf16_t*)(p.ws + WS_U);
    LAS int* hist = (LAS int*)(lds + RT_HIST);
    LAS float* LGT = (LAS float*)(lds + RT_LG);
    LAS int* ENT = (LAS int*)(lds + RT_ENT) + wave * 384;
    const int b = (tile * 128) >> 12;
    __syncthreads();
    if (tid < 64) hist[tid] = 0;
    if (tid == 64) hist[128] = 0;
    { LAS float* NV = (LAS float*)(lds + RT_NV);
      for (int i = tid; i < 256; i += NTHR) { const f32x4 g = *(const f32x4*)(g2 + 4 * i), sc = *(const f32x4*)(ada + b * 6144 + 4096 + 4 * i), sh = *(const f32x4*)(ada + b * 6144 + 3072 + 4 * i);
          *(LAS f32x4*)(NV + 4 * i) = g * (sc + 1.0f); *(LAS f32x4*)(NV + 1024 + 4 * i) = sh; } }
    __syncthreads();
    if (wave < 4) {
        const int tokw = tile * 128 + wave * 32;
        float rstd[2]; const bf16_t* hrow[2];
#pragma unroll
        for (int rt = 0; rt < 2; ++rt) { const int m = tokw + rt * 16 + hd; hrow[rt] = (const bf16_t*)(p.out + (size_t)m * D) + qd * 8;
            const f32x4 q4 = *(const f32x4*)((const float*)(p.ws + WS_SS) + (size_t)m * 16 + qd * 4); float ss = (q4.x + q4.y) + (q4.z + q4.w);
            ss += __shfl_xor(ss, 16); ss += __shfl_xor(ss, 32); rstd[rt] = 1.0f / sqrtf(ss * (1.f / D) + EPS); }
        const bf16x8* WH = (const bf16x8*)(p.ws + WS_WRF) + lane; const bf16x8* WL = WH + 32 * 4 * 64;
        f32x4 acc[2][4];
#pragma unroll
        for (int rt = 0; rt < 2; ++rt)
#pragma unroll
            for (int nt = 0; nt < 4; ++nt) acc[rt][nt] = (f32x4){0.f, 0.f, 0.f, 0.f};
        bf16x8 wh[4], wl[4], whn[4], wln[4]; u32x4 xa[2], xn[2], xnn[2];
#pragma unroll
        for (int nt = 0; nt < 4; ++nt) { wh[nt] = WH[nt * 64]; wl[nt] = WL[nt * 64]; }
#pragma unroll
        for (int rt = 0; rt < 2; ++rt) { xa[rt] = *(const u32x4*)(hrow[rt]); xn[rt] = *(const u32x4*)(hrow[rt] + 32); }
#pragma unroll 2
        for (int ks = 0; ks < 32; ++ks) {
            const int kn = (ks + 1 < 32) ? ks + 1 : ks;
#pragma unroll
            for (int nt = 0; nt < 4; ++nt) { whn[nt] = WH[(kn * 4 + nt) * 64]; wln[nt] = WL[(kn * 4 + nt) * 64]; }
#pragma unroll
            for (int rt = 0; rt < 2; ++rt) xnn[rt] = *(const u32x4*)(hrow[rt] + ((ks + 2 < 32) ? ks + 2 : ks) * 32);
            const int c0 = ks * 32 + qd * 8;
            const LAS float* NV = (const LAS float*)(lds + RT_NV);
            const f32x4 ma = *(const LAS f32x4*)(NV + c0), mb = *(const LAS f32x4*)(NV + c0 + 4), ha = *(const LAS f32x4*)(NV + 1024 + c0), hb = *(const LAS f32x4*)(NV + 1024 + c0 + 4);
#pragma unroll
            for (int rt = 0; rt < 2; ++rt) {
                const f32x4 x0 = {bflo(xa[rt].x), bfhi(xa[rt].x), bflo(xa[rt].y), bfhi(xa[rt].y)}, x1 = {bflo(xa[rt].z), bfhi(xa[rt].z), bflo(xa[rt].w), bfhi(xa[rt].w)};
                const f32x4 y0 = x0 * rstd[rt] * ma + ha, y1 = x1 * rstd[rt] * mb + hb;
                const u32x4 hi = pack8(y0, y1);
                f32x4 r0, r1; r0.x = y0.x - bflo(hi.x); r0.y = y0.y - bfhi(hi.x); r0.z = y0.z - bflo(hi.y); r0.w = y0.w - bfhi(hi.y);
                r1.x = y1.x - bflo(hi.z); r1.y = y1.y - bfhi(hi.z); r1.z = y1.z - bflo(hi.w); r1.w = y1.w - bfhi(hi.w);
                const bf16x8 uh = __builtin_bit_cast(bf16x8, hi), ul = __builtin_bit_cast(bf16x8, pack8(r0, r1));
#pragma unroll
                for (int nt = 0; nt < 4; ++nt) {
                    acc[rt][nt] = __builtin_amdgcn_mfma_f32_16x16x32_bf16(wh[nt], uh, acc[rt][nt], 0, 0, 0);
                    acc[rt][nt] = __builtin_amdgcn_mfma_f32_16x16x32_bf16(wl[nt], uh, acc[rt][nt], 0, 0, 0);
                    acc[rt][nt] = __builtin_amdgcn_mfma_f32_16x16x32_bf16(wh[nt], ul, acc[rt][nt], 0, 0, 0); } }
#pragma unroll
            for (int nt = 0; nt < 4; ++nt) { wh[nt] = whn[nt]; wl[nt] = wln[nt]; }
#pragma unroll
            for (int rt = 0; rt < 2; ++rt) { xa[rt] = xn[rt]; xn[rt] = xnn[rt]; }
        }
#pragma unroll
        for (int rt = 0; rt < 2; ++rt)
#pragma unroll
            for (int nt = 0; nt < 4; ++nt) *(LAS f32x4*)(LGT + (wave * 32 + rt * 16 + hd) * 64 + nt * 16 + qd * 4) = acc[rt][nt];
    }
    {
        LAS int* rowctr = hist + 128;
        LAS const float* NV = (LAS const float*)(lds + RT_NV);
        auto claim = [&]() -> int { int r = 0; if (lane == 0) r = __hip_atomic_fetch_add(rowctr, 1, __ATOMIC_RELAXED, __HIP_MEMORY_SCOPE_WORKGROUP); return __builtin_amdgcn_readfirstlane(r); };
        const float* SSp = (const float*)(p.ws + WS_SS);
#define RT_ROWLOAD(vv, sv, rr) do { if ((rr) < 128) { const int m_ = tile * 128 + (rr); const u32x4* xr_ = (const u32x4*)(p.out + (size_t)m_ * D) + lane; vv[0] = xr_[0]; vv[1] = xr_[64]; sv = SSp[(size_t)m_ * 16 + (lane & 15)]; } } while (0)
        int r = claim(), rn = claim(); u32x4 v[2] = {}, vn[2] = {}; float ssl = 0.f, ssn = 0.f;
        RT_ROWLOAD(v, ssl, r); RT_ROWLOAD(vn, ssn, rn);
        while (r < 128) {
            const int rnn = (rn < 128) ? claim() : 128; u32x4 vnn[2] = {vn[0], vn[1]}; float ssnn = 0.f;
            RT_ROWLOAD(vnn, ssnn, rnn);
            float ss = ssl; ss += __shfl_xor(ss, 1); ss += __shfl_xor(ss, 2); ss += __shfl_xor(ss, 4); ss += __shfl_xor(ss, 8);
            const float rstd = 1.0f / sqrtf(ss * (1.f / D) + EPS);
            u32x4* o16 = (u32x4*)(U2 + (size_t)(tile * 128 + r) * D) + lane;
#pragma unroll
            for (int j = 0; j < 2; ++j) { const int c0 = 8 * lane + 512 * j;
                const f32x4 ma = *(LAS const f32x4*)(NV + c0), mb = *(LAS const f32x4*)(NV + c0 + 4), sh = *(LAS const f32x4*)(NV + 1024 + c0), sb = *(LAS const f32x4*)(NV + 1024 + c0 + 4);
                const f32x4 x0 = {bflo(v[j].x), bfhi(v[j].x), bflo(v[j].y), bfhi(v[j].y)}, x1 = {bflo(v[j].z), bfhi(v[j].z), bflo(v[j].w), bfhi(v[j].w)};
                o16[64 * j] = pack8(x0 * rstd * ma + sh, x1 * rstd * mb + sb); }
            v[0] = vn[0]; v[1] = vn[1]; vn[0] = vnn[0]; vn[1] = vnn[1];
            ssl = ssn; ssn = ssnn; r = rn; rn = rnn;
        }
#undef RT_ROWLOAD
    }
    __syncthreads();
    const int tok0 = tile * 128 + wave * 16;
    LAS float* LG = LGT + wave * 1024;
    const float rbias = p.in[21][lane];
#pragma unroll 1
    for (int mi = 0; mi < 16; ++mi) {
        const float score = sigmoidf_(LG[mi * 64 + lane]); const float biased = score + rbias;
        float m1 = biased;
        m1 = fmaxf(m1, DPP_F(m1, 0xb1, 0xf)); m1 = fmaxf(m1, DPP_F(m1, 0x4e, 0xf)); m1 = fmaxf(m1, DPP_F(m1, 0x141, 0xf));
        const unsigned long long bal = __ballot(biased == m1); const int grp = lane >> 3;
        const unsigned gm = (unsigned)((bal >> (grp * 8)) & 0xffull); const int first = __ffs((int)gm) - 1;
        float v2 = ((lane & 7) == first) ? -INFINITY : biased;
        v2 = fmaxf(v2, DPP_F(v2, 0xb1, 0xf)); v2 = fmaxf(v2, DPP_F(v2, 0x4e, 0xf)); v2 = fmaxf(v2, DPP_F(v2, 0x141, 0xf));
        const float gscore = m1 + v2;
        int grank = 0;
#pragma unroll
        for (int og = 0; og < 8; ++og) { const float o = __builtin_bit_cast(float, __builtin_amdgcn_readlane(__builtin_bit_cast(int, gscore), og * 8)); grank += (o > gscore || (o == gscore && og < grp)) ? 1 : 0; }
        float mv = (grank < 4) ? biased : -INFINITY;
        unsigned long long chosen_m = 0ull;
#pragma unroll 1
        for (int it = 0; it < 8; ++it) { const float mxv = wave_max_dpp(mv); const unsigned long long e = __ballot(mv == mxv); const int w = (int)__builtin_ctzll(e); chosen_m |= 1ull << w; if (lane == w) mv = -INFINITY; }
        const bool chosen = (chosen_m >> lane) & 1ull;
        const int rank = (int)__builtin_amdgcn_mbcnt_hi((unsigned)(chosen_m >> 32), __builtin_amdgcn_mbcnt_lo((unsigned)chosen_m, 0u));
        const float gsum = wave_sum_dpp(chosen ? score : 0.f);
        if (chosen) { const int lpos = __hip_atomic_fetch_add(hist + lane, 1, __ATOMIC_RELAXED, __HIP_MEMORY_SCOPE_WORKGROUP);   const int e = mi * 8 + rank; ENT[e * 3] = lane; ENT[e * 3 + 1] = lpos; ENT[e * 3 + 2] = __builtin_bit_cast(int, score / gsum * 2.5f); }
    }
    __syncthreads();
    const int ch = (tile * 128) / CHTOK;
    if (skip) return;
    if (tid < 64) { const int c = hist[tid]; int base = 0; if (c > 0) base = (int)atomicAdd((unsigned*)(p.ws + WS_CTL) + CW_CNT + ch * NE + tid, (unsigned)c); hist[64 + tid] = base; }
    __syncthreads();
#pragma unroll
    for (int i = 0; i < 2; ++i) { const int e = lane + 64 * i; const int ex = ENT[e * 3], lpos = ENT[e * 3 + 1]; const float gate = __builtin_bit_cast(float, ENT[e * 3 + 2]);
        const int m = tok0 + (e >> 3), rk = e & 7, pair = ch * NE + ex, ps = hist[64 + ex] + lpos;
        ((int*)(p.ws + WS_DSTL))[(size_t)pair * PAIRCAP + ps] = (m - ch * CHTOK) * NSLOT + rk; ((float*)(p.ws + WS_GATEL))[(size_t)pair * PAIRCAP + ps] = gate; }
}

#define XB_TMO      128
#define XB_XCNT(j)  (256  + 64 * (j))
#define XB_XSUB(j)  (1280 + 64 * (j))
#define XB_XGEN(j)  (2304 + 64 * (j))
#define XB_TOP      3328
#define XB_TOPGEN   3392
#define XCD_BAR_WORDS 3456
#define XB_SPIN_CAP (1u << 22)
__device__ __forceinline__ unsigned xb_ld(unsigned* p)              { return __hip_atomic_load(p, __ATOMIC_RELAXED, __HIP_MEMORY_SCOPE_AGENT); }
__device__ __forceinline__ unsigned xb_add(unsigned* p, unsigned v) { return __hip_atomic_fetch_add(p, v, __ATOMIC_RELAXED, __HIP_MEMORY_SCOPE_AGENT); }
__device__ __forceinline__ unsigned xb_xcc_id() { return (unsigned)__builtin_amdgcn_s_getreg((3 << 11) | 20) & 0xFu; }
#define XB_SPIN(cond, bar) do { unsigned _sp = 0; while (cond) { __builtin_amdgcn_s_sleep(1); \
    if ((++_sp & 255u) == 0u) { if (xb_ld(&(bar)[XB_TMO])) break; if (_sp > XB_SPIN_CAP) { atomicAdd(&(bar)[XB_TMO], 1u); break; } } } } while (0)
struct XcdBarrier { unsigned* bar; unsigned x; volatile LAS unsigned* st; };
__device__ __forceinline__ XcdBarrier xcd_barrier_post(unsigned* bar, volatile LAS unsigned* st) {
    XcdBarrier b; b.bar = bar; b.x = xb_xcc_id(); b.st = st;
    if (tidx() == 0) (void)xb_add(&bar[XB_XCNT(b.x)], 1u);
    return b;
}
__device__ __forceinline__ void xcd_barrier_complete(unsigned* bar, unsigned x, unsigned& nloc, unsigned& nx) {
    const unsigned G = gridDim.x * gridDim.y * gridDim.z;
    unsigned sum, cnt, mine, sp = 0u;
    for (;;) {
        sum = 0u; cnt = 0u; mine = 0u;
#pragma unroll
        for (unsigned j = 0; j < 16; ++j) { const unsigned c = xb_ld(&bar[XB_XCNT(j)]); sum += c; cnt += (c > 0u) ? 1u : 0u; mine = (j == x) ? c : mine; }
        if (sum == G) break;
        __builtin_amdgcn_s_sleep(1);
        if ((++sp & 255u) == 0u) { if (xb_ld(&bar[XB_TMO])) break; if (sp > XB_SPIN_CAP) { atomicAdd(&bar[XB_TMO], 1u); break; } }
    }
    nloc = mine > 0u ? mine : 1u; nx = cnt > 0u ? cnt : 1u;
}
__device__ __forceinline__ void xcd_barrier(const XcdBarrier& b) {
    asm volatile("s_waitcnt vmcnt(0)" ::: "memory");
    __syncthreads();
    if (tidx() == 0) {
        unsigned* bar = b.bar;
        __builtin_amdgcn_s_waitcnt(0);
        unsigned nloc = b.st[0], nx = b.st[1];
        if (nloc == 0u) { xcd_barrier_complete(bar, b.x, nloc, nx); b.st[0] = nloc; b.st[1] = nx; }
        const unsigned old = xb_add(&bar[XB_XSUB(b.x)], 1u);
        const unsigned gen = old / nloc;
        if (old + 1u == (gen + 1u) * nloc) {
            __builtin_amdgcn_fence(__ATOMIC_RELEASE, "agent");
            asm volatile("s_waitcnt vmcnt(0)" ::: "memory");
            const unsigned og = xb_add(&bar[XB_TOP], 1u);
            const unsigned tg = og / nx;
            if (og + 1u == (tg + 1u) * nx) xb_add(&bar[XB_TOPGEN], 1u);
            else XB_SPIN(xb_ld(&bar[XB_TOPGEN]) == tg, bar);
            __builtin_amdgcn_fence(__ATOMIC_ACQUIRE, "agent");
            xb_add(&bar[XB_XGEN(b.x)], 1u);
            asm volatile("s_waitcnt vmcnt(0)" ::: "memory");
        } else {
            XB_SPIN(xb_ld(&bar[XB_XGEN(b.x)]) == gen, bar);
            __builtin_amdgcn_fence(__ATOMIC_ACQUIRE, "agent");
            asm volatile("s_waitcnt vmcnt(0)" ::: "memory");
        }
    }
    __syncthreads();
}

enum { PH_PREP = 0, PH_MOD, PH_INPROJ, PH_MIX  , PH_GLU, PH_MIXAB, PH_OUT, PH_ROUTE  , PH_MOE1, PH_MOE2_0, PH_COMB_0, PH_END };

#ifndef USE_CG_SYNC
#define USE_CG_SYNC 0
#endif
__global__ void __launch_bounds__(NTHR, 2) mega(Params p_arg) {
    extern __shared__ __attribute__((aligned(16))) unsigned char lds_raw[];
    LAS unsigned char* lds = (LAS unsigned char*)lds_raw;
    const int G = gridDim.x, bx = blockIdx.x;
    const int vcu = (G % 8 == 0) ? (bx % 8) * (G / 8) + bx / 8 : bx;
    const int tid = tidx(), lane = tid & 63, wave = __builtin_amdgcn_readfirstlane(tid >> 6);
    unsigned char* const ws_ = p_arg.ws; unsigned char* ws = ws_; (void)ws;
    if (tid < 32) ((LAS unsigned*)(lds + LDS_MISC))[tid] = 0u;
    __syncthreads();
#if USE_CG_SYNC
    cg::grid_group grid = cg::this_grid();
#define GRID_SYNC() grid.sync()
#else
    XcdBarrier xbar = xcd_barrier_post((unsigned*)(ws + WS_CTL) + CW_BAR, (volatile LAS unsigned*)(lds + LDS_MISC) + 8);
#define GRID_SYNC() xcd_barrier(xbar)
#endif
#ifndef ONLY_PH
#define ONLY_PH -1
#endif
#define IN(k) (ONLY_PH < 0 || ONLY_PH == (k))
#define SEAM(k) do { if ((k) + 1 < PH_END) GRID_SYNC(); } while (0)
#ifndef REP_PH
#define REP_PH -1
#endif
#ifndef REP_N
#define REP_N 3
#endif
#ifndef PROBE_NOSTORE
#define PROBE_NOSTORE 0
#endif
#define PHASE(k, ...) do { if (IN(k)) { { const int PROBE_SKIP = 0; unsigned zoff_ = 0u; asm volatile("" : "+s"(zoff_)); unsigned char* ws = ws_ + zoff_; const Params& p = *(const Params*)((const char*)&p_arg + zoff_); __VA_ARGS__ } if ((REP_PH) == (k)) { GRID_SYNC(); { const int PROBE_SKIP = PROBE_NOSTORE; unsigned zoff_ = 0u; asm volatile("" : "+s"(zoff_)); unsigned char* ws = ws_ + zoff_; const Params& p = *(const Params*)((const char*)&p_arg + zoff_); __VA_ARGS__ } GRID_SYNC(); { const int PROBE_SKIP = PROBE_NOSTORE; unsigned zoff_ = 0u; asm volatile("" : "+s"(zoff_)); unsigned char* ws = ws_ + zoff_; const Params& p = *(const Params*)((const char*)&p_arg + zoff_); __VA_ARGS__ } } } SEAM(k); } while (0)
    PHASE(PH_PREP, p0_prep(p, lds, vcu, G););
    PHASE(PH_MOD, p1_modulate(p, vcu, G););
    PHASE(PH_INPROJ, {
        pg8::DenseSched S; S.init(ws + WS_U, ws + WS_W_IN, NTOK, NIN, 1024, G, bx);
        EpiInProj E{(bf16_t*)(ws + WS_PROJ), (bf16_t*)(ws + WS_G), (bf16_t*)(ws + WS_KIF)};
        pg8::gemm_phase<EpiInProj, pg8::DenseSched, false>(lds, 1024, S, E);
        if (G == 256 && bx >= 128) { __syncthreads(); run_transposes(p, ws, lds, T_NITEMS - T_LATE2 - T_LATE, T_NITEMS - T_LATE2, (bx - 128) * NWAVES + wave, 128 * NWAVES); } });
    PHASE(PH_MIX, {
#ifdef GOLD_S5
        for (int it = vcu + G * wave; it < 256; it += G * NWAVES) gold_s5(p, it, lane);
#else
#ifndef REP_S5
#define REP_S5 1
#endif
#ifndef REP_ATTN
#define REP_ATTN 1
#endif
        for (int r_ = 0; r_ < REP_S5; ++r_) for (int it = vcu; it < 256; it += G) s5_item(p, lds, it);
#endif
#ifdef GOLD_ATTN
        for (int pr = vcu; pr < NTOK / 2; pr += G) gold_attn_pair(p, lds, pr);
#else
        for (int r_ = 0; r_ < REP_ATTN; ++r_) {
            for (int k = 0; ; ++k) { int ab, aq;
                if (G == 256) { if (k >= 16) break; ab = vcu >> 5; aq = 511 - ((vcu & 31) + 32 * k); }
                else { const int it = vcu + k * G; if (it >= NTOK / 8) break; ab = it & 7; aq = 511 - (it >> 3); }
                attn_item(p, lds, ab, aq); } }
#endif
        __syncthreads(); });
    PHASE(PH_GLU, {
        pg8::DenseSched S; S.init(ws + WS_YG, ws + WS_W_GLU, NTOK, 512, 512, G, bx);
        EpiGlu E{(const bf16_t*)(ws + WS_YG), p.in[15], (bf16_t*)(ws + WS_U)};
        pg8::gemm_phase<EpiGlu, pg8::DenseSched, false>(lds, 512, S, E); });
    PHASE(PH_MIXAB, {
        MixSched S; S.D0.init(ws + WS_U, ws + WS_W_PS, NTOK, 1024, 512, G, bx); S.D1.init(ws + WS_YATTN, ws + WS_W_PA, NTOK, 1024, 512, G, bx);
        EpiMix E{(const bf16_t*)(ws + WS_G), (bf16_t*)(ws + WS_MERGED)};
        pg8::gemm_phase<EpiMix, MixSched, false, false, true>(lds, 512, S, E); });
    PHASE(PH_OUT, {
        pg8::DenseSched S; S.init(ws + WS_MERGED, ws + WS_W_OUT, NTOK, 1024, 1024, G, bx);
        EpiOut E{p.in[0], (const float*)(ws + WS_ADA), p.out, (float*)(ws + WS_SS)};
        pg8::gemm_phase<EpiOut, pg8::DenseSched, false>(lds, 1024, S, E); });
    PHASE(PH_ROUTE, { for (int tile = vcu; tile < NTOK / 128; tile += G) route_tile(p, lds, tile, PROBE_SKIP); });
    PHASE(PH_MOE1, {
        build_moe_tables(lds, (const unsigned*)(ws + WS_CTL) + CW_CNT);
        Moe1Sched S{lds, G, vcu, (const char*)(ws + WS_U), (const int*)(ws + WS_DSTL), (const int*)(ws + WS_IDENT), (const char*)(ws + WS_W_EGU), (const char*)(ws + WS_W_SGU)};
        EpiMoe1 E{(bf16_t*)(ws + WS_H)};
        pg8::gemm_phase<EpiMoe1, Moe1Sched, true>(lds, 1024, S, E);
        { LAS int* TB_ = (LAS int*)(lds + LDS_TB); const int total = (RFL(TB_[256]) + 128) * 2, rem = total % G, nidle = rem ? G - rem : 0;
          __syncthreads();
          if (nidle == 0) run_transposes(p, ws, lds, T_NITEMS - T_LATE2, T_NITEMS, vcu * NWAVES + wave, G * NWAVES);
          else if (vcu >= rem) run_transposes(p, ws, lds, T_NITEMS - T_LATE2, T_NITEMS, (vcu - rem) * NWAVES + wave, nidle * NWAVES); } });
#pragma unroll
    for (int ch = 0; ch < NCHUNK; ++ch) {
        PHASE(PH_MOE2_0 + 2 * ch, {
            build_moe_tables(lds, (const unsigned*)(ws + WS_CTL) + CW_CNT);
            Moe2Sched S{lds, G, vcu, ch, ws};
            EpiMoe2 E{(unsigned char*)(ws + WS_Y), PROBE_SKIP, lds};
            pg8::gemm_phase<EpiMoe2, Moe2Sched, false, true>(lds, 256, S, E); });
        PHASE(PH_COMB_0 + 2 * ch, { p_combine(p, vcu, G, ch); });
    }
#undef IN
}

extern "C" void kernel_launch(void* const* d_in, const int* in_sizes, int n_in, void* d_out, int out_size, void* d_ws, size_t ws_size, hipStream_t stream) {
    static int grid = 0;
    if (grid == 0) {
        if (n_in != 29 || out_size != NTOK * D || ws_size < WS_NEED) { fprintf(stderr, "kernel_launch: unexpected shapes n_in %d out %d ws %zu\n", n_in, out_size, ws_size); grid = -1; return; }
        int dev = 0, cus = 0, per_cu = 0;
        hipGetDevice(&dev); hipDeviceGetAttribute(&cus, hipDeviceAttributeMultiprocessorCount, dev);
        hipFuncSetAttribute((const void*)mega, hipFuncAttributeMaxDynamicSharedMemorySize, LDS_BYTES);
        hipOccupancyMaxActiveBlocksPerMultiprocessor(&per_cu, (const void*)mega, NTHR, LDS_BYTES);
        (void)hipGetLastError();
        grid = (per_cu >= 1) ? cus : -1;
        if (grid < 0) { fprintf(stderr, "kernel_launch: occupancy query says %d blocks/CU\n", per_cu); return; }
    }
    if (grid < 0) return;
    hipMemsetAsync((char*)d_ws + WS_CTL, 0, CTL_BYTES, stream);
    Params p{};
    for (int i = 0; i < 29; ++i) p.in[i] = (const float*)d_in[i];
    p.out = (float*)d_out; p.ws = (unsigned char*)d_ws;
    p.ph_lo = 0; p.ph_hi = PH_END;
    void* args[] = {&p};
    hipError_t e = hipLaunchCooperativeKernel((const void*)mega, dim3(grid), dim3(NTHR), args, LDS_BYTES, stream);
    if (e != hipSuccess) fprintf(stderr, "kernel_launch: cooperative launch failed: %s (grid %d)\n", hipGetErrorString(e), grid);
}
```

```cpp
#include <hip/hip_runtime.h>
#include <hip/hip_cooperative_groups.h>
#include <cstdio>
#include <cstdint>
#include <cmath>
namespace cg = cooperative_groups;

#define GAS __attribute__((address_space(1)))
#define LAS __attribute__((address_space(3)))
typedef unsigned short bf16_t;
typedef short bf16x8 __attribute__((ext_vector_type(8)));
typedef float f32x4 __attribute__((ext_vector_type(4)));
typedef float f32x2 __attribute__((ext_vector_type(2)));
typedef unsigned u32x4 __attribute__((ext_vector_type(4)));
typedef unsigned u32x2 __attribute__((ext_vector_type(2)));

constexpr int NB = 8, SEQ = 4096, NTOK = NB * SEQ, D = 1024;
constexpr int IN_W = 3784, NIN = 3840, PROJ_W = 1792, G_W = 2048;
constexpr int C_USSM = 0, C_Q = 512, C_K = 1024, C_V = 1088, C_QI = 1152, C_KI = 1664, C_WI = 1728, PROJ_USED = 1736;
constexpr int NE = 64, TOPK = 8, NCHUNK = 1, CHTOK = NTOK / NCHUNK, NPAIR = NCHUNK * NE, PAIRCAP = CHTOK, NSLOT = 9;
constexpr float Y_SCALE = 64.0f;
constexpr int HROWS_ROUTED = NTOK * TOPK, HSH_ROW0 = HROWS_ROUTED + 256;
constexpr float EPS = 1e-6f;
constexpr int NWAVES = 8, NTHR = 512;

constexpr size_t MiB = 1u << 20;
constexpr size_t WS_CTL = 0, CTL_BYTES = 1 * MiB;
constexpr size_t WS_ADA = 1 * MiB;
constexpr size_t WS_ONES = 1 * MiB + 224 * 1024;
constexpr size_t WS_A32 = 1 * MiB + 256 * 1024;
constexpr size_t WS_IDENT = 1 * MiB + 512 * 1024;
constexpr size_t WS_WRF = 1 * MiB + 768 * 1024;
constexpr size_t WS_W_IN = 2 * MiB;
constexpr size_t WS_W_GLU = 10 * MiB;
constexpr size_t WS_W_PS = 11 * MiB;
constexpr size_t WS_W_PA = 12 * MiB;
constexpr size_t WS_W_OUT = 13 * MiB;
constexpr size_t WS_W_SGU = 15 * MiB;
constexpr size_t WS_W_SD = 16 * MiB;
constexpr size_t WS_TZF = 17 * MiB, WS_WINF = 18 * MiB, WS_WOUTF = 22 * MiB;
constexpr size_t WS_W_ED = 26 * MiB;
constexpr size_t WS_W_EGU = 58 * MiB;
constexpr size_t WS_KIF = 122 * MiB;
constexpr size_t WS_U = 128 * MiB;
constexpr size_t WS_PROJ = 192 * MiB;
constexpr size_t WS_G = 304 * MiB;
constexpr size_t WS_YG = 432 * MiB;
constexpr size_t WS_YATTN = 464 * MiB;
constexpr size_t WS_MERGED = 192 * MiB;
constexpr size_t WS_Y = 58 * MiB;
constexpr size_t WS_H = 346 * MiB;
constexpr size_t WS_DSTL = 492 * MiB;
constexpr size_t WS_SS = 4 * MiB;
constexpr size_t WS_GATEL = 500 * MiB;
constexpr size_t WS_NEED = 512 * MiB;
constexpr int CW_CNT = 0;
constexpr int CW_BAR = 4096;
constexpr int CW_Q0 = 1024;

constexpr int STAGE_BYTES = 131072;
constexpr int LDS_RO = STAGE_BYTES;
constexpr int LDS_MISC = LDS_RO + 2048;
constexpr int LDS_CNT = LDS_MISC + 128;
constexpr int LDS_RS = LDS_CNT + 1024;
constexpr int LDS_TB = LDS_RS + 1040;
constexpr int LDS_TD = LDS_TB + 1040;
constexpr int LDS_META = LDS_TD + 1408 * 4;
constexpr int LDS_BYTES = 147456;
static_assert(LDS_META + 4096 <= LDS_BYTES, "LDS map");

__device__ __forceinline__ unsigned f2bf(float f) { unsigned u = __builtin_bit_cast(unsigned, f); return (u + 0x7fffu + ((u >> 16) & 1u)) >> 16; }
typedef __bf16 bf16x2_t __attribute__((ext_vector_type(2)));
__device__ __forceinline__ unsigned pk2(float lo, float hi) { const f32x2 v = {lo, hi}; const bf16x2_t r = __builtin_convertvector(v, bf16x2_t); return __builtin_bit_cast(unsigned, r); }
__device__ __forceinline__ float bf2f(unsigned short b) { return __builtin_bit_cast(float, (unsigned)b << 16); }
__device__ __forceinline__ float bflo(unsigned w) { return __builtin_bit_cast(float, w << 16); }
__device__ __forceinline__ float bfhi(unsigned w) { return __builtin_bit_cast(float, w & 0xffff0000u); }
__device__ __forceinline__ float sigmoidf_(float x) { return __builtin_amdgcn_rcpf(1.0f + __builtin_amdgcn_exp2f(-1.44269504089f * x)); }
__device__ __forceinline__ float wave_sum(float v) {
#pragma unroll
    for (int o = 1; o < 64; o <<= 1) v += __shfl_xor(v, o);
    return v;
}
__device__ __forceinline__ int tidx() { int t = threadIdx.x; asm volatile("" : "+v"(t)); return t; }
#define LDS_WAIT() asm volatile("s_waitcnt lgkmcnt(0)" ::: "memory")

namespace pg8 {
constexpr int BM = 256, BK = 64, HALF = 128, HTB = HALF * BK * 2, NXCD = 8, WGM = 8;
__host__ __device__ __forceinline__ int lds_byte(int r, int c) { const int st = (r >> 4) * 2 + (c >> 5), rr = r & 15, cc = c & 31, ob = rr * 64 + cc * 2; return st * 1024 + (ob ^ (((ob >> 9) & 1) << 5)); }
__host__ __device__ __forceinline__ void stage_rc(int b, int& R, int& C) { const int st = b / 1024, sb = b % 1024, swz = sb ^ (((sb >> 9) & 1) << 5); R = (st >> 1) * 16 + swz / 64; C = (st & 1) * 32 + (swz % 64) / 2; }
__host__ __device__ __forceinline__ int perm32(int rho) { const int n = rho >> 4, i = rho & 15; return 8 * (i >> 2) + 4 * n + (i & 3); }

struct Unit { int pm, pn; const char* A; const char* B; const int* rows; int valid; int x0; int rbase; const float* gp; };

struct DenseSched {
    int nM, nN, nwg, G, c; const char* A; const char* B; size_t tstep;
    __device__ __forceinline__ void init(const void* A_, const void* B_, int M, int N, int K, int G_, int c_) { nM = M / BM; nN = N / BM; nwg = nM * nN; G = G_; c = c_; A = (const char*)A_; B = (const char*)B_; tstep = (size_t)BM * K * 2; }
    __device__ __forceinline__ bool next(int i, Unit& u) const {
        const long L = (long)i * G + c; if (L >= nwg) return false;
        int wgid = (int)L; { const int q = nwg / NXCD, r = nwg % NXCD, xcd = wgid % NXCD, off = wgid / NXCD; wgid = (xcd < r ? xcd * (q + 1) : r * (q + 1) + (xcd - r) * q) + off; }
        const int nig = WGM * nN, gid = wgid / nig, fm = gid * WGM, gsz = (nM - fm) < WGM ? (nM - fm) : WGM;
        u.pm = fm + ((wgid % nig) % gsz); u.pn = (wgid % nig) / gsz;
        u.A = A + (size_t)u.pm * tstep; u.B = B + (size_t)u.pn * tstep; u.rows = nullptr; u.valid = 256; u.x0 = 0; u.rbase = 0; u.gp = nullptr; return true;
    }
};

template <class Epi, class Sched, bool GATHER, bool RMETA = false, bool KEEPACC = false>
__device__ __forceinline__ void gemm_phase(LAS unsigned char* lds, const int K, const Sched& S, const Epi& E) {
    int tid_ = tidx(); asm volatile("" : "+v"(tid_));
    const int tid = tid_, wid = __builtin_amdgcn_readfirstlane(tid >> 6), lane = tid & 63, wr = wid >> 2, wc = wid & 3, fr = lane & 15, fq = lane >> 4;
    const int nt = K / BK;
    unsigned voffA[2], voffB[2]; int roA[2];
#pragma unroll
    for (int i = 0; i < 2; ++i) { int R, C; stage_rc(tid * 16 + i * 8192, R, C); const int Rb = (R & ~31) + perm32(R & 31);
        voffA[i] = GATHER ? (unsigned)(C * 2) : (unsigned)(R * K + C) * 2u; voffB[i] = (unsigned)(Rb * K + C) * 2u; roA[i] = R * 4; }
    const size_t kstep = (size_t)(BK * 2);
    const size_t hstep = (size_t)HALF * K * 2;
    const unsigned ldsw = (unsigned)wid * 1024u;
    const int aoff = lds_byte(wr * 64 + fr, fq * 8), boff = lds_byte(wc * 32 + fr, fq * 8);
    LAS unsigned char* ro = lds + LDS_RO;
#define PG8_SA(b, h) (((b) * 2 + (h)) * HTB)
#define PG8_SB(b, h) ((4 + (b) * 2 + (h)) * HTB)
#define PG8_STAGE_B(bufoff, gbase) do { _Pragma("unroll") for (int _i = 0; _i < 2; ++_i) \
        __builtin_amdgcn_global_load_lds((const unsigned*)((const char*)(gbase) + voffB[_i]), (LAS unsigned*)(lds + (bufoff) + ldsw + _i * 8192), 16, 0, 0); } while (0)
#define PG8_STAGE_A(bufoff, gbase, h, slot) do { _Pragma("unroll") for (int _i = 0; _i < 2; ++_i) { \
        unsigned _vo = voffA[_i]; const char* _gb = (const char*)(gbase); \
        if (GATHER) _vo += *(const LAS unsigned*)(ro + (slot) * 1024 + (h) * 512 + roA[_i]); else _gb += (h) * hstep; \
        __builtin_amdgcn_global_load_lds((const unsigned*)(_gb + _vo), (LAS unsigned*)(lds + (bufoff) + ldsw + _i * 8192), 16, 0, 0); } } while (0)
#define PG8_LDA(dst, b, h) do { _Pragma("unroll") for (int m = 0; m < 4; ++m) _Pragma("unroll") for (int k = 0; k < 2; ++k) dst[m][k] = *(const LAS bf16x8*)(lds + PG8_SA(b, h) + aoff + m * 2048 + k * 1024); } while (0)
#define PG8_LDB(dst, b, h) do { _Pragma("unroll") for (int n = 0; n < 2; ++n) _Pragma("unroll") for (int k = 0; k < 2; ++k) dst[n][k] = *(const LAS bf16x8*)(lds + PG8_SB(b, h) + boff + n * 2048 + k * 1024); } while (0)
#define PG8_MMA(ai, bj, At, Bt) do { __builtin_amdgcn_s_setprio(1); _Pragma("unroll") for (int m = 0; m < 4; ++m) _Pragma("unroll") for (int n = 0; n < 2; ++n) _Pragma("unroll") for (int k = 0; k < 2; ++k) \
        acc[ai][bj][m][n] = __builtin_amdgcn_mfma_f32_16x16x32_bf16(Bt[n][k], At[m][k], acc[ai][bj][m][n], 0, 0, 0); __builtin_amdgcn_s_setprio(0); } while (0)
#define PG8_WAIT_V(n) asm volatile("s_waitcnt vmcnt(" #n ")" ::: "memory")
#define PG8_WAIT_L(n) asm volatile("s_waitcnt lgkmcnt(" #n ")" ::: "memory")
#define PG8_BAR __builtin_amdgcn_s_barrier()
#define PG8_SCHED __builtin_amdgcn_sched_barrier(0)
    Unit cur, nxt; int ui = 0;
    if (!S.next(0, cur)) return;
    f32x4 acc[2][2][4][2];
#pragma unroll
    for (int a = 0; a < 2; ++a)
#pragma unroll
        for (int b = 0; b < 2; ++b)
#pragma unroll
            for (int m = 0; m < 4; ++m)
#pragma unroll
                for (int n = 0; n < 2; ++n) acc[a][b][m][n] = (f32x4){0.f, 0.f, 0.f, 0.f};
    bf16x8 At[4][2], B0[2][2], B1[2][2];
    const char* cA = cur.A; const char* cB = cur.B;
    if (GATHER) {
        if (tid < 256) { const int r = tid < cur.valid ? cur.rbase + cur.rows[tid] / NSLOT : 0; *(LAS unsigned*)(ro + tid * 4) = (unsigned)r * (unsigned)(K * 2); }
        __syncthreads();
    }
    PG8_STAGE_B(PG8_SB(0, 0), cB); PG8_STAGE_B(PG8_SB(0, 1), cB + hstep); PG8_STAGE_A(PG8_SA(0, 0), cA, 0, 0); PG8_STAGE_A(PG8_SA(0, 1), cA, 1, 0);
    if (wr == 1) PG8_BAR;
    PG8_WAIT_V(2); PG8_BAR;
    PG8_STAGE_B(PG8_SB(1, 0), cB + kstep); PG8_STAGE_A(PG8_SA(1, 0), cA + kstep, 0, 0); PG8_STAGE_B(PG8_SB(1, 1), cB + hstep + kstep);
    PG8_WAIT_V(6); PG8_BAR;
    for (;;) {
        const bool has_next = S.next(ui + 1, nxt);
        const int cslot = ui & 1, nslot = has_next ? (cslot ^ 1) : cslot;
        int pre_r = 0;
        if (GATHER) { if (has_next && tid < 256 && tid < nxt.valid) pre_r = nxt.rows[tid]; }
        if (RMETA) { if (wid < 4) {
            __builtin_amdgcn_global_load_lds((const unsigned*)(cur.gp + lane + wid * 64), (LAS unsigned*)(lds + LDS_META + cslot * 1024 + wid * 256), 4, 0, 0);
            __builtin_amdgcn_global_load_lds((const unsigned*)(cur.rows + lane + wid * 64), (LAS unsigned*)(lds + LDS_META + 2048 + cslot * 1024 + wid * 256), 4, 0, 0); } }
        const char* nA = has_next ? nxt.A : cA; const char* nB = has_next ? nxt.B : cB;
#pragma unroll 1
        for (int t = 0; t < nt; t += 2) {
            const bool last = (t == nt - 2);
            const char* a1 = cA + (size_t)(t + 1) * kstep;
            const char* a2 = last ? nA : cA + (size_t)(t + 2) * kstep; const char* b2 = last ? nB : cB + (size_t)(t + 2) * kstep;
            const char* a3 = a2 + kstep; const char* b3 = b2 + kstep;
            const int slot2 = last ? nslot : cslot;
            if (t == 2 || nt == 2) {
                if (GATHER) { if (has_next && tid < 256) { const int r = tid < nxt.valid ? nxt.rbase + pre_r / NSLOT : 0; *(LAS unsigned*)(ro + nslot * 1024 + tid * 4) = (unsigned)r * (unsigned)(K * 2); } }
            }
            PG8_LDB(B0, 0, 0); PG8_LDB(B1, 0, 1); PG8_SCHED; PG8_LDA(At, 0, 0); PG8_STAGE_A(PG8_SA(1, 1), a1, 1, cslot);
            PG8_WAIT_V(8); PG8_WAIT_L(0); PG8_BAR; PG8_MMA(0, 0, At, B0); PG8_MMA(0, 1, At, B1); PG8_BAR; PG8_SCHED;
            PG8_LDA(At, 0, 1); PG8_STAGE_B(PG8_SB(0, 0), b2); PG8_STAGE_B(PG8_SB(0, 1), b2 + hstep); PG8_STAGE_A(PG8_SA(0, 0), a2, 0, slot2);
            PG8_WAIT_V(8); PG8_WAIT_L(0); PG8_BAR; PG8_MMA(1, 0, At, B0); PG8_MMA(1, 1, At, B1); PG8_BAR; PG8_SCHED;
            PG8_LDB(B0, 1, 0); PG8_LDB(B1, 1, 1); PG8_SCHED; PG8_LDA(At, 1, 0); PG8_STAGE_A(PG8_SA(0, 1), a2, 1, slot2);
            PG8_WAIT_V(8); PG8_WAIT_L(0); PG8_BAR; PG8_MMA(0, 0, At, B0); PG8_MMA(0, 1, At, B1); PG8_BAR; PG8_SCHED;
            PG8_LDA(At, 1, 1); PG8_STAGE_B(PG8_SB(1, 0), b3); PG8_STAGE_B(PG8_SB(1, 1), b3 + hstep); PG8_STAGE_A(PG8_SA(1, 0), a3, 0, slot2);
            PG8_WAIT_V(8); PG8_WAIT_L(0); PG8_BAR; PG8_MMA(1, 0, At, B0); PG8_MMA(1, 1, At, B1); PG8_BAR; PG8_SCHED;
        }
        if (wr == 0) PG8_BAR;
        E(acc, cur, wr, wc, fr, fq, lds + LDS_META + (ui & 1) * 1024);
        if (!has_next) break;
        if (!KEEPACC || nxt.x0 == 0) {
#pragma unroll
        for (int a = 0; a < 2; ++a)
#pragma unroll
            for (int b = 0; b < 2; ++b)
#pragma unroll
                for (int m = 0; m < 4; ++m)
#pragma unroll
                    for (int n = 0; n < 2; ++n) acc[a][b][m][n] = (f32x4){0.f, 0.f, 0.f, 0.f};
        }
        cur = nxt; cA = nA; cB = nB; ++ui;
        if (wr == 1) PG8_BAR;
    }
    PG8_WAIT_V(0);
    PG8_BAR;
#undef PG8_SA
#undef PG8_SB
#undef PG8_STAGE_A
#undef PG8_STAGE_B
#undef PG8_LDA
#undef PG8_LDB
#undef PG8_MMA
#undef PG8_WAIT_V
#undef PG8_WAIT_L
#undef PG8_BAR
#undef PG8_SCHED
}
}
using pg8::Unit;

#define EPI_LOOP_BEGIN \
    _Pragma("unroll") for (int ai = 0; ai < 2; ++ai) _Pragma("unroll") for (int m = 0; m < 4; ++m) { const int rl = ai * 128 + wr * 64 + m * 16 + fr; const int row = u.pm * 256 + rl; \
    _Pragma("unroll") for (int bj = 0; bj < 2; ++bj) { const int col = u.pn * 256 + bj * 128 + wc * 32 + 8 * fq; const f32x4 v0 = acc[ai][bj][m][0], v1 = acc[ai][bj][m][1]; (void)row; (void)col; (void)rl;
#define EPI_LOOP_END } if (m == 3) asm volatile("" ::: "memory"); }
__device__ __forceinline__ u32x4 pack8(const f32x4 a, const f32x4 b) { u32x4 w; w.x = pk2(a[0], a[1]); w.y = pk2(a[2], a[3]); w.z = pk2(b[0], b[1]); w.w = pk2(b[2], b[3]); return w; }
__device__ __forceinline__ void unpack8(const u32x4 w, float (&f)[8]) { f[0] = bflo(w.x); f[1] = bfhi(w.x); f[2] = bflo(w.y); f[3] = bfhi(w.y); f[4] = bflo(w.z); f[5] = bfhi(w.z); f[6] = bflo(w.w); f[7] = bfhi(w.w); }

struct EpiInProj {
    bf16_t* PROJ; bf16_t* G; bf16_t* KIF;
    __device__ __forceinline__ void operator()(const f32x4 (&acc)[2][2][4][2], const Unit& u, int wr, int wc, int fr, int fq, LAS unsigned char* meta) const {
        if (u.pn < 7) {
        EPI_LOOP_BEGIN
            { const u32x4 w8 = pack8(v0, v1); *(u32x4*)(PROJ + (size_t)row * PROJ_W + col) = w8;
                if (u.pn == 6 && col >= C_KI && col < C_KI + 64) { const int d0 = col - C_KI, key = row & 4095, bb = row >> 12;
                    *(u32x4*)(KIF + ((size_t)((bb * 128 + (key >> 5)) * 4 + (d0 >> 4)) * 64 + (key & 31) + 32 * ((d0 >> 3) & 1)) * 8) = w8; } }
        EPI_LOOP_END
        } else {
            const int ch0 = (u.pn - 7) * 128 + wc * 32 + 8 * fq;
#pragma unroll
            for (int ai = 0; ai < 2; ++ai)
#pragma unroll
                for (int m = 0; m < 4; ++m) { const int row = u.pm * 256 + ai * 128 + wr * 64 + m * 16 + fr;
                    f32x4 s2a, s2b;
#pragma unroll
                    for (int j = 0; j < 4; ++j) { s2a[j] = fmaxf(sigmoidf_(acc[ai][1][m][0][j]), 1e-6f); s2b[j] = fmaxf(sigmoidf_(acc[ai][1][m][1][j]), 1e-6f); }
                    const u32x4 w2 = pack8(s2a, s2b); float s2r[8]; unpack8(w2, s2r); f32x4 r0, r1;
#pragma unroll
                    for (int j = 0; j < 4; ++j) { r0[j] = sigmoidf_(acc[ai][0][m][0][j]) * __builtin_amdgcn_rcpf(s2r[j]); r1[j] = sigmoidf_(acc[ai][0][m][1][j]) * __builtin_amdgcn_rcpf(s2r[4 + j]); }
                    *(u32x4*)(G + (size_t)row * G_W + ch0) = pack8(r0, r1); *(u32x4*)(G + (size_t)row * G_W + 1024 + ch0) = w2;
                    asm volatile("" ::: "memory"); __builtin_amdgcn_sched_barrier(0); }
        }
    }
};
struct EpiGlu {
    const bf16_t* YG; const float* bias; bf16_t* O;
    __device__ __forceinline__ void operator()(const f32x4 (&acc)[2][2][4][2], const Unit& u, int wr, int wc, int fr, int fq, LAS unsigned char* meta) const {
        f32x4 bb[2][2];
#pragma unroll
        for (int bj = 0; bj < 2; ++bj) { const int col = u.pn * 256 + bj * 128 + wc * 32 + 8 * fq; bb[bj][0] = *(const f32x4*)(bias + col); bb[bj][1] = *(const f32x4*)(bias + col + 4); }
        EPI_LOOP_BEGIN
            float y[8]; unpack8(*(const u32x4*)(YG + (size_t)row * 512 + col), y);
            const f32x4 b0 = bb[bj][0], b1 = bb[bj][1]; f32x4 o0, o1;
#pragma unroll
            for (int j = 0; j < 4; ++j) { o0[j] = y[j] * sigmoidf_(v0[j] + b0[j]); o1[j] = y[4 + j] * sigmoidf_(v1[j] + b1[j]); }
            *(u32x4*)(O + (size_t)row * 512 + col) = pack8(o0, o1);
        EPI_LOOP_END
    }
};
struct EpiMix {
    const bf16_t* G; bf16_t* O;
    __device__ __forceinline__ void operator()(f32x4 (&acc)[2][2][4][2], const Unit& u, int wr, int wc, int fr, int fq, LAS unsigned char* meta) const {
        unsigned rowl = (unsigned)(wr * 64 + fr); asm volatile("" : "+v"(rowl));
        const size_t gbase = (size_t)(u.pm * 256 + rowl) * G_W + u.pn * 256 + wc * 32 + 8 * fq + (u.x0 ? 1024 : 0);
#define EPM_LOADS u32x4 q[2][4][2]; _Pragma("unroll") for (int ai = 0; ai < 2; ++ai) _Pragma("unroll") for (int m = 0; m < 4; ++m) _Pragma("unroll") for (int bj = 0; bj < 2; ++bj) q[ai][m][bj] = *(const u32x4*)(G + gbase + (size_t)(ai * 128 + m * 16) * G_W + bj * 128)
        if (u.x0 == 0) { EPM_LOADS;
#pragma unroll
            for (int ai = 0; ai < 2; ++ai)
#pragma unroll
                for (int m = 0; m < 4; ++m)
#pragma unroll
                    for (int bj = 0; bj < 2; ++bj) { float g[8]; unpack8(q[ai][m][bj], g);
#pragma unroll
                        for (int j = 0; j < 4; ++j) { acc[ai][bj][m][0][j] *= g[j]; acc[ai][bj][m][1][j] *= g[4 + j]; } }
        } else { asm volatile("" : "+v"(rowl)); const size_t gbase = (size_t)(u.pm * 256 + rowl) * G_W + u.pn * 256 + wc * 32 + 8 * fq + 1024; EPM_LOADS;
#pragma unroll
            for (int ai = 0; ai < 2; ++ai)
#pragma unroll
                for (int m = 0; m < 4; ++m)
#pragma unroll
                    for (int bj = 0; bj < 2; ++bj) { float g2[8]; unpack8(q[ai][m][bj], g2); f32x4 o0, o1;
#pragma unroll
                        for (int j = 0; j < 4; ++j) { o0[j] = acc[ai][bj][m][0][j] * g2[j]; o1[j] = acc[ai][bj][m][1][j] * g2[4 + j]; }
                        *(u32x4*)(O + (size_t)(u.pm * 256 + ai * 128 + wr * 64 + m * 16 + fr) * D + u.pn * 256 + bj * 128 + wc * 32 + 8 * fq) = pack8(o0, o1); }
        }
#undef EPM_LOADS
    }
};
struct MixSched {
    pg8::DenseSched D0, D1;
    __device__ __forceinline__ bool next(int i, Unit& u) const { const bool ok = (i & 1) ? D1.next(i >> 1, u) : D0.next(i >> 1, u); u.x0 = i & 1; return ok; }
};
struct EpiOut {
    const float* X; const float* ada; float* O; float* SS;
    __device__ __forceinline__ void operator()(const f32x4 (&acc)[2][2][4][2], const Unit& u, int wr, int wc, int fr, int fq, LAS unsigned char* meta) const {
        f32x4 gg[2][2];
#pragma unroll
        for (int bj = 0; bj < 2; ++bj) { const float* gp = ada + (size_t)((u.pm * 256) >> 12) * 6144 + 2048 + u.pn * 256 + bj * 128 + wc * 32 + 8 * fq; gg[bj][0] = *(const f32x4*)gp; gg[bj][1] = *(const f32x4*)(gp + 4); }
        const size_t base = (size_t)(u.pm * 256 + wr * 64 + fr) * D + u.pn * 256 + wc * 32 + 8 * fq;
        f32x4 xq[3][2][2];
#define EPO_LOAD(slot, rg) do { const size_t o_ = base + (size_t)(((rg) >> 2) * 128 + ((rg) & 3) * 16) * D; _Pragma("unroll") for (int bj = 0; bj < 2; ++bj) { xq[slot][bj][0] = *(const f32x4*)(X + o_ + bj * 128); xq[slot][bj][1] = *(const f32x4*)(X + o_ + bj * 128 + 4); } } while (0)
        EPO_LOAD(0, 0); EPO_LOAD(1, 1);
#pragma unroll
        for (int rg = 0; rg < 8; ++rg) { const int ai = rg >> 2, m = rg & 3;
            if (rg + 2 < 8) EPO_LOAD((rg + 2) % 3, rg + 2);
            const size_t o_ = base + (size_t)(ai * 128 + m * 16) * D; float ss = 0.f;
#pragma unroll
            for (int bj = 0; bj < 2; ++bj) { const f32x4 o0 = xq[rg % 3][bj][0] + gg[bj][0] * acc[ai][bj][m][0], o1 = xq[rg % 3][bj][1] + gg[bj][1] * acc[ai][bj][m][1];
                *(u32x4*)((bf16_t*)O + 2 * (o_ - (size_t)(u.pn * 256 + wc * 32 + 8 * fq)) + (u.pn * 256 + wc * 32 + 8 * fq) + bj * 128) = pack8(o0, o1);
                ss += (o0.x * o0.x + o0.y * o0.y) + (o0.z * o0.z + o0.w * o0.w) + (o1.x * o1.x + o1.y * o1.y) + (o1.z * o1.z + o1.w * o1.w); }
            ss += __shfl_xor(ss, 16); ss += __shfl_xor(ss, 32);
            if (fq == 0) SS[(size_t)(u.pm * 256 + ai * 128 + wr * 64 + m * 16 + fr) * 16 + u.pn * 4 + wc] = ss;
            asm volatile("" ::: "memory"); }
#undef EPO_LOAD
    }
};
struct EpiMoe1 {
    bf16_t* H;
    __device__ __forceinline__ void operator()(const f32x4 (&acc)[2][2][4][2], const Unit& u, int wr, int wc, int fr, int fq, LAS unsigned char* meta) const {
#pragma unroll
        for (int ai = 0; ai < 2; ++ai)
#pragma unroll
            for (int m = 0; m < 4; ++m) { const int rl = ai * 128 + wr * 64 + m * 16 + fr;
                if (rl < u.valid) { f32x4 o0, o1;
#pragma unroll
                    for (int j = 0; j < 4; ++j) { const float g0 = acc[ai][0][m][0][j], g1 = acc[ai][1][m][0][j]; o0[j] = g0 * sigmoidf_(g0) * acc[ai][0][m][1][j]; o1[j] = g1 * sigmoidf_(g1) * acc[ai][1][m][1][j]; }
                    *(u32x4*)(H + (size_t)(u.x0 + rl) * 256 + u.pn * 128 + wc * 32 + 8 * fq) = pack8(o0, o1); } }
    }
};
__device__ __forceinline__ void epi_stage_write(LAS unsigned char* sc, int fr, int fq, const u32x4 w0, const u32x4 w1) {
    LAS unsigned char* rowp = sc + (fr >> 3) * 8192 + (fr & 7) * 128; const int x = fr & 7;
    *(LAS u32x4*)(rowp + ((fq ^ x) * 16)) = w0; *(LAS u32x4*)(rowp + (((4 + fq) ^ x) * 16)) = w1;
}
__device__ __forceinline__ u32x4 epi_stage_read(const LAS unsigned char* sc, int q, int lane) {
    const int r = lane >> 3, c = lane & 7; return *(const LAS u32x4*)(sc + q * 8192 + r * 128 + ((c ^ r) * 16));
}
__device__ __forceinline__ unsigned pk4_fp8(float a, float b, float c, float d) {
    a = __builtin_amdgcn_fmed3f(a, -448.f, 448.f); b = __builtin_amdgcn_fmed3f(b, -448.f, 448.f); c = __builtin_amdgcn_fmed3f(c, -448.f, 448.f); d = __builtin_amdgcn_fmed3f(d, -448.f, 448.f);
    int w = 0; w = __builtin_amdgcn_cvt_pk_fp8_f32(a, b, w, false); w = __builtin_amdgcn_cvt_pk_fp8_f32(c, d, w, true); return (unsigned)w;
}
struct EpiMoe2 {
    unsigned char* Y; int skip; LAS unsigned char* lds0;
    __device__ __forceinline__ void operator()(const f32x4 (&acc)[2][2][4][2], const Unit& u, int wr, int wc, int fr, int fq, LAS unsigned char* meta) const {
        asm volatile("" : "+v"(fr), "+v"(fq));
        const int lane = fr + 16 * fq;
        LAS unsigned char* sc0 = lds0 + 3 * pg8::HTB + (wr * 4 + wc) * 1024;
#pragma unroll
        for (int ai = 0; ai < 2; ++ai)
#pragma unroll
            for (int m = 0; m < 4; ++m) { const int rl0 = ai * 128 + wr * 64 + m * 16; LAS unsigned char* sc = sc0 + (m & 1) * 8192;
                const float g = *(const LAS float*)(meta + (rl0 + fr) * 4) * Y_SCALE;
                u32x2 w0, w1;
                w0.x = pk4_fp8(acc[ai][0][m][0][0] * g, acc[ai][0][m][0][1] * g, acc[ai][0][m][0][2] * g, acc[ai][0][m][0][3] * g); w0.y = pk4_fp8(acc[ai][0][m][1][0] * g, acc[ai][0][m][1][1] * g, acc[ai][0][m][1][2] * g, acc[ai][0][m][1][3] * g);
                w1.x = pk4_fp8(acc[ai][1][m][0][0] * g, acc[ai][1][m][0][1] * g, acc[ai][1][m][0][2] * g, acc[ai][1][m][0][3] * g); w1.y = pk4_fp8(acc[ai][1][m][1][0] * g, acc[ai][1][m][1][1] * g, acc[ai][1][m][1][2] * g, acc[ai][1][m][1][3] * g);
                *(LAS u32x2*)(sc + fr * 64 + fq * 8) = w0; *(LAS u32x2*)(sc + fr * 64 + 32 + fq * 8) = w1;
                { const int r = lane >> 2, c = lane & 3, rl = rl0 + r; const u32x4 v = *(const LAS u32x4*)(sc + r * 64 + c * 16);
                  if (rl < u.valid && !skip) { const int dst = *(const LAS int*)(meta + 2048 + rl * 4); *(u32x4*)(Y + (size_t)dst * D + u.pn * 256 + wc * 64 + c * 16) = v; } } }
    }
};

__device__ __forceinline__ void build_moe_tables(LAS unsigned char* lds, const unsigned* cnt_g) {
    LAS int* CNT = (LAS int*)(lds + LDS_CNT); LAS int* RS = (LAS int*)(lds + LDS_RS); LAS int* TB = (LAS int*)(lds + LDS_TB); LAS unsigned* TD = (LAS unsigned*)(lds + LDS_TD);
    const int tid = tidx();
    __syncthreads();
    if (tid < 256) { int c = tid < NPAIR ? (int)cnt_g[tid] : 0; c = c < 0 ? 0 : (c > PAIRCAP ? PAIRCAP : c); CNT[tid] = c; }
    __syncthreads();
    if (tid < 64) {
        int c[4], rs = 0, tb = 0;
#pragma unroll
        for (int i = 0; i < 4; ++i) { c[i] = CNT[4 * tid + i]; rs += c[i]; tb += (c[i] + 255) >> 8; }
        int srs = rs, stb = tb;
#pragma unroll
        for (int o = 1; o < 64; o <<= 1) { const int a = __shfl_up(srs, o), e = __shfl_up(stb, o); if (tid >= o) { srs += a; stb += e; } }
        int ers = srs - rs, etb = stb - tb;
#pragma unroll
        for (int i = 0; i < 4; ++i) { RS[4 * tid + i] = ers; TB[4 * tid + i] = etb; ers += c[i]; etb += (c[i] + 255) >> 8; }
        if (tid == 63) { RS[256] = srs; TB[256] = stb; }
    }
    __syncthreads();
    if (tid < 256) { const int c = CNT[tid], nt = (c + 255) >> 8, tb = TB[tid]; for (int k = 0; k < nt; ++k) TD[tb + k] = (unsigned)tid | ((unsigned)k << 9); }
    __syncthreads();
}
#define RFL(x) __builtin_amdgcn_readfirstlane(x)
struct Moe1Sched {
    LAS unsigned char* lds; int G, c; const char* U2; const int* dstl; const int* ident; const char* Wegu; const char* Wsgu;
    __device__ __forceinline__ bool next(int i, Unit& u) const {
        LAS int* CNT = (LAS int*)(lds + LDS_CNT); LAS int* RS = (LAS int*)(lds + LDS_RS); LAS int* TB = (LAS int*)(lds + LDS_TB); LAS unsigned* TD = (LAS unsigned*)(lds + LDS_TD);
        const int ntr = RFL(TB[256]); const int L = i * G + c; if (L >= (ntr + 128) * 2) return false;
        const int tau = L >> 1; u.pn = L & 1; u.pm = 0; u.A = U2; u.gp = nullptr;
        if (tau < ntr) { const unsigned d = (unsigned)RFL((int)TD[tau]); const int j = d & 511, k = d >> 9; u.valid = min(256, RFL(CNT[j]) - k * 256); u.rows = dstl + (size_t)(j * PAIRCAP + k * 256); u.x0 = RFL(RS[j]) + k * 256; u.rbase = (j >> 6) * CHTOK;
            u.B = Wegu + (size_t)(j & 63) * (512 * 1024 * 2) + (size_t)u.pn * (256 * 1024 * 2); }
        else { const int k = tau - ntr; u.valid = 256; u.rows = ident + k * 256; u.x0 = HSH_ROW0 + k * 256; u.rbase = (k / (CHTOK / 256)) * CHTOK; u.B = Wsgu + (size_t)u.pn * (256 * 1024 * 2); }
        return true;
    }
};
struct Moe2Sched {
    LAS unsigned char* lds; int G, c, ch; const unsigned char* ws;
    __device__ __forceinline__ bool next(int i, Unit& u) const {
        LAS int* CNT = (LAS int*)(lds + LDS_CNT); LAS int* RS = (LAS int*)(lds + LDS_RS); LAS int* TB = (LAS int*)(lds + LDS_TB); LAS unsigned* TD = (LAS unsigned*)(lds + LDS_TD);
        constexpr int NSH = CHTOK / 256;
        const int t0 = RFL(TB[64 * ch]), ntr = RFL(TB[64 * ch + 64]) - t0; const int L = i * G + c; if (L >= (ntr + NSH) * 4) return false;
        const int tau = L >> 2; u.pn = L & 3; u.pm = 0; u.rbase = 0; u.x0 = 0;
        if (tau < ntr) { const unsigned d = (unsigned)RFL((int)TD[t0 + tau]); const int j = d & 511, k = d >> 9; u.valid = min(256, RFL(CNT[j]) - k * 256);
            u.A = (const char*)(ws + WS_H) + (size_t)(RFL(RS[j]) + k * 256) * 512; u.rows = (const int*)(ws + WS_DSTL) + (size_t)(j * PAIRCAP + k * 256); u.gp = (const float*)(ws + WS_GATEL) + (size_t)(j * PAIRCAP + k * 256);
            u.B = (const char*)(ws + WS_W_ED) + (size_t)(j & 63) * (1024 * 256 * 2) + (size_t)u.pn * (256 * 256 * 2); }
        else { const int k = NSH * ch + (tau - ntr); u.valid = 256; u.A = (const char*)(ws + WS_H) + (size_t)(HSH_ROW0 + k * 256) * 512; u.rows = (const int*)(ws + WS_IDENT) + k * 256; u.gp = (const float*)(ws + WS_ONES); u.B = (const char*)(ws + WS_W_SD) + (size_t)u.pn * (256 * 256 * 2); }
        return true;
    }
};

struct Params { const float* in[29]; float* out; unsigned char* ws; int ph_lo, ph_hi; };

__device__ __forceinline__ void s5_tables_item(const Params& p, LAS unsigned char* lds, int item) {
    const int g = item >> 3, part = item & 7, tid = tidx();
    LAS float* AP = (LAS float*)lds;
    LAS float* BB = AP + 64 * 33 * 2;
    LAS float* CC = BB + 64 * 16 * 2;
    const float dt = expf(p.in[8][g]);
    __syncthreads();
    for (int i = tid; i < 64 * 33; i += NTHR) { const int pp = i / 33, tau = i - pp * 33; const float lr = p.in[6][g * 64 + pp], li = p.in[7][g * 64 + pp];
        const float mag = expf(lr * dt * (float)tau), th = li * dt * (float)tau; AP[i * 2] = mag * cosf(th); AP[i * 2 + 1] = mag * sinf(th); }
    for (int i = tid; i < 64 * 16; i += NTHR) { const int pp = i >> 4; const float lr = p.in[6][g * 64 + pp], li = p.in[7][g * 64 + pp];
        const float mag = expf(lr * dt); const float a_re = mag * cosf(li * dt), a_im = mag * sinf(li * dt);
        const float den = lr * lr + li * li, n_re = a_re - 1.0f; const float f_re = (n_re * lr + a_im * li) / den, f_im = (a_im * lr - n_re * li) / den;
        const float br = p.in[9][(size_t)(g * 64) * 16 + i], bi = p.in[10][(size_t)(g * 64) * 16 + i];
        BB[i * 2] = f_re * br - f_im * bi; BB[i * 2 + 1] = f_re * bi + f_im * br; }
    for (int i = tid; i < 16 * 64; i += NTHR) { CC[i * 2] = p.in[11][(size_t)g * 1024 + i]; CC[i * 2 + 1] = p.in[12][(size_t)g * 1024 + i]; }
    __syncthreads();
    if (part == 0 && tid < 64) { float* a32 = (float*)(p.ws + WS_A32); a32[(g * 64 + tid) * 2] = AP[(tid * 33 + 32) * 2]; a32[(g * 64 + tid) * 2 + 1] = AP[(tid * 33 + 32) * 2 + 1]; }
    {
        const int jh = tid >> 8, t2 = tid & 255;
        const int fr = t2 >> 6, l = t2 & 63, delta = part * 4 + fr, ho = l & 15, q = l >> 4, tau = delta - (q >> 1); float v[4];
#pragma unroll 1
        for (int jj = 0; jj < 4; ++jj) { const int j = jh * 4 + jj; const int hi = (q & 1) * 8 + j; float acc = 0.f;
            if (tau >= 0) { for (int pp = 0; pp < 64; ++pp) { const float ar = AP[(pp * 33 + tau) * 2], ai = AP[(pp * 33 + tau) * 2 + 1], br = BB[(pp * 16 + hi) * 2], bi = BB[(pp * 16 + hi) * 2 + 1], cr = CC[(ho * 64 + pp) * 2], ci = CC[(ho * 64 + pp) * 2 + 1];
                    acc += cr * (ar * br - ai * bi) - ci * (ar * bi + ai * br); }
                if (tau == 0 && ho == hi) acc += p.in[13][g * 16 + ho]; }
            v[jj] = acc; }
        u32x2 o; o.x = pk2(v[0], v[1]); o.y = pk2(v[2], v[3]);
        *(u32x2*)((bf16_t*)(p.ws + WS_TZF) + ((size_t)(g * 32 + delta) * 64 + l) * 8 + jh * 4) = o;
    }
    for (int u = tid; u < 1024; u += NTHR) {
        const int ks = u >> 6, l = u & 63, n = part * 16 + (l & 15), q = l >> 4, ri = n >> 6, pp = n & 63; float v[8];
#pragma unroll
        for (int j = 0; j < 8; ++j) { const int k = ks * 32 + q * 8 + j, sidx = k >> 4, hi = k & 15;
            const float ar = AP[(pp * 33 + 31 - sidx) * 2], ai = AP[(pp * 33 + 31 - sidx) * 2 + 1], br = BB[(pp * 16 + hi) * 2], bi = BB[(pp * 16 + hi) * 2 + 1];
            v[j] = ri ? (ar * bi + ai * br) : (ar * br - ai * bi); }
        u32x4 o; o.x = pk2(v[0], v[1]); o.y = pk2(v[2], v[3]); o.z = pk2(v[4], v[5]); o.w = pk2(v[6], v[7]);
        *(u32x4*)((bf16_t*)(p.ws + WS_WINF) + ((size_t)((g * 8 + part) * 16 + ks) * 64 + l) * 8) = o;
    }
    for (int u = tid; u < 1024; u += NTHR) {
        const int fr = u >> 6, l = u & 63, t = part * 4 + (fr >> 2), ksp = fr & 3, ho = l & 15, q = l >> 4; float v[8];
#pragma unroll
        for (int j = 0; j < 8; ++j) { const int kp = ksp * 32 + q * 8 + j, ri = kp >> 6, pp = kp & 63;
            const float cr = CC[(ho * 64 + pp) * 2], ci = CC[(ho * 64 + pp) * 2 + 1], ar = AP[(pp * 33 + t + 1) * 2], ai = AP[(pp * 33 + t + 1) * 2 + 1];
            v[j] = ri ? -(cr * ai + ci * ar) : (cr * ar - ci * ai); }
        u32x4 o; o.x = pk2(v[0], v[1]); o.y = pk2(v[2], v[3]); o.z = pk2(v[4], v[5]); o.w = pk2(v[6], v[7]);
        *(u32x4*)((bf16_t*)(p.ws + WS_WOUTF) + ((size_t)((g * 32 + t) * 4 + ksp) * 64 + l) * 8) = o;
    }
    __syncthreads();
}

__device__ __forceinline__ float gelu_tanh(float y) { const float z = 0.7978845608028654f * (y + 0.044715f * y * y * y); const float e = __expf(2.0f * z); const float th = 1.0f - 2.0f / (e + 1.0f); return 0.5f * y * (1.0f + th); }

__device__ __forceinline__ void s5_item(const Params& p, LAS unsigned char* lds, int item) {
    const int b = item >> 5, g = item & 31;
    const int tid = tidx(), lane = tid & 63, wave = __builtin_amdgcn_readfirstlane(tid >> 6), hd = lane & 15, qd = lane >> 4;
    const bf16_t* PROJ = (const bf16_t*)(p.ws + WS_PROJ); bf16_t* YG = (bf16_t*)(p.ws + WS_YG);
    LAS float* SL = (LAS float*)lds;
    LAS unsigned char* WO = lds + 65536;
    const char* WoutG = (const char*)(p.ws + WS_WOUTF) + (size_t)g * 32 * 4 * 1024;
#define S5_WO_DMA(h) do { _Pragma("unroll") for (int j_ = 0; j_ < 8; ++j_) \
        __builtin_amdgcn_global_load_lds((const unsigned*)(WoutG + (size_t)(h) * 65536 + (j_ * 512 + tid) * 16), (LAS unsigned*)(WO + j_ * 8192 + wave * 1024), 16, 0, 0); } while (0)
    const int c = 16 * wave + hd;
    __syncthreads();
    S5_WO_DMA(0);
    bf16x8 Uf[16];
#pragma unroll
    for (int ks = 0; ks < 16; ++ks) Uf[ks] = *(const bf16x8*)(PROJ + ((size_t)b * SEQ + c * 32 + 2 * ks + (qd >> 1)) * PROJ_W + C_USSM + g * 16 + (qd & 1) * 8);
    { const bf16x8* WinF = (const bf16x8*)(p.ws + WS_WINF) + (size_t)g * 8 * 16 * 64 + lane;
      bf16x8 wc_[8], wn_[8];
#pragma unroll
      for (int ks = 0; ks < 8; ++ks) wc_[ks] = WinF[ks * 64];
      f32x4 a = (f32x4){0.f, 0.f, 0.f, 0.f};
#pragma unroll 2
      for (int j = 0; j < 16; ++j) { const int jn = (j < 15) ? j + 1 : j;
#pragma unroll
          for (int i = 0; i < 8; ++i) wn_[i] = WinF[(jn * 8 + i) * 64];
          if ((j & 1) == 0) {
#pragma unroll
              for (int i = 0; i < 8; ++i) a = __builtin_amdgcn_mfma_f32_16x16x32_bf16(wc_[i], Uf[i], a, 0, 0, 0); }
          else {
#pragma unroll
              for (int i = 0; i < 8; ++i) a = __builtin_amdgcn_mfma_f32_16x16x32_bf16(wc_[i], Uf[8 + i], a, 0, 0, 0);
              *(LAS f32x4*)(SL + c * 128 + (j >> 1) * 16 + qd * 4) = a; a = (f32x4){0.f, 0.f, 0.f, 0.f}; }
#pragma unroll
          for (int i = 0; i < 8; ++i) wc_[i] = wn_[i]; } }
    __syncthreads();
    if (wave == 0) { const float* a32 = (const float*)(p.ws + WS_A32); const float ar = a32[(g * 64 + lane) * 2], ai = a32[(g * 64 + lane) * 2 + 1]; float hr = 0.f, hi = 0.f;
#pragma unroll 4
        for (int cc = 0; cc < 128; ++cc) { const float sr = SL[cc * 128 + lane], si = SL[cc * 128 + 64 + lane]; const float nr = ar * hr - ai * hi + sr, ni = ar * hi + ai * hr + si; hr = nr; hi = ni; SL[cc * 128 + lane] = hr; SL[cc * 128 + 64 + lane] = hi; } }
    __syncthreads();
    bf16x8 Hf[4];
#pragma unroll
    for (int ks = 0; ks < 4; ++ks) { if (c >= 1) { const f32x4 x0 = *(const LAS f32x4*)(SL + (c - 1) * 128 + ks * 32 + qd * 8), x1 = *(const LAS f32x4*)(SL + (c - 1) * 128 + ks * 32 + qd * 8 + 4); Hf[ks] = __builtin_bit_cast(bf16x8, pack8(x0, x1)); }
        else Hf[ks] = (bf16x8){0, 0, 0, 0, 0, 0, 0, 0}; }
    const bf16x8* TzF = (const bf16x8*)(p.ws + WS_TZF) + (size_t)g * 32 * 64 + lane;
#pragma unroll
    for (int half = 0; half < 2; ++half) {
        f32x4 acc[16];
#pragma unroll
        for (int tt = 0; tt < 16; ++tt) acc[tt] = (f32x4){0.f, 0.f, 0.f, 0.f};
        const int ndelta = half * 16 + 16;
        bf16x8 fr[4];
#pragma unroll
        for (int i = 0; i < 4; ++i) fr[i] = TzF[i * 64];
#pragma unroll
        for (int delta = 0; delta < 32; ++delta) {
            if (delta < ndelta) {
                const bf16x8 f0 = fr[delta & 3];
                if (delta + 4 < ndelta) fr[delta & 3] = TzF[(delta + 4) * 64];
#pragma unroll
                for (int ks = 0; ks < 16; ++ks) { const int t = delta + 2 * ks; if (t >= half * 16 && t < half * 16 + 16) acc[t - half * 16] = __builtin_amdgcn_mfma_f32_16x16x32_bf16(f0, Uf[ks], acc[t - half * 16], 0, 0, 0); }
            }
        }
        asm volatile("s_waitcnt vmcnt(0)" ::: "memory");
        __syncthreads();
#pragma unroll
        for (int tt = 0; tt < 16; ++tt) { const int t = half * 16 + tt;
#pragma unroll
            for (int ks = 0; ks < 4; ++ks) acc[tt] = __builtin_amdgcn_mfma_f32_16x16x32_bf16(*(const LAS bf16x8*)(WO + (tt * 4 + ks) * 1024 + lane * 16), Hf[ks], acc[tt], 0, 0, 0);
            u32x2 w; w.x = pk2(gelu_tanh(acc[tt][0]), gelu_tanh(acc[tt][1])); w.y = pk2(gelu_tanh(acc[tt][2]), gelu_tanh(acc[tt][3]));
            *(u32x2*)(YG + ((size_t)b * SEQ + c * 32 + t) * 512 + g * 16 + qd * 4) = w;
            if ((tt & 1) == 1) asm volatile("" ::: "memory"); }
        if (half == 0) { asm volatile("s_waitcnt lgkmcnt(0)" ::: "memory"); __syncthreads(); S5_WO_DMA(1); }
    }
#undef S5_WO_DMA
    __syncthreads();
}

struct TDesc { const float* W; bf16_t* WT; int K, N, item, kind; };
__device__ __forceinline__ void t_load(const TDesc& d, int lane, f32x4 (&v)[16]) {
    const int nblk = (d.N + 63) >> 6, kb = d.item / nblk, nb = d.item - kb * nblk, k0 = 64 * kb, n0 = 64 * nb;
    const int lr = lane >> 4, lc = (lane & 15) * 4;
#pragma unroll
    for (int i = 0; i < 16; ++i) v[i] = (n0 + lc < d.N) ? *(const f32x4*)(d.W + (size_t)(k0 + 4 * i + lr) * d.N + n0 + lc) : (f32x4){0.f, 0.f, 0.f, 0.f};
}
struct RmId { __device__ int operator()(int n) const { return n; } };
struct RmWave { __device__ int operator()(int n) const { const int L = n & 255; return (n & ~255) + 128 * ((L >> 5) & 1) + 32 * (L >> 6) + (L & 31); } };
struct RmIn { __device__ int operator()(int n) const { if (n < PROJ_USED) return n; const int g = n - PROJ_USED, c = g & 1023; return PROJ_W + 256 * (c >> 7) + 128 * (g >> 10) + (c & 127); } };
struct RmGate { __device__ int operator()(int n) const { const int hl = n & 127; return 256 * (n >> 7) + 128 * ((hl >> 2) & 1) + 32 * (hl >> 5) + 8 * ((hl >> 3) & 3) + (hl & 3); } };
struct RmUp { __device__ int operator()(int n) const { const int hl = n & 127; return 256 * (n >> 7) + 128 * ((hl >> 2) & 1) + 32 * (hl >> 5) + 8 * ((hl >> 3) & 3) + 4 + (hl & 3); } };
__device__ __forceinline__ int t_rowmap(int kind, int n) { return kind == 0 ? n : kind == 1 ? RmWave()(n) : kind == 2 ? RmIn()(n) : kind == 3 ? RmGate()(n) : RmUp()(n); }
__device__ __forceinline__ void t_store(const TDesc& d, const f32x4 (&v)[16], LAS float* scr, int lane) {
    const int nblk = (d.N + 63) >> 6, kb = d.item / nblk, nb = d.item - kb * nblk, k0 = 64 * kb, n0 = 64 * nb;
    const int lr = lane >> 4, lc = (lane & 15) * 4;
#pragma unroll
    for (int i = 0; i < 16; ++i) { LAS float* dd = scr + (4 * i + lr) * 65 + lc; dd[0] = v[i].x; dd[1] = v[i].y; dd[2] = v[i].z; dd[3] = v[i].w; }
    LDS_WAIT(); asm volatile("" ::: "memory");
    const int nl = lane >> 3, kc = (lane & 7) * 8;
#pragma unroll
    for (int j = 0; j < 8; ++j) { const int n = nl + 8 * j; const LAS float* sp = scr + kc * 65 + n;
        u32x4 o; o.x = pk2(sp[0 * 65], sp[1 * 65]); o.y = pk2(sp[2 * 65], sp[3 * 65]); o.z = pk2(sp[4 * 65], sp[5 * 65]); o.w = pk2(sp[6 * 65], sp[7 * 65]);
        if (n0 + n < d.N) *(u32x4*)(d.WT + (size_t)t_rowmap(d.kind, n0 + n) * d.K + k0 + kc) = o; }
    LDS_WAIT(); asm volatile("" ::: "memory");
}

constexpr int T_I_IN = 16 * 60, T_I_GLU = 8 * 8, T_I_PS = 8 * 16, T_I_OUT = 16 * 16, T_I_SG = 16 * 4, T_I_SD = 4 * 16, T_I_EG = 64 * 64;
constexpr int T_NITEMS = T_I_IN + T_I_GLU + 2 * T_I_PS + T_I_OUT + 2 * T_I_SG + T_I_SD + 3 * T_I_EG;
constexpr int T_LATE = 5 * 128 * NWAVES;
constexpr int T_LATE2 = T_I_EG;
static_assert(T_LATE + T_LATE2 <= 3 * T_I_EG, "late items are expert matrices");
__device__ __forceinline__ TDesc tdesc_of(const Params& p, unsigned char* ws, int r) { TDesc d;
    if (r < T_I_IN) { d = TDesc{p.in[5], (bf16_t*)(ws + WS_W_IN), 1024, IN_W, r, 2}; return d; } r -= T_I_IN;
    if (r < T_I_GLU) { d = TDesc{p.in[14], (bf16_t*)(ws + WS_W_GLU), 512, 512, r, 0}; return d; } r -= T_I_GLU;
    if (r < T_I_PS) { d = TDesc{p.in[16], (bf16_t*)(ws + WS_W_PS), 512, 1024, r, 0}; return d; } r -= T_I_PS;
    if (r < T_I_PS) { d = TDesc{p.in[17], (bf16_t*)(ws + WS_W_PA), 512, 1024, r, 0}; return d; } r -= T_I_PS;
    if (r < T_I_OUT) { d = TDesc{p.in[18], (bf16_t*)(ws + WS_W_OUT), 1024, 1024, r, 0}; return d; } r -= T_I_OUT;
    if (r < T_I_SG) { d = TDesc{p.in[25], (bf16_t*)(ws + WS_W_SGU), 1024, 256, r, 3}; return d; } r -= T_I_SG;
    if (r < T_I_SG) { d = TDesc{p.in[26], (bf16_t*)(ws + WS_W_SGU), 1024, 256, r, 4}; return d; } r -= T_I_SG;
    if (r < T_I_SD) { d = TDesc{p.in[27], (bf16_t*)(ws + WS_W_SD), 256, 1024, r, 1}; return d; } r -= T_I_SD;
    if (r < T_I_EG) { const int e = r >> 6; d = TDesc{p.in[22] + (size_t)e * 262144, (bf16_t*)(ws + WS_W_EGU) + (size_t)e * 524288, 1024, 256, r & 63, 3}; return d; } r -= T_I_EG;
    if (r < T_I_EG) { const int e = r >> 6; d = TDesc{p.in[23] + (size_t)e * 262144, (bf16_t*)(ws + WS_W_EGU) + (size_t)e * 524288, 1024, 256, r & 63, 4}; return d; } r -= T_I_EG;
    { const int e = r >> 6; d = TDesc{p.in[24] + (size_t)e * 262144, (bf16_t*)(ws + WS_W_ED) + (size_t)e * 262144, 256, 1024, r & 63, 1}; return d; } }
__device__ __forceinline__ void run_transposes(const Params& p, unsigned char* ws, LAS unsigned char* lds, int r0, int r1, int widx, int nw) {
    const int lane = tidx() & 63, wave = __builtin_amdgcn_readfirstlane(tidx() >> 6);
    LAS float* scr = (LAS float*)(lds + wave * 16640);
    int r = r1 - 1 - widx;
    if (r < r0) return;
    TDesc d0 = tdesc_of(p, ws, r), d1 = d0, d2 = d0; f32x4 v0[16], v1[16], v2[16];
    t_load(d0, lane, v0);
    bool h1 = (r - nw >= r0);
    if (h1) { d1 = tdesc_of(p, ws, r - nw); t_load(d1, lane, v1); }
    for (;;) {
        const bool h2 = h1 && (r - 2 * nw >= r0);
        if (h2) { d2 = tdesc_of(p, ws, r - 2 * nw); t_load(d2, lane, v2); }
        t_store(d0, v0, scr, lane);
        if (!h1) break;
        d0 = d1; d1 = d2; r -= nw; h1 = h2;
#pragma unroll
        for (int i = 0; i < 16; ++i) { v0[i] = v1[i]; v1[i] = v2[i]; }
    }
}
__device__ __forceinline__ void p0_prep(const Params& p, LAS unsigned char* lds, int vcu, int G) {
    const int tid = tidx(), lane = tid & 63, wave = __builtin_amdgcn_readfirstlane(tid >> 6);
    unsigned char* ws = p.ws;
    for (int it = vcu; it < 256; it += G) s5_tables_item(p, lds, it);
    {
        LAS float* sc = (LAS float*)lds;
        LAS float* red = (LAS float*)(lds + 32768);
        const float* c = p.in[1]; const float* w = p.in[2]; const float* bb = p.in[3]; float* ada = (float*)(ws + WS_ADA);
        bool loaded = false;
        for (int it = vcu; it < 96; it += G) {
            if (!loaded) { for (int i = tid; i < 8192; i += NTHR) { const float v = c[i]; sc[i] = v * sigmoidf_(v); } loaded = true; }
            __syncthreads();
            const int kq = tid >> 6, col = it * 64 + lane; float a[8];
#pragma unroll
            for (int b = 0; b < 8; ++b) a[b] = 0.f;
#pragma unroll 16
            for (int k = kq * 128; k < kq * 128 + 128; ++k) { const float wv = w[(size_t)k * 6144 + col];
#pragma unroll
                for (int b = 0; b < 8; ++b) a[b] += sc[b * 1024 + k] * wv; }
#pragma unroll
            for (int b = 0; b < 8; ++b) red[(kq * 8 + b) * 64 + lane] = a[b];
            __syncthreads();
            { const int b = tid >> 6; float s = bb[col];
#pragma unroll
              for (int q = 0; q < 8; ++q) s += red[(q * 8 + b) * 64 + lane];
              ada[b * 6144 + col] = s; }
            __syncthreads();
        }
        __syncthreads();
    }
    run_transposes(p, ws, lds, 0, T_NITEMS - T_LATE2 - ((G == 256) ? T_LATE : 0), vcu * NWAVES + wave, G * NWAVES);
    { const int gt = vcu * NTHR + tid, NGT = G * NTHR;
      u32x4* z = (u32x4*)(ws + WS_W_IN + (size_t)PROJ_USED * 1024 * 2);
      for (int i = gt; i < (PROJ_W - PROJ_USED) * 1024 * 2 / 16; i += NGT) z[i] = (u32x4){0u, 0u, 0u, 0u};
      int* id = (int*)(ws + WS_IDENT); for (int i = gt; i < NTOK; i += NGT) id[i] = (i % CHTOK) * NSLOT + 8;
      if (gt < 256) ((float*)(ws + WS_ONES))[gt] = 1.0f;
      for (int u = gt; u < 32 * 4 * 64; u += NGT) { const int l = u & 63, nt = (u >> 6) & 3, ks = u >> 8; const int n = nt * 16 + (l & 15), q = l >> 4; float hi[8], lo[8];
#pragma unroll
          for (int j = 0; j < 8; ++j) { const float w = p.in[20][(size_t)(ks * 32 + q * 8 + j) * 64 + n]; const float h = bf2f((unsigned short)f2bf(w)); hi[j] = h; lo[j] = w - h; }
          u32x4 o; o.x = pk2(hi[0], hi[1]); o.y = pk2(hi[2], hi[3]); o.z = pk2(hi[4], hi[5]); o.w = pk2(hi[6], hi[7]);
          *(u32x4*)((bf16_t*)(ws + WS_WRF) + (size_t)u * 8) = o;
          o.x = pk2(lo[0], lo[1]); o.y = pk2(lo[2], lo[3]); o.z = pk2(lo[4], lo[5]); o.w = pk2(lo[6], lo[7]);
          *(u32x4*)((bf16_t*)(ws + WS_WRF) + (size_t)(32 * 4 * 64 + u) * 8) = o; } }
}

__device__ __forceinline__ void p1_modulate(const Params& p, int vcu, int G) {
    const int tid = tidx(), lane = tid & 63, wave = tid >> 6; const int gw = vcu * NWAVES + wave, NGW = G * NWAVES;
    const float* ada = (const float*)(p.ws + WS_ADA); const float* g1 = p.in[4]; bf16_t* U = (bf16_t*)(p.ws + WS_U);
    for (int m = gw; m < NTOK; m += NGW) {
        const f32x4* xr = (const f32x4*)(p.in[0] + (size_t)m * D) + lane; const int b = m >> 12;
        f32x4 v[4]; float s = 0.f;
#pragma unroll
        for (int j = 0; j < 4; ++j) { v[j] = xr[64 * j]; s += (v[j].x * v[j].x + v[j].y * v[j].y) + (v[j].z * v[j].z + v[j].w * v[j].w); }
        const float rstd = 1.0f / sqrtf(wave_sum(s) * (1.f / D) + EPS);
        unsigned long long* o8 = (unsigned long long*)(U + (size_t)m * D) + lane;
#pragma unroll
        for (int j = 0; j < 4; ++j) { const int c0 = 4 * lane + 256 * j;
            const f32x4 gg = *(const f32x4*)(g1 + c0), sh = *(const f32x4*)(ada + b * 6144 + c0), scl = *(const f32x4*)(ada + b * 6144 + 1024 + c0);
            const f32x4 y = v[j] * rstd * gg * (scl + 1.0f) + sh;
            o8[64 * j] = (unsigned long long)pk2(y.x, y.y) | ((unsigned long long)pk2(y.z, y.w) << 32); }
    }
}

__device__ __forceinline__ void p_combine(const Params& p, int vcu, int G, int ch) {
    const int tid = tidx(), lane = tid & 63, wave = tid >> 6; const int gw = vcu * NWAVES + wave, NGW = G * NWAVES;
    const float* ada = (const float*)(p.ws + WS_ADA); const float* gf = p.in[28];
    const unsigned char* Y = (const unsigned char*)(p.ws + WS_Y);
    u32x4 w[NSLOT];
    { const int mi0 = gw < CHTOK ? gw : 0; const unsigned char* yp = Y + (size_t)mi0 * NSLOT * D + lane * 16;
#pragma unroll
      for (int k = 0; k < NSLOT; ++k) w[k] = *(const u32x4*)(yp + (size_t)k * D); }
    for (int mi = gw; mi < CHTOK; mi += NGW) {
        const int m = ch * CHTOK + mi; const int b = m >> 12;
        float* orow = p.out + (size_t)m * D + lane * 16;
        f32x4 h[4], g2[4];
        { const u32x4* hp = (const u32x4*)((const bf16_t*)(p.out + (size_t)m * D) + lane * 16); const u32x4 h0 = hp[0], h1 = hp[1];
          h[0] = (f32x4){bflo(h0.x), bfhi(h0.x), bflo(h0.y), bfhi(h0.y)}; h[1] = (f32x4){bflo(h0.z), bfhi(h0.z), bflo(h0.w), bfhi(h0.w)};
          h[2] = (f32x4){bflo(h1.x), bfhi(h1.x), bflo(h1.y), bfhi(h1.y)}; h[3] = (f32x4){bflo(h1.z), bfhi(h1.z), bflo(h1.w), bfhi(h1.w)}; }
#pragma unroll
        for (int q = 0; q < 4; ++q) g2[q] = *(const f32x4*)(ada + b * 6144 + 5120 + lane * 16 + 4 * q);
        float a[16];
#pragma unroll
        for (int j = 0; j < 16; ++j) a[j] = 0.f;
#pragma unroll
        for (int k = 0; k < NSLOT; ++k)
#pragma unroll
            for (int q = 0; q < 4; ++q) { const f32x2 lo = __builtin_amdgcn_cvt_pk_f32_fp8((int)w[k][q], false), hi = __builtin_amdgcn_cvt_pk_f32_fp8((int)w[k][q], true);
                a[4 * q] += lo.x; a[4 * q + 1] += lo.y; a[4 * q + 2] += hi.x; a[4 * q + 3] += hi.y; }
        { const int mn = (mi + NGW < CHTOK) ? mi + NGW : mi; const unsigned char* yp = Y + (size_t)mn * NSLOT * D + lane * 16;
#pragma unroll
          for (int k = 0; k < NSLOT; ++k) w[k] = *(const u32x4*)(yp + (size_t)k * D); }
        float r[16]; float s = 0.f;
#pragma unroll
        for (int i = 0; i < 4; ++i)
#pragma unroll
            for (int j = 0; j < 4; ++j) { const float v = h[i][j] + g2[i][j] * (a[i * 4 + j] * (1.0f / Y_SCALE)); r[i * 4 + j] = v; s += v * v; }
        const float rstd = 1.0f / sqrtf(wave_sum(s) * (1.f / D) + EPS);
#pragma unroll
        for (int q = 0; q < 4; ++q) { const f32x4 g = *(const f32x4*)(gf + lane * 16 + 4 * q); f32x4 o;
#pragma unroll
            for (int j = 0; j < 4; ++j) o[j] = r[q * 4 + j] * rstd * g[j];
            *(f32x4*)(orow + 4 * q) = o; }
    }
}

__device__ __forceinline__ unsigned fkey(float x) { const unsigned u = __builtin_bit_cast(unsigned, x); return (u & 0x80000000u) ? ~u : (u | 0x80000000u); }

__device__ __forceinline__ void gold_s5(const Params& p, int item, int lane) {
    const int b = item >> 5, g = item & 31;
    const bf16_t* PROJ = (const bf16_t*)(p.ws + WS_PROJ); bf16_t* YG = (bf16_t*)(p.ws + WS_YG);
    const float dt = expf(p.in[8][g]); const float lr = p.in[6][g * 64 + lane], li = p.in[7][g * 64 + lane];
    const float mag = expf(lr * dt); const float a_re = mag * cosf(li * dt), a_im = mag * sinf(li * dt);
    const float den = lr * lr + li * li, n_re = a_re - 1.0f;
    const float f_re = (n_re * lr + a_im * li) / den, f_im = (a_im * lr - n_re * li) / den;
    float bbr[16], bbi[16], cr[16], ci[16];
#pragma unroll
    for (int h = 0; h < 16; ++h) { const float br = p.in[9][(g * 64 + lane) * 16 + h], bi = p.in[10][(g * 64 + lane) * 16 + h];
        bbr[h] = f_re * br - f_im * bi; bbi[h] = f_re * bi + f_im * br;
        cr[h] = p.in[11][(g * 16 + h) * 64 + lane]; ci[h] = p.in[12][(g * 16 + h) * 64 + lane]; }
    const float dsk = p.in[13][g * 16 + (lane & 15)];
    float hr = 0.f, hi = 0.f;
    for (int t = 0; t < SEQ; ++t) {
        const size_t row = (size_t)b * SEQ + t;
        const u32x4 w0 = *(const u32x4*)(PROJ + row * PROJ_W + C_USSM + g * 16), w1 = *(const u32x4*)(PROJ + row * PROJ_W + C_USSM + g * 16 + 8);
        float u[16]; { float f[8]; unpack8(w0, f);
#pragma unroll
            for (int j = 0; j < 8; ++j) u[j] = f[j];
            unpack8(w1, f);
#pragma unroll
            for (int j = 0; j < 8; ++j) u[8 + j] = f[j]; }
        float bur = 0.f, bui = 0.f;
#pragma unroll
        for (int h = 0; h < 16; ++h) { bur += bbr[h] * u[h]; bui += bbi[h] * u[h]; }
        const float nr = a_re * hr - a_im * hi + bur, ni = a_re * hi + a_im * hr + bui; hr = nr; hi = ni;
        float y = 0.f, um = 0.f;
#pragma unroll
        for (int h = 0; h < 16; ++h) { const float v = wave_sum(cr[h] * hr - ci[h] * hi); if ((lane & 15) == h) { y = v; um = u[h]; } }
        y += dsk * um;
        const float gl = 0.5f * y * (1.0f + tanhf(0.7978845608028654f * (y + 0.044715f * y * y * y)));
        if (lane < 16) YG[row * 512 + g * 16 + lane] = (bf16_t)f2bf(gl);
    }
}

__device__ __forceinline__ void gold_attn_pair(const Params& p, LAS unsigned char* lds, int pairid) {
    const int half = tidx() >> 8, tid = tidx() & 255;
    LAS unsigned char* base = lds + half * 32768;
    LAS float* qi = (LAS float*)base; LAS float* qv = qi + 512; LAS float* sc = qv + 512; LAS float* lg = sc + 4096;
    LAS float* wi = lg + 2048; LAS float* mx = wi + 8; LAS float* sm = mx + 8; LAS int* sel = (LAS int*)(sm + 8); LAS int* red = sel + 256; LAS int* cntp = red + 256;
    const int qid = pairid * 2 + half; const int b = qid >> 12, t = qid & 4095;
    const bf16_t* PROJ = (const bf16_t*)(p.ws + WS_PROJ); bf16_t* YA = (bf16_t*)(p.ws + WS_YATTN);
    const size_t qrow = (size_t)qid * PROJ_W;
    __syncthreads();
    for (int i = tid; i < 512; i += 256) { qi[i] = bf2f(PROJ[qrow + C_QI + i]); qv[i] = bf2f(PROJ[qrow + C_Q + i]); }
    if (tid < 8) wi[tid] = bf2f(PROJ[qrow + C_WI + tid]);
    if (tid == 0) cntp[0] = 0;
    __syncthreads();
    const int n = t + 1;
    for (int s = tid; s < n; s += 256) {
        const bf16_t* kp = PROJ + ((size_t)b * SEQ + s) * PROJ_W + C_KI; float kk[64];
#pragma unroll
        for (int c8 = 0; c8 < 8; ++c8) { float f[8]; unpack8(*(const u32x4*)(kp + c8 * 8), f);
#pragma unroll
            for (int j = 0; j < 8; ++j) kk[c8 * 8 + j] = f[j]; }
        float score = 0.f;
        for (int h = 0; h < 8; ++h) { float d = 0.f;
#pragma unroll
            for (int j = 0; j < 64; ++j) d += qi[h * 64 + j] * kk[j];
            score += wi[h] * fmaxf(d, 0.f); }
        sc[s] = score;
    }
    __syncthreads();
    const bool small = (t | 1) <= 255;
    if (small) { if (tid < n) sel[tid] = tid; if (tid == 0) cntp[0] = n; __syncthreads(); }
    else {
        unsigned thr = 0u;
        for (int bit = 31; bit >= 0; --bit) {
            const unsigned cand = thr | (1u << bit); int c = 0;
            for (int s = tid; s < n; s += 256) c += (fkey(sc[s]) >= cand) ? 1 : 0;
            red[tid] = c; __syncthreads();
            for (int o = 128; o > 0; o >>= 1) { if (tid < o) red[tid] += red[tid + o]; __syncthreads(); }
            if (red[0] >= 256) thr = cand;
            __syncthreads();
        }
        for (int s = tid; s < n; s += 256) if (fkey(sc[s]) > thr) { const int ps = atomicAdd((int*)cntp, 1); sel[ps] = s; }
        __syncthreads();
        if (tid == 0) { int c = cntp[0]; for (int s = 0; s < n && c < 256; ++s) if (fkey(sc[s]) == thr) sel[c++] = s; cntp[0] = c; }
        __syncthreads();
    }
    const int ns = cntp[0];
    { const int j = tid; const int s = (j < ns) ? sel[j] : 0;
      const bf16_t* kp = PROJ + ((size_t)b * SEQ + s) * PROJ_W + C_K; float kk[64];
#pragma unroll
      for (int c8 = 0; c8 < 8; ++c8) { float f[8]; unpack8(*(const u32x4*)(kp + c8 * 8), f);
#pragma unroll
          for (int jj = 0; jj < 8; ++jj) kk[c8 * 8 + jj] = f[jj]; }
      for (int h = 0; h < 8; ++h) { float d = 0.f;
#pragma unroll
          for (int jj = 0; jj < 64; ++jj) d += qv[h * 64 + jj] * kk[jj];
          const float slope = exp2f(-(float)(h + 1));
          lg[h * 256 + j] = (j < ns) ? d * 0.125f - slope * (float)(t - s) : -INFINITY; } }
    __syncthreads();
    if (tid < 8) { float m = -INFINITY; for (int j = 0; j < 256; ++j) m = fmaxf(m, lg[tid * 256 + j]); float sum = 0.f; for (int j = 0; j < 256; ++j) sum += __expf(lg[tid * 256 + j] - m); mx[tid] = m; sm[tid] = sum; }
    __syncthreads();
    for (int i = tid; i < 2048; i += 256) { const int h = i >> 8; lg[i] = __expf(lg[i] - mx[h]) / sm[h]; }
    __syncthreads();
    { const int h = tid >> 5, d0 = (tid & 31) * 2; float o0 = 0.f, o1 = 0.f;
      for (int j = 0; j < ns; ++j) { const unsigned w = *(const unsigned*)(PROJ + ((size_t)b * SEQ + sel[j]) * PROJ_W + C_V + d0); const float pj = lg[h * 256 + j]; o0 += pj * bflo(w); o1 += pj * bfhi(w); }
      *(unsigned*)(YA + (size_t)qid * 512 + h * 64 + d0) = pk2(o0, o1); }
}

typedef float f32x16 __attribute__((ext_vector_type(16)));
typedef _Float16 f16_t;
constexpr int AT_SC = 0;
constexpr int AT_V = 65536;
constexpr int AT_SEL = LDS_CNT;
static_assert(AT_V + 8 * 2 * 4096 <= STAGE_BYTES && AT_SEL + 8 * 1152 <= LDS_BYTES, "attention LDS map");

#define DPP_ZI(v, ctrl, rmask, bmask) __builtin_amdgcn_update_dpp(0, (int)(v), ctrl, rmask, bmask, false)
__device__ __forceinline__ int wave_scan_i(int v0) {
    int v1 = v0 + DPP_ZI(v0, 0x111, 0xf, 0xf); v1 += DPP_ZI(v0, 0x112, 0xf, 0xf); v1 += DPP_ZI(v0, 0x113, 0xf, 0xf);
    v1 += DPP_ZI(v1, 0x114, 0xf, 0xe); v1 += DPP_ZI(v1, 0x118, 0xf, 0xc);
    v1 += DPP_ZI(v1, 0x142, 0xa, 0xf); v1 += DPP_ZI(v1, 0x143, 0xc, 0xf);
    return v1;
}
__device__ __forceinline__ float relu_i(float x) { const int xi = __builtin_bit_cast(int, x); return __builtin_bit_cast(float, xi > 0 ? xi : 0); }
__device__ __forceinline__ u32x2 tr_read16(unsigned addr) { u32x2 r; asm volatile("ds_read_b64_tr_b16 %0, %1" : "=v"(r) : "v"(addr) : "memory"); return r; }

__device__ __forceinline__ void attn_item(const Params& p, LAS unsigned char* lds, int b, int qblk, int nb, int nqblk) {
    const int tid = tidx(), lane = tid & 63, wave = __builtin_amdgcn_readfirstlane(tid >> 6);
    const int q0 = qblk * 8;
    const bf16_t* PROJ = (const bf16_t*)(p.ws + WS_PROJ); bf16_t* YA = (bf16_t*)(p.ws + WS_YATTN);
    const size_t tok0 = (size_t)b * SEQ + q0;
    LAS unsigned short* SC = (LAS unsigned short*)(lds + AT_SC);
    LAS unsigned short* SELq = (LAS unsigned short*)(lds + AT_SEL) + wave * 576;
    const int nkt = (q0 + 8 + 31) >> 5;
    const int nchmax = (q0 + 8 + 511) >> 9;
    __syncthreads();
    for (int i = nkt * 32 + lane; i < nchmax * 512; i += 64) SC[wave * 4096 + i] = 0xFC00u;
    __syncthreads();
#ifndef AT_REP_A
#define AT_REP_A 1
#endif
#ifndef AT_REP_B
#define AT_REP_B 1
#endif
#ifndef AT_REP_C
#define AT_REP_C 1
#endif
#ifndef AT_SKIP_A
    for (int ra_ = 0; ra_ < AT_REP_A; ++ra_) {
        const int hf = lane >> 5, l32 = lane & 31;
        const int rq = 2 * ((l32 >> 2) & 1) + ((l32 >> 4) & 1), rh = (l32 & 3) + 4 * ((l32 >> 3) & 1);
        bf16x8 Af[2][4]; float wgt[2][16];
#pragma unroll
        for (int qg = 0; qg < 2; ++qg) { const bf16_t* qp = PROJ + (tok0 + 4 * qg + rq) * PROJ_W + C_QI + rh * 64 + hf * 8;
#pragma unroll
            for (int s = 0; s < 4; ++s) Af[qg][s] = *(const bf16x8*)(qp + s * 16);
#pragma unroll
            for (int qq = 0; qq < 2; ++qq) { const u32x4 w = *(const u32x4*)(PROJ + (tok0 + 4 * qg + 2 * hf + qq) * PROJ_W + C_WI); float f[8]; unpack8(w, f);
#pragma unroll
                for (int h = 0; h < 8; ++h) wgt[qg][qq * 8 + h] = f[h] * 0.0441941738f; } }
        const bf16x8* KIF = (const bf16x8*)(p.ws + WS_KIF) + (size_t)b * 128 * 4 * 64 + lane;
        bf16x8 B0[4], B1[4];
        { const int kt0 = wave < nkt ? wave : 0, kt1 = wave + 8 < nkt ? wave + 8 : kt0;
#pragma unroll
          for (int s = 0; s < 4; ++s) { B0[s] = KIF[(kt0 * 4 + s) * 64]; B1[s] = KIF[(kt1 * 4 + s) * 64]; } }
#define STEP_A_TILE(BF, KT) do { const int key = (KT) * 32 + l32; \
            _Pragma("unroll") for (int qg = 0; qg < 2; ++qg) { \
                f32x16 c; _Pragma("unroll") for (int j = 0; j < 16; ++j) c[j] = 0.f; \
                _Pragma("unroll") for (int s = 0; s < 4; ++s) c = __builtin_amdgcn_mfma_f32_32x32x16_bf16(Af[qg][s], BF[s], c, 0, 0, 0); \
                float sa = 0.f, sb = 0.f; \
                _Pragma("unroll") for (int h = 0; h < 8; ++h) { sa += wgt[qg][h] * relu_i(c[h]); sb += wgt[qg][8 + h] * relu_i(c[8 + h]); } \
                const int qa = 4 * qg + 2 * hf; \
                const unsigned hw = __builtin_bit_cast(unsigned, __builtin_amdgcn_cvt_pkrtz(sa, sb));        \
                SC[qa * 4096 + key] = (unsigned short)hw; SC[(qa + 1) * 4096 + key] = (unsigned short)(hw >> 16); } } while (0)
        for (int kt = wave; kt < nkt; kt += 16) {
            STEP_A_TILE(B0, kt);
            { const int ktn = (kt + 16 < nkt) ? kt + 16 : kt;
#pragma unroll
              for (int s = 0; s < 4; ++s) B0[s] = KIF[(ktn * 4 + s) * 64]; }
            if (kt + 8 < nkt) {
                STEP_A_TILE(B1, kt + 8);
                { const int ktn = (kt + 24 < nkt) ? kt + 24 : kt;
#pragma unroll
                  for (int s = 0; s < 4; ++s) B1[s] = KIF[(ktn * 4 + s) * 64]; } }
        }
#undef STEP_A_TILE
        if (wave == ((nkt - 1) & 7)) {
#pragma unroll
            for (int i = 0; i < 4; ++i) { const int idx = lane + 64 * i, q = idx >> 5, key = (nkt - 1) * 32 + (idx & 31); if (key > q0 + q) SC[q * 4096 + key] = 0xFC00u; } }
    }
#endif
    __syncthreads();
    const int t = q0 + wave, n = t + 1;
    int ns;
    for (int rb_ = 0; rb_ < AT_REP_B; ++rb_) {
#ifdef AT_SKIP_B
    if (true) {
#else
    if (n <= 256) {
#endif
#pragma unroll
        for (int i = 0; i < 4; ++i) { const int pos = lane + 64 * i; SELq[pos] = (unsigned short)(pos < n ? pos : 0); }
        ns = n;
    } else {
        const int nch = (n + 511) >> 9;
        unsigned XH[32], XL[32];
        LAS unsigned char* row = lds + AT_SC + wave * 8192;
#pragma unroll
        for (int i = 0; i < 8; ++i) {
            if (i < nch) { const u32x4 w = *(const LAS u32x4*)(row + i * 1024 + lane * 16);
#pragma unroll
                for (int e2 = 0; e2 < 4; ++e2) { const unsigned x = w[e2]; const unsigned sg = (x & 0x80008000u) >> 15; const unsigned k2 = x ^ ((sg * 0xffffu) | 0x80008000u);
                    XH[i * 4 + e2] = k2; XL[i * 4 + e2] = k2 << 16; } }
            else {
#pragma unroll
                for (int e2 = 0; e2 < 4; ++e2) { XH[i * 4 + e2] = 0u; XL[i * 4 + e2] = 0u; } }
        }
        LAS unsigned* H1 = (LAS unsigned*)(lds + 65536 + wave * 8192);
        LAS unsigned* H2 = (LAS unsigned*)((LAS unsigned char*)SELq + 640);
        LAS unsigned* H1p = H1 + (lane & 1) * 1024;
#pragma unroll
        for (int i = 0; i < 8; ++i) *(LAS u32x4*)(H1 + (i * 64 + lane) * 4) = (u32x4){0u, 0u, 0u, 0u};
        H2[lane] = 0u;
        LDS_WAIT(); __builtin_amdgcn_wave_barrier();
#pragma unroll
        for (int i = 0; i < 8; ++i) if (i < nch) {
#pragma unroll
            for (int e2 = 0; e2 < 4; ++e2) { const unsigned x = XH[i * 4 + e2];
                __hip_atomic_fetch_add(H1p + (x >> 22), 1u, __ATOMIC_RELAXED, __HIP_MEMORY_SCOPE_WORKGROUP);
                __hip_atomic_fetch_add(H1p + ((x >> 6) & 1023u), 1u, __ATOMIC_RELAXED, __HIP_MEMORY_SCOPE_WORKGROUP); } }
        LDS_WAIT(); __builtin_amdgcn_wave_barrier();
        unsigned B1, cabove; const unsigned dummy = 64u + (unsigned)lane;
        {
            unsigned hb[16];
#pragma unroll
            for (int i = 0; i < 4; ++i) { const u32x4 w = *(const LAS u32x4*)(H1 + lane * 16 + i * 4), w2 = *(const LAS u32x4*)(H1 + 1024 + lane * 16 + i * 4); hb[4 * i] = w.x + w2.x; hb[4 * i + 1] = w.y + w2.y; hb[4 * i + 2] = w.z + w2.z; hb[4 * i + 3] = w.w + w2.w; }
            unsigned sl_ = 0u;
#pragma unroll
            for (int i = 0; i < 16; ++i) sl_ += hb[i];
            const int inc_ = wave_scan_i((int)sl_);
            const unsigned above = (unsigned)(__builtin_amdgcn_readlane(inc_, 63) - inc_), suf = above + sl_;
            const bool mine = above < 256u && suf >= 256u;
            unsigned bsel = 0u, cab = 0u;
            if (mine) { unsigned run = above; bool done = false;
#pragma unroll
                for (int i = 15; i >= 0; --i) { if (!done && run + hb[i] >= 256u) { bsel = (unsigned)(lane * 16 + i); cab = run; done = true; } run += hb[i]; } }
            const unsigned long long mk = __ballot(mine); const int src = (int)__builtin_ctzll(mk);
            B1 = (unsigned)__builtin_amdgcn_readlane((int)bsel, src); cabove = (unsigned)__builtin_amdgcn_readlane((int)cab, src);
        }
#pragma unroll
        for (int i = 0; i < 8; ++i) if (i < nch) {
#pragma unroll
            for (int e2 = 0; e2 < 4; ++e2) { const unsigned x = XH[i * 4 + e2];
                const unsigned ah = ((x >> 22) == B1) ? ((x >> 16) & 63u) : dummy, al = (((x >> 6) & 1023u) == B1) ? (x & 63u) : dummy;
                __hip_atomic_fetch_add(H2 + ah, 1u, __ATOMIC_RELAXED, __HIP_MEMORY_SCOPE_WORKGROUP);
                __hip_atomic_fetch_add(H2 + al, 1u, __ATOMIC_RELAXED, __HIP_MEMORY_SCOPE_WORKGROUP); } }
        LDS_WAIT(); __builtin_amdgcn_wave_barrier();
        unsigned thr;
        {   const unsigned h2 = H2[lane]; const int inc_ = wave_scan_i((int)h2); const unsigned ab2 = (unsigned)(__builtin_amdgcn_readlane(inc_, 63) - inc_), suf = ab2 + h2;
            const unsigned need = 256u - cabove;
            const bool mine = ab2 < need && suf >= need;
            const unsigned long long mk = __ballot(mine); const unsigned B2 = (unsigned)__builtin_ctzll(mk);
            thr = (B1 << 6) | B2; }
        const unsigned c32 = thr << 16, c32h = c32 | 0xffffu;
#define TIE2(a, b) asm volatile("" : "+v"(a), "+v"(b))
        int cgt = 0, ceq = 0;
#pragma unroll
        for (int j = 0; j < 32; ++j) { unsigned xh = XH[j], xl = XL[j]; TIE2(xh, cgt); TIE2(xl, ceq);
            cgt += (xh > c32h) ? 1 : 0; cgt += (xl > c32) ? 1 : 0; ceq += ((xh >> 16) == thr) ? 1 : 0; ceq += (xl == c32) ? 1 : 0; }
        const int sgt = wave_scan_i(cgt), seq = wave_scan_i(ceq);
        const int tot_gt = __builtin_amdgcn_readlane(sgt, 63);
        int o1 = sgt - cgt, o2 = tot_gt + seq - ceq;
        const int trash = 256 + lane;
#pragma unroll
        for (int i = 0; i < 8; ++i) if (i < nch) {
#pragma unroll
            for (int e2 = 0; e2 < 4; ++e2) { const int j = i * 4 + e2; const int idx = i * 512 + lane * 8 + 2 * e2;
                unsigned xl = XL[j], xh = XH[j]; TIE2(xl, o1); TIE2(xh, o2);
                { const bool gt = xl > c32, eq = xl == c32; const int a2 = (eq && o2 < 256) ? o2 : trash, a1 = gt ? o1 : a2; SELq[a1] = (unsigned short)idx; o1 += gt ? 1 : 0; o2 += eq ? 1 : 0; }
                TIE2(xh, o1);
                { const bool gt = xh > c32h, eq = (xh >> 16) == thr; const int a2 = (eq && o2 < 256) ? o2 : trash, a1 = gt ? o1 : a2; SELq[a1] = (unsigned short)(idx + 1); o1 += gt ? 1 : 0; o2 += eq ? 1 : 0; } } }
        ns = 256;
    }
    LDS_WAIT(); __builtin_amdgcn_wave_barrier(); }
    __syncthreads();
    {
        const int hd = lane & 15, qd = lane >> 4;
        const size_t tok = tok0 + wave;
        LAS unsigned char* vb = lds + wave * 16384;
        const unsigned vb_addr = (unsigned)(size_t)vb;
        const int vrow = lane >> 3, vch = lane & 7;
        const char* bbase = (const char*)(PROJ + (size_t)b * SEQ * PROJ_W);
        const unsigned voff0 = (unsigned)(C_V * 2 + vch * 16), koff0 = (unsigned)(C_K * 2 + qd * 16);
        unsigned roff[32];
#pragma unroll
        for (int j_ = 0; j_ < 32; ++j_) roff[j_] = (unsigned)SELq[(j_ >> 2) * 32 + vrow + 8 * (j_ & 3)] * (unsigned)(PROJ_W * 2);
#define V_DMA(sl) do { _Pragma("unroll") for (int i_ = 0; i_ < 4; ++i_) { \
            __builtin_amdgcn_global_load_lds((const unsigned*)(bbase + (roff[(sl) * 4 + i_] + voff0)), (LAS unsigned*)(vb + ((sl) & 3) * 4096 + i_ * 1024), 16, 0, 0); } } while (0)
        bf16x8 Qf[2];
#pragma unroll
        for (int ks = 0; ks < 2; ++ks) { if (hd < 8) Qf[ks] = *(const bf16x8*)(PROJ + tok * PROJ_W + C_Q + hd * 64 + ks * 32 + qd * 8); else Qf[ks] = (bf16x8){0, 0, 0, 0, 0, 0, 0, 0}; }
#define KSWZ(row) ((unsigned)(((row) & 3) | ((((row) >> 3) & 1) << 2)))
#define K_DMA(sl) do { _Pragma("unroll") for (int i_ = 0; i_ < 4; ++i_) { const int row_ = i_ * 8 + vrow; \
            __builtin_amdgcn_global_load_lds((const unsigned*)(bbase + (roff[(sl) * 4 + i_] + (unsigned)(C_K * 2) + (((unsigned)vch ^ KSWZ(row_)) * 16u))), (LAS unsigned*)(vb + ((sl) & 3) * 4096 + i_ * 1024), 16, 0, 0); } } while (0)
        (void)koff0;
        unsigned warm0 = 0u, warm1 = 0u;
        if (wave == 0 && nqblk >= 0) { const bf16_t* nq = PROJ + ((size_t)nb * SEQ + nqblk * 8 + (lane >> 3)) * PROJ_W;
            const bf16_t* a0 = nq + C_QI + (lane & 7) * 64; const bf16_t* a1 = nq + C_WI;
            asm volatile("global_load_dword %0, %2, off\n\tglobal_load_dword %1, %3, off" : "=&v"(warm0), "=&v"(warm1) : "v"(a0), "v"(a1) : "memory"); }
        K_DMA(0); K_DMA(1); K_DMA(2); K_DMA(3);
        f32x4 S[16];
#pragma unroll
        for (int sl = 0; sl < 8; ++sl) {
            asm volatile("s_waitcnt vmcnt(12)" ::: "memory");
#pragma unroll
            for (int Th = 0; Th < 2; ++Th) { const int prow = (hd >> 2) * 8 + Th * 4 + (hd & 3); const unsigned fp = KSWZ(prow);
                const LAS unsigned char* ka = vb + (sl & 3) * 4096 + prow * 128;
                const bf16x8 K0 = *(const LAS bf16x8*)(ka + (((unsigned)qd ^ fp) * 16u)), K1 = *(const LAS bf16x8*)(ka + (((unsigned)(4 + qd) ^ fp) * 16u));
                f32x4 a = (f32x4){0.f, 0.f, 0.f, 0.f};
                a = __builtin_amdgcn_mfma_f32_16x16x32_bf16(K0, Qf[0], a, 0, 0, 0); a = __builtin_amdgcn_mfma_f32_16x16x32_bf16(K1, Qf[1], a, 0, 0, 0); S[2 * sl + Th] = a; }
            asm volatile("s_waitcnt lgkmcnt(0)" ::: "memory");
            if (sl == 0) asm volatile("" :: "v"(warm0), "v"(warm1));
            if (sl + 4 < 8) K_DMA(sl + 4); else V_DMA(sl - 4);
        }
        const float slope = exp2f(-(float)((hd & 7) + 1)), abase = -slope * (float)t;
        float mx = -INFINITY;
#pragma unroll
        for (int sl = 0; sl < 8; ++sl) { const u32x4 w = *(const LAS u32x4*)((LAS unsigned char*)SELq + (sl * 32 + qd * 8) * 2);
#pragma unroll
            for (int e = 0; e < 8; ++e) { const int T = sl * 2 + (e >> 2), r = e & 3; const unsigned ww = w[e >> 1]; const float sf = (float)((e & 1) ? (ww >> 16) : (ww & 0xffffu));
                const float lgv = __builtin_fmaf(S[T][r], 0.125f, __builtin_fmaf(slope, sf, abase)); S[T][r] = lgv; } }
        if (ns < 256) {
#pragma unroll
            for (int sl = 0; sl < 8; ++sl)
#pragma unroll
                for (int e = 0; e < 8; ++e) { if (sl * 32 + qd * 8 + e >= ns) S[sl * 2 + (e >> 2)][e & 3] = -INFINITY; } }
#pragma unroll
        for (int T = 0; T < 16; ++T) { asm("v_max3_f32 %0, %0, %1, %2" : "+v"(mx) : "v"(S[T][0]), "v"(S[T][1])); asm("v_max3_f32 %0, %0, %1, %2" : "+v"(mx) : "v"(S[T][2]), "v"(S[T][3])); }
        mx = fmaxf(mx, __shfl_xor(mx, 16)); mx = fmaxf(mx, __shfl_xor(mx, 32));
        float sum = 0.f;
        const float mxl = mx * 1.44269504089f;
#pragma unroll
        for (int T = 0; T < 16; ++T)
#pragma unroll
            for (int r = 0; r < 4; ++r) { const float e = __builtin_amdgcn_exp2f(S[T][r] * 1.44269504089f - mxl); S[T][r] = e; sum += e; }
        sum += __shfl_xor(sum, 16); sum += __shfl_xor(sum, 32);
        u32x4 Pk[8];
#pragma unroll
        for (int sl = 0; sl < 8; ++sl) { Pk[sl].x = pk2(S[2 * sl][0], S[2 * sl][1]); Pk[sl].y = pk2(S[2 * sl][2], S[2 * sl][3]); Pk[sl].z = pk2(S[2 * sl + 1][0], S[2 * sl + 1][1]); Pk[sl].w = pk2(S[2 * sl + 1][2], S[2 * sl + 1][3]); }
        f32x4 O[4];
#pragma unroll
        for (int dt = 0; dt < 4; ++dt) O[dt] = (f32x4){0.f, 0.f, 0.f, 0.f};
#pragma unroll
        for (int sl = 0; sl < 8; ++sl) {
            if (sl <= 4) asm volatile("s_waitcnt vmcnt(12)" ::: "memory"); else if (sl == 5) asm volatile("s_waitcnt vmcnt(8)" ::: "memory"); else if (sl == 6) asm volatile("s_waitcnt vmcnt(4)" ::: "memory"); else asm volatile("s_waitcnt vmcnt(0)" ::: "memory");
            const unsigned a0 = vb_addr + (sl & 3) * 4096 + (8 * qd + (hd >> 2)) * 128 + (hd & 3) * 8;
            u32x2 tr[4][2];
            asm volatile("ds_read_b64_tr_b16 %0, %8\n\tds_read_b64_tr_b16 %1, %8 offset:512\n\tds_read_b64_tr_b16 %2, %8 offset:32\n\tds_read_b64_tr_b16 %3, %8 offset:544\n\t"
                         "ds_read_b64_tr_b16 %4, %8 offset:64\n\tds_read_b64_tr_b16 %5, %8 offset:576\n\tds_read_b64_tr_b16 %6, %8 offset:96\n\tds_read_b64_tr_b16 %7, %8 offset:608\n\ts_waitcnt lgkmcnt(0)"
                         : "=&v"(tr[0][0]), "=&v"(tr[0][1]), "=&v"(tr[1][0]), "=&v"(tr[1][1]), "=&v"(tr[2][0]), "=&v"(tr[2][1]), "=&v"(tr[3][0]), "=&v"(tr[3][1]) : "v"(a0) : "memory");
            if (sl + 4 < 8) V_DMA(sl + 4);
            const bf16x8 Pf = __builtin_bit_cast(bf16x8, Pk[sl]);
#pragma unroll
            for (int dt = 0; dt < 4; ++dt) { u32x4 vw; vw.x = tr[dt][0].x; vw.y = tr[dt][0].y; vw.z = tr[dt][1].x; vw.w = tr[dt][1].y;
                O[dt] = __builtin_amdgcn_mfma_f32_16x16x32_bf16(__builtin_bit_cast(bf16x8, vw), Pf, O[dt], 0, 0, 0); }
        }
#undef V_DMA
        const float inv = 1.0f / sum;
        if (hd < 8) {
#pragma unroll
            for (int dt = 0; dt < 4; ++dt) { u32x2 w; w.x = pk2(O[dt][0] * inv, O[dt][1] * inv); w.y = pk2(O[dt][2] * inv, O[dt][3] * inv);
                *(u32x2*)(YA + tok * 512 + hd * 64 + dt * 16 + qd * 4) = w; } }
    }
}

#define DPP_F(v, ctrl, rmask) __builtin_bit_cast(float, __builtin_amdgcn_update_dpp(__builtin_bit_cast(int, v), __builtin_bit_cast(int, v), ctrl, rmask, 0xf, false))
__device__ __forceinline__ float wave_max_dpp(float v) {
    asm volatile("s_nop 1\n\tv_max_f32_dpp %0, %0, %0 row_shr:1 row_mask:0xf bank_mask:0xf\n\ts_nop 1\n\tv_max_f32_dpp %0, %0, %0 row_shr:2 row_mask:0xf bank_mask:0xf\n\ts_nop 1\n\t"
                 "v_max_f32_dpp %0, %0, %0 row_shr:3 row_mask:0xf bank_mask:0xf\n\ts_nop 1\n\tv_max_f32_dpp %0, %0, %0 row_shr:4 row_mask:0xf bank_mask:0xf\n\ts_nop 1\n\t"
                 "v_max_f32_dpp %0, %0, %0 row_shr:8 row_mask:0xf bank_mask:0xf\n\ts_nop 1\n\tv_max_f32_dpp %0, %0, %0 row_bcast:15 row_mask:0xa bank_mask:0xf\n\ts_nop 1\n\t"
                 "v_max_f32_dpp %0, %0, %0 row_bcast:31 row_mask:0xc bank_mask:0xf\n\ts_nop 1" : "+v"(v));
    return __builtin_bit_cast(float, __builtin_amdgcn_readlane(__builtin_bit_cast(int, v), 63));
}
#define DPP_Z(v, ctrl, rmask, bmask) __builtin_bit_cast(float, __builtin_amdgcn_update_dpp(0, __builtin_bit_cast(int, v), ctrl, rmask, bmask, false))
__device__ __forceinline__ float wave_sum_dpp(float v0) {
    float v1 = v0 + DPP_Z(v0, 0x111, 0xf, 0xf); v1 += DPP_Z(v0, 0x112, 0xf, 0xf); v1 += DPP_Z(v0, 0x113, 0xf, 0xf);
    v1 += DPP_Z(v1, 0x114, 0xf, 0xe); v1 += DPP_Z(v1, 0x118, 0xf, 0xc);
    v1 += DPP_Z(v1, 0x142, 0xa, 0xf); v1 += DPP_Z(v1, 0x143, 0xc, 0xf);
    return __builtin_bit_cast(float, __builtin_amdgcn_readlane(__builtin_bit_cast(int, v1), 63));
}
constexpr int RT_LG = 0;
constexpr int RT_ENT = 32768;
constexpr int RT_HIST = RT_ENT + 8 * 128 * 12;
constexpr int RT_NV = 49152;
__device__ __forceinline__ void route_tile(const Params& p, LAS unsigned char* lds, int tile, int skip) {
    const int tid = tidx(), lane = tid & 63, wave = __builtin_amdgcn_readfirstlane(tid >> 6), hd = lane & 15, qd = lane >> 4;
    const float* ada = (const float*)(p.ws + WS_ADA); const float* g2 = p.in[19];
    bf16_t* U2 = (bf16_t*)(p.ws + WS_U);
    LAS int* hist = (LAS int*)(lds + RT_HIST);
    LAS float* LGT = (LAS float*)(lds + RT_LG);
    LAS int* ENT = (LAS int*)(lds + RT_ENT) + wave * 384;
    const int b = (tile * 128) >> 12;
    __syncthreads();
    if (tid < 64) hist[tid] = 0;
    if (tid == 64) hist[128] = 0;
    { LAS float* NV = (LAS float*)(lds + RT_NV);
      for (int i = tid; i < 256; i += NTHR) { const f32x4 g = *(const f32x4*)(g2 + 4 * i), sc = *(const f32x4*)(ada + b * 6144 + 4096 + 4 * i), sh = *(const f32x4*)(ada + b * 6144 + 3072 + 4 * i);
          *(LAS f32x4*)(NV + 4 * i) = g * (sc + 1.0f); *(LAS f32x4*)(NV + 1024 + 4 * i) = sh; } }
    __syncthreads();
    if (wave < 4) {
        const int tokw = tile * 128 + wave * 32;
        float rstd[2]; const bf16_t* hrow[2];
#pragma unroll
        for (int rt = 0; rt < 2; ++rt) { const int m = tokw + rt * 16 + hd; hrow[rt] = (const bf16_t*)(p.out + (size_t)m * D) + qd * 8;
            const f32x4 q4 = *(const f32x4*)((const float*)(p.ws + WS_SS) + (size_t)m * 16 + qd * 4); float ss = (q4.x + q4.y) + (q4.z + q4.w);
            ss += __shfl_xor(ss, 16); ss += __shfl_xor(ss, 32); rstd[rt] = 1.0f / sqrtf(ss * (1.f / D) + EPS); }
        const bf16x8* WH = (const bf16x8*)(p.ws + WS_WRF) + lane; const bf16x8* WL = WH + 32 * 4 * 64;
        f32x4 acc[2][4];
#pragma unroll
        for (int rt = 0; rt < 2; ++rt)
#pragma unroll
            for (int nt = 0; nt < 4; ++nt) acc[rt][nt] = (f32x4){0.f, 0.f, 0.f, 0.f};
        bf16x8 wh[4], wl[4], whn[4], wln[4]; u32x4 xa[2], xn[2], xnn[2];
#pragma unroll
        for (int nt = 0; nt < 4; ++nt) { wh[nt] = WH[nt * 64]; wl[nt] = WL[nt * 64]; }
#pragma unroll
        for (int rt = 0; rt < 2; ++rt) { xa[rt] = *(const u32x4*)(hrow[rt]); xn[rt] = *(const u32x4*)(hrow[rt] + 32); }
#pragma unroll 2
        for (int ks = 0; ks < 32; ++ks) {
            const int kn = (ks + 1 < 32) ? ks + 1 : ks;
#pragma unroll
            for (int nt = 0; nt < 4; ++nt) { whn[nt] = WH[(kn * 4 + nt) * 64]; wln[nt] = WL[(kn * 4 + nt) * 64]; }
#pragma unroll
            for (int rt = 0; rt < 2; ++rt) xnn[rt] = *(const u32x4*)(hrow[rt] + ((ks + 2 < 32) ? ks + 2 : ks) * 32);
            const int c0 = ks * 32 + qd * 8;
            const LAS float* NV = (const LAS float*)(lds + RT_NV);
            const f32x4 ma = *(const LAS f32x4*)(NV + c0), mb = *(const LAS f32x4*)(NV + c0 + 4), ha = *(const LAS f32x4*)(NV + 1024 + c0), hb = *(const LAS f32x4*)(NV + 1024 + c0 + 4);
#pragma unroll
            for (int rt = 0; rt < 2; ++rt) {
                const f32x4 x0 = {bflo(xa[rt].x), bfhi(xa[rt].x), bflo(xa[rt].y), bfhi(xa[rt].y)}, x1 = {bflo(xa[rt].z), bfhi(xa[rt].z), bflo(xa[rt].w), bfhi(xa[rt].w)};
                const f32x4 y0 = x0 * rstd[rt] * ma + ha, y1 = x1 * rstd[rt] * mb + hb;
                const u32x4 hi = pack8(y0, y1);
                f32x4 r0, r1; r0.x = y0.x - bflo(hi.x); r0.y = y0.y - bfhi(hi.x); r0.z = y0.z - bflo(hi.y); r0.w = y0.w - bfhi(hi.y);
                r1.x = y1.x - bflo(hi.z); r1.y = y1.y - bfhi(hi.z); r1.z = y1.z - bflo(hi.w); r1.w = y1.w - bfhi(hi.w);
                const bf16x8 uh = __builtin_bit_cast(bf16x8, hi), ul = __builtin_bit_cast(bf16x8, pack8(r0, r1));
#pragma unroll
                for (int nt = 0; nt < 4; ++nt) {
                    acc[rt][nt] = __builtin_amdgcn_mfma_f32_16x16x32_bf16(wh[nt], uh, acc[rt][nt], 0, 0, 0);
                    acc[rt][nt] = __builtin_amdgcn_mfma_f32_16x16x32_bf16(wl[nt], uh, acc[rt][nt], 0, 0, 0);
                    acc[rt][nt] = __builtin_amdgcn_mfma_f32_16x16x32_bf16(wh[nt], ul, acc[rt][nt], 0, 0, 0); } }
#pragma unroll
            for (int nt = 0; nt < 4; ++nt) { wh[nt] = whn[nt]; wl[nt] = wln[nt]; }
#pragma unroll
            for (int rt = 0; rt < 2; ++rt) { xa[rt] = xn[rt]; xn[rt] = xnn[rt]; }
        }
#pragma unroll
        for (int rt = 0; rt < 2; ++rt)
#pragma unroll
            for (int nt = 0; nt < 4; ++nt) *(LAS f32x4*)(LGT + (wave * 32 + rt * 16 + hd) * 64 + nt * 16 + qd * 4) = acc[rt][nt];
    }
    {
        LAS int* rowctr = hist + 128;
        LAS const float* NV = (LAS const float*)(lds + RT_NV);
        auto claim = [&]() -> int { int r = 0; if (lane == 0) r = __hip_atomic_fetch_add(rowctr, 1, __ATOMIC_RELAXED, __HIP_MEMORY_SCOPE_WORKGROUP); return __builtin_amdgcn_readfirstlane(r); };
        const float* SSp = (const float*)(p.ws + WS_SS);
#define RT_ROWLOAD(vv, sv, rr) do { if ((rr) < 128) { const int m_ = tile * 128 + (rr); const u32x4* xr_ = (const u32x4*)(p.out + (size_t)m_ * D) + lane; vv[0] = xr_[0]; vv[1] = xr_[64]; sv = SSp[(size_t)m_ * 16 + (lane & 15)]; } } while (0)
        int r = claim(), rn = claim(); u32x4 v[2] = {}, vn[2] = {}; float ssl = 0.f, ssn = 0.f;
        RT_ROWLOAD(v, ssl, r); RT_ROWLOAD(vn, ssn, rn);
        while (r < 128) {
            const int rnn = (rn < 128) ? claim() : 128; u32x4 vnn[2] = {vn[0], vn[1]}; float ssnn = 0.f;
            RT_ROWLOAD(vnn, ssnn, rnn);
            float ss = ssl; ss += __shfl_xor(ss, 1); ss += __shfl_xor(ss, 2); ss += __shfl_xor(ss, 4); ss += __shfl_xor(ss, 8);
            const float rstd = 1.0f / sqrtf(ss * (1.f / D) + EPS);
            u32x4* o16 = (u32x4*)(U2 + (size_t)(tile * 128 + r) * D) + lane;
#pragma unroll
            for (int j = 0; j < 2; ++j) { const int c0 = 8 * lane + 512 * j;
                const f32x4 ma = *(LAS const f32x4*)(NV + c0), mb = *(LAS const f32x4*)(NV + c0 + 4), sh = *(LAS const f32x4*)(NV + 1024 + c0), sb = *(LAS const f32x4*)(NV + 1024 + c0 + 4);
                const f32x4 x0 = {bflo(v[j].x), bfhi(v[j].x), bflo(v[j].y), bfhi(v[j].y)}, x1 = {bflo(v[j].z), bfhi(v[j].z), bflo(v[j].w), bfhi(v[j].w)};
                o16[64 * j] = pack8(x0 * rstd * ma + sh, x1 * rstd * mb + sb); }
            v[0] = vn[0]; v[1] = vn[1]; vn[0] = vnn[0]; vn[1] = vnn[1];
            ssl = ssn; ssn = ssnn; r = rn; rn = rnn;
        }
#undef RT_ROWLOAD
    }
    __syncthreads();
    const int tok0 = tile * 128 + wave * 16;
    LAS float* LG = LGT + wave * 1024;
    const float rbias = p.in[21][lane];
#pragma unroll 1
    for (int mi = 0; mi < 16; ++mi) {
        const float score = sigmoidf_(LG[mi * 64 + lane]); const float biased = score + rbias;
        float m1 = biased;
        m1 = fmaxf(m1, DPP_F(m1, 0xb1, 0xf)); m1 = fmaxf(m1, DPP_F(m1, 0x4e, 0xf)); m1 = fmaxf(m1, DPP_F(m1, 0x141, 0xf));
        const unsigned long long bal = __ballot(biased == m1); const int grp = lane >> 3;
        const unsigned gm = (unsigned)((bal >> (grp * 8)) & 0xffull); const int first = __ffs((int)gm) - 1;
        float v2 = ((lane & 7) == first) ? -INFINITY : biased;
        v2 = fmaxf(v2, DPP_F(v2, 0xb1, 0xf)); v2 = fmaxf(v2, DPP_F(v2, 0x4e, 0xf)); v2 = fmaxf(v2, DPP_F(v2, 0x141, 0xf));
        const float gscore = m1 + v2;
        int grank = 0;
#pragma unroll
        for (int og = 0; og < 8; ++og) { const float o = __builtin_bit_cast(float, __builtin_amdgcn_readlane(__builtin_bit_cast(int, gscore), og * 8)); grank += (o > gscore || (o == gscore && og < grp)) ? 1 : 0; }
        float mv = (grank < 4) ? biased : -INFINITY;
        unsigned long long chosen_m = 0ull;
#pragma unroll 1
        for (int it = 0; it < 8; ++it) { const float mxv = wave_max_dpp(mv); const unsigned long long e = __ballot(mv == mxv); const int w = (int)__builtin_ctzll(e); chosen_m |= 1ull << w; if (lane == w) mv = -INFINITY; }
        const bool chosen = (chosen_m >> lane) & 1ull;
        const int rank = (int)__builtin_amdgcn_mbcnt_hi((unsigned)(chosen_m >> 32), __builtin_amdgcn_mbcnt_lo((unsigned)chosen_m, 0u));
        const float gsum = wave_sum_dpp(chosen ? score : 0.f);
        if (chosen) { const int lpos = __hip_atomic_fetch_add(hist + lane, 1, __ATOMIC_RELAXED, __HIP_MEMORY_SCOPE_WORKGROUP);   const int e = mi * 8 + rank; ENT[e * 3] = lane; ENT[e * 3 + 1] = lpos; ENT[e * 3 + 2] = __builtin_bit_cast(int, score / gsum * 2.5f); }
    }
    __syncthreads();
    const int ch = (tile * 128) / CHTOK;
    if (skip) return;
    if (tid < 64) { const int c = hist[tid]; int base = 0; if (c > 0) base = (int)atomicAdd((unsigned*)(p.ws + WS_CTL) + CW_CNT + ch * NE + tid, (unsigned)c); hist[64 + tid] = base; }
    __syncthreads();
#pragma unroll
    for (int i = 0; i < 2; ++i) { const int e = lane + 64 * i; const int ex = ENT[e * 3], lpos = ENT[e * 3 + 1]; const float gate = __builtin_bit_cast(float, ENT[e * 3 + 2]);
        const int m = tok0 + (e >> 3), rk = e & 7, pair = ch * NE + ex, ps = hist[64 + ex] + lpos;
        ((int*)(p.ws + WS_DSTL))[(size_t)pair * PAIRCAP + ps] = (m - ch * CHTOK) * NSLOT + rk; ((float*)(p.ws + WS_GATEL))[(size_t)pair * PAIRCAP + ps] = gate; }
}

#define XB_TMO      128
#define XB_XCNT(j)  (256  + 64 * (j))
#define XB_XSUB(j)  (1280 + 64 * (j))
#define XB_XGEN(j)  (2304 + 64 * (j))
#define XB_TOP      3328
#define XB_TOPGEN   3392
#define XCD_BAR_WORDS 3456
#define XB_SPIN_CAP (1u << 22)
__device__ __forceinline__ unsigned xb_ld(unsigned* p)              { return __hip_atomic_load(p, __ATOMIC_RELAXED, __HIP_MEMORY_SCOPE_AGENT); }
__device__ __forceinline__ unsigned xb_add(unsigned* p, unsigned v) { return __hip_atomic_fetch_add(p, v, __ATOMIC_RELAXED, __HIP_MEMORY_SCOPE_AGENT); }
__device__ __forceinline__ unsigned xb_xcc_id() { return (unsigned)__builtin_amdgcn_s_getreg((3 << 11) | 20) & 0xFu; }
#define XB_SPIN(cond, bar) do { unsigned _sp = 0; while (cond) { __builtin_amdgcn_s_sleep(1); \
    if ((++_sp & 255u) == 0u) { if (xb_ld(&(bar)[XB_TMO])) break; if (_sp > XB_SPIN_CAP) { atomicAdd(&(bar)[XB_TMO], 1u); break; } } } } while (0)
struct XcdBarrier { unsigned* bar; unsigned x; volatile LAS unsigned* st; };
__device__ __forceinline__ XcdBarrier xcd_barrier_post(unsigned* bar, volatile LAS unsigned* st) {
    XcdBarrier b; b.bar = bar; b.x = xb_xcc_id(); b.st = st;
    if (tidx() == 0) (void)xb_add(&bar[XB_XCNT(b.x)], 1u);
    return b;
}
__device__ __forceinline__ void xcd_barrier_complete(unsigned* bar, unsigned x, unsigned& nloc, unsigned& nx) {
    const unsigned G = gridDim.x * gridDim.y * gridDim.z;
    unsigned sum, cnt, mine, sp = 0u;
    for (;;) {
        sum = 0u; cnt = 0u; mine = 0u;
#pragma unroll
        for (unsigned j = 0; j < 16; ++j) { const unsigned c = xb_ld(&bar[XB_XCNT(j)]); sum += c; cnt += (c > 0u) ? 1u : 0u; mine = (j == x) ? c : mine; }
        if (sum == G) break;
        __builtin_amdgcn_s_sleep(1);
        if ((++sp & 255u) == 0u) { if (xb_ld(&bar[XB_TMO])) break; if (sp > XB_SPIN_CAP) { atomicAdd(&bar[XB_TMO], 1u); break; } }
    }
    nloc = mine > 0u ? mine : 1u; nx = cnt > 0u ? cnt : 1u;
}
__device__ __forceinline__ void xcd_barrier(const XcdBarrier& b) {
    asm volatile("s_waitcnt vmcnt(0)" ::: "memory");
    __syncthreads();
    if (tidx() == 0) {
        unsigned* bar = b.bar;
        __builtin_amdgcn_s_waitcnt(0);
        unsigned nloc = b.st[0], nx = b.st[1];
        if (nloc == 0u) { xcd_barrier_complete(bar, b.x, nloc, nx); b.st[0] = nloc; b.st[1] = nx; }
        const unsigned old = xb_add(&bar[XB_XSUB(b.x)], 1u);
        const unsigned gen = old / nloc;
        if (old + 1u == (gen + 1u) * nloc) {
            __builtin_amdgcn_fence(__ATOMIC_RELEASE, "agent");
            asm volatile("s_waitcnt vmcnt(0)" ::: "memory");
            const unsigned og = xb_add(&bar[XB_TOP], 1u);
            const unsigned tg = og / nx;
            if (og + 1u == (tg + 1u) * nx) xb_add(&bar[XB_TOPGEN], 1u);
            else XB_SPIN(xb_ld(&bar[XB_TOPGEN]) == tg, bar);
            __builtin_amdgcn_fence(__ATOMIC_ACQUIRE, "agent");
            xb_add(&bar[XB_XGEN(b.x)], 1u);
            asm volatile("s_waitcnt vmcnt(0)" ::: "memory");
        } else {
            XB_SPIN(xb_ld(&bar[XB_XGEN(b.x)]) == gen, bar);
            __builtin_amdgcn_fence(__ATOMIC_ACQUIRE, "agent");
            asm volatile("s_waitcnt vmcnt(0)" ::: "memory");
        }
    }
    __syncthreads();
}

enum { PH_PREP = 0, PH_MOD, PH_INPROJ, PH_MIX  , PH_GLU, PH_MIXAB, PH_OUT, PH_ROUTE  , PH_MOE1, PH_MOE2_0, PH_COMB_0, PH_END };

#ifndef USE_CG_SYNC
#define USE_CG_SYNC 0
#endif
__global__ void __launch_bounds__(NTHR, 2) mega(Params p_arg) {
    extern __shared__ __attribute__((aligned(16))) unsigned char lds_raw[];
    LAS unsigned char* lds = (LAS unsigned char*)lds_raw;
    const int G = gridDim.x, bx = blockIdx.x;
    const int vcu = (G % 8 == 0) ? (bx % 8) * (G / 8) + bx / 8 : bx;
    const int tid = tidx(), lane = tid & 63, wave = __builtin_amdgcn_readfirstlane(tid >> 6);
    unsigned char* const ws_ = p_arg.ws; unsigned char* ws = ws_; (void)ws;
    if (tid < 32) ((LAS unsigned*)(lds + LDS_MISC))[tid] = 0u;
    __syncthreads();
#if USE_CG_SYNC
    cg::grid_group grid = cg::this_grid();
#define GRID_SYNC() grid.sync()
#else
    XcdBarrier xbar = xcd_barrier_post((unsigned*)(ws + WS_CTL) + CW_BAR, (volatile LAS unsigned*)(lds + LDS_MISC) + 8);
#define GRID_SYNC() xcd_barrier(xbar)
#endif
#ifndef ONLY_PH
#define ONLY_PH -1
#endif
#define IN(k) (ONLY_PH < 0 || ONLY_PH == (k))
#define SEAM(k) do { if ((k) + 1 < PH_END) GRID_SYNC(); } while (0)
#ifndef REP_PH
#define REP_PH -1
#endif
#ifndef REP_N
#define REP_N 3
#endif
#ifndef PROBE_NOSTORE
#define PROBE_NOSTORE 0
#endif
#define PHASE(k, ...) do { if (IN(k)) { { const int PROBE_SKIP = 0; unsigned zoff_ = 0u; asm volatile("" : "+s"(zoff_)); unsigned char* ws = ws_ + zoff_; const Params& p = *(const Params*)((const char*)&p_arg + zoff_); __VA_ARGS__ } if ((REP_PH) == (k)) { GRID_SYNC(); { const int PROBE_SKIP = PROBE_NOSTORE; unsigned zoff_ = 0u; asm volatile("" : "+s"(zoff_)); unsigned char* ws = ws_ + zoff_; const Params& p = *(const Params*)((const char*)&p_arg + zoff_); __VA_ARGS__ } GRID_SYNC(); { const int PROBE_SKIP = PROBE_NOSTORE; unsigned zoff_ = 0u; asm volatile("" : "+s"(zoff_)); unsigned char* ws = ws_ + zoff_; const Params& p = *(const Params*)((const char*)&p_arg + zoff_); __VA_ARGS__ } } } SEAM(k); } while (0)
    PHASE(PH_PREP, p0_prep(p, lds, vcu, G););
    PHASE(PH_MOD, p1_modulate(p, vcu, G););
    PHASE(PH_INPROJ, {
        pg8::DenseSched S; S.init(ws + WS_U, ws + WS_W_IN, NTOK, NIN, 1024, G, bx);
        EpiInProj E{(bf16_t*)(ws + WS_PROJ), (bf16_t*)(ws + WS_G), (bf16_t*)(ws + WS_KIF)};
        pg8::gemm_phase<EpiInProj, pg8::DenseSched, false>(lds, 1024, S, E);
        if (G == 256 && bx >= 128) { __syncthreads(); run_transposes(p, ws, lds, T_NITEMS - T_LATE2 - T_LATE, T_NITEMS - T_LATE2, (bx - 128) * NWAVES + wave, 128 * NWAVES); } });
    PHASE(PH_MIX, {
#ifdef GOLD_S5
        for (int it = vcu + G * wave; it < 256; it += G * NWAVES) gold_s5(p, it, lane);
#else
#ifndef REP_S5
#define REP_S5 1
#endif
#ifndef REP_ATTN
#define REP_ATTN 1
#endif
        for (int r_ = 0; r_ < REP_S5; ++r_) for (int it = vcu; it < 256; it += G) s5_item(p, lds, it);
#endif
#ifdef GOLD_ATTN
        for (int pr = vcu; pr < NTOK / 2; pr += G) gold_attn_pair(p, lds, pr);
#else
        for (int r_ = 0; r_ < REP_ATTN; ++r_) {
            for (int k = 0; ; ++k) { int ab, aq;
                int nb_ = 0, nq_ = -1;
                if (G == 256) { if (k >= 16) break; ab = vcu >> 5; aq = 511 - ((vcu & 31) + 32 * k); nb_ = ab; nq_ = (k + 1 < 16) ? aq - 32 : -1; }
                else { const int it = vcu + k * G; if (it >= NTOK / 8) break; ab = it & 7; aq = 511 - (it >> 3); const int itn = it + G; if (itn < NTOK / 8) { nb_ = itn & 7; nq_ = 511 - (itn >> 3); } }
                attn_item(p, lds, ab, aq, nb_, nq_); } }
#endif
        __syncthreads(); });
    PHASE(PH_GLU, {
        pg8::DenseSched S; S.init(ws + WS_YG, ws + WS_W_GLU, NTOK, 512, 512, G, bx);
        EpiGlu E{(const bf16_t*)(ws + WS_YG), p.in[15], (bf16_t*)(ws + WS_U)};
        pg8::gemm_phase<EpiGlu, pg8::DenseSched, false>(lds, 512, S, E); });
    PHASE(PH_MIXAB, {
        MixSched S; S.D0.init(ws + WS_U, ws + WS_W_PS, NTOK, 1024, 512, G, bx); S.D1.init(ws + WS_YATTN, ws + WS_W_PA, NTOK, 1024, 512, G, bx);
        EpiMix E{(const bf16_t*)(ws + WS_G), (bf16_t*)(ws + WS_MERGED)};
        pg8::gemm_phase<EpiMix, MixSched, false, false, true>(lds, 512, S, E); });
    PHASE(PH_OUT, {
        pg8::DenseSched S; S.init(ws + WS_MERGED, ws + WS_W_OUT, NTOK, 1024, 1024, G, bx);
        EpiOut E{p.in[0], (const float*)(ws + WS_ADA), p.out, (float*)(ws + WS_SS)};
        pg8::gemm_phase<EpiOut, pg8::DenseSched, false>(lds, 1024, S, E); });
    PHASE(PH_ROUTE, { for (int tile = vcu; tile < NTOK / 128; tile += G) route_tile(p, lds, tile, PROBE_SKIP); });
    PHASE(PH_MOE1, {
        build_moe_tables(lds, (const unsigned*)(ws + WS_CTL) + CW_CNT);
        Moe1Sched S{lds, G, vcu, (const char*)(ws + WS_U), (const int*)(ws + WS_DSTL), (const int*)(ws + WS_IDENT), (const char*)(ws + WS_W_EGU), (const char*)(ws + WS_W_SGU)};
        EpiMoe1 E{(bf16_t*)(ws + WS_H)};
        pg8::gemm_phase<EpiMoe1, Moe1Sched, true>(lds, 1024, S, E);
        { LAS int* TB_ = (LAS int*)(lds + LDS_TB); const int total = (RFL(TB_[256]) + 128) * 2, rem = total % G, nidle = rem ? G - rem : 0;
          __syncthreads();
          if (nidle == 0) run_transposes(p, ws, lds, T_NITEMS - T_LATE2, T_NITEMS, vcu * NWAVES + wave, G * NWAVES);
          else if (vcu >= rem) run_transposes(p, ws, lds, T_NITEMS - T_LATE2, T_NITEMS, (vcu - rem) * NWAVES + wave, nidle * NWAVES); } });
#pragma unroll
    for (int ch = 0; ch < NCHUNK; ++ch) {
        PHASE(PH_MOE2_0 + 2 * ch, {
            build_moe_tables(lds, (const unsigned*)(ws + WS_CTL) + CW_CNT);
            Moe2Sched S{lds, G, vcu, ch, ws};
            EpiMoe2 E{(unsigned char*)(ws + WS_Y), PROBE_SKIP, lds};
            pg8::gemm_phase<EpiMoe2, Moe2Sched, false, true>(lds, 256, S, E); });
        PHASE(PH_COMB_0 + 2 * ch, { p_combine(p, vcu, G, ch); });
    }
#undef IN
}

extern "C" void kernel_launch(void* const* d_in, const int* in_sizes, int n_in, void* d_out, int out_size, void* d_ws, size_t ws_size, hipStream_t stream) {
    static int grid = 0;
    if (grid == 0) {
        if (n_in != 29 || out_size != NTOK * D || ws_size < WS_NEED) { fprintf(stderr, "kernel_launch: unexpected shapes n_in %d out %d ws %zu\n", n_in, out_size, ws_size); grid = -1; return; }
        int dev = 0, cus = 0, per_cu = 0;
        hipGetDevice(&dev); hipDeviceGetAttribute(&cus, hipDeviceAttributeMultiprocessorCount, dev);
        hipFuncSetAttribute((const void*)mega, hipFuncAttributeMaxDynamicSharedMemorySize, LDS_BYTES);
        hipOccupancyMaxActiveBlocksPerMultiprocessor(&per_cu, (const void*)mega, NTHR, LDS_BYTES);
        (void)hipGetLastError();
        grid = (per_cu >= 1) ? cus : -1;
        if (grid < 0) { fprintf(stderr, "kernel_launch: occupancy query says %d blocks/CU\n", per_cu); return; }
    }
    if (grid < 0) return;
    hipMemsetAsync((char*)d_ws + WS_CTL, 0, CTL_BYTES, stream);
    Params p{};
    for (int i = 0; i < 29; ++i) p.in[i] = (const float*)d_in[i];
    p.out = (float*)d_out; p.ws = (unsigned char*)d_ws;
    p.ph_lo = 0; p.ph_hi = PH_END;
    void* args[] = {&p};
    hipError_t e = hipLaunchCooperativeKernel((const void*)mega, dim3(grid), dim3(NTHR), args, LDS_BYTES, stream);
    if (e != hipSuccess) fprintf(stderr, "kernel_launch: cooperative launch failed: %s (grid %d)\n", hipGetErrorString(e), grid);
}
```

```cpp
#include <hip/hip_runtime.h>
#include <hip/hip_cooperative_groups.h>
#include <cstdio>
#include <cstdint>
#include <cmath>
namespace cg = cooperative_groups;

#define GAS __attribute__((address_space(1)))
#define LAS __attribute__((address_space(3)))
typedef unsigned short bf16_t;
typedef short bf16x8 __attribute__((ext_vector_type(8)));
typedef float f32x4 __attribute__((ext_vector_type(4)));
typedef float f32x2 __attribute__((ext_vector_type(2)));
typedef unsigned u32x4 __attribute__((ext_vector_type(4)));
typedef unsigned u32x2 __attribute__((ext_vector_type(2)));

constexpr int NB = 8, SEQ = 4096, NTOK = NB * SEQ, D = 1024;
constexpr int IN_W = 3784, NIN = 3840, PROJ_W = 1792, G_W = 2048;
constexpr int C_USSM = 0, C_Q = 512, C_K = 1024, C_V = 1088, C_QI = 1152, C_KI = 1664, C_WI = 1728, PROJ_USED = 1736;
constexpr int NE = 64, TOPK = 8, NCHUNK = 1, CHTOK = NTOK / NCHUNK, NPAIR = NCHUNK * NE, PAIRCAP = CHTOK, NSLOT = 9;
constexpr float Y_SCALE = 64.0f;
constexpr int HROWS_ROUTED = NTOK * TOPK, HSH_ROW0 = HROWS_ROUTED + 256;
constexpr float EPS = 1e-6f;
constexpr int NWAVES = 8, NTHR = 512;

constexpr size_t MiB = 1u << 20;
constexpr size_t WS_CTL = 0, CTL_BYTES = 1 * MiB;
constexpr size_t WS_ADA = 1 * MiB;
constexpr size_t WS_ONES = 1 * MiB + 224 * 1024;
constexpr size_t WS_A32 = 1 * MiB + 256 * 1024;
constexpr size_t WS_IDENT = 1 * MiB + 512 * 1024;
constexpr size_t WS_WRF = 1 * MiB + 768 * 1024;
constexpr size_t WS_W_IN = 2 * MiB;
constexpr size_t WS_W_GLU = 10 * MiB;
constexpr size_t WS_W_PS = 11 * MiB;
constexpr size_t WS_W_PA = 12 * MiB;
constexpr size_t WS_W_OUT = 13 * MiB;
constexpr size_t WS_W_SGU = 15 * MiB;
constexpr size_t WS_W_SD = 16 * MiB;
constexpr size_t WS_TZF = 17 * MiB, WS_WINF = 18 * MiB, WS_WOUTF = 22 * MiB;
constexpr size_t WS_W_ED = 26 * MiB;
constexpr size_t WS_W_EGU = 58 * MiB;
constexpr size_t WS_KIF = 122 * MiB;
constexpr size_t WS_U = 128 * MiB;
constexpr size_t WS_PROJ = 192 * MiB;
constexpr size_t WS_G = 304 * MiB;
constexpr size_t WS_YG = 432 * MiB;
constexpr size_t WS_YATTN = 464 * MiB;
constexpr size_t WS_MERGED = 192 * MiB;
constexpr size_t WS_Y = 58 * MiB;
constexpr size_t WS_H = 346 * MiB;
constexpr size_t WS_DSTL = 492 * MiB;
constexpr size_t WS_SS = 4 * MiB;
constexpr size_t WS_GATEL = 500 * MiB;
constexpr size_t WS_NEED = 512 * MiB;
constexpr int CW_CNT = 0;
constexpr int CW_BAR = 4096;
constexpr int CW_Q0 = 1024;

constexpr int STAGE_BYTES = 131072;
constexpr int LDS_RO = STAGE_BYTES;
constexpr int LDS_MISC = LDS_RO + 2048;
constexpr int LDS_CNT = LDS_MISC + 128;
constexpr int LDS_RS = LDS_CNT + 1024;
constexpr int LDS_TB = LDS_RS + 1040;
constexpr int LDS_TD = LDS_TB + 1040;
constexpr int LDS_META = LDS_TD + 1408 * 4;
constexpr int LDS_BYTES = 147456;
static_assert(LDS_META + 4096 <= LDS_BYTES, "LDS map");

__device__ __forceinline__ unsigned f2bf(float f) { unsigned u = __builtin_bit_cast(unsigned, f); return (u + 0x7fffu + ((u >> 16) & 1u)) >> 16; }
typedef __bf16 bf16x2_t __attribute__((ext_vector_type(2)));
__device__ __forceinline__ unsigned pk2(float lo, float hi) { const f32x2 v = {lo, hi}; const bf16x2_t r = __builtin_convertvector(v, bf16x2_t); return __builtin_bit_cast(unsigned, r); }
__device__ __forceinline__ float bf2f(unsigned short b) { return __builtin_bit_cast(float, (unsigned)b << 16); }
__device__ __forceinline__ float bflo(unsigned w) { return __builtin_bit_cast(float, w << 16); }
__device__ __forceinline__ float bfhi(unsigned w) { return __builtin_bit_cast(float, w & 0xffff0000u); }
__device__ __forceinline__ float sigmoidf_(float x) { return __builtin_amdgcn_rcpf(1.0f + __builtin_amdgcn_exp2f(-1.44269504089f * x)); }
__device__ __forceinline__ float wave_sum(float v) {
#pragma unroll
    for (int o = 1; o < 64; o <<= 1) v += __shfl_xor(v, o);
    return v;
}
__device__ __forceinline__ int tidx() { int t = threadIdx.x; asm volatile("" : "+v"(t)); return t; }
#define LDS_WAIT() asm volatile("s_waitcnt lgkmcnt(0)" ::: "memory")

namespace pg8 {
constexpr int BM = 256, BK = 64, HALF = 128, HTB = HALF * BK * 2, NXCD = 8, WGM = 8;
__host__ __device__ __forceinline__ int lds_byte(int r, int c) { const int st = (r >> 4) * 2 + (c >> 5), rr = r & 15, cc = c & 31, ob = rr * 64 + cc * 2; return st * 1024 + (ob ^ (((ob >> 9) & 1) << 5)); }
__host__ __device__ __forceinline__ void stage_rc(int b, int& R, int& C) { const int st = b / 1024, sb = b % 1024, swz = sb ^ (((sb >> 9) & 1) << 5); R = (st >> 1) * 16 + swz / 64; C = (st & 1) * 32 + (swz % 64) / 2; }
__host__ __device__ __forceinline__ int perm32(int rho) { const int n = rho >> 4, i = rho & 15; return 8 * (i >> 2) + 4 * n + (i & 3); }

struct Unit { int pm, pn; const char* A; const char* B; const int* rows; int valid; int x0; int rbase; const float* gp; };

struct DenseSched {
    int nM, nN, nwg, G, c; const char* A; const char* B; size_t tstep;
    __device__ __forceinline__ void init(const void* A_, const void* B_, int M, int N, int K, int G_, int c_) { nM = M / BM; nN = N / BM; nwg = nM * nN; G = G_; c = c_; A = (const char*)A_; B = (const char*)B_; tstep = (size_t)BM * K * 2; }
    __device__ __forceinline__ bool next(int i, Unit& u) const {
        const long L = (long)i * G + c; if (L >= nwg) return false;
        int wgid = (int)L; { const int q = nwg / NXCD, r = nwg % NXCD, xcd = wgid % NXCD, off = wgid / NXCD; wgid = (xcd < r ? xcd * (q + 1) : r * (q + 1) + (xcd - r) * q) + off; }
        const int nig = WGM * nN, gid = wgid / nig, fm = gid * WGM, gsz = (nM - fm) < WGM ? (nM - fm) : WGM;
        u.pm = fm + ((wgid % nig) % gsz); u.pn = (wgid % nig) / gsz;
        u.A = A + (size_t)u.pm * tstep; u.B = B + (size_t)u.pn * tstep; u.rows = nullptr; u.valid = 256; u.x0 = 0; u.rbase = 0; u.gp = nullptr; return true;
    }
};

template <class Epi, class Sched, bool GATHER, bool RMETA = false, bool KEEPACC = false>
__device__ __forceinline__ void gemm_phase(LAS unsigned char* lds, const int K, const Sched& S, const Epi& E) {
    int tid_ = tidx(); asm volatile("" : "+v"(tid_));
    const int tid = tid_, wid = __builtin_amdgcn_readfirstlane(tid >> 6), lane = tid & 63, wr = wid >> 2, wc = wid & 3, fr = lane & 15, fq = lane >> 4;
    const int nt = K / BK;
    unsigned voffA[2], voffB[2]; int roA[2];
#pragma unroll
    for (int i = 0; i < 2; ++i) { int R, C; stage_rc(tid * 16 + i * 8192, R, C); const int Rb = (R & ~31) + perm32(R & 31);
        voffA[i] = GATHER ? (unsigned)(C * 2) : (unsigned)(R * K + C) * 2u; voffB[i] = (unsigned)(Rb * K + C) * 2u; roA[i] = R * 4; }
    const size_t kstep = (size_t)(BK * 2);
    const size_t hstep = (size_t)HALF * K * 2;
    const unsigned ldsw = (unsigned)wid * 1024u;
    const int aoff = lds_byte(wr * 64 + fr, fq * 8), boff = lds_byte(wc * 32 + fr, fq * 8);
    LAS unsigned char* ro = lds + LDS_RO;
#define PG8_SA(b, h) (((b) * 2 + (h)) * HTB)
#define PG8_SB(b, h) ((4 + (b) * 2 + (h)) * HTB)
#define PG8_STAGE_B(bufoff, gbase) do { _Pragma("unroll") for (int _i = 0; _i < 2; ++_i) \
        __builtin_amdgcn_global_load_lds((const unsigned*)((const char*)(gbase) + voffB[_i]), (LAS unsigned*)(lds + (bufoff) + ldsw + _i * 8192), 16, 0, 0); } while (0)
#define PG8_STAGE_A(bufoff, gbase, h, slot) do { _Pragma("unroll") for (int _i = 0; _i < 2; ++_i) { \
        unsigned _vo = voffA[_i]; const char* _gb = (const char*)(gbase); \
        if (GATHER) _vo += *(const LAS unsigned*)(ro + (slot) * 1024 + (h) * 512 + roA[_i]); else _gb += (h) * hstep; \
        __builtin_amdgcn_global_load_lds((const unsigned*)(_gb + _vo), (LAS unsigned*)(lds + (bufoff) + ldsw + _i * 8192), 16, 0, 0); } } while (0)
#define PG8_LDA(dst, b, h) do { _Pragma("unroll") for (int m = 0; m < 4; ++m) _Pragma("unroll") for (int k = 0; k < 2; ++k) dst[m][k] = *(const LAS bf16x8*)(lds + PG8_SA(b, h) + aoff + m * 2048 + k * 1024); } while (0)
#define PG8_LDB(dst, b, h) do { _Pragma("unroll") for (int n = 0; n < 2; ++n) _Pragma("unroll") for (int k = 0; k < 2; ++k) dst[n][k] = *(const LAS bf16x8*)(lds + PG8_SB(b, h) + boff + n * 2048 + k * 1024); } while (0)
#define PG8_MMA(ai, bj, At, Bt) do { __builtin_amdgcn_s_setprio(1); _Pragma("unroll") for (int m = 0; m < 4; ++m) _Pragma("unroll") for (int n = 0; n < 2; ++n) _Pragma("unroll") for (int k = 0; k < 2; ++k) \
        acc[ai][bj][m][n] = __builtin_amdgcn_mfma_f32_16x16x32_bf16(Bt[n][k], At[m][k], acc[ai][bj][m][n], 0, 0, 0); __builtin_amdgcn_s_setprio(0); } while (0)
#define PG8_WAIT_V(n) asm volatile("s_waitcnt vmcnt(" #n ")" ::: "memory")
#define PG8_WAIT_L(n) asm volatile("s_waitcnt lgkmcnt(" #n ")" ::: "memory")
#define PG8_BAR __builtin_amdgcn_s_barrier()
#define PG8_SCHED __builtin_amdgcn_sched_barrier(0)
    Unit cur, nxt; int ui = 0;
    if (!S.next(0, cur)) return;
    f32x4 acc[2][2][4][2];
#pragma unroll
    for (int a = 0; a < 2; ++a)
#pragma unroll
        for (int b = 0; b < 2; ++b)
#pragma unroll
            for (int m = 0; m < 4; ++m)
#pragma unroll
                for (int n = 0; n < 2; ++n) acc[a][b][m][n] = (f32x4){0.f, 0.f, 0.f, 0.f};
    bf16x8 At[4][2], B0[2][2], B1[2][2];
    const char* cA = cur.A; const char* cB = cur.B;
    if (GATHER) {
        if (tid < 256) { const int r = tid < cur.valid ? cur.rbase + cur.rows[tid] / NSLOT : 0; *(LAS unsigned*)(ro + tid * 4) = (unsigned)r * (unsigned)(K * 2); }
        __syncthreads();
    }
    PG8_STAGE_B(PG8_SB(0, 0), cB); PG8_STAGE_B(PG8_SB(0, 1), cB + hstep); PG8_STAGE_A(PG8_SA(0, 0), cA, 0, 0); PG8_STAGE_A(PG8_SA(0, 1), cA, 1, 0);
    if (wr == 1) PG8_BAR;
    PG8_WAIT_V(2); PG8_BAR;
    PG8_STAGE_B(PG8_SB(1, 0), cB + kstep); PG8_STAGE_A(PG8_SA(1, 0), cA + kstep, 0, 0); PG8_STAGE_B(PG8_SB(1, 1), cB + hstep + kstep);
    PG8_WAIT_V(6); PG8_BAR;
    for (;;) {
        const bool has_next = S.next(ui + 1, nxt);
        const int cslot = ui & 1, nslot = has_next ? (cslot ^ 1) : cslot;
        int pre_r = 0;
        if (GATHER) { if (has_next && tid < 256 && tid < nxt.valid) pre_r = nxt.rows[tid]; }
        if (RMETA) { if (wid < 4) {
            __builtin_amdgcn_global_load_lds((const unsigned*)(cur.gp + lane + wid * 64), (LAS unsigned*)(lds + LDS_META + cslot * 1024 + wid * 256), 4, 0, 0);
            __builtin_amdgcn_global_load_lds((const unsigned*)(cur.rows + lane + wid * 64), (LAS unsigned*)(lds + LDS_META + 2048 + cslot * 1024 + wid * 256), 4, 0, 0); } }
        const char* nA = has_next ? nxt.A : cA; const char* nB = has_next ? nxt.B : cB;
#pragma unroll 1
        for (int t = 0; t < nt; t += 2) {
            const bool last = (t == nt - 2);
            const char* a1 = cA + (size_t)(t + 1) * kstep;
            const char* a2 = last ? nA : cA + (size_t)(t + 2) * kstep; const char* b2 = last ? nB : cB + (size_t)(t + 2) * kstep;
            const char* a3 = a2 + kstep; const char* b3 = b2 + kstep;
            const int slot2 = last ? nslot : cslot;
            if (t == 2 || nt == 2) {
                if (GATHER) { if (has_next && tid < 256) { const int r = tid < nxt.valid ? nxt.rbase + pre_r / NSLOT : 0; *(LAS unsigned*)(ro + nslot * 1024 + tid * 4) = (unsigned)r * (unsigned)(K * 2); } }
            }
            PG8_LDB(B0, 0, 0); PG8_LDB(B1, 0, 1); PG8_SCHED; PG8_LDA(At, 0, 0); PG8_STAGE_A(PG8_SA(1, 1), a1, 1, cslot);
            PG8_WAIT_V(8); PG8_WAIT_L(0); PG8_BAR; PG8_MMA(0, 0, At, B0); PG8_MMA(0, 1, At, B1); PG8_BAR; PG8_SCHED;
            PG8_LDA(At, 0, 1); PG8_STAGE_B(PG8_SB(0, 0), b2); PG8_STAGE_B(PG8_SB(0, 1), b2 + hstep); PG8_STAGE_A(PG8_SA(0, 0), a2, 0, slot2);
            PG8_WAIT_V(8); PG8_WAIT_L(0); PG8_BAR; PG8_MMA(1, 0, At, B0); PG8_MMA(1, 1, At, B1); PG8_BAR; PG8_SCHED;
            PG8_LDB(B0, 1, 0); PG8_LDB(B1, 1, 1); PG8_SCHED; PG8_LDA(At, 1, 0); PG8_STAGE_A(PG8_SA(0, 1), a2, 1, slot2);
            PG8_WAIT_V(8); PG8_WAIT_L(0); PG8_BAR; PG8_MMA(0, 0, At, B0); PG8_MMA(0, 1, At, B1); PG8_BAR; PG8_SCHED;
            PG8_LDA(At, 1, 1); PG8_STAGE_B(PG8_SB(1, 0), b3); PG8_STAGE_B(PG8_SB(1, 1), b3 + hstep); PG8_STAGE_A(PG8_SA(1, 0), a3, 0, slot2);
            PG8_WAIT_V(8); PG8_WAIT_L(0); PG8_BAR; PG8_MMA(1, 0, At, B0); PG8_MMA(1, 1, At, B1); PG8_BAR; PG8_SCHED;
        }
        if (wr == 0) PG8_BAR;
        E(acc, cur, wr, wc, fr, fq, lds + LDS_META + (ui & 1) * 1024);
        if (!has_next) break;
        if (!KEEPACC || nxt.x0 == 0) {
#pragma unroll
        for (int a = 0; a < 2; ++a)
#pragma unroll
            for (int b = 0; b < 2; ++b)
#pragma unroll
                for (int m = 0; m < 4; ++m)
#pragma unroll
                    for (int n = 0; n < 2; ++n) acc[a][b][m][n] = (f32x4){0.f, 0.f, 0.f, 0.f};
        }
        cur = nxt; cA = nA; cB = nB; ++ui;
        if (wr == 1) PG8_BAR;
    }
    PG8_WAIT_V(0);
    PG8_BAR;
#undef PG8_SA
#undef PG8_SB
#undef PG8_STAGE_A
#undef PG8_STAGE_B
#undef PG8_LDA
#undef PG8_LDB
#undef PG8_MMA
#undef PG8_WAIT_V
#undef PG8_WAIT_L
#undef PG8_BAR
#undef PG8_SCHED
}
}
using pg8::Unit;

#define EPI_LOOP_BEGIN \
    _Pragma("unroll") for (int ai = 0; ai < 2; ++ai) _Pragma("unroll") for (int m = 0; m < 4; ++m) { const int rl = ai * 128 + wr * 64 + m * 16 + fr; const int row = u.pm * 256 + rl; \
    _Pragma("unroll") for (int bj = 0; bj < 2; ++bj) { const int col = u.pn * 256 + bj * 128 + wc * 32 + 8 * fq; const f32x4 v0 = acc[ai][bj][m][0], v1 = acc[ai][bj][m][1]; (void)row; (void)col; (void)rl;
#define EPI_LOOP_END } if (m == 3) asm volatile("" ::: "memory"); }
__device__ __forceinline__ u32x4 pack8(const f32x4 a, const f32x4 b) { u32x4 w; w.x = pk2(a[0], a[1]); w.y = pk2(a[2], a[3]); w.z = pk2(b[0], b[1]); w.w = pk2(b[2], b[3]); return w; }
__device__ __forceinline__ void unpack8(const u32x4 w, float (&f)[8]) { f[0] = bflo(w.x); f[1] = bfhi(w.x); f[2] = bflo(w.y); f[3] = bfhi(w.y); f[4] = bflo(w.z); f[5] = bfhi(w.z); f[6] = bflo(w.w); f[7] = bfhi(w.w); }

struct EpiInProj {
    bf16_t* PROJ; bf16_t* G; bf16_t* KIF;
    __device__ __forceinline__ void operator()(const f32x4 (&acc)[2][2][4][2], const Unit& u, int wr, int wc, int fr, int fq, LAS unsigned char* meta) const {
        if (u.pn < 7) {
        EPI_LOOP_BEGIN
            { const u32x4 w8 = pack8(v0, v1); *(u32x4*)(PROJ + (size_t)row * PROJ_W + col) = w8;
                if (u.pn == 6 && col >= C_KI && col < C_KI + 64) { const int d0 = col - C_KI, key = row & 4095, bb = row >> 12;
                    *(u32x4*)(KIF + ((size_t)((bb * 128 + (key >> 5)) * 4 + (d0 >> 4)) * 64 + (key & 31) + 32 * ((d0 >> 3) & 1)) * 8) = w8; } }
        EPI_LOOP_END
        } else {
            const int ch0 = (u.pn - 7) * 128 + wc * 32 + 8 * fq;
#pragma unroll
            for (int ai = 0; ai < 2; ++ai)
#pragma unroll
                for (int m = 0; m < 4; ++m) { const int row = u.pm * 256 + ai * 128 + wr * 64 + m * 16 + fr;
                    f32x4 s2a, s2b;
#pragma unroll
                    for (int j = 0; j < 4; ++j) { s2a[j] = fmaxf(sigmoidf_(acc[ai][1][m][0][j]), 1e-6f); s2b[j] = fmaxf(sigmoidf_(acc[ai][1][m][1][j]), 1e-6f); }
                    const u32x4 w2 = pack8(s2a, s2b); float s2r[8]; unpack8(w2, s2r); f32x4 r0, r1;
#pragma unroll
                    for (int j = 0; j < 4; ++j) { r0[j] = sigmoidf_(acc[ai][0][m][0][j]) * __builtin_amdgcn_rcpf(s2r[j]); r1[j] = sigmoidf_(acc[ai][0][m][1][j]) * __builtin_amdgcn_rcpf(s2r[4 + j]); }
                    *(u32x4*)(G + (size_t)row * G_W + ch0) = pack8(r0, r1); *(u32x4*)(G + (size_t)row * G_W + 1024 + ch0) = w2;
                    asm volatile("" ::: "memory"); __builtin_amdgcn_sched_barrier(0); }
        }
    }
};
struct EpiGlu {
    const bf16_t* YG; const float* bias; bf16_t* O;
    __device__ __forceinline__ void operator()(const f32x4 (&acc)[2][2][4][2], const Unit& u, int wr, int wc, int fr, int fq, LAS unsigned char* meta) const {
        f32x4 bb[2][2];
#pragma unroll
        for (int bj = 0; bj < 2; ++bj) { const int col = u.pn * 256 + bj * 128 + wc * 32 + 8 * fq; bb[bj][0] = *(const f32x4*)(bias + col); bb[bj][1] = *(const f32x4*)(bias + col + 4); }
        EPI_LOOP_BEGIN
            float y[8]; unpack8(*(const u32x4*)(YG + (size_t)row * 512 + col), y);
            const f32x4 b0 = bb[bj][0], b1 = bb[bj][1]; f32x4 o0, o1;
#pragma unroll
            for (int j = 0; j < 4; ++j) { o0[j] = y[j] * sigmoidf_(v0[j] + b0[j]); o1[j] = y[4 + j] * sigmoidf_(v1[j] + b1[j]); }
            *(u32x4*)(O + (size_t)row * 512 + col) = pack8(o0, o1);
        EPI_LOOP_END
    }
};
struct EpiMix {
    const bf16_t* G; bf16_t* O;
    __device__ __forceinline__ void operator()(f32x4 (&acc)[2][2][4][2], const Unit& u, int wr, int wc, int fr, int fq, LAS unsigned char* meta) const {
        unsigned rowl = (unsigned)(wr * 64 + fr); asm volatile("" : "+v"(rowl));
        const size_t gbase = (size_t)(u.pm * 256 + rowl) * G_W + u.pn * 256 + wc * 32 + 8 * fq + (u.x0 ? 1024 : 0);
#define EPM_LOADS u32x4 q[2][4][2]; _Pragma("unroll") for (int ai = 0; ai < 2; ++ai) _Pragma("unroll") for (int m = 0; m < 4; ++m) _Pragma("unroll") for (int bj = 0; bj < 2; ++bj) q[ai][m][bj] = *(const u32x4*)(G + gbase + (size_t)(ai * 128 + m * 16) * G_W + bj * 128)
        if (u.x0 == 0) { EPM_LOADS;
#pragma unroll
            for (int ai = 0; ai < 2; ++ai)
#pragma unroll
                for (int m = 0; m < 4; ++m)
#pragma unroll
                    for (int bj = 0; bj < 2; ++bj) { float g[8]; unpack8(q[ai][m][bj], g);
#pragma unroll
                        for (int j = 0; j < 4; ++j) { acc[ai][bj][m][0][j] *= g[j]; acc[ai][bj][m][1][j] *= g[4 + j]; } }
        } else { asm volatile("" : "+v"(rowl)); const size_t gbase = (size_t)(u.pm * 256 + rowl) * G_W + u.pn * 256 + wc * 32 + 8 * fq + 1024; EPM_LOADS;
#pragma unroll
            for (int ai = 0; ai < 2; ++ai)
#pragma unroll
                for (int m = 0; m < 4; ++m)
#pragma unroll
                    for (int bj = 0; bj < 2; ++bj) { float g2[8]; unpack8(q[ai][m][bj], g2); f32x4 o0, o1;
#pragma unroll
                        for (int j = 0; j < 4; ++j) { o0[j] = acc[ai][bj][m][0][j] * g2[j]; o1[j] = acc[ai][bj][m][1][j] * g2[4 + j]; }
                        *(u32x4*)(O + (size_t)(u.pm * 256 + ai * 128 + wr * 64 + m * 16 + fr) * D + u.pn * 256 + bj * 128 + wc * 32 + 8 * fq) = pack8(o0, o1); }
        }
#undef EPM_LOADS
    }
};
struct MixSched {
    pg8::DenseSched D0, D1;
    __device__ __forceinline__ bool next(int i, Unit& u) const { const bool ok = (i & 1) ? D1.next(i >> 1, u) : D0.next(i >> 1, u); u.x0 = i & 1; return ok; }
};
struct EpiOut {
    const float* X; const float* ada; float* O; float* SS;
    __device__ __forceinline__ void operator()(const f32x4 (&acc)[2][2][4][2], const Unit& u, int wr, int wc, int fr, int fq, LAS unsigned char* meta) const {
        f32x4 gg[2][2];
#pragma unroll
        for (int bj = 0; bj < 2; ++bj) { const float* gp = ada + (size_t)((u.pm * 256) >> 12) * 6144 + 2048 + u.pn * 256 + bj * 128 + wc * 32 + 8 * fq; gg[bj][0] = *(const f32x4*)gp; gg[bj][1] = *(const f32x4*)(gp + 4); }
        const size_t base = (size_t)(u.pm * 256 + wr * 64 + fr) * D + u.pn * 256 + wc * 32 + 8 * fq;
        f32x4 xq[3][2][2];
#define EPO_LOAD(slot, rg) do { const size_t o_ = base + (size_t)(((rg) >> 2) * 128 + ((rg) & 3) * 16) * D; _Pragma("unroll") for (int bj = 0; bj < 2; ++bj) { xq[slot][bj][0] = *(const f32x4*)(X + o_ + bj * 128); xq[slot][bj][1] = *(const f32x4*)(X + o_ + bj * 128 + 4); } } while (0)
        EPO_LOAD(0, 0); EPO_LOAD(1, 1);
#pragma unroll
        for (int rg = 0; rg < 8; ++rg) { const int ai = rg >> 2, m = rg & 3;
            if (rg + 2 < 8) EPO_LOAD((rg + 2) % 3, rg + 2);
            const size_t o_ = base + (size_t)(ai * 128 + m * 16) * D; float ss = 0.f;
#pragma unroll
            for (int bj = 0; bj < 2; ++bj) { const f32x4 o0 = xq[rg % 3][bj][0] + gg[bj][0] * acc[ai][bj][m][0], o1 = xq[rg % 3][bj][1] + gg[bj][1] * acc[ai][bj][m][1];
                *(u32x4*)((bf16_t*)O + 2 * (o_ - (size_t)(u.pn * 256 + wc * 32 + 8 * fq)) + (u.pn * 256 + wc * 32 + 8 * fq) + bj * 128) = pack8(o0, o1);
                ss += (o0.x * o0.x + o0.y * o0.y) + (o0.z * o0.z + o0.w * o0.w) + (o1.x * o1.x + o1.y * o1.y) + (o1.z * o1.z + o1.w * o1.w); }
            ss += __shfl_xor(ss, 16); ss += __shfl_xor(ss, 32);
            if (fq == 0) SS[(size_t)(u.pm * 256 + ai * 128 + wr * 64 + m * 16 + fr) * 16 + u.pn * 4 + wc] = ss;
            asm volatile("" ::: "memory"); }
#undef EPO_LOAD
    }
};
struct EpiMoe1 {
    bf16_t* H;
    __device__ __forceinline__ void operator()(const f32x4 (&acc)[2][2][4][2], const Unit& u, int wr, int wc, int fr, int fq, LAS unsigned char* meta) const {
#pragma unroll
        for (int ai = 0; ai < 2; ++ai)
#pragma unroll
            for (int m = 0; m < 4; ++m) { const int rl = ai * 128 + wr * 64 + m * 16 + fr;
                if (rl < u.valid) { f32x4 o0, o1;
#pragma unroll
                    for (int j = 0; j < 4; ++j) { const float g0 = acc[ai][0][m][0][j], g1 = acc[ai][1][m][0][j]; o0[j] = g0 * sigmoidf_(g0) * acc[ai][0][m][1][j]; o1[j] = g1 * sigmoidf_(g1) * acc[ai][1][m][1][j]; }
                    *(u32x4*)(H + (size_t)(u.x0 + rl) * 256 + u.pn * 128 + wc * 32 + 8 * fq) = pack8(o0, o1); } }
    }
};
__device__ __forceinline__ void epi_stage_write(LAS unsigned char* sc, int fr, int fq, const u32x4 w0, const u32x4 w1) {
    LAS unsigned char* rowp = sc + (fr >> 3) * 8192 + (fr & 7) * 128; const int x = fr & 7;
    *(LAS u32x4*)(rowp + ((fq ^ x) * 16)) = w0; *(LAS u32x4*)(rowp + (((4 + fq) ^ x) * 16)) = w1;
}
__device__ __forceinline__ u32x4 epi_stage_read(const LAS unsigned char* sc, int q, int lane) {
    const int r = lane >> 3, c = lane & 7; return *(const LAS u32x4*)(sc + q * 8192 + r * 128 + ((c ^ r) * 16));
}
__device__ __forceinline__ unsigned pk4_fp8(float a, float b, float c, float d) {
    a = __builtin_amdgcn_fmed3f(a, -448.f, 448.f); b = __builtin_amdgcn_fmed3f(b, -448.f, 448.f); c = __builtin_amdgcn_fmed3f(c, -448.f, 448.f); d = __builtin_amdgcn_fmed3f(d, -448.f, 448.f);
    int w = 0; w = __builtin_amdgcn_cvt_pk_fp8_f32(a, b, w, false); w = __builtin_amdgcn_cvt_pk_fp8_f32(c, d, w, true); return (unsigned)w;
}
struct EpiMoe2 {
    unsigned char* Y; int skip; LAS unsigned char* lds0;
    __device__ __forceinline__ void operator()(const f32x4 (&acc)[2][2][4][2], const Unit& u, int wr, int wc, int fr, int fq, LAS unsigned char* meta) const {
        asm volatile("" : "+v"(fr), "+v"(fq));
        const int lane = fr + 16 * fq;
        LAS unsigned char* sc0 = lds0 + 3 * pg8::HTB + (wr * 4 + wc) * 1024;
#pragma unroll
        for (int ai = 0; ai < 2; ++ai)
#pragma unroll
            for (int m = 0; m < 4; ++m) { const int rl0 = ai * 128 + wr * 64 + m * 16; LAS unsigned char* sc = sc0 + (m & 1) * 8192;
                const float g = *(const LAS float*)(meta + (rl0 + fr) * 4) * Y_SCALE;
                u32x2 w0, w1;
                w0.x = pk4_fp8(acc[ai][0][m][0][0] * g, acc[ai][0][m][0][1] * g, acc[ai][0][m][0][2] * g, acc[ai][0][m][0][3] * g); w0.y = pk4_fp8(acc[ai][0][m][1][0] * g, acc[ai][0][m][1][1] * g, acc[ai][0][m][1][2] * g, acc[ai][0][m][1][3] * g);
                w1.x = pk4_fp8(acc[ai][1][m][0][0] * g, acc[ai][1][m][0][1] * g, acc[ai][1][m][0][2] * g, acc[ai][1][m][0][3] * g); w1.y = pk4_fp8(acc[ai][1][m][1][0] * g, acc[ai][1][m][1][1] * g, acc[ai][1][m][1][2] * g, acc[ai][1][m][1][3] * g);
                *(LAS u32x2*)(sc + fr * 64 + fq * 8) = w0; *(LAS u32x2*)(sc + fr * 64 + 32 + fq * 8) = w1;
                { const int r = lane >> 2, c = lane & 3, rl = rl0 + r; const u32x4 v = *(const LAS u32x4*)(sc + r * 64 + c * 16);
                  if (rl < u.valid && !skip) { const int dst = *(const LAS int*)(meta + 2048 + rl * 4); *(u32x4*)(Y + (size_t)dst * D + u.pn * 256 + wc * 64 + c * 16) = v; } } }
    }
};

__device__ __forceinline__ void build_moe_tables(LAS unsigned char* lds, const unsigned* cnt_g) {
    LAS int* CNT = (LAS int*)(lds + LDS_CNT); LAS int* RS = (LAS int*)(lds + LDS_RS); LAS int* TB = (LAS int*)(lds + LDS_TB); LAS unsigned* TD = (LAS unsigned*)(lds + LDS_TD);
    const int tid = tidx();
    __syncthreads();
    if (tid < 256) { int c = tid < NPAIR ? (int)cnt_g[tid] : 0; c = c < 0 ? 0 : (c > PAIRCAP ? PAIRCAP : c); CNT[tid] = c; }
    __syncthreads();
    if (tid < 64) {
        int c[4], rs = 0, tb = 0;
#pragma unroll
        for (int i = 0; i < 4; ++i) { c[i] = CNT[4 * tid + i]; rs += c[i]; tb += (c[i] + 255) >> 8; }
        int srs = rs, stb = tb;
#pragma unroll
        for (int o = 1; o < 64; o <<= 1) { const int a = __shfl_up(srs, o), e = __shfl_up(stb, o); if (tid >= o) { srs += a; stb += e; } }
        int ers = srs - rs, etb = stb - tb;
#pragma unroll
        for (int i = 0; i < 4; ++i) { RS[4 * tid + i] = ers; TB[4 * tid + i] = etb; ers += c[i]; etb += (c[i] + 255) >> 8; }
        if (tid == 63) { RS[256] = srs; TB[256] = stb; }
    }
    __syncthreads();
    if (tid < 256) { const int c = CNT[tid], nt = (c + 255) >> 8, tb = TB[tid]; for (int k = 0; k < nt; ++k) TD[tb + k] = (unsigned)tid | ((unsigned)k << 9); }
    __syncthreads();
}
#define RFL(x) __builtin_amdgcn_readfirstlane(x)
struct Moe1Sched {
    LAS unsigned char* lds; int G, c; const char* U2; const int* dstl; const int* ident; const char* Wegu; const char* Wsgu;
    __device__ __forceinline__ bool next(int i, Unit& u) const {
        LAS int* CNT = (LAS int*)(lds + LDS_CNT); LAS int* RS = (LAS int*)(lds + LDS_RS); LAS int* TB = (LAS int*)(lds + LDS_TB); LAS unsigned* TD = (LAS unsigned*)(lds + LDS_TD);
        const int ntr = RFL(TB[256]); const int L = i * G + c; if (L >= (ntr + 128) * 2) return false;
        const int tau = L >> 1; u.pn = L & 1; u.pm = 0; u.A = U2; u.gp = nullptr;
        if (tau < ntr) { const unsigned d = (unsigned)RFL((int)TD[tau]); const int j = d & 511, k = d >> 9; u.valid = min(256, RFL(CNT[j]) - k * 256); u.rows = dstl + (size_t)(j * PAIRCAP + k * 256); u.x0 = RFL(RS[j]) + k * 256; u.rbase = (j >> 6) * CHTOK;
            u.B = Wegu + (size_t)(j & 63) * (512 * 1024 * 2) + (size_t)u.pn * (256 * 1024 * 2); }
        else { const int k = tau - ntr; u.valid = 256; u.rows = ident + k * 256; u.x0 = HSH_ROW0 + k * 256; u.rbase = (k / (CHTOK / 256)) * CHTOK; u.B = Wsgu + (size_t)u.pn * (256 * 1024 * 2); }
        return true;
    }
};
struct Moe2Sched {
    LAS unsigned char* lds; int G, c, ch; const unsigned char* ws;
    __device__ __forceinline__ bool next(int i, Unit& u) const {
        LAS int* CNT = (LAS int*)(lds + LDS_CNT); LAS int* RS = (LAS int*)(lds + LDS_RS); LAS int* TB = (LAS int*)(lds + LDS_TB); LAS unsigned* TD = (LAS unsigned*)(lds + LDS_TD);
        constexpr int NSH = CHTOK / 256;
        const int t0 = RFL(TB[64 * ch]), ntr = RFL(TB[64 * ch + 64]) - t0; const int L = i * G + c; if (L >= (ntr + NSH) * 4) return false;
        const int tau = L >> 2; u.pn = L & 3; u.pm = 0; u.rbase = 0; u.x0 = 0;
        if (tau < ntr) { const unsigned d = (unsigned)RFL((int)TD[t0 + tau]); const int j = d & 511, k = d >> 9; u.valid = min(256, RFL(CNT[j]) - k * 256);
            u.A = (const char*)(ws + WS_H) + (size_t)(RFL(RS[j]) + k * 256) * 512; u.rows = (const int*)(ws + WS_DSTL) + (size_t)(j * PAIRCAP + k * 256); u.gp = (const float*)(ws + WS_GATEL) + (size_t)(j * PAIRCAP + k * 256);
            u.B = (const char*)(ws + WS_W_ED) + (size_t)(j & 63) * (1024 * 256 * 2) + (size_t)u.pn * (256 * 256 * 2); }
        else { const int k = NSH * ch + (tau - ntr); u.valid = 256; u.A = (const char*)(ws + WS_H) + (size_t)(HSH_ROW0 + k * 256) * 512; u.rows = (const int*)(ws + WS_IDENT) + k * 256; u.gp = (const float*)(ws + WS_ONES); u.B = (const char*)(ws + WS_W_SD) + (size_t)u.pn * (256 * 256 * 2); }
        return true;
    }
};

struct Params { const float* in[29]; float* out; unsigned char* ws; int ph_lo, ph_hi; };

__device__ __forceinline__ void s5_tables_item(const Params& p, LAS unsigned char* lds, int item) {
    const int g = item >> 3, part = item & 7, tid = tidx();
    LAS float* AP = (LAS float*)lds;
    LAS float* BB = AP + 64 * 33 * 2;
    LAS float* CC = BB + 64 * 16 * 2;
    const float dt = expf(p.in[8][g]);
    __syncthreads();
    for (int i = tid; i < 64 * 33; i += NTHR) { const int pp = i / 33, tau = i - pp * 33; const float lr = p.in[6][g * 64 + pp], li = p.in[7][g * 64 + pp];
        const float mag = expf(lr * dt * (float)tau), th = li * dt * (float)tau; AP[i * 2] = mag * cosf(th); AP[i * 2 + 1] = mag * sinf(th); }
    for (int i = tid; i < 64 * 16; i += NTHR) { const int pp = i >> 4; const float lr = p.in[6][g * 64 + pp], li = p.in[7][g * 64 + pp];
        const float mag = expf(lr * dt); const float a_re = mag * cosf(li * dt), a_im = mag * sinf(li * dt);
        const float den = lr * lr + li * li, n_re = a_re - 1.0f; const float f_re = (n_re * lr + a_im * li) / den, f_im = (a_im * lr - n_re * li) / den;
        const float br = p.in[9][(size_t)(g * 64) * 16 + i], bi = p.in[10][(size_t)(g * 64) * 16 + i];
        BB[i * 2] = f_re * br - f_im * bi; BB[i * 2 + 1] = f_re * bi + f_im * br; }
    for (int i = tid; i < 16 * 64; i += NTHR) { CC[i * 2] = p.in[11][(size_t)g * 1024 + i]; CC[i * 2 + 1] = p.in[12][(size_t)g * 1024 + i]; }
    __syncthreads();
    if (part == 0 && tid < 64) { float* a32 = (float*)(p.ws + WS_A32); a32[(g * 64 + tid) * 2] = AP[(tid * 33 + 32) * 2]; a32[(g * 64 + tid) * 2 + 1] = AP[(tid * 33 + 32) * 2 + 1]; }
    {
        const int jh = tid >> 8, t2 = tid & 255;
        const int fr = t2 >> 6, l = t2 & 63, delta = part * 4 + fr, ho = l & 15, q = l >> 4, tau = delta - (q >> 1); float v[4];
#pragma unroll 1
        for (int jj = 0; jj < 4; ++jj) { const int j = jh * 4 + jj; const int hi = (q & 1) * 8 + j; float acc = 0.f;
            if (tau >= 0) { for (int pp = 0; pp < 64; ++pp) { const float ar = AP[(pp * 33 + tau) * 2], ai = AP[(pp * 33 + tau) * 2 + 1], br = BB[(pp * 16 + hi) * 2], bi = BB[(pp * 16 + hi) * 2 + 1], cr = CC[(ho * 64 + pp) * 2], ci = CC[(ho * 64 + pp) * 2 + 1];
                    acc += cr * (ar * br - ai * bi) - ci * (ar * bi + ai * br); }
                if (tau == 0 && ho == hi) acc += p.in[13][g * 16 + ho]; }
            v[jj] = acc; }
        u32x2 o; o.x = pk2(v[0], v[1]); o.y = pk2(v[2], v[3]);
        *(u32x2*)((bf16_t*)(p.ws + WS_TZF) + ((size_t)(g * 32 + delta) * 64 + l) * 8 + jh * 4) = o;
    }
    for (int u = tid; u < 1024; u += NTHR) {
        const int ks = u >> 6, l = u & 63, n = part * 16 + (l & 15), q = l >> 4, ri = n >> 6, pp = n & 63; float v[8];
#pragma unroll
        for (int j = 0; j < 8; ++j) { const int k = ks * 32 + q * 8 + j, sidx = k >> 4, hi = k & 15;
            const float ar = AP[(pp * 33 + 31 - sidx) * 2], ai = AP[(pp * 33 + 31 - sidx) * 2 + 1], br = BB[(pp * 16 + hi) * 2], bi = BB[(pp * 16 + hi) * 2 + 1];
            v[j] = ri ? (ar * bi + ai * br) : (ar * br - ai * bi); }
        u32x4 o; o.x = pk2(v[0], v[1]); o.y = pk2(v[2], v[3]); o.z = pk2(v[4], v[5]); o.w = pk2(v[6], v[7]);
        *(u32x4*)((bf16_t*)(p.ws + WS_WINF) + ((size_t)((g * 8 + part) * 16 + ks) * 64 + l) * 8) = o;
    }
    for (int u = tid; u < 1024; u += NTHR) {
        const int fr = u >> 6, l = u & 63, t = part * 4 + (fr >> 2), ksp = fr & 3, ho = l & 15, q = l >> 4; float v[8];
#pragma unroll
        for (int j = 0; j < 8; ++j) { const int kp = ksp * 32 + q * 8 + j, ri = kp >> 6, pp = kp & 63;
            const float cr = CC[(ho * 64 + pp) * 2], ci = CC[(ho * 64 + pp) * 2 + 1], ar = AP[(pp * 33 + t + 1) * 2], ai = AP[(pp * 33 + t + 1) * 2 + 1];
            v[j] = ri ? -(cr * ai + ci * ar) : (cr * ar - ci * ai); }
        u32x4 o; o.x = pk2(v[0], v[1]); o.y = pk2(v[2], v[3]); o.z = pk2(v[4], v[5]); o.w = pk2(v[6], v[7]);
        *(u32x4*)((bf16_t*)(p.ws + WS_WOUTF) + ((size_t)((g * 32 + t) * 4 + ksp) * 64 + l) * 8) = o;
    }
    __syncthreads();
}

__device__ __forceinline__ float gelu_tanh(float y) { const float z = 0.7978845608028654f * (y + 0.044715f * y * y * y); const float e = __expf(2.0f * z); const float th = 1.0f - 2.0f / (e + 1.0f); return 0.5f * y * (1.0f + th); }

__device__ __forceinline__ void s5_item(const Params& p, LAS unsigned char* lds, int item) {
    const int b = item >> 5, g = item & 31;
    const int tid = tidx(), lane = tid & 63, wave = __builtin_amdgcn_readfirstlane(tid >> 6), hd = lane & 15, qd = lane >> 4;
    const bf16_t* PROJ = (const bf16_t*)(p.ws + WS_PROJ); bf16_t* YG = (bf16_t*)(p.ws + WS_YG);
    LAS float* SL = (LAS float*)lds;
    LAS unsigned char* WO = lds + 65536;
    const char* WoutG = (const char*)(p.ws + WS_WOUTF) + (size_t)g * 32 * 4 * 1024;
#define S5_WO_DMA(h) do { _Pragma("unroll") for (int j_ = 0; j_ < 8; ++j_) \
        __builtin_amdgcn_global_load_lds((const unsigned*)(WoutG + (size_t)(h) * 65536 + (j_ * 512 + tid) * 16), (LAS unsigned*)(WO + j_ * 8192 + wave * 1024), 16, 0, 0); } while (0)
    const int c = 16 * wave + hd;
    __syncthreads();
    S5_WO_DMA(0);
    bf16x8 Uf[16];
#pragma unroll
    for (int ks = 0; ks < 16; ++ks) Uf[ks] = *(const bf16x8*)(PROJ + ((size_t)b * SEQ + c * 32 + 2 * ks + (qd >> 1)) * PROJ_W + C_USSM + g * 16 + (qd & 1) * 8);
    { const bf16x8* WinF = (const bf16x8*)(p.ws + WS_WINF) + (size_t)g * 8 * 16 * 64 + lane;
      bf16x8 wc_[8], wn_[8];
#pragma unroll
      for (int ks = 0; ks < 8; ++ks) wc_[ks] = WinF[ks * 64];
      f32x4 a = (f32x4){0.f, 0.f, 0.f, 0.f};
#pragma unroll 2
      for (int j = 0; j < 16; ++j) { const int jn = (j < 15) ? j + 1 : j;
#pragma unroll
          for (int i = 0; i < 8; ++i) wn_[i] = WinF[(jn * 8 + i) * 64];
          if ((j & 1) == 0) {
#pragma unroll
              for (int i = 0; i < 8; ++i) a = __builtin_amdgcn_mfma_f32_16x16x32_bf16(wc_[i], Uf[i], a, 0, 0, 0); }
          else {
#pragma unroll
              for (int i = 0; i < 8; ++i) a = __builtin_amdgcn_mfma_f32_16x16x32_bf16(wc_[i], Uf[8 + i], a, 0, 0, 0);
              *(LAS f32x4*)(SL + c * 128 + (j >> 1) * 16 + qd * 4) = a; a = (f32x4){0.f, 0.f, 0.f, 0.f}; }
#pragma unroll
          for (int i = 0; i < 8; ++i) wc_[i] = wn_[i]; } }
    __syncthreads();
    if (wave == 0) { const float* a32 = (const float*)(p.ws + WS_A32); const float ar = a32[(g * 64 + lane) * 2], ai = a32[(g * 64 + lane) * 2 + 1]; float hr = 0.f, hi = 0.f;
#pragma unroll 4
        for (int cc = 0; cc < 128; ++cc) { const float sr = SL[cc * 128 + lane], si = SL[cc * 128 + 64 + lane]; const float nr = ar * hr - ai * hi + sr, ni = ar * hi + ai * hr + si; hr = nr; hi = ni; SL[cc * 128 + lane] = hr; SL[cc * 128 + 64 + lane] = hi; } }
    __syncthreads();
    bf16x8 Hf[4];
#pragma unroll
    for (int ks = 0; ks < 4; ++ks) { if (c >= 1) { const f32x4 x0 = *(const LAS f32x4*)(SL + (c - 1) * 128 + ks * 32 + qd * 8), x1 = *(const LAS f32x4*)(SL + (c - 1) * 128 + ks * 32 + qd * 8 + 4); Hf[ks] = __builtin_bit_cast(bf16x8, pack8(x0, x1)); }
        else Hf[ks] = (bf16x8){0, 0, 0, 0, 0, 0, 0, 0}; }
    const bf16x8* TzF = (const bf16x8*)(p.ws + WS_TZF) + (size_t)g * 32 * 64 + lane;
#pragma unroll
    for (int half = 0; half < 2; ++half) {
        f32x4 acc[16];
#pragma unroll
        for (int tt = 0; tt < 16; ++tt) acc[tt] = (f32x4){0.f, 0.f, 0.f, 0.f};
        const int ndelta = half * 16 + 16;
        bf16x8 fr[4];
#pragma unroll
        for (int i = 0; i < 4; ++i) fr[i] = TzF[i * 64];
#pragma unroll
        for (int delta = 0; delta < 32; ++delta) {
            if (delta < ndelta) {
                const bf16x8 f0 = fr[delta & 3];
                if (delta + 4 < ndelta) fr[delta & 3] = TzF[(delta + 4) * 64];
#pragma unroll
                for (int ks = 0; ks < 16; ++ks) { const int t = delta + 2 * ks; if (t >= half * 16 && t < half * 16 + 16) acc[t - half * 16] = __builtin_amdgcn_mfma_f32_16x16x32_bf16(f0, Uf[ks], acc[t - half * 16], 0, 0, 0); }
            }
        }
        asm volatile("s_waitcnt vmcnt(0)" ::: "memory");
        __syncthreads();
#pragma unroll
        for (int tt = 0; tt < 16; ++tt) { const int t = half * 16 + tt;
#pragma unroll
            for (int ks = 0; ks < 4; ++ks) acc[tt] = __builtin_amdgcn_mfma_f32_16x16x32_bf16(*(const LAS bf16x8*)(WO + (tt * 4 + ks) * 1024 + lane * 16), Hf[ks], acc[tt], 0, 0, 0);
            u32x2 w; w.x = pk2(gelu_tanh(acc[tt][0]), gelu_tanh(acc[tt][1])); w.y = pk2(gelu_tanh(acc[tt][2]), gelu_tanh(acc[tt][3]));
            *(u32x2*)(YG + ((size_t)b * SEQ + c * 32 + t) * 512 + g * 16 + qd * 4) = w;
            if ((tt & 1) == 1) asm volatile("" ::: "memory"); }
        if (half == 0) { asm volatile("s_waitcnt lgkmcnt(0)" ::: "memory"); __syncthreads(); S5_WO_DMA(1); }
    }
#undef S5_WO_DMA
    __syncthreads();
}

struct TDesc { const float* W; bf16_t* WT; int K, N, item, kind; };
__device__ __forceinline__ void t_load(const TDesc& d, int lane, f32x4 (&v)[16]) {
    const int nblk = (d.N + 63) >> 6, kb = d.item / nblk, nb = d.item - kb * nblk, k0 = 64 * kb, n0 = 64 * nb;
    const int lr = lane >> 4, lc = (lane & 15) * 4;
#pragma unroll
    for (int i = 0; i < 16; ++i) v[i] = (n0 + lc < d.N) ? *(const f32x4*)(d.W + (size_t)(k0 + 4 * i + lr) * d.N + n0 + lc) : (f32x4){0.f, 0.f, 0.f, 0.f};
}
struct RmId { __device__ int operator()(int n) const { return n; } };
struct RmWave { __device__ int operator()(int n) const { const int L = n & 255; return (n & ~255) + 128 * ((L >> 5) & 1) + 32 * (L >> 6) + (L & 31); } };
struct RmIn { __device__ int operator()(int n) const { if (n < PROJ_USED) return n; const int g = n - PROJ_USED, c = g & 1023; return PROJ_W + 256 * (c >> 7) + 128 * (g >> 10) + (c & 127); } };
struct RmGate { __device__ int operator()(int n) const { const int hl = n & 127; return 256 * (n >> 7) + 128 * ((hl >> 2) & 1) + 32 * (hl >> 5) + 8 * ((hl >> 3) & 3) + (hl & 3); } };
struct RmUp { __device__ int operator()(int n) const { const int hl = n & 127; return 256 * (n >> 7) + 128 * ((hl >> 2) & 1) + 32 * (hl >> 5) + 8 * ((hl >> 3) & 3) + 4 + (hl & 3); } };
__device__ __forceinline__ int t_rowmap(int kind, int n) { return kind == 0 ? n : kind == 1 ? RmWave()(n) : kind == 2 ? RmIn()(n) : kind == 3 ? RmGate()(n) : RmUp()(n); }
__device__ __forceinline__ void t_store(const TDesc& d, const f32x4 (&v)[16], LAS float* scr, int lane) {
    const int nblk = (d.N + 63) >> 6, kb = d.item / nblk, nb = d.item - kb * nblk, k0 = 64 * kb, n0 = 64 * nb;
    const int lr = lane >> 4, lc = (lane & 15) * 4;
#pragma unroll
    for (int i = 0; i < 16; ++i) { LAS float* dd = scr + (4 * i + lr) * 65 + lc; dd[0] = v[i].x; dd[1] = v[i].y; dd[2] = v[i].z; dd[3] = v[i].w; }
    LDS_WAIT(); asm volatile("" ::: "memory");
    const int nl = lane >> 3, kc = (lane & 7) * 8;
#pragma unroll
    for (int j = 0; j < 8; ++j) { const int n = nl + 8 * j; const LAS float* sp = scr + kc * 65 + n;
        u32x4 o; o.x = pk2(sp[0 * 65], sp[1 * 65]); o.y = pk2(sp[2 * 65], sp[3 * 65]); o.z = pk2(sp[4 * 65], sp[5 * 65]); o.w = pk2(sp[6 * 65], sp[7 * 65]);
        if (n0 + n < d.N) *(u32x4*)(d.WT + (size_t)t_rowmap(d.kind, n0 + n) * d.K + k0 + kc) = o; }
    LDS_WAIT(); asm volatile("" ::: "memory");
}

constexpr int T_I_IN = 16 * 60, T_I_GLU = 8 * 8, T_I_PS = 8 * 16, T_I_OUT = 16 * 16, T_I_SG = 16 * 4, T_I_SD = 4 * 16, T_I_EG = 64 * 64;
constexpr int T_NITEMS = T_I_IN + T_I_GLU + 2 * T_I_PS + T_I_OUT + 2 * T_I_SG + T_I_SD + 3 * T_I_EG;
constexpr int T_LATE = 5 * 128 * NWAVES;
constexpr int T_LATE2 = T_I_EG;
static_assert(T_LATE + T_LATE2 <= 3 * T_I_EG, "late items are expert matrices");
__device__ __forceinline__ TDesc tdesc_of(const Params& p, unsigned char* ws, int r) { TDesc d;
    if (r < T_I_IN) { d = TDesc{p.in[5], (bf16_t*)(ws + WS_W_IN), 1024, IN_W, r, 2}; return d; } r -= T_I_IN;
    if (r < T_I_GLU) { d = TDesc{p.in[14], (bf16_t*)(ws + WS_W_GLU), 512, 512, r, 0}; return d; } r -= T_I_GLU;
    if (r < T_I_PS) { d = TDesc{p.in[16], (bf16_t*)(ws + WS_W_PS), 512, 1024, r, 0}; return d; } r -= T_I_PS;
    if (r < T_I_PS) { d = TDesc{p.in[17], (bf16_t*)(ws + WS_W_PA), 512, 1024, r, 0}; return d; } r -= T_I_PS;
    if (r < T_I_OUT) { d = TDesc{p.in[18], (bf16_t*)(ws + WS_W_OUT), 1024, 1024, r, 0}; return d; } r -= T_I_OUT;
    if (r < T_I_SG) { d = TDesc{p.in[25], (bf16_t*)(ws + WS_W_SGU), 1024, 256, r, 3}; return d; } r -= T_I_SG;
    if (r < T_I_SG) { d = TDesc{p.in[26], (bf16_t*)(ws + WS_W_SGU), 1024, 256, r, 4}; return d; } r -= T_I_SG;
    if (r < T_I_SD) { d = TDesc{p.in[27], (bf16_t*)(ws + WS_W_SD), 256, 1024, r, 1}; return d; } r -= T_I_SD;
    if (r < T_I_EG) { const int e = r >> 6; d = TDesc{p.in[22] + (size_t)e * 262144, (bf16_t*)(ws + WS_W_EGU) + (size_t)e * 524288, 1024, 256, r & 63, 3}; return d; } r -= T_I_EG;
    if (r < T_I_EG) { const int e = r >> 6; d = TDesc{p.in[23] + (size_t)e * 262144, (bf16_t*)(ws + WS_W_EGU) + (size_t)e * 524288, 1024, 256, r & 63, 4}; return d; } r -= T_I_EG;
    { const int e = r >> 6; d = TDesc{p.in[24] + (size_t)e * 262144, (bf16_t*)(ws + WS_W_ED) + (size_t)e * 262144, 256, 1024, r & 63, 1}; return d; } }
__device__ __forceinline__ void run_transposes(const Params& p, unsigned char* ws, LAS unsigned char* lds, int r0, int r1, int widx, int nw) {
    const int lane = tidx() & 63, wave = __builtin_amdgcn_readfirstlane(tidx() >> 6);
    LAS float* scr = (LAS float*)(lds + wave * 16640);
    int r = r1 - 1 - widx;
    if (r < r0) return;
    TDesc d0 = tdesc_of(p, ws, r), d1 = d0, d2 = d0; f32x4 v0[16], v1[16], v2[16];
    t_load(d0, lane, v0);
    bool h1 = (r - nw >= r0);
    if (h1) { d1 = tdesc_of(p, ws, r - nw); t_load(d1, lane, v1); }
    for (;;) {
        const bool h2 = h1 && (r - 2 * nw >= r0);
        if (h2) { d2 = tdesc_of(p, ws, r - 2 * nw); t_load(d2, lane, v2); }
        t_store(d0, v0, scr, lane);
        if (!h1) break;
        d0 = d1; d1 = d2; r -= nw; h1 = h2;
#pragma unroll
        for (int i = 0; i < 16; ++i) { v0[i] = v1[i]; v1[i] = v2[i]; }
    }
}
__device__ __forceinline__ void p0_prep(const Params& p, LAS unsigned char* lds, int vcu, int G) {
    const int tid = tidx(), lane = tid & 63, wave = __builtin_amdgcn_readfirstlane(tid >> 6);
    unsigned char* ws = p.ws;
    for (int it = vcu; it < 256; it += G) s5_tables_item(p, lds, it);
    {
        LAS float* sc = (LAS float*)lds;
        LAS float* red = (LAS float*)(lds + 32768);
        const float* c = p.in[1]; const float* w = p.in[2]; const float* bb = p.in[3]; float* ada = (float*)(ws + WS_ADA);
        bool loaded = false;
        for (int it = vcu; it < 96; it += G) {
            if (!loaded) { for (int i = tid; i < 8192; i += NTHR) { const float v = c[i]; sc[i] = v * sigmoidf_(v); } loaded = true; }
            __syncthreads();
            const int kq = tid >> 6, col = it * 64 + lane; float a[8];
#pragma unroll
            for (int b = 0; b < 8; ++b) a[b] = 0.f;
#pragma unroll 16
            for (int k = kq * 128; k < kq * 128 + 128; ++k) { const float wv = w[(size_t)k * 6144 + col];
#pragma unroll
                for (int b = 0; b < 8; ++b) a[b] += sc[b * 1024 + k] * wv; }
#pragma unroll
            for (int b = 0; b < 8; ++b) red[(kq * 8 + b) * 64 + lane] = a[b];
            __syncthreads();
            { const int b = tid >> 6; float s = bb[col];
#pragma unroll
              for (int q = 0; q < 8; ++q) s += red[(q * 8 + b) * 64 + lane];
              ada[b * 6144 + col] = s; }
            __syncthreads();
        }
        __syncthreads();
    }
    run_transposes(p, ws, lds, 0, T_NITEMS - T_LATE2 - ((G == 256) ? T_LATE : 0), vcu * NWAVES + wave, G * NWAVES);
    { const int gt = vcu * NTHR + tid, NGT = G * NTHR;
      u32x4* z = (u32x4*)(ws + WS_W_IN + (size_t)PROJ_USED * 1024 * 2);
      for (int i = gt; i < (PROJ_W - PROJ_USED) * 1024 * 2 / 16; i += NGT) z[i] = (u32x4){0u, 0u, 0u, 0u};
      int* id = (int*)(ws + WS_IDENT); for (int i = gt; i < NTOK; i += NGT) id[i] = (i % CHTOK) * NSLOT + 8;
      if (gt < 256) ((float*)(ws + WS_ONES))[gt] = 1.0f;
      for (int u = gt; u < 32 * 4 * 64; u += NGT) { const int l = u & 63, nt = (u >> 6) & 3, ks = u >> 8; const int n = nt * 16 + (l & 15), q = l >> 4; float hi[8], lo[8];
#pragma unroll
          for (int j = 0; j < 8; ++j) { const float w = p.in[20][(size_t)(ks * 32 + q * 8 + j) * 64 + n]; const float h = bf2f((unsigned short)f2bf(w)); hi[j] = h; lo[j] = w - h; }
          u32x4 o; o.x = pk2(hi[0], hi[1]); o.y = pk2(hi[2], hi[3]); o.z = pk2(hi[4], hi[5]); o.w = pk2(hi[6], hi[7]);
          *(u32x4*)((bf16_t*)(ws + WS_WRF) + (size_t)u * 8) = o;
          o.x = pk2(lo[0], lo[1]); o.y = pk2(lo[2], lo[3]); o.z = pk2(lo[4], lo[5]); o.w = pk2(lo[6], lo[7]);
          *(u32x4*)((bf16_t*)(ws + WS_WRF) + (size_t)(32 * 4 * 64 + u) * 8) = o; } }
}

__device__ __forceinline__ void p1_modulate(const Params& p, int vcu, int G) {
    const int tid = tidx(), lane = tid & 63, wave = tid >> 6; const int gw = vcu * NWAVES + wave, NGW = G * NWAVES;
    const float* ada = (const float*)(p.ws + WS_ADA); const float* g1 = p.in[4]; bf16_t* U = (bf16_t*)(p.ws + WS_U);
    for (int m = gw; m < NTOK; m += NGW) {
        const f32x4* xr = (const f32x4*)(p.in[0] + (size_t)m * D) + lane; const int b = m >> 12;
        f32x4 v[4]; float s = 0.f;
#pragma unroll
        for (int j = 0; j < 4; ++j) { v[j] = xr[64 * j]; s += (v[j].x * v[j].x + v[j].y * v[j].y) + (v[j].z * v[j].z + v[j].w * v[j].w); }
        const float rstd = 1.0f / sqrtf(wave_sum(s) * (1.f / D) + EPS);
        unsigned long long* o8 = (unsigned long long*)(U + (size_t)m * D) + lane;
#pragma unroll
        for (int j = 0; j < 4; ++j) { const int c0 = 4 * lane + 256 * j;
            const f32x4 gg = *(const f32x4*)(g1 + c0), sh = *(const f32x4*)(ada + b * 6144 + c0), scl = *(const f32x4*)(ada + b * 6144 + 1024 + c0);
            const f32x4 y = v[j] * rstd * gg * (scl + 1.0f) + sh;
            o8[64 * j] = (unsigned long long)pk2(y.x, y.y) | ((unsigned long long)pk2(y.z, y.w) << 32); }
    }
}

__device__ __forceinline__ void p_combine(const Params& p, int vcu, int G, int ch) {
    const int tid = tidx(), lane = tid & 63, wave = tid >> 6; const int gw = vcu * NWAVES + wave, NGW = G * NWAVES;
    const float* ada = (const float*)(p.ws + WS_ADA); const float* gf = p.in[28];
    const unsigned char* Y = (const unsigned char*)(p.ws + WS_Y);
    unsigned w[NSLOT][4];
    { const int mi0 = gw < CHTOK ? gw : 0; const unsigned* yp = (const unsigned*)(Y + (size_t)mi0 * NSLOT * D) + lane;
#pragma unroll
      for (int k = 0; k < NSLOT; ++k)
#pragma unroll
          for (int j = 0; j < 4; ++j) w[k][j] = yp[k * 256 + 64 * j]; }
    for (int mi = gw; mi < CHTOK; mi += NGW) {
        const int m = ch * CHTOK + mi; const int b = m >> 12;
        f32x4* orow = (f32x4*)(p.out + (size_t)m * D) + lane;
        u32x2 hq[4]; f32x4 g2[4];
        { const u32x2* hp = (const u32x2*)(p.out + (size_t)m * D) + lane;
#pragma unroll
          for (int j = 0; j < 4; ++j) { hq[j] = hp[64 * j]; g2[j] = *(const f32x4*)(ada + b * 6144 + 5120 + 4 * lane + 256 * j); } }
        f32x4 a[4];
#pragma unroll
        for (int j = 0; j < 4; ++j) { a[j] = (f32x4){0.f, 0.f, 0.f, 0.f};
#pragma unroll
            for (int k = 0; k < NSLOT; ++k) { const f32x2 lo = __builtin_amdgcn_cvt_pk_f32_fp8((int)w[k][j], false), hi = __builtin_amdgcn_cvt_pk_f32_fp8((int)w[k][j], true);
                a[j].x += lo.x; a[j].y += lo.y; a[j].z += hi.x; a[j].w += hi.y; } }
        { const int mn = (mi + NGW < CHTOK) ? mi + NGW : mi; const unsigned* yp = (const unsigned*)(Y + (size_t)mn * NSLOT * D) + lane;
#pragma unroll
          for (int k = 0; k < NSLOT; ++k)
#pragma unroll
              for (int j = 0; j < 4; ++j) w[k][j] = yp[k * 256 + 64 * j]; }
        f32x4 r[4]; float s = 0.f;
#pragma unroll
        for (int j = 0; j < 4; ++j) { const f32x4 h = {bflo(hq[j].x), bfhi(hq[j].x), bflo(hq[j].y), bfhi(hq[j].y)};
            r[j] = h + g2[j] * (a[j] * (1.0f / Y_SCALE)); s += (r[j].x * r[j].x + r[j].y * r[j].y) + (r[j].z * r[j].z + r[j].w * r[j].w); }
        const float rstd = 1.0f / sqrtf(wave_sum(s) * (1.f / D) + EPS);
#pragma unroll
        for (int j = 0; j < 4; ++j) { const f32x4 g = *(const f32x4*)(gf + 4 * lane + 256 * j); orow[64 * j] = r[j] * rstd * g; }
    }
}

__device__ __forceinline__ unsigned fkey(float x) { const unsigned u = __builtin_bit_cast(unsigned, x); return (u & 0x80000000u) ? ~u : (u | 0x80000000u); }

__device__ __forceinline__ void gold_s5(const Params& p, int item, int lane) {
    const int b = item >> 5, g = item & 31;
    const bf16_t* PROJ = (const bf16_t*)(p.ws + WS_PROJ); bf16_t* YG = (bf16_t*)(p.ws + WS_YG);
    const float dt = expf(p.in[8][g]); const float lr = p.in[6][g * 64 + lane], li = p.in[7][g * 64 + lane];
    const float mag = expf(lr * dt); const float a_re = mag * cosf(li * dt), a_im = mag * sinf(li * dt);
    const float den = lr * lr + li * li, n_re = a_re - 1.0f;
    const float f_re = (n_re * lr + a_im * li) / den, f_im = (a_im * lr - n_re * li) / den;
    float bbr[16], bbi[16], cr[16], ci[16];
#pragma unroll
    for (int h = 0; h < 16; ++h) { const float br = p.in[9][(g * 64 + lane) * 16 + h], bi = p.in[10][(g * 64 + lane) * 16 + h];
        bbr[h] = f_re * br - f_im * bi; bbi[h] = f_re * bi + f_im * br;
        cr[h] = p.in[11][(g * 16 + h) * 64 + lane]; ci[h] = p.in[12][(g * 16 + h) * 64 + lane]; }
    const float dsk = p.in[13][g * 16 + (lane & 15)];
    float hr = 0.f, hi = 0.f;
    for (int t = 0; t < SEQ; ++t) {
        const size_t row = (size_t)b * SEQ + t;
        const u32x4 w0 = *(const u32x4*)(PROJ + row * PROJ_W + C_USSM + g * 16), w1 = *(const u32x4*)(PROJ + row * PROJ_W + C_USSM + g * 16 + 8);
        float u[16]; { float f[8]; unpack8(w0, f);
#pragma unroll
            for (int j = 0; j < 8; ++j) u[j] = f[j];
            unpack8(w1, f);
#pragma unroll
            for (int j = 0; j < 8; ++j) u[8 + j] = f[j]; }
        float bur = 0.f, bui = 0.f;
#pragma unroll
        for (int h = 0; h < 16; ++h) { bur += bbr[h] * u[h]; bui += bbi[h] * u[h]; }
        const float nr = a_re * hr - a_im * hi + bur, ni = a_re * hi + a_im * hr + bui; hr = nr; hi = ni;
        float y = 0.f, um = 0.f;
#pragma unroll
        for (int h = 0; h < 16; ++h) { const float v = wave_sum(cr[h] * hr - ci[h] * hi); if ((lane & 15) == h) { y = v; um = u[h]; } }
        y += dsk * um;
        const float gl = 0.5f * y * (1.0f + tanhf(0.7978845608028654f * (y + 0.044715f * y * y * y)));
        if (lane < 16) YG[row * 512 + g * 16 + lane] = (bf16_t)f2bf(gl);
    }
}

__device__ __forceinline__ void gold_attn_pair(const Params& p, LAS unsigned char* lds, int pairid) {
    const int half = tidx() >> 8, tid = tidx() & 255;
    LAS unsigned char* base = lds + half * 32768;
    LAS float* qi = (LAS float*)base; LAS float* qv = qi + 512; LAS float* sc = qv + 512; LAS float* lg = sc + 4096;
    LAS float* wi = lg + 2048; LAS float* mx = wi + 8; LAS float* sm = mx + 8; LAS int* sel = (LAS int*)(sm + 8); LAS int* red = sel + 256; LAS int* cntp = red + 256;
    const int qid = pairid * 2 + half; const int b = qid >> 12, t = qid & 4095;
    const bf16_t* PROJ = (const bf16_t*)(p.ws + WS_PROJ); bf16_t* YA = (bf16_t*)(p.ws + WS_YATTN);
    const size_t qrow = (size_t)qid * PROJ_W;
    __syncthreads();
    for (int i = tid; i < 512; i += 256) { qi[i] = bf2f(PROJ[qrow + C_QI + i]); qv[i] = bf2f(PROJ[qrow + C_Q + i]); }
    if (tid < 8) wi[tid] = bf2f(PROJ[qrow + C_WI + tid]);
    if (tid == 0) cntp[0] = 0;
    __syncthreads();
    const int n = t + 1;
    for (int s = tid; s < n; s += 256) {
        const bf16_t* kp = PROJ + ((size_t)b * SEQ + s) * PROJ_W + C_KI; float kk[64];
#pragma unroll
        for (int c8 = 0; c8 < 8; ++c8) { float f[8]; unpack8(*(const u32x4*)(kp + c8 * 8), f);
#pragma unroll
            for (int j = 0; j < 8; ++j) kk[c8 * 8 + j] = f[j]; }
        float score = 0.f;
        for (int h = 0; h < 8; ++h) { float d = 0.f;
#pragma unroll
            for (int j = 0; j < 64; ++j) d += qi[h * 64 + j] * kk[j];
            score += wi[h] * fmaxf(d, 0.f); }
        sc[s] = score;
    }
    __syncthreads();
    const bool small = (t | 1) <= 255;
    if (small) { if (tid < n) sel[tid] = tid; if (tid == 0) cntp[0] = n; __syncthreads(); }
    else {
        unsigned thr = 0u;
        for (int bit = 31; bit >= 0; --bit) {
            const unsigned cand = thr | (1u << bit); int c = 0;
            for (int s = tid; s < n; s += 256) c += (fkey(sc[s]) >= cand) ? 1 : 0;
            red[tid] = c; __syncthreads();
            for (int o = 128; o > 0; o >>= 1) { if (tid < o) red[tid] += red[tid + o]; __syncthreads(); }
            if (red[0] >= 256) thr = cand;
            __syncthreads();
        }
        for (int s = tid; s < n; s += 256) if (fkey(sc[s]) > thr) { const int ps = atomicAdd((int*)cntp, 1); sel[ps] = s; }
        __syncthreads();
        if (tid == 0) { int c = cntp[0]; for (int s = 0; s < n && c < 256; ++s) if (fkey(sc[s]) == thr) sel[c++] = s; cntp[0] = c; }
        __syncthreads();
    }
    const int ns = cntp[0];
    { const int j = tid; const int s = (j < ns) ? sel[j] : 0;
      const bf16_t* kp = PROJ + ((size_t)b * SEQ + s) * PROJ_W + C_K; float kk[64];
#pragma unroll
      for (int c8 = 0; c8 < 8; ++c8) { float f[8]; unpack8(*(const u32x4*)(kp + c8 * 8), f);
#pragma unroll
          for (int jj = 0; jj < 8; ++jj) kk[c8 * 8 + jj] = f[jj]; }
      for (int h = 0; h < 8; ++h) { float d = 0.f;
#pragma unroll
          for (int jj = 0; jj < 64; ++jj) d += qv[h * 64 + jj] * kk[jj];
          const float slope = exp2f(-(float)(h + 1));
          lg[h * 256 + j] = (j < ns) ? d * 0.125f - slope * (float)(t - s) : -INFINITY; } }
    __syncthreads();
    if (tid < 8) { float m = -INFINITY; for (int j = 0; j < 256; ++j) m = fmaxf(m, lg[tid * 256 + j]); float sum = 0.f; for (int j = 0; j < 256; ++j) sum += __expf(lg[tid * 256 + j] - m); mx[tid] = m; sm[tid] = sum; }
    __syncthreads();
    for (int i = tid; i < 2048; i += 256) { const int h = i >> 8; lg[i] = __expf(lg[i] - mx[h]) / sm[h]; }
    __syncthreads();
    { const int h = tid >> 5, d0 = (tid & 31) * 2; float o0 = 0.f, o1 = 0.f;
      for (int j = 0; j < ns; ++j) { const unsigned w = *(const unsigned*)(PROJ + ((size_t)b * SEQ + sel[j]) * PROJ_W + C_V + d0); const float pj = lg[h * 256 + j]; o0 += pj * bflo(w); o1 += pj * bfhi(w); }
      *(unsigned*)(YA + (size_t)qid * 512 + h * 64 + d0) = pk2(o0, o1); }
}

typedef float f32x16 __attribute__((ext_vector_type(16)));
typedef _Float16 f16_t;
constexpr int AT_SC = 0;
constexpr int AT_V = 65536;
constexpr int AT_SEL = LDS_CNT;
static_assert(AT_V + 8 * 2 * 4096 <= STAGE_BYTES && AT_SEL + 8 * 1152 <= LDS_BYTES, "attention LDS map");

#define DPP_ZI(v, ctrl, rmask, bmask) __builtin_amdgcn_update_dpp(0, (int)(v), ctrl, rmask, bmask, false)
__device__ __forceinline__ int wave_scan_i(int v0) {
    int v1 = v0 + DPP_ZI(v0, 0x111, 0xf, 0xf); v1 += DPP_ZI(v0, 0x112, 0xf, 0xf); v1 += DPP_ZI(v0, 0x113, 0xf, 0xf);
    v1 += DPP_ZI(v1, 0x114, 0xf, 0xe); v1 += DPP_ZI(v1, 0x118, 0xf, 0xc);
    v1 += DPP_ZI(v1, 0x142, 0xa, 0xf); v1 += DPP_ZI(v1, 0x143, 0xc, 0xf);
    return v1;
}
__device__ __forceinline__ float relu_i(float x) { const int xi = __builtin_bit_cast(int, x); return __builtin_bit_cast(float, xi > 0 ? xi : 0); }
__device__ __forceinline__ u32x2 tr_read16(unsigned addr) { u32x2 r; asm volatile("ds_read_b64_tr_b16 %0, %1" : "=v"(r) : "v"(addr) : "memory"); return r; }

__device__ __forceinline__ void attn_item(const Params& p, LAS unsigned char* lds, int b, int qblk, int nb, int nqblk) {
    const int tid = tidx(), lane = tid & 63, wave = __builtin_amdgcn_readfirstlane(tid >> 6);
    const int q0 = qblk * 8;
    const bf16_t* PROJ = (const bf16_t*)(p.ws + WS_PROJ); bf16_t* YA = (bf16_t*)(p.ws + WS_YATTN);
    const size_t tok0 = (size_t)b * SEQ + q0;
    LAS unsigned short* SC = (LAS unsigned short*)(lds + AT_SC);
    LAS unsigned short* SELq = (LAS unsigned short*)(lds + AT_SEL) + wave * 576;
    const int nkt = (q0 + 8 + 31) >> 5;
    const int nchmax = (q0 + 8 + 511) >> 9;
    __syncthreads();
    for (int i = nkt * 32 + lane; i < nchmax * 512; i += 64) SC[wave * 4096 + i] = 0xFC00u;
    __syncthreads();
#ifndef AT_REP_A
#define AT_REP_A 1
#endif
#ifndef AT_REP_B
#define AT_REP_B 1
#endif
#ifndef AT_REP_C
#define AT_REP_C 1
#endif
#ifndef AT_SKIP_A
    for (int ra_ = 0; ra_ < AT_REP_A; ++ra_) {
        const int hf = lane >> 5, l32 = lane & 31;
        const int rq = 2 * ((l32 >> 2) & 1) + ((l32 >> 4) & 1), rh = (l32 & 3) + 4 * ((l32 >> 3) & 1);
        bf16x8 Af[2][4]; float wgt[2][16];
#pragma unroll
        for (int qg = 0; qg < 2; ++qg) { const bf16_t* qp = PROJ + (tok0 + 4 * qg + rq) * PROJ_W + C_QI + rh * 64 + hf * 8;
#pragma unroll
            for (int s = 0; s < 4; ++s) Af[qg][s] = *(const bf16x8*)(qp + s * 16);
#pragma unroll
            for (int qq = 0; qq < 2; ++qq) { const u32x4 w = *(const u32x4*)(PROJ + (tok0 + 4 * qg + 2 * hf + qq) * PROJ_W + C_WI); float f[8]; unpack8(w, f);
#pragma unroll
                for (int h = 0; h < 8; ++h) wgt[qg][qq * 8 + h] = f[h] * 0.0441941738f; } }
        const bf16x8* KIF = (const bf16x8*)(p.ws + WS_KIF) + (size_t)b * 128 * 4 * 64 + lane;
        bf16x8 B0[4], B1[4];
        { const int kt0 = wave < nkt ? wave : 0, kt1 = wave + 8 < nkt ? wave + 8 : kt0;
#pragma unroll
          for (int s = 0; s < 4; ++s) { B0[s] = KIF[(kt0 * 4 + s) * 64]; B1[s] = KIF[(kt1 * 4 + s) * 64]; } }
#define STEP_A_TILE(BF, KT) do { const int key = (KT) * 32 + l32; \
            _Pragma("unroll") for (int qg = 0; qg < 2; ++qg) { \
                f32x16 c; _Pragma("unroll") for (int j = 0; j < 16; ++j) c[j] = 0.f; \
                _Pragma("unroll") for (int s = 0; s < 4; ++s) c = __builtin_amdgcn_mfma_f32_32x32x16_bf16(Af[qg][s], BF[s], c, 0, 0, 0); \
                float sa = 0.f, sb = 0.f; \
                _Pragma("unroll") for (int h = 0; h < 8; ++h) { sa += wgt[qg][h] * relu_i(c[h]); sb += wgt[qg][8 + h] * relu_i(c[8 + h]); } \
                const int qa = 4 * qg + 2 * hf; \
                const unsigned hw = __builtin_bit_cast(unsigned, __builtin_amdgcn_cvt_pkrtz(sa, sb));        \
                SC[qa * 4096 + key] = (unsigned short)hw; SC[(qa + 1) * 4096 + key] = (unsigned short)(hw >> 16); } } while (0)
        for (int kt = wave; kt < nkt; kt += 16) {
            STEP_A_TILE(B0, kt);
            { const int ktn = (kt + 16 < nkt) ? kt + 16 : kt;
#pragma unroll
              for (int s = 0; s < 4; ++s) B0[s] = KIF[(ktn * 4 + s) * 64]; }
            if (kt + 8 < nkt) {
                STEP_A_TILE(B1, kt + 8);
                { const int ktn = (kt + 24 < nkt) ? kt + 24 : kt;
#pragma unroll
                  for (int s = 0; s < 4; ++s) B1[s] = KIF[(ktn * 4 + s) * 64]; } }
        }
#undef STEP_A_TILE
        if (wave == ((nkt - 1) & 7)) {
#pragma unroll
            for (int i = 0; i < 4; ++i) { const int idx = lane + 64 * i, q = idx >> 5, key = (nkt - 1) * 32 + (idx & 31); if (key > q0 + q) SC[q * 4096 + key] = 0xFC00u; } }
    }
#endif
    __syncthreads();
    const int t = q0 + wave, n = t + 1;
    int ns;
    for (int rb_ = 0; rb_ < AT_REP_B; ++rb_) {
#ifdef AT_SKIP_B
    if (true) {
#else
    if (n <= 256) {
#endif
#pragma unroll
        for (int i = 0; i < 4; ++i) { const int pos = lane + 64 * i; SELq[pos] = (unsigned short)(pos < n ? pos : 0); }
        ns = n;
    } else {
        const int nch = (n + 511) >> 9;
        unsigned XH[32], XL[32];
        LAS unsigned char* row = lds + AT_SC + wave * 8192;
#pragma unroll
        for (int i = 0; i < 8; ++i) {
            if (i < nch) { const u32x4 w = *(const LAS u32x4*)(row + i * 1024 + lane * 16);
#pragma unroll
                for (int e2 = 0; e2 < 4; ++e2) { const unsigned x = w[e2]; const unsigned sg = (x & 0x80008000u) >> 15; const unsigned k2 = x ^ ((sg * 0xffffu) | 0x80008000u);
                    XH[i * 4 + e2] = k2; XL[i * 4 + e2] = k2 << 16; } }
            else {
#pragma unroll
                for (int e2 = 0; e2 < 4; ++e2) { XH[i * 4 + e2] = 0u; XL[i * 4 + e2] = 0u; } }
        }
        LAS unsigned* H1 = (LAS unsigned*)(lds + 65536 + wave * 8192);
        LAS unsigned* H2 = (LAS unsigned*)((LAS unsigned char*)SELq + 640);
        LAS unsigned* H1p = H1 + (lane & 1) * 1024;
#pragma unroll
        for (int i = 0; i < 8; ++i) *(LAS u32x4*)(H1 + (i * 64 + lane) * 4) = (u32x4){0u, 0u, 0u, 0u};
        H2[lane] = 0u;
        LDS_WAIT(); __builtin_amdgcn_wave_barrier();
#pragma unroll
        for (int i = 0; i < 8; ++i) if (i < nch) {
#pragma unroll
            for (int e2 = 0; e2 < 4; ++e2) { const unsigned x = XH[i * 4 + e2];
                __hip_atomic_fetch_add(H1p + (x >> 22), 1u, __ATOMIC_RELAXED, __HIP_MEMORY_SCOPE_WORKGROUP);
                __hip_atomic_fetch_add(H1p + ((x >> 6) & 1023u), 1u, __ATOMIC_RELAXED, __HIP_MEMORY_SCOPE_WORKGROUP); } }
        LDS_WAIT(); __builtin_amdgcn_wave_barrier();
        unsigned B1, cabove; const unsigned dummy = 64u + (unsigned)lane;
        {
            unsigned hb[16];
#pragma unroll
            for (int i = 0; i < 4; ++i) { const u32x4 w = *(const LAS u32x4*)(H1 + lane * 16 + i * 4), w2 = *(const LAS u32x4*)(H1 + 1024 + lane * 16 + i * 4); hb[4 * i] = w.x + w2.x; hb[4 * i + 1] = w.y + w2.y; hb[4 * i + 2] = w.z + w2.z; hb[4 * i + 3] = w.w + w2.w; }
            unsigned sl_ = 0u;
#pragma unroll
            for (int i = 0; i < 16; ++i) sl_ += hb[i];
            const int inc_ = wave_scan_i((int)sl_);
            const unsigned above = (unsigned)(__builtin_amdgcn_readlane(inc_, 63) - inc_), suf = above + sl_;
            const bool mine = above < 256u && suf >= 256u;
            unsigned bsel = 0u, cab = 0u;
            if (mine) { unsigned run = above; bool done = false;
#pragma unroll
                for (int i = 15; i >= 0; --i) { if (!done && run + hb[i] >= 256u) { bsel = (unsigned)(lane * 16 + i); cab = run; done = true; } run += hb[i]; } }
            const unsigned long long mk = __ballot(mine); const int src = (int)__builtin_ctzll(mk);
            B1 = (unsigned)__builtin_amdgcn_readlane((int)bsel, src); cabove = (unsigned)__builtin_amdgcn_readlane((int)cab, src);
        }
#pragma unroll
        for (int i = 0; i < 8; ++i) if (i < nch) {
#pragma unroll
            for (int e2 = 0; e2 < 4; ++e2) { const unsigned x = XH[i * 4 + e2];
                const unsigned ah = ((x >> 22) == B1) ? ((x >> 16) & 63u) : dummy, al = (((x >> 6) & 1023u) == B1) ? (x & 63u) : dummy;
                __hip_atomic_fetch_add(H2 + ah, 1u, __ATOMIC_RELAXED, __HIP_MEMORY_SCOPE_WORKGROUP);
                __hip_atomic_fetch_add(H2 + al, 1u, __ATOMIC_RELAXED, __HIP_MEMORY_SCOPE_WORKGROUP); } }
        LDS_WAIT(); __builtin_amdgcn_wave_barrier();
        unsigned thr;
        {   const unsigned h2 = H2[lane]; const int inc_ = wave_scan_i((int)h2); const unsigned ab2 = (unsigned)(__builtin_amdgcn_readlane(inc_, 63) - inc_), suf = ab2 + h2;
            const unsigned need = 256u - cabove;
            const bool mine = ab2 < need && suf >= need;
            const unsigned long long mk = __ballot(mine); const unsigned B2 = (unsigned)__builtin_ctzll(mk);
            thr = (B1 << 6) | B2; }
        const unsigned c32 = thr << 16, c32h = c32 | 0xffffu;
#define TIE2(a, b) asm volatile("" : "+v"(a), "+v"(b))
        int cgt = 0, ceq = 0;
#pragma unroll
        for (int j = 0; j < 32; ++j) { unsigned xh = XH[j], xl = XL[j]; TIE2(xh, cgt); TIE2(xl, ceq);
            cgt += (xh > c32h) ? 1 : 0; cgt += (xl > c32) ? 1 : 0; ceq += ((xh >> 16) == thr) ? 1 : 0; ceq += (xl == c32) ? 1 : 0; }
        const int sgt = wave_scan_i(cgt), seq = wave_scan_i(ceq);
        const int tot_gt = __builtin_amdgcn_readlane(sgt, 63);
        int o1 = sgt - cgt, o2 = tot_gt + seq - ceq;
        const int trash = 256 + lane;
#pragma unroll
        for (int i = 0; i < 8; ++i) if (i < nch) {
#pragma unroll
            for (int e2 = 0; e2 < 4; ++e2) { const int j = i * 4 + e2; const int idx = i * 512 + lane * 8 + 2 * e2;
                unsigned xl = XL[j], xh = XH[j]; TIE2(xl, o1); TIE2(xh, o2);
                { const bool gt = xl > c32, eq = xl == c32; const int a2 = (eq && o2 < 256) ? o2 : trash, a1 = gt ? o1 : a2; SELq[a1] = (unsigned short)idx; o1 += gt ? 1 : 0; o2 += eq ? 1 : 0; }
                TIE2(xh, o1);
                { const bool gt = xh > c32h, eq = (xh >> 16) == thr; const int a2 = (eq && o2 < 256) ? o2 : trash, a1 = gt ? o1 : a2; SELq[a1] = (unsigned short)(idx + 1); o1 += gt ? 1 : 0; o2 += eq ? 1 : 0; } } }
        ns = 256;
    }
    LDS_WAIT(); __builtin_amdgcn_wave_barrier(); }
    __syncthreads();
    {
        const int hd = lane & 15, qd = lane >> 4;
        const size_t tok = tok0 + wave;
        LAS unsigned char* vb = lds + wave * 16384;
        const unsigned vb_addr = (unsigned)(size_t)vb;
        const int vrow = lane >> 3, vch = lane & 7;
        const char* bbase = (const char*)(PROJ + (size_t)b * SEQ * PROJ_W);
        const unsigned voff0 = (unsigned)(C_V * 2 + vch * 16), koff0 = (unsigned)(C_K * 2 + qd * 16);
        unsigned roff[32];
#pragma unroll
        for (int j_ = 0; j_ < 32; ++j_) roff[j_] = (unsigned)SELq[(j_ >> 2) * 32 + vrow + 8 * (j_ & 3)] * (unsigned)(PROJ_W * 2);
#define V_DMA(sl) do { _Pragma("unroll") for (int i_ = 0; i_ < 4; ++i_) { \
            __builtin_amdgcn_global_load_lds((const unsigned*)(bbase + (roff[(sl) * 4 + i_] + voff0)), (LAS unsigned*)(vb + ((sl) & 3) * 4096 + i_ * 1024), 16, 0, 0); } } while (0)
        bf16x8 Qf[2];
#pragma unroll
        for (int ks = 0; ks < 2; ++ks) { if (hd < 8) Qf[ks] = *(const bf16x8*)(PROJ + tok * PROJ_W + C_Q + hd * 64 + ks * 32 + qd * 8); else Qf[ks] = (bf16x8){0, 0, 0, 0, 0, 0, 0, 0}; }
#define KSWZ(row) ((unsigned)(((row) & 3) | ((((row) >> 3) & 1) << 2)))
#define K_DMA(sl) do { _Pragma("unroll") for (int i_ = 0; i_ < 4; ++i_) { const int row_ = i_ * 8 + vrow; \
            __builtin_amdgcn_global_load_lds((const unsigned*)(bbase + (roff[(sl) * 4 + i_] + (unsigned)(C_K * 2) + (((unsigned)vch ^ KSWZ(row_)) * 16u))), (LAS unsigned*)(vb + ((sl) & 3) * 4096 + i_ * 1024), 16, 0, 0); } } while (0)
        (void)koff0;
        unsigned warm0 = 0u, warm1 = 0u;
        if (wave == 0 && nqblk >= 0) { const bf16_t* nq = PROJ + ((size_t)nb * SEQ + nqblk * 8 + (lane >> 3)) * PROJ_W;
            const bf16_t* a0 = nq + C_QI + (lane & 7) * 64; const bf16_t* a1 = nq + C_WI;
            asm volatile("global_load_dword %0, %2, off\n\tglobal_load_dword %1, %3, off" : "=&v"(warm0), "=&v"(warm1) : "v"(a0), "v"(a1) : "memory"); }
        K_DMA(0); K_DMA(1); K_DMA(2); K_DMA(3);
        f32x4 S[16];
#pragma unroll
        for (int sl = 0; sl < 8; ++sl) {
            asm volatile("s_waitcnt vmcnt(12)" ::: "memory");
#pragma unroll
            for (int Th = 0; Th < 2; ++Th) { const int prow = (hd >> 2) * 8 + Th * 4 + (hd & 3); const unsigned fp = KSWZ(prow);
                const LAS unsigned char* ka = vb + (sl & 3) * 4096 + prow * 128;
                const bf16x8 K0 = *(const LAS bf16x8*)(ka + (((unsigned)qd ^ fp) * 16u)), K1 = *(const LAS bf16x8*)(ka + (((unsigned)(4 + qd) ^ fp) * 16u));
                f32x4 a = (f32x4){0.f, 0.f, 0.f, 0.f};
                a = __builtin_amdgcn_mfma_f32_16x16x32_bf16(K0, Qf[0], a, 0, 0, 0); a = __builtin_amdgcn_mfma_f32_16x16x32_bf16(K1, Qf[1], a, 0, 0, 0); S[2 * sl + Th] = a; }
            asm volatile("s_waitcnt lgkmcnt(0)" ::: "memory");
            if (sl == 0) asm volatile("" :: "v"(warm0), "v"(warm1));
            if (sl + 4 < 8) K_DMA(sl + 4); else V_DMA(sl - 4);
        }
        const float slope = exp2f(-(float)((hd & 7) + 1)), abase = -slope * (float)t;
        float mx = -INFINITY;
#pragma unroll
        for (int sl = 0; sl < 8; ++sl) { const u32x4 w = *(const LAS u32x4*)((LAS unsigned char*)SELq + (sl * 32 + qd * 8) * 2);
#pragma unroll
            for (int e = 0; e < 8; ++e) { const int T = sl * 2 + (e >> 2), r = e & 3; const unsigned ww = w[e >> 1]; const float sf = (float)((e & 1) ? (ww >> 16) : (ww & 0xffffu));
                const float lgv = __builtin_fmaf(S[T][r], 0.125f, __builtin_fmaf(slope, sf, abase)); S[T][r] = lgv; } }
        if (ns < 256) {
#pragma unroll
            for (int sl = 0; sl < 8; ++sl)
#pragma unroll
                for (int e = 0; e < 8; ++e) { if (sl * 32 + qd * 8 + e >= ns) S[sl * 2 + (e >> 2)][e & 3] = -INFINITY; } }
#pragma unroll
        for (int T = 0; T < 16; ++T) { asm("v_max3_f32 %0, %0, %1, %2" : "+v"(mx) : "v"(S[T][0]), "v"(S[T][1])); asm("v_max3_f32 %0, %0, %1, %2" : "+v"(mx) : "v"(S[T][2]), "v"(S[T][3])); }
        mx = fmaxf(mx, __shfl_xor(mx, 16)); mx = fmaxf(mx, __shfl_xor(mx, 32));
        float sum = 0.f;
        const float mxl = mx * 1.44269504089f;
#pragma unroll
        for (int T = 0; T < 16; ++T)
#pragma unroll
            for (int r = 0; r < 4; ++r) { const float e = __builtin_amdgcn_exp2f(S[T][r] * 1.44269504089f - mxl); S[T][r] = e; sum += e; }
        sum += __shfl_xor(sum, 16); sum += __shfl_xor(sum, 32);
        u32x4 Pk[8];
#pragma unroll
        for (int sl = 0; sl < 8; ++sl) { Pk[sl].x = pk2(S[2 * sl][0], S[2 * sl][1]); Pk[sl].y = pk2(S[2 * sl][2], S[2 * sl][3]); Pk[sl].z = pk2(S[2 * sl + 1][0], S[2 * sl + 1][1]); Pk[sl].w = pk2(S[2 * sl + 1][2], S[2 * sl + 1][3]); }
        f32x4 O[4];
#pragma unroll
        for (int dt = 0; dt < 4; ++dt) O[dt] = (f32x4){0.f, 0.f, 0.f, 0.f};
#pragma unroll
        for (int sl = 0; sl < 8; ++sl) {
            if (sl <= 4) asm volatile("s_waitcnt vmcnt(12)" ::: "memory"); else if (sl == 5) asm volatile("s_waitcnt vmcnt(8)" ::: "memory"); else if (sl == 6) asm volatile("s_waitcnt vmcnt(4)" ::: "memory"); else asm volatile("s_waitcnt vmcnt(0)" ::: "memory");
            const unsigned a0 = vb_addr + (sl & 3) * 4096 + (8 * qd + (hd >> 2)) * 128 + (hd & 3) * 8;
            u32x2 tr[4][2];
            asm volatile("ds_read_b64_tr_b16 %0, %8\n\tds_read_b64_tr_b16 %1, %8 offset:512\n\tds_read_b64_tr_b16 %2, %8 offset:32\n\tds_read_b64_tr_b16 %3, %8 offset:544\n\t"
                         "ds_read_b64_tr_b16 %4, %8 offset:64\n\tds_read_b64_tr_b16 %5, %8 offset:576\n\tds_read_b64_tr_b16 %6, %8 offset:96\n\tds_read_b64_tr_b16 %7, %8 offset:608\n\ts_waitcnt lgkmcnt(0)"
                         : "=&v"(tr[0][0]), "=&v"(tr[0][1]), "=&v"(tr[1][0]), "=&v"(tr[1][1]), "=&v"(tr[2][0]), "=&v"(tr[2][1]), "=&v"(tr[3][0]), "=&v"(tr[3][1]) : "v"(a0) : "memory");
            if (sl + 4 < 8) V_DMA(sl + 4);
            const bf16x8 Pf = __builtin_bit_cast(bf16x8, Pk[sl]);
#pragma unroll
            for (int dt = 0; dt < 4; ++dt) { u32x4 vw; vw.x = tr[dt][0].x; vw.y = tr[dt][0].y; vw.z = tr[dt][1].x; vw.w = tr[dt][1].y;
                O[dt] = __builtin_amdgcn_mfma_f32_16x16x32_bf16(__builtin_bit_cast(bf16x8, vw), Pf, O[dt], 0, 0, 0); }
        }
#undef V_DMA
        const float inv = 1.0f / sum;
        if (hd < 8) {
#pragma unroll
            for (int dt = 0; dt < 4; ++dt) { u32x2 w; w.x = pk2(O[dt][0] * inv, O[dt][1] * inv); w.y = pk2(O[dt][2] * inv, O[dt][3] * inv);
                *(u32x2*)(YA + tok * 512 + hd * 64 + dt * 16 + qd * 4) = w; } }
    }
}

#define DPP_F(v, ctrl, rmask) __builtin_bit_cast(float, __builtin_amdgcn_update_dpp(__builtin_bit_cast(int, v), __builtin_bit_cast(int, v), ctrl, rmask, 0xf, false))
__device__ __forceinline__ float wave_max_dpp(float v) {
    asm volatile("s_nop 1\n\tv_max_f32_dpp %0, %0, %0 row_shr:1 row_mask:0xf bank_mask:0xf\n\ts_nop 1\n\tv_max_f32_dpp %0, %0, %0 row_shr:2 row_mask:0xf bank_mask:0xf\n\ts_nop 1\n\t"
                 "v_max_f32_dpp %0, %0, %0 row_shr:3 row_mask:0xf bank_mask:0xf\n\ts_nop 1\n\tv_max_f32_dpp %0, %0, %0 row_shr:4 row_mask:0xf bank_mask:0xf\n\ts_nop 1\n\t"
                 "v_max_f32_dpp %0, %0, %0 row_shr:8 row_mask:0xf bank_mask:0xf\n\ts_nop 1\n\tv_max_f32_dpp %0, %0, %0 row_bcast:15 row_mask:0xa bank_mask:0xf\n\ts_nop 1\n\t"
                 "v_max_f32_dpp %0, %0, %0 row_bcast:31 row_mask:0xc bank_mask:0xf\n\ts_nop 1" : "+v"(v));
    return __builtin_bit_cast(float, __builtin_amdgcn_readlane(__builtin_bit_cast(int, v), 63));
}
#define DPP_Z(v, ctrl, rmask, bmask) __builtin_bit_cast(float, __builtin_amdgcn_update_dpp(0, __builtin_bit_cast(int, v), ctrl, rmask, bmask, false))
__device__ __forceinline__ float wave_sum_dpp(float v0) {
    float v1 = v0 + DPP_Z(v0, 0x111, 0xf, 0xf); v1 += DPP_Z(v0, 0x112, 0xf, 0xf); v1 += DPP_Z(v0, 0x113, 0xf, 0xf);
    v1 += DPP_Z(v1, 0x114, 0xf, 0xe); v1 += DPP_Z(v1, 0x118, 0xf, 0xc);
    v1 += DPP_Z(v1, 0x142, 0xa, 0xf); v1 += DPP_Z(v1, 0x143, 0xc, 0xf);
    return __builtin_bit_cast(float, __builtin_amdgcn_readlane(__builtin_bit_cast(int, v1), 63));
}
constexpr int RT_LG = 0;
constexpr int RT_ENT = 32768;
constexpr int RT_HIST = RT_ENT + 8 * 128 * 12;
constexpr int RT_NV = 49152;
__device__ __forceinline__ void route_tile(const Params& p, LAS unsigned char* lds, int tile, int skip) {
    const int tid = tidx(), lane = tid & 63, wave = __builtin_amdgcn_readfirstlane(tid >> 6), hd = lane & 15, qd = lane >> 4;
    const float* ada = (const float*)(p.ws + WS_ADA); const float* g2 = p.in[19];
    bf16_t* U2 = (bf16_t*)(p.ws + WS_U);
    LAS int* hist = (LAS int*)(lds + RT_HIST);
    LAS float* LGT = (LAS float*)(lds + RT_LG);
    LAS int* ENT = (LAS int*)(lds + RT_ENT) + wave * 384;
    const int b = (tile * 128) >> 12;
    __syncthreads();
    if (tid < 64) hist[tid] = 0;
    if (tid == 64) hist[128] = 0;
    { LAS float* NV = (LAS float*)(lds + RT_NV);
      for (int i = tid; i < 256; i += NTHR) { const f32x4 g = *(const f32x4*)(g2 + 4 * i), sc = *(const f32x4*)(ada + b * 6144 + 4096 + 4 * i), sh = *(const f32x4*)(ada + b * 6144 + 3072 + 4 * i);
          *(LAS f32x4*)(NV + 4 * i) = g * (sc + 1.0f); *(LAS f32x4*)(NV + 1024 + 4 * i) = sh; } }
    __syncthreads();
    if (wave < 4) {
        const int tokw = tile * 128 + wave * 32;
        float rstd[2]; const bf16_t* hrow[2];
#pragma unroll
        for (int rt = 0; rt < 2; ++rt) { const int m = tokw + rt * 16 + hd; hrow[rt] = (const bf16_t*)(p.out + (size_t)m * D) + qd * 8;
            const f32x4 q4 = *(const f32x4*)((const float*)(p.ws + WS_SS) + (size_t)m * 16 + qd * 4); float ss = (q4.x + q4.y) + (q4.z + q4.w);
            ss += __shfl_xor(ss, 16); ss += __shfl_xor(ss, 32); rstd[rt] = 1.0f / sqrtf(ss * (1.f / D) + EPS); }
        const bf16x8* WH = (const bf16x8*)(p.ws + WS_WRF) + lane; const bf16x8* WL = WH + 32 * 4 * 64;
        f32x4 acc[2][4];
#pragma unroll
        for (int rt = 0; rt < 2; ++rt)
#pragma unroll
            for (int nt = 0; nt < 4; ++nt) acc[rt][nt] = (f32x4){0.f, 0.f, 0.f, 0.f};
        bf16x8 wh[4], wl[4], whn[4], wln[4]; u32x4 xa[2], xn[2], xnn[2];
#pragma unroll
        for (int nt = 0; nt < 4; ++nt) { wh[nt] = WH[nt * 64]; wl[nt] = WL[nt * 64]; }
#pragma unroll
        for (int rt = 0; rt < 2; ++rt) { xa[rt] = *(const u32x4*)(hrow[rt]); xn[rt] = *(const u32x4*)(hrow[rt] + 32); }
#pragma unroll 2
        for (int ks = 0; ks < 32; ++ks) {
            const int kn = (ks + 1 < 32) ? ks + 1 : ks;
#pragma unroll
            for (int nt = 0; nt < 4; ++nt) { whn[nt] = WH[(kn * 4 + nt) * 64]; wln[nt] = WL[(kn * 4 + nt) * 64]; }
#pragma unroll
            for (int rt = 0; rt < 2; ++rt) xnn[rt] = *(const u32x4*)(hrow[rt] + ((ks + 2 < 32) ? ks + 2 : ks) * 32);
            const int c0 = ks * 32 + qd * 8;
            const LAS float* NV = (const LAS float*)(lds + RT_NV);
            const f32x4 ma = *(const LAS f32x4*)(NV + c0), mb = *(const LAS f32x4*)(NV + c0 + 4), ha = *(const LAS f32x4*)(NV + 1024 + c0), hb = *(const LAS f32x4*)(NV + 1024 + c0 + 4);
#pragma unroll
            for (int rt = 0; rt < 2; ++rt) {
                const f32x4 x0 = {bflo(xa[rt].x), bfhi(xa[rt].x), bflo(xa[rt].y), bfhi(xa[rt].y)}, x1 = {bflo(xa[rt].z), bfhi(xa[rt].z), bflo(xa[rt].w), bfhi(xa[rt].w)};
                const f32x4 y0 = x0 * rstd[rt] * ma + ha, y1 = x1 * rstd[rt] * mb + hb;
                const u32x4 hi = pack8(y0, y1);
                f32x4 r0, r1; r0.x = y0.x - bflo(hi.x); r0.y = y0.y - bfhi(hi.x); r0.z = y0.z - bflo(hi.y); r0.w = y0.w - bfhi(hi.y);
                r1.x = y1.x - bflo(hi.z); r1.y = y1.y - bfhi(hi.z); r1.z = y1.z - bflo(hi.w); r1.w = y1.w - bfhi(hi.w);
                const bf16x8 uh = __builtin_bit_cast(bf16x8, hi), ul = __builtin_bit_cast(bf16x8, pack8(r0, r1));
#pragma unroll
                for (int nt = 0; nt < 4; ++nt) {
                    acc[rt][nt] = __builtin_amdgcn_mfma_f32_16x16x32_bf16(wh[nt], uh, acc[rt][nt], 0, 0, 0);
                    acc[rt][nt] = __builtin_amdgcn_mfma_f32_16x16x32_bf16(wl[nt], uh, acc[rt][nt], 0, 0, 0);
                    acc[rt][nt] = __builtin_amdgcn_mfma_f32_16x16x32_bf16(wh[nt], ul, acc[rt][nt], 0, 0, 0); } }
#pragma unroll
            for (int nt = 0; nt < 4; ++nt) { wh[nt] = whn[nt]; wl[nt] = wln[nt]; }
#pragma unroll
            for (int rt = 0; rt < 2; ++rt) { xa[rt] = xn[rt]; xn[rt] = xnn[rt]; }
        }
#pragma unroll
        for (int rt = 0; rt < 2; ++rt)
#pragma unroll
            for (int nt = 0; nt < 4; ++nt) *(LAS f32x4*)(LGT + (wave * 32 + rt * 16 + hd) * 64 + nt * 16 + qd * 4) = acc[rt][nt];
    }
    {
        LAS int* rowctr = hist + 128;
        LAS const float* NV = (LAS const float*)(lds + RT_NV);
        auto claim = [&]() -> int { int r = 0; if (lane == 0) r = __hip_atomic_fetch_add(rowctr, 1, __ATOMIC_RELAXED, __HIP_MEMORY_SCOPE_WORKGROUP); return __builtin_amdgcn_readfirstlane(r); };
        const float* SSp = (const float*)(p.ws + WS_SS);
#define RT_ROWLOAD(vv, sv, rr) do { if ((rr) < 128) { const int m_ = tile * 128 + (rr); const u32x4* xr_ = (const u32x4*)(p.out + (size_t)m_ * D) + lane; vv[0] = xr_[0]; vv[1] = xr_[64]; sv = SSp[(size_t)m_ * 16 + (lane & 15)]; } } while (0)
        int r = claim(), rn = claim(); u32x4 v[2] = {}, vn[2] = {}; float ssl = 0.f, ssn = 0.f;
        RT_ROWLOAD(v, ssl, r); RT_ROWLOAD(vn, ssn, rn);
        while (r < 128) {
            const int rnn = (rn < 128) ? claim() : 128; u32x4 vnn[2] = {vn[0], vn[1]}; float ssnn = 0.f;
            RT_ROWLOAD(vnn, ssnn, rnn);
            float ss = ssl; ss += __shfl_xor(ss, 1); ss += __shfl_xor(ss, 2); ss += __shfl_xor(ss, 4); ss += __shfl_xor(ss, 8);
            const float rstd = 1.0f / sqrtf(ss * (1.f / D) + EPS);
            u32x4* o16 = (u32x4*)(U2 + (size_t)(tile * 128 + r) * D) + lane;
#pragma unroll
            for (int j = 0; j < 2; ++j) { const int c0 = 8 * lane + 512 * j;
                const f32x4 ma = *(LAS const f32x4*)(NV + c0), mb = *(LAS const f32x4*)(NV + c0 + 4), sh = *(LAS const f32x4*)(NV + 1024 + c0), sb = *(LAS const f32x4*)(NV + 1024 + c0 + 4);
                const f32x4 x0 = {bflo(v[j].x), bfhi(v[j].x), bflo(v[j].y), bfhi(v[j].y)}, x1 = {bflo(v[j].z), bfhi(v[j].z), bflo(v[j].w), bfhi(v[j].w)};
                o16[64 * j] = pack8(x0 * rstd * ma + sh, x1 * rstd * mb + sb); }
            v[0] = vn[0]; v[1] = vn[1]; vn[0] = vnn[0]; vn[1] = vnn[1];
            ssl = ssn; ssn = ssnn; r = rn; rn = rnn;
        }
#undef RT_ROWLOAD
    }
    __syncthreads();
    const int tok0 = tile * 128 + wave * 16;
    LAS float* LG = LGT + wave * 1024;
    const float rbias = p.in[21][lane];
#pragma unroll 1
    for (int mi = 0; mi < 16; ++mi) {
        const float score = sigmoidf_(LG[mi * 64 + lane]); const float biased = score + rbias;
        float m1 = biased;
        m1 = fmaxf(m1, DPP_F(m1, 0xb1, 0xf)); m1 = fmaxf(m1, DPP_F(m1, 0x4e, 0xf)); m1 = fmaxf(m1, DPP_F(m1, 0x141, 0xf));
        const unsigned long long bal = __ballot(biased == m1); const int grp = lane >> 3;
        const unsigned gm = (unsigned)((bal >> (grp * 8)) & 0xffull); const int first = __ffs((int)gm) - 1;
        float v2 = ((lane & 7) == first) ? -INFINITY : biased;
        v2 = fmaxf(v2, DPP_F(v2, 0xb1, 0xf)); v2 = fmaxf(v2, DPP_F(v2, 0x4e, 0xf)); v2 = fmaxf(v2, DPP_F(v2, 0x141, 0xf));
        const float gscore = m1 + v2;
        int grank = 0;
#pragma unroll
        for (int og = 0; og < 8; ++og) { const float o = __builtin_bit_cast(float, __builtin_amdgcn_readlane(__builtin_bit_cast(int, gscore), og * 8)); grank += (o > gscore || (o == gscore && og < grp)) ? 1 : 0; }
        float mv = (grank < 4) ? biased : -INFINITY;
        unsigned long long chosen_m = 0ull;
#pragma unroll 1
        for (int it = 0; it < 8; ++it) { const float mxv = wave_max_dpp(mv); const unsigned long long e = __ballot(mv == mxv); const int w = (int)__builtin_ctzll(e); chosen_m |= 1ull << w; if (lane == w) mv = -INFINITY; }
        const bool chosen = (chosen_m >> lane) & 1ull;
        const int rank = (int)__builtin_amdgcn_mbcnt_hi((unsigned)(chosen_m >> 32), __builtin_amdgcn_mbcnt_lo((unsigned)chosen_m, 0u));
        const float gsum = wave_sum_dpp(chosen ? score : 0.f);
        if (chosen) { const int lpos = __hip_atomic_fetch_add(hist + lane, 1, __ATOMIC_RELAXED, __HIP_MEMORY_SCOPE_WORKGROUP);   const int e = mi * 8 + rank; ENT[e * 3] = lane; ENT[e * 3 + 1] = lpos; ENT[e * 3 + 2] = __builtin_bit_cast(int, score / gsum * 2.5f); }
    }
    __syncthreads();
    const int ch = (tile * 128) / CHTOK;
    if (skip) return;
    if (tid < 64) { const int c = hist[tid]; int base = 0; if (c > 0) base = (int)atomicAdd((unsigned*)(p.ws + WS_CTL) + CW_CNT + ch * NE + tid, (unsigned)c); hist[64 + tid] = base; }
    __syncthreads();
#pragma unroll
    for (int i = 0; i < 2; ++i) { const int e = lane + 64 * i; const int ex = ENT[e * 3], lpos = ENT[e * 3 + 1]; const float gate = __builtin_bit_cast(float, ENT[e * 3 + 2]);
        const int m = tok0 + (e >> 3), rk = e & 7, pair = ch * NE + ex, ps = hist[64 + ex] + lpos;
        ((int*)(p.ws + WS_DSTL))[(size_t)pair * PAIRCAP + ps] = (m - ch * CHTOK) * NSLOT + rk; ((float*)(p.ws + WS_GATEL))[(size_t)pair * PAIRCAP + ps] = gate; }
}

#define XB_TMO      128
#define XB_XCNT(j)  (256  + 64 * (j))
#define XB_XSUB(j)  (1280 + 64 * (j))
#define XB_XGEN(j)  (2304 + 64 * (j))
#define XB_TOP      3328
#define XB_TOPGEN   3392
#define XCD_BAR_WORDS 3456
#define XB_SPIN_CAP (1u << 22)
__device__ __forceinline__ unsigned xb_ld(unsigned* p)              { return __hip_atomic_load(p, __ATOMIC_RELAXED, __HIP_MEMORY_SCOPE_AGENT); }
__device__ __forceinline__ unsigned xb_add(unsigned* p, unsigned v) { return __hip_atomic_fetch_add(p, v, __ATOMIC_RELAXED, __HIP_MEMORY_SCOPE_AGENT); }
__device__ __forceinline__ unsigned xb_xcc_id() { return (unsigned)__builtin_amdgcn_s_getreg((3 << 11) | 20) & 0xFu; }
#define XB_SPIN(cond, bar) do { unsigned _sp = 0; while (cond) { __builtin_amdgcn_s_sleep(1); \
    if ((++_sp & 255u) == 0u) { if (xb_ld(&(bar)[XB_TMO])) break; if (_sp > XB_SPIN_CAP) { atomicAdd(&(bar)[XB_TMO], 1u); break; } } } } while (0)
struct XcdBarrier { unsigned* bar; unsigned x; volatile LAS unsigned* st; };
__device__ __forceinline__ XcdBarrier xcd_barrier_post(unsigned* bar, volatile LAS unsigned* st) {
    XcdBarrier b; b.bar = bar; b.x = xb_xcc_id(); b.st = st;
    if (tidx() == 0) (void)xb_add(&bar[XB_XCNT(b.x)], 1u);
    return b;
}
__device__ __forceinline__ void xcd_barrier_complete(unsigned* bar, unsigned x, unsigned& nloc, unsigned& nx) {
    const unsigned G = gridDim.x * gridDim.y * gridDim.z;
    unsigned sum, cnt, mine, sp = 0u;
    for (;;) {
        sum = 0u; cnt = 0u; mine = 0u;
#pragma unroll
        for (unsigned j = 0; j < 16; ++j) { const unsigned c = xb_ld(&bar[XB_XCNT(j)]); sum += c; cnt += (c > 0u) ? 1u : 0u; mine = (j == x) ? c : mine; }
        if (sum == G) break;
        __builtin_amdgcn_s_sleep(1);
        if ((++sp & 255u) == 0u) { if (xb_ld(&bar[XB_TMO])) break; if (sp > XB_SPIN_CAP) { atomicAdd(&bar[XB_TMO], 1u); break; } }
    }
    nloc = mine > 0u ? mine : 1u; nx = cnt > 0u ? cnt : 1u;
}
__device__ __forceinline__ void xcd_barrier(const XcdBarrier& b) {
    asm volatile("s_waitcnt vmcnt(0)" ::: "memory");
    __syncthreads();
    if (tidx() == 0) {
        unsigned* bar = b.bar;
        __builtin_amdgcn_s_waitcnt(0);
        unsigned nloc = b.st[0], nx = b.st[1];
        if (nloc == 0u) { xcd_barrier_complete(bar, b.x, nloc, nx); b.st[0] = nloc; b.st[1] = nx; }
        const unsigned old = xb_add(&bar[XB_XSUB(b.x)], 1u);
        const unsigned gen = old / nloc;
        if (old + 1u == (gen + 1u) * nloc) {
            __builtin_amdgcn_fence(__ATOMIC_RELEASE, "agent");
            asm volatile("s_waitcnt vmcnt(0)" ::: "memory");
            const unsigned og = xb_add(&bar[XB_TOP], 1u);
            const unsigned tg = og / nx;
            if (og + 1u == (tg + 1u) * nx) xb_add(&bar[XB_TOPGEN], 1u);
            else XB_SPIN(xb_ld(&bar[XB_TOPGEN]) == tg, bar);
            __builtin_amdgcn_fence(__ATOMIC_ACQUIRE, "agent");
            xb_add(&bar[XB_XGEN(b.x)], 1u);
            asm volatile("s_waitcnt vmcnt(0)" ::: "memory");
        } else {
            XB_SPIN(xb_ld(&bar[XB_XGEN(b.x)]) == gen, bar);
            __builtin_amdgcn_fence(__ATOMIC_ACQUIRE, "agent");
            asm volatile("s_waitcnt vmcnt(0)" ::: "memory");
        }
    }
    __syncthreads();
}

enum { PH_PREP = 0, PH_MOD, PH_INPROJ, PH_MIX  , PH_GLU, PH_MIXAB, PH_OUT, PH_ROUTE  , PH_MOE1, PH_MOE2_0, PH_COMB_0, PH_END };

#ifndef USE_CG_SYNC
#define USE_CG_SYNC 0
#endif
__global__ void __launch_bounds__(NTHR, 2) mega(Params p_arg) {
    extern __shared__ __attribute__((aligned(16))) unsigned char lds_raw[];
    LAS unsigned char* lds = (LAS unsigned char*)lds_raw;
    const int G = gridDim.x, bx = blockIdx.x;
    const int vcu = (G % 8 == 0) ? (bx % 8) * (G / 8) + bx / 8 : bx;
    const int tid = tidx(), lane = tid & 63, wave = __builtin_amdgcn_readfirstlane(tid >> 6);
    unsigned char* const ws_ = p_arg.ws; unsigned char* ws = ws_; (void)ws;
    if (tid < 32) ((LAS unsigned*)(lds + LDS_MISC))[tid] = 0u;
    __syncthreads();
#if USE_CG_SYNC
    cg::grid_group grid = cg::this_grid();
#define GRID_SYNC() grid.sync()
#else
    XcdBarrier xbar = xcd_barrier_post((unsigned*)(ws + WS_CTL) + CW_BAR, (volatile LAS unsigned*)(lds + LDS_MISC) + 8);
#define GRID_SYNC() xcd_barrier(xbar)
#endif
#ifndef ONLY_PH
#define ONLY_PH -1
#endif
#define IN(k) (ONLY_PH < 0 || ONLY_PH == (k))
#define SEAM(k) do { if ((k) + 1 < PH_END) GRID_SYNC(); } while (0)
#ifndef REP_PH
#define REP_PH -1
#endif
#ifndef REP_N
#define REP_N 3
#endif
#ifndef PROBE_NOSTORE
#define PROBE_NOSTORE 0
#endif
#define PHASE(k, ...) do { if (IN(k)) { { const int PROBE_SKIP = 0; unsigned zoff_ = 0u; asm volatile("" : "+s"(zoff_)); unsigned char* ws = ws_ + zoff_; const Params& p = *(const Params*)((const char*)&p_arg + zoff_); __VA_ARGS__ } if ((REP_PH) == (k)) { GRID_SYNC(); { const int PROBE_SKIP = PROBE_NOSTORE; unsigned zoff_ = 0u; asm volatile("" : "+s"(zoff_)); unsigned char* ws = ws_ + zoff_; const Params& p = *(const Params*)((const char*)&p_arg + zoff_); __VA_ARGS__ } GRID_SYNC(); { const int PROBE_SKIP = PROBE_NOSTORE; unsigned zoff_ = 0u; asm volatile("" : "+s"(zoff_)); unsigned char* ws = ws_ + zoff_; const Params& p = *(const Params*)((const char*)&p_arg + zoff_); __VA_ARGS__ } } } SEAM(k); } while (0)
    PHASE(PH_PREP, p0_prep(p, lds, vcu, G););
    PHASE(PH_MOD, p1_modulate(p, vcu, G););
    PHASE(PH_INPROJ, {
        pg8::DenseSched S; S.init(ws + WS_U, ws + WS_W_IN, NTOK, NIN, 1024, G, bx);
        EpiInProj E{(bf16_t*)(ws + WS_PROJ), (bf16_t*)(ws + WS_G), (bf16_t*)(ws + WS_KIF)};
        pg8::gemm_phase<EpiInProj, pg8::DenseSched, false>(lds, 1024, S, E);
        if (G == 256 && bx >= 128) { __syncthreads(); run_transposes(p, ws, lds, T_NITEMS - T_LATE2 - T_LATE, T_NITEMS - T_LATE2, (bx - 128) * NWAVES + wave, 128 * NWAVES); } });
    PHASE(PH_MIX, {
#ifdef GOLD_S5
        for (int it = vcu + G * wave; it < 256; it += G * NWAVES) gold_s5(p, it, lane);
#else
#ifndef REP_S5
#define REP_S5 1
#endif
#ifndef REP_ATTN
#define REP_ATTN 1
#endif
        for (int r_ = 0; r_ < REP_S5; ++r_) for (int it = vcu; it < 256; it += G) s5_item(p, lds, it);
#endif
#ifdef GOLD_ATTN
        for (int pr = vcu; pr < NTOK / 2; pr += G) gold_attn_pair(p, lds, pr);
#else
        for (int r_ = 0; r_ < REP_ATTN; ++r_) {
            for (int k = 0; ; ++k) { int ab, aq;
                int nb_ = 0, nq_ = -1;
                if (G == 256) { if (k >= 16) break; ab = vcu >> 5; aq = 511 - ((vcu & 31) + 32 * k); nb_ = ab; nq_ = (k + 1 < 16) ? aq - 32 : -1; }
                else { const int it = vcu + k * G; if (it >= NTOK / 8) break; ab = it & 7; aq = 511 - (it >> 3); const int itn = it + G; if (itn < NTOK / 8) { nb_ = itn & 7; nq_ = 511 - (itn >> 3); } }
                attn_item(p, lds, ab, aq, nb_, nq_); } }
#endif
        __syncthreads(); });
    PHASE(PH_GLU, {
        pg8::DenseSched S; S.init(ws + WS_YG, ws + WS_W_GLU, NTOK, 512, 512, G, bx);
        EpiGlu E{(const bf16_t*)(ws + WS_YG), p.in[15], (bf16_t*)(ws + WS_U)};
        pg8::gemm_phase<EpiGlu, pg8::DenseSched, false>(lds, 512, S, E); });
    PHASE(PH_MIXAB, {
        MixSched S; S.D0.init(ws + WS_U, ws + WS_W_PS, NTOK, 1024, 512, G, bx); S.D1.init(ws + WS_YATTN, ws + WS_W_PA, NTOK, 1024, 512, G, bx);
        EpiMix E{(const bf16_t*)(ws + WS_G), (bf16_t*)(ws + WS_MERGED)};
        pg8::gemm_phase<EpiMix, MixSched, false, false, true>(lds, 512, S, E); });
    PHASE(PH_OUT, {
        pg8::DenseSched S; S.init(ws + WS_MERGED, ws + WS_W_OUT, NTOK, 1024, 1024, G, bx);
        EpiOut E{p.in[0], (const float*)(ws + WS_ADA), p.out, (float*)(ws + WS_SS)};
        pg8::gemm_phase<EpiOut, pg8::DenseSched, false>(lds, 1024, S, E); });
    PHASE(PH_ROUTE, { for (int tile = vcu; tile < NTOK / 128; tile += G) route_tile(p, lds, tile, PROBE_SKIP); });
    PHASE(PH_MOE1, {
        build_moe_tables(lds, (const unsigned*)(ws + WS_CTL) + CW_CNT);
        Moe1Sched S{lds, G, vcu, (const char*)(ws + WS_U), (const int*)(ws + WS_DSTL), (const int*)(ws + WS_IDENT), (const char*)(ws + WS_W_EGU), (const char*)(ws + WS_W_SGU)};
        EpiMoe1 E{(bf16_t*)(ws + WS_H)};
        pg8::gemm_phase<EpiMoe1, Moe1Sched, true>(lds, 1024, S, E);
        { LAS int* TB_ = (LAS int*)(lds + LDS_TB); const int total = (RFL(TB_[256]) + 128) * 2, rem = total % G, nidle = rem ? G - rem : 0;
          __syncthreads();
          if (nidle == 0) run_transposes(p, ws, lds, T_NITEMS - T_LATE2, T_NITEMS, vcu * NWAVES + wave, G * NWAVES);
          else if (vcu >= rem) run_transposes(p, ws, lds, T_NITEMS - T_LATE2, T_NITEMS, (vcu - rem) * NWAVES + wave, nidle * NWAVES); } });
#pragma unroll
    for (int ch = 0; ch < NCHUNK; ++ch) {
        PHASE(PH_MOE2_0 + 2 * ch, {
            build_moe_tables(lds, (const unsigned*)(ws + WS_CTL) + CW_CNT);
            Moe2Sched S{lds, G, vcu, ch, ws};
            EpiMoe2 E{(unsigned char*)(ws + WS_Y), PROBE_SKIP, lds};
            pg8::gemm_phase<EpiMoe2, Moe2Sched, false, true>(lds, 256, S, E); });
        PHASE(PH_COMB_0 + 2 * ch, { p_combine(p, vcu, G, ch); });
    }
#undef IN
}

extern "C" void kernel_launch(void* const* d_in, const int* in_sizes, int n_in, void* d_out, int out_size, void* d_ws, size_t ws_size, hipStream_t stream) {
    static int grid = 0;
    if (grid == 0) {
        if (n_in != 29 || out_size != NTOK * D || ws_size < WS_NEED) { fprintf(stderr, "kernel_launch: unexpected shapes n_in %d out %d ws %zu\n", n_in, out_size, ws_size); grid = -1; return; }
        int dev = 0, cus = 0, per_cu = 0;
        hipGetDevice(&dev); hipDeviceGetAttribute(&cus, hipDeviceAttributeMultiprocessorCount, dev);
        hipFuncSetAttribute((const void*)mega, hipFuncAttributeMaxDynamicSharedMemorySize, LDS_BYTES);
        hipOccupancyMaxActiveBlocksPerMultiprocessor(&per_cu, (const void*)mega, NTHR, LDS_BYTES);
        (void)hipGetLastError();
        grid = (per_cu >= 1) ? cus : -1;
        if (grid < 0) { fprintf(stderr, "kernel_launch: occupancy query says %d blocks/CU\n", per_cu); return; }
    }
    if (grid < 0) return;
    hipMemsetAsync((char*)d_ws + WS_CTL, 0, CTL_BYTES, stream);
    Params p{};
    for (int i = 0; i < 29; ++i) p.in[i] = (const float*)d_in[i];
    p.out = (float*)d_out; p.ws = (unsigned char*)d_ws;
    p.ph_lo = 0; p.ph_hi = PH_END;
    void* args[] = {&p};
    hipError_t e = hipLaunchCooperativeKernel((const void*)mega, dim3(grid), dim3(NTHR), args, LDS_BYTES, stream);
    if (e != hipSuccess) fprintf(stderr, "kernel_launch: cooperative launch failed: %s (grid %d)\n", hipGetErrorString(e), grid);
}
```
